# Optimizing an MI355X kernel written in HIP

```python
import math
import jax, jax.numpy as jnp
from jax import lax
import numpy as np

D_MODEL = 2048
BATCH = 4
SEQ = 4096
DEPTH = 2

CHUNK = 64
D_MIX = D_MODEL
HEAD_DIM = 128
LRU_HEADS = 6
D_LRU = LRU_HEADS * HEAD_DIM
CONV_A = 4
LRU_C = 8.0
CONV_GROUPS = 4
D_CONV = CONV_GROUPS * HEAD_DIM
CONV_B = 3
SB_HEADS = 6
D_SB = SB_HEADS * HEAD_DIM
Q_BLOCK = 128
IN_SPLIT_SIZES = (D_LRU, D_LRU, D_CONV, D_CONV, D_CONV, D_SB, D_SB, D_SB)
D_IN = 2 * D_LRU + 3 * D_CONV + 3 * D_SB
N_GROUPS = 4
EXPERTS_PER_GROUP = 8
N_EXPERTS = N_GROUPS * EXPERTS_PER_GROUP
TOP_K = 2
D_EXPERT = 512
ROW_BLOCK = 128
EPS = 1e-6

kernel_name = 'hymba_style_rglru_shortconv_stickbreak_hiermoe'


def rmsnorm(x, g):
    xf = x.astype(jnp.float32)
    y = xf * lax.rsqrt(jnp.mean(xf * xf, axis=-1, keepdims=True) + EPS)
    return (y * g.astype(jnp.float32)).astype(x.dtype)


def causal_depthwise_conv(x, w):
    k = w.shape[0]
    return lax.conv_general_dilated(x, w[:, None, :].astype(x.dtype), window_strides=(1,),
                                    padding=[(k - 1, 0)],
                                    dimension_numbers=('NWC', 'WIO', 'NWC'),
                                    feature_group_count=x.shape[-1])


def _linear_combine(c1, c2):
    a1, b1 = c1
    a2, b2 = c2
    return a1 * a2, a2 * b1 + b2


def rg_lru(x, w_a, b_a, w_x, b_x, lam):
    bsz, s, _ = x.shape
    xf = x.astype(jnp.float32)
    xh = xf.reshape(bsz, s, LRU_HEADS, HEAD_DIM)
    r = jax.nn.sigmoid(jnp.einsum('bshi,hij->bshj', xh, w_a.astype(jnp.float32)).reshape(bsz, s, D_LRU)
                       + b_a.astype(jnp.float32))
    i = jax.nn.sigmoid(jnp.einsum('bshi,hij->bshj', xh, w_x.astype(jnp.float32)).reshape(bsz, s, D_LRU)
                       + b_x.astype(jnp.float32))
    log_a = -LRU_C * r * jax.nn.softplus(-lam.astype(jnp.float32))
    a = jnp.exp(log_a)
    u = jnp.sqrt(-jnp.expm1(2.0 * log_a)) * (i * xf)
    _, h = lax.associative_scan(_linear_combine, (a, u), axis=1)
    return h.astype(x.dtype)


def stick_breaking_attention(q, k, v):
    s_len = q.shape[2]
    scale = 1.0 / math.sqrt(HEAD_DIM)
    outs = []
    for blk in range(s_len // Q_BLOCK):
        start = blk * Q_BLOCK
        end = start + Q_BLOCK
        qb = q[:, :, start:end]
        kb = k[:, :, :end]
        vb = v[:, :, :end]
        z = jnp.einsum('bhqd,bhkd->bhqk', qb, kb) * scale
        t_pos = start + jnp.arange(Q_BLOCK)[:, None]
        s_pos = jnp.arange(end)[None, :]
        mask = s_pos < t_pos
        log_keep = jnp.where(mask, jax.nn.log_sigmoid(-z), 0.0)
        suffix = lax.cumsum(log_keep, axis=3, reverse=True) - log_keep
        w = jnp.where(mask, jnp.exp(jax.nn.log_sigmoid(z) + suffix), 0.0)
        outs.append(jnp.einsum('bhqk,bhkd->bhqd', w, vb))
    return jnp.concatenate(outs, axis=2)


def hierarchical_moe(h, w_rg, b_rg, w_re, b_re, w_gate, w_up, w_down):
    bsz, s, d = h.shape
    t = bsz * s
    xt = h.reshape(t, d)
    grp_logits = (xt @ w_rg).astype(jnp.float32) + b_rg.astype(jnp.float32)
    grp_prob = jax.nn.softmax(grp_logits, axis=-1)
    g_idx = jnp.argmax(grp_logits, axis=-1)
    p_g = jnp.take_along_axis(grp_prob, g_idx[:, None], axis=-1)[:, 0]
    exp_logits = ((xt @ w_re).astype(jnp.float32) + b_re.astype(jnp.float32)).reshape(t, N_GROUPS, EXPERTS_PER_GROUP)
    in_grp = jnp.take_along_axis(exp_logits, g_idx[:, None, None], axis=1)[:, 0]
    top_p, top_i = lax.top_k(jax.nn.softmax(in_grp, axis=-1), TOP_K)
    top_p = top_p / jnp.sum(top_p, axis=-1, keepdims=True)
    gates = p_g[:, None] * top_p
    expert_ids = g_idx[:, None] * EXPERTS_PER_GROUP + top_i

    tk = t * TOP_K
    flat_e = expert_ids.reshape(tk).astype(jnp.int32)
    flat_g = gates.reshape(tk)
    flat_tok = jnp.repeat(jnp.arange(t, dtype=jnp.int32), TOP_K)
    order = jnp.argsort(flat_e)
    e_sorted = flat_e[order]
    tok_sorted = flat_tok[order]
    g_sorted = flat_g[order]
    counts = jnp.zeros((N_EXPERTS,), jnp.int32).at[flat_e].add(1)
    padded = (counts + ROW_BLOCK - 1) // ROW_BLOCK * ROW_BLOCK
    starts = jnp.cumsum(counts) - counts
    pends = jnp.cumsum(padded)
    pstarts = pends - padded
    dest = pstarts[e_sorted] + (jnp.arange(tk, dtype=jnp.int32) - starts[e_sorted])
    n_blocks = -(-tk // ROW_BLOCK) + N_EXPERTS
    rows = n_blocks * ROW_BLOCK
    x_pad = jnp.zeros((rows, d), xt.dtype).at[dest].set(xt[tok_sorted])
    tok_pad = jnp.full((rows,), t, jnp.int32).at[dest].set(tok_sorted)
    gate_pad = jnp.zeros((rows,), jnp.float32).at[dest].set(g_sorted)
    block_start = jnp.arange(n_blocks, dtype=jnp.int32) * ROW_BLOCK
    block_expert = jnp.minimum(jnp.searchsorted(pends, block_start, side='right'), N_EXPERTS - 1)

    def expert_block(args):
        xb, e = args
        hid = jax.nn.silu(xb @ w_gate[e]) * (xb @ w_up[e])
        return hid @ w_down[e]

    y_pad = lax.map(expert_block, (x_pad.reshape(n_blocks, ROW_BLOCK, d), block_expert))
    y_pad = y_pad.reshape(rows, d) * gate_pad[:, None].astype(y_pad.dtype)
    out = jax.ops.segment_sum(y_pad, tok_pad, num_segments=t + 1)[:t]
    return out.reshape(bsz, s, d)


def setup_inputs(seed: int = 0) -> dict:
    key = jax.random.key(seed)
    ks = jax.random.split(key, 24)
    f32 = jnp.float32
    nrm = lambda k, shape, sc: jax.random.normal(k, shape, f32) * sc
    u = jax.random.uniform(ks[9], (DEPTH, D_LRU), f32, minval=0.9, maxval=0.999)
    sig = u ** (1.0 / LRU_C)
    lam = jnp.log(sig) - jnp.log1p(-sig)
    return {
        'x': jax.random.normal(ks[0], (BATCH, SEQ, D_MODEL), f32),
        'norm_mix': 1.0 + nrm(ks[1], (DEPTH, D_MODEL), 0.1),
        'w_in': nrm(ks[2], (DEPTH, D_MODEL, D_IN), D_MODEL ** -0.5),
        'conv_a_w': nrm(ks[3], (DEPTH, CONV_A, D_LRU), CONV_A ** -0.5),
        'conv_a_b': nrm(ks[4], (DEPTH, D_LRU), 0.02),
        'lru_wa': nrm(ks[5], (DEPTH, LRU_HEADS, HEAD_DIM, HEAD_DIM), HEAD_DIM ** -0.5),
        'lru_ba': nrm(ks[6], (DEPTH, D_LRU), 0.02),
        'lru_wx': nrm(ks[7], (DEPTH, LRU_HEADS, HEAD_DIM, HEAD_DIM), HEAD_DIM ** -0.5),
        'lru_bx': nrm(ks[8], (DEPTH, D_LRU), 0.02),
        'lru_lam': lam,
        'conv_b_w': nrm(ks[10], (DEPTH, CONV_B, D_CONV), CONV_B ** -0.5),
        'q_norm': 1.0 + nrm(ks[11], (DEPTH, HEAD_DIM), 0.1),
        'k_norm': 1.0 + nrm(ks[12], (DEPTH, HEAD_DIM), 0.1),
        'mix_norm': 1.0 + nrm(ks[13], (DEPTH, D_MIX), 0.1),
        'w_out': nrm(ks[14], (DEPTH, D_MIX, D_MODEL), D_MIX ** -0.5),
        'norm_ffn': 1.0 + nrm(ks[15], (DEPTH, D_MODEL), 0.1),
        'w_router_group': nrm(ks[16], (DEPTH, D_MODEL, N_GROUPS), D_MODEL ** -0.5),
        'b_router_group': nrm(ks[17], (DEPTH, N_GROUPS), 0.01),
        'w_router_expert': nrm(ks[18], (DEPTH, D_MODEL, N_EXPERTS), D_MODEL ** -0.5),
        'b_router_expert': nrm(ks[19], (DEPTH, N_EXPERTS), 0.01),
        'w_gate': nrm(ks[20], (DEPTH, N_EXPERTS, D_MODEL, D_EXPERT), D_MODEL ** -0.5),
        'w_up': nrm(ks[21], (DEPTH, N_EXPERTS, D_MODEL, D_EXPERT), D_MODEL ** -0.5),
        'w_down': nrm(ks[22], (DEPTH, N_EXPERTS, D_EXPERT, D_MODEL), D_EXPERT ** -0.5),
    }


def reference(x, norm_mix, w_in, conv_a_w, conv_a_b, lru_wa, lru_ba, lru_wx, lru_bx, lru_lam,
              conv_b_w, q_norm, k_norm, mix_norm, w_out, norm_ffn, w_router_group, b_router_group,
              w_router_expert, b_router_expert, w_gate, w_up, w_down):
    bsz, s, _ = x.shape
    split_idx = [int(c) for c in np.cumsum(IN_SPLIT_SIZES)[:-1]]
    for l in range(DEPTH):
        h = rmsnorm(x, norm_mix[l])
        proj = h @ w_in[l]
        xa, ga, bg, cg, xb, q, k, v = jnp.split(proj, split_idx, axis=-1)
        xa = causal_depthwise_conv(xa, conv_a_w[l]) + conv_a_b[l].astype(xa.dtype)
        ya = rg_lru(xa, lru_wa[l], lru_ba[l], lru_wx[l], lru_bx[l], lru_lam[l]) * jax.nn.gelu(ga)
        yb = bg * causal_depthwise_conv(cg * xb, conv_b_w[l])
        to_heads = lambda z: z.reshape(bsz, s, SB_HEADS, HEAD_DIM).transpose(0, 2, 1, 3).astype(jnp.float32)
        qh = to_heads(rmsnorm(q.reshape(bsz, s, SB_HEADS, HEAD_DIM), q_norm[l]))
        kh = to_heads(rmsnorm(k.reshape(bsz, s, SB_HEADS, HEAD_DIM), k_norm[l]))
        vh = to_heads(v)
        yc = stick_breaking_attention(qh, kh, vh).transpose(0, 2, 1, 3).reshape(bsz, s, D_SB).astype(x.dtype)
        y = jnp.concatenate([ya, yb, yc], axis=-1)
        y = rmsnorm(y.reshape(bsz, s, D_MIX // HEAD_DIM, HEAD_DIM), jnp.ones((HEAD_DIM,), jnp.float32))
        y = y.reshape(bsz, s, D_MIX) * mix_norm[l].astype(y.dtype)
        x = x + y @ w_out[l]
        h2 = rmsnorm(x, norm_ffn[l])
        x = x + hierarchical_moe(h2, w_router_group[l], b_router_group[l], w_router_expert[l],
                                 b_router_expert[l], w_gate[l], w_up[l], w_down[l])
    return x
```

```cpp
#include <hip/hip_runtime.h>
#include <stdint.h>
#include <stdio.h>

typedef unsigned short bf16_t;
typedef float f32x4 __attribute__((ext_vector_type(4)));
typedef unsigned u32x4 __attribute__((ext_vector_type(4)));
typedef unsigned u32x2 __attribute__((ext_vector_type(2)));

constexpr int T = 16384, DM = 2048, DIN = 5376, DPROJ = 4608, SEQ = 4096, NB = 4, DEPTH = 2;
constexpr int DLRU = 768, DCONV = 512, DSB = 768, HD = 128, NHL = 6, NHS = 6;
constexpr int NEXP = 32, DEXP = 512, MAXTILES = 160, PADROWS = MAXTILES * 256;
constexpr float EPS = 1e-6f;
constexpr float YSCALE_G = 8.0f;
constexpr int VTS = SEQ + 64;
constexpr int C_XA = 0, C_GA = 768, C_BG = 1536, C_CG = 2048, C_XB = 2560, C_Q = 3072, C_K = 3840, C_V = 4608;

constexpr size_t AL(size_t x) { return (x + 255) & ~(size_t)255; }
constexpr size_t SZ_WIN = (size_t)DIN * DM * 2, SZ_WOUT = (size_t)DM * DM * 2, SZ_WGU = (size_t)NEXP * 1024 * DM * 2, SZ_WD = (size_t)NEXP * DM * DEXP * 2;
constexpr size_t SZ_WA = (size_t)NHL * HD * HD * 2, SZ_WR = (size_t)48 * DM * 4;
constexpr size_t OFF_CTL = 0, SZ_CTL = 131072;
constexpr size_t OFF_WIN = OFF_CTL + SZ_CTL;
constexpr size_t OFF_WOUT = OFF_WIN + DEPTH * SZ_WIN;
constexpr size_t OFF_WGU = OFF_WOUT + DEPTH * SZ_WOUT;
constexpr size_t OFF_WD = OFF_WGU + DEPTH * SZ_WGU;
constexpr size_t OFF_WA = OFF_WD + DEPTH * SZ_WD;
constexpr size_t OFF_WX = OFF_WA + DEPTH * SZ_WA;
constexpr size_t OFF_WR = OFF_WX + DEPTH * SZ_WA;
constexpr size_t OFF_HB = OFF_WR + DEPTH * SZ_WR;
constexpr size_t OFF_PROJ = OFF_HB + (size_t)T * DM * 2;
constexpr size_t OFF_VT = OFF_PROJ + (size_t)T * DPROJ * 2;
constexpr size_t OFF_YPAD = OFF_PROJ;
constexpr size_t OFF_YMIX = OFF_VT + (size_t)NB * NHS * HD * VTS * 2;
constexpr size_t OFF_X = OFF_YMIX + (size_t)T * DM * 2;
constexpr size_t OFF_HID = OFF_X + (size_t)T * DM * 4;
constexpr size_t OFF_AGG = OFF_HID + (size_t)PADROWS * DEXP * 2;
constexpr size_t OFF_ROUTE = OFF_AGG + (size_t)256 * DLRU * 8;
constexpr size_t OFF_LIST = OFF_ROUTE + (size_t)T * 8 * 4;
constexpr size_t OFF_LISTR = OFF_LIST + (size_t)NEXP * T * 4;
constexpr size_t OFF_DB = OFF_LISTR + (size_t)NEXP * T * 4;
constexpr size_t WS_END = OFF_DB + (size_t)T * DM * 2;
static_assert((size_t)PADROWS * DM * 2 <= (size_t)T * DPROJ * 2 + (size_t)NB * NHS * HD * VTS * 2, "YPAD alias");
constexpr int CW_RT = 16384;
constexpr int CW_CNT = 8192;

typedef __bf16 bf16v2_t __attribute__((ext_vector_type(2)));
typedef float f32v2_t __attribute__((ext_vector_type(2)));
__device__ __forceinline__ unsigned cvt_pk_bf16(float lo, float hi) { const f32v2_t f = {lo, hi}; const bf16v2_t b = __builtin_convertvector(f, bf16v2_t); return __builtin_bit_cast(unsigned, b); }
__device__ __forceinline__ bf16_t f2bf(float f) { return (bf16_t)(cvt_pk_bf16(f, 0.f) & 0xffffu); }
__device__ __forceinline__ float bf2f(bf16_t b) { return __uint_as_float(((unsigned)b) << 16); }
__device__ __forceinline__ float bflo(unsigned w) { return __uint_as_float(w << 16); }
__device__ __forceinline__ float bfhi(unsigned w) { return __uint_as_float(w & 0xffff0000u); }
__device__ __forceinline__ float wave_sum(float v) {
#pragma unroll
    for (int o = 32; o >= 1; o >>= 1) v += __shfl_xor(v, o);
    return v;
}
__device__ __forceinline__ float fast_exp(float x) { return __builtin_amdgcn_exp2f(x * 1.4426950408889634f); }
__device__ __forceinline__ float sigmoidf_(float x) { return __builtin_amdgcn_rcpf(1.0f + fast_exp(-x)); }
__device__ __forceinline__ float one_minus_exp(float x) { const float s = -x * (1.0f + x * (0.5f + x * 0.16666667f)); const float d = 1.0f - fast_exp(x); return x > -0.02f ? s : d; }
__device__ __forceinline__ float softplusf_(float x) { return fmaxf(x, 0.f) + log1pf(__expf(-fabsf(x))); }
__device__ __forceinline__ float gelu_tanh(float x) { const float u2 = 1.5957691216057308f * (x + 0.044715f * x * x * x); return x * sigmoidf_(u2); }

__device__ __forceinline__ int otid() { int t = (int)threadIdx.x; asm volatile("" : "+v"(t)); return t; }
__device__ __forceinline__ int obid() { int b = (int)blockIdx.x; asm volatile("" : "+s"(b)); return b; }
#ifndef PROBE_SUB
#define PROBE_SUB 0
#endif
struct Params { const float* in[23]; float* out; unsigned char* ws; int ph_lo, ph_hi; };

struct InProxy { const float* const* p; int z; __device__ __forceinline__ const float* operator[](int k) const { return p[k + z]; } };
struct Ctx {
    InProxy in; float* out; unsigned char* ws;
    __device__ __forceinline__ unsigned* ctl() const { return (unsigned*)(ws + OFF_CTL); }
    __device__ __forceinline__ bf16_t* WIN(int l) const { return (bf16_t*)(ws + OFF_WIN + l * SZ_WIN); }
    __device__ __forceinline__ bf16_t* WOUT(int l) const { return (bf16_t*)(ws + OFF_WOUT + l * SZ_WOUT); }
    __device__ __forceinline__ bf16_t* WGU(int l) const { return (bf16_t*)(ws + OFF_WGU + l * SZ_WGU); }
    __device__ __forceinline__ bf16_t* WD(int l) const { return (bf16_t*)(ws + OFF_WD + l * SZ_WD); }
    __device__ __forceinline__ bf16_t* WA(int l) const { return (bf16_t*)(ws + OFF_WA + l * SZ_WA); }
    __device__ __forceinline__ bf16_t* WX(int l) const { return (bf16_t*)(ws + OFF_WX + l * SZ_WA); }
    __device__ __forceinline__ float* WR(int l) const { return (float*)(ws + OFF_WR + l * SZ_WR); }
    __device__ __forceinline__ unsigned* RTC(int l) const { return ctl() + CW_RT + l * 8192; }
    __device__ __forceinline__ unsigned* CNT(int l) const { return ctl() + CW_CNT + l * 2048; }
#define WSP(name, type, off) __device__ __forceinline__ type* name() const { return (type*)(ws + (off)); }
    WSP(HB, bf16_t, OFF_HB) WSP(PROJ, bf16_t, OFF_PROJ) WSP(VT, bf16_t, OFF_VT) WSP(YPAD, bf16_t, OFF_YPAD) WSP(YPAD8, unsigned char, OFF_YPAD) WSP(YMIX, bf16_t, OFF_YMIX) WSP(HID, bf16_t, OFF_HID)
    WSP(X, float, OFF_X) WSP(XB, bf16_t, OFF_X) WSP(AGG, float, OFF_AGG) WSP(ROUTE, unsigned, OFF_ROUTE) WSP(LIST, int, OFF_LIST) WSP(LISTR, float, OFF_LISTR) WSP(PT, bf16_t, OFF_X + (size_t)T * DM * 2) WSP(X1, bf16_t, OFF_X + (size_t)T * DM * 2) WSP(DB, bf16_t, OFF_DB) WSP(HL, bf16_t, OFF_DB) WSP(PL, bf16_t, OFF_DB + (size_t)T * DLRU * 2)
#undef WSP
};

__device__ __forceinline__ Ctx octx(const Ctx& c) { int z = 0; asm volatile("" : "+s"(z)); Ctx r; r.in.p = c.in.p; r.in.z = z; r.out = c.out + z; r.ws = c.ws + z; return r; }

__device__ __forceinline__ void cvt_tile_out(const float* tile, int st, int r0, bf16_t* dst, int ld_dst, int drow0) {
    const int rr = (st & 7) * 8;
#pragma unroll
    for (int p = 0; p < 2; ++p) {
        const int c = (st >> 3) + 32 * p;
        u32x4 w;
        w.x = cvt_pk_bf16(tile[(rr + 0) * 65 + c], tile[(rr + 1) * 65 + c]); w.y = cvt_pk_bf16(tile[(rr + 2) * 65 + c], tile[(rr + 3) * 65 + c]);
        w.z = cvt_pk_bf16(tile[(rr + 4) * 65 + c], tile[(rr + 5) * 65 + c]); w.w = cvt_pk_bf16(tile[(rr + 6) * 65 + c], tile[(rr + 7) * 65 + c]);
        __builtin_nontemporal_store(w, (u32x4*)(dst + (size_t)(drow0 + c) * ld_dst + r0 + rr));
    }
}
constexpr int CV_WIN = 32 * 84, CV_WOUT = 32 * 32, CV_EXP = 32 * 8  , CV_G = NEXP * CV_EXP, CV_LRU = NHL * 4;
constexpr int CV_PER_LAYER = CV_WIN + CV_WOUT + 3 * CV_G + 2 * CV_LRU;
struct CvtTile { const float* src; bf16_t* dst; const float* gk; int ld_src, ld_dst, r0, c0, drow0; };
__device__ __forceinline__ void cvt_decode(const Ctx& c, int id, CvtTile& t) {
    const int l = id / CV_PER_LAYER; int j = id % CV_PER_LAYER; t.gk = nullptr;
    if (j < CV_WIN) { t.src = c.in[2] + (size_t)l * DM * DIN; t.ld_src = DIN; { const int g = j >> 3, kp = g / 21, nq = g % 21; t.r0 = (2 * kp + ((j >> 2) & 1)) * 64; t.c0 = (4 * nq + (j & 3)) * 64; } t.dst = c.WIN(l); t.ld_dst = DM; t.drow0 = t.c0; }
    else if ((j -= CV_WIN) < CV_WOUT) { t.src = c.in[14] + (size_t)l * DM * DM; t.ld_src = DM; { const int g = j >> 3, kp = g / 8, nq = g % 8; t.r0 = (2 * kp + ((j >> 2) & 1)) * 64; t.c0 = (4 * nq + (j & 3)) * 64; } t.dst = c.WOUT(l); t.ld_dst = DM; t.drow0 = t.c0; }
    else if ((j -= CV_WOUT) < 2 * CV_G) {
        const int isup = j / CV_G; j %= CV_G; const int e = j / CV_EXP; j %= CV_EXP;
        t.src = c.in[isup ? 21 : 20] + ((size_t)l * NEXP + e) * DM * DEXP; t.ld_src = DEXP; { const int g = j >> 3, kp = g / 2, nq = g % 2; t.r0 = (2 * kp + ((j >> 2) & 1)) * 64; t.c0 = (4 * nq + (j & 3)) * 64; }
        t.dst = c.WGU(l) + (size_t)e * 1024 * DM; t.ld_dst = DM; t.drow0 = 256 * (t.c0 / 128) + 128 * isup + (t.c0 % 128); t.gk = c.in[15] + (size_t)l * DM;
    } else if ((j -= 2 * CV_G) < CV_G) {
        const int e = j / CV_EXP; j %= CV_EXP;
        t.src = c.in[22] + ((size_t)l * NEXP + e) * DEXP * DM; t.ld_src = DM; { const int g = j >> 3, kp = g / 8, nq = g % 8; t.r0 = (2 * kp + ((j >> 2) & 1)) * 64; t.c0 = (4 * nq + (j & 3)) * 64; }
        t.dst = c.WD(l) + (size_t)e * DM * DEXP; t.ld_dst = DEXP; t.drow0 = t.c0;
    } else { j -= CV_G; const int isx = j / CV_LRU; j %= CV_LRU; const int h = j / 4; j %= 4;
        t.src = c.in[isx ? 7 : 5] + ((size_t)l * NHL + h) * HD * HD; t.ld_src = HD; t.r0 = (j / 2) * 64; t.c0 = (j % 2) * 64;
        t.dst = (isx ? c.WX(l) : c.WA(l)) + (size_t)h * HD * HD; t.ld_dst = HD; t.drow0 = t.c0; }
}
constexpr int CVT_NT = 4;
__device__ __forceinline__ void phase_convert(const Ctx& c, float* lds) {
    const int tid = otid(), sb = tid >> 8, st = tid & 255;
    float* tile0 = lds + sb * (CVT_NT * 64 * 65);
    const int total = DEPTH * CV_PER_LAYER;
    const int nsub = gridDim.x * 2 * CVT_NT;
    const int idb = (obid() * 2 + sb) * CVT_NT;
    CvtTile tA[CVT_NT]; f32x4 vA[CVT_NT][4];
#define CVT_LOAD(T_, V_, base_) do { _Pragma("unroll") for (int k = 0; k < CVT_NT; ++k) { const int id_ = (base_) + idb + k; cvt_decode(c, id_ < total ? id_ : 0, T_[k]); \
        _Pragma("unroll") for (int i = 0; i < 4; ++i) V_[k][i] = __builtin_nontemporal_load((const f32x4*)(T_[k].src + (size_t)(T_[k].r0 + (st >> 4) + 16 * i) * T_[k].ld_src + T_[k].c0 + (st & 15) * 4)); } } while (0)
#define CVT_FLUSH(T_, V_, base_) do { _Pragma("unroll") for (int k = 0; k < CVT_NT; ++k) _Pragma("unroll") for (int i = 0; i < 4; ++i) { \
            float* p = tile0 + k * (64 * 65) + ((st >> 4) + 16 * i) * 65 + (st & 15) * 4; const float gs_ = T_[k].gk ? T_[k].gk[T_[k].r0 + (st >> 4) + 16 * i] : 1.0f; \
            p[0] = V_[k][i][0] * gs_; p[1] = V_[k][i][1] * gs_; p[2] = V_[k][i][2] * gs_; p[3] = V_[k][i][3] * gs_; } \
        __syncthreads(); \
        _Pragma("unroll") for (int k = 0; k < CVT_NT; ++k) if ((base_) + idb + k < total) cvt_tile_out(tile0 + k * (64 * 65), st, T_[k].r0, T_[k].dst, T_[k].ld_dst, T_[k].drow0); \
        __syncthreads(); } while (0)
    for (int base = 0; base < total; base += nsub) { CVT_LOAD(tA, vA, base); CVT_FLUSH(tA, vA, base); }
#undef CVT_LOAD
#undef CVT_FLUSH
    for (int i = obid() * blockDim.x + tid; i < DEPTH * 48 * DM; i += gridDim.x * blockDim.x) {
        const int l = i / (48 * DM), n = (i / DM) % 48, k = i % DM;
        float v = 0.f;
        if (n < 4) v = c.in[16][((size_t)l * DM + k) * 4 + n]; else if (n < 36) v = c.in[18][((size_t)l * DM + k) * 32 + (n - 4)];
        c.WR(l)[(size_t)n * DM + k] = v * c.in[15][(size_t)l * DM + k];
    }
}

__device__ __forceinline__ void norm_store_row(const f32x4 (&v)[8], const float* g, bf16_t* dst, int lane) {
    float s = 0.f;
#pragma unroll
    for (int j = 0; j < 8; ++j) s += v[j][0] * v[j][0] + v[j][1] * v[j][1] + v[j][2] * v[j][2] + v[j][3] * v[j][3];
    s = wave_sum(s);
    const float rstd = rsqrtf(s * (1.0f / DM) + EPS);
#pragma unroll
    for (int j = 0; j < 8; ++j) {
        const f32x4 gg = *(const f32x4*)(g + j * 256 + lane * 4);
        u32x2 w; w.x = cvt_pk_bf16(v[j][0] * rstd * gg[0], v[j][1] * rstd * gg[1]); w.y = cvt_pk_bf16(v[j][2] * rstd * gg[2], v[j][3] * rstd * gg[3]);
        *(u32x2*)(dst + j * 256 + lane * 4) = w;
    }
}
__device__ __forceinline__ void phase_norm_in(const Ctx& c, int l) {
    const int tid = otid(), lane = tid & 63, wv = tid >> 6, stride = gridDim.x * 8;
    for (int r = obid() * 8 + wv; r < T; r += 4 * stride) {
        f32x4 v[4][8];
#pragma unroll
        for (int k = 0; k < 4; ++k) { const int rr = (r + k * stride < T) ? r + k * stride : r;
#pragma unroll
            for (int j = 0; j < 8; ++j) v[k][j] = *(const f32x4*)(c.in[0] + (size_t)rr * DM + j * 256 + lane * 4); }
#pragma unroll
        for (int k = 0; k < 4; ++k) if (k == 0 || r + k * stride < T) norm_store_row(v[k], c.in[1] + (size_t)l * DM, c.HB() + (size_t)(r + k * stride) * DM, lane);
    }
}

struct MoeTab { int cnt[NEXP]; int tstart[NEXP + 1]; int texp[MAXTILES]; };
__device__ __forceinline__ void build_moe_tab(const Ctx& c, int l, MoeTab* mt) {
    __syncthreads();
    const int tid = otid();
    if (tid < 64) {
        const int n = tid < NEXP ? (int)__hip_atomic_load(c.CNT(l) + tid * 64, __ATOMIC_RELAXED, __HIP_MEMORY_SCOPE_AGENT) : 0;
        const int nt = (n + 255) >> 8;
        int incl = nt;
#pragma unroll
        for (int o = 1; o < 32; o <<= 1) { const int v = __shfl_up(incl, o); if (tid >= o) incl += v; }
        const int excl = incl - nt;
        if (tid < NEXP) { mt->cnt[tid] = n; mt->tstart[tid] = excl; for (int i = 0; i < nt; ++i) if (excl + i < MAXTILES) mt->texp[excl + i] = tid; }
        if (tid == NEXP - 1) mt->tstart[NEXP] = incl < MAXTILES ? incl : MAXTILES;
    }
    __syncthreads();
}

template <bool DRY> __device__ __forceinline__ void phase_combine(const Ctx& c, int l, const MoeTab* mt) {
    const int tid = otid(), lane = tid & 63, wv = tid >> 6, stride = gridDim.x * 8;
    bf16_t* XB = c.XB(); const bf16_t* X1 = c.X1(); const unsigned char* YPAD = c.YPAD8(); const unsigned* ROUTE = c.ROUTE();
    for (int r = obid() * 8 + wv; r < T; r += 2 * stride) {
        f32x4 v[2][8]; unsigned ya[2][8], yb[2][8]; u32x2 yd[2][8]; float g0[2], g1[2]; int rr[2];
#pragma unroll
        for (int k = 0; k < 2; ++k) {
            rr[k] = (r + k * stride < T) ? r + k * stride : r;
            const u32x4 ra = *(const u32x4*)(ROUTE + (size_t)rr[k] * 8); const u32x2 rb = *(const u32x2*)(ROUTE + (size_t)rr[k] * 8 + 4);
            const int e0 = ra.x, p0 = ra.y, e1 = ra.w, p1 = rb.x; g0[k] = __uint_as_float(ra.z) * (1.0f / YSCALE_G); g1[k] = __uint_as_float(rb.y) * (1.0f / YSCALE_G);
            const unsigned char* y0 = YPAD + ((size_t)mt->tstart[e0] * 256 + p0) * DM + lane * 4; const unsigned char* y1 = YPAD + ((size_t)mt->tstart[e1] * 256 + p1) * DM + lane * 4;
            const bf16_t* dp = X1 + (size_t)rr[k] * DM + lane * 4;
#pragma unroll
            for (int j = 0; j < 8; ++j) { v[k][j] = (f32x4){0.f, 0.f, 0.f, 0.f};
                ya[k][j] = *(const unsigned*)(y0 + j * 256); yb[k][j] = *(const unsigned*)(y1 + j * 256); yd[k][j] = *(const u32x2*)(dp + j * 256); }
        }
        __builtin_amdgcn_sched_barrier(0);
#pragma unroll
        for (int k = 0; k < 2; ++k) {
            if (k == 0 || r + stride < T) {
#pragma unroll
                for (int j = 0; j < 8; ++j) {
                    typedef float f32x2_t __attribute__((ext_vector_type(2)));
                    const f32x2_t a01 = __builtin_amdgcn_cvt_pk_f32_fp8((int)ya[k][j], false), a23 = __builtin_amdgcn_cvt_pk_f32_fp8((int)ya[k][j], true);
                    const f32x2_t b01 = __builtin_amdgcn_cvt_pk_f32_fp8((int)yb[k][j], false), b23 = __builtin_amdgcn_cvt_pk_f32_fp8((int)yb[k][j], true);
                    v[k][j][0] += bflo(yd[k][j].x) + g0[k] * a01.x + g1[k] * b01.x; v[k][j][1] += bfhi(yd[k][j].x) + g0[k] * a01.y + g1[k] * b01.y;
                    v[k][j][2] += bflo(yd[k][j].y) + g0[k] * a23.x + g1[k] * b23.x; v[k][j][3] += bfhi(yd[k][j].y) + g0[k] * a23.y + g1[k] * b23.y;
                }
                if (l == DEPTH - 1) {
                    if (!DRY) {
#pragma unroll
                    for (int j = 0; j < 8; ++j) *(f32x4*)(c.out + (size_t)rr[k] * DM + j * 256 + lane * 4) = v[k][j]; }
                    else norm_store_row(v[k], c.in[1], c.HB() + (size_t)rr[k] * DM, lane);
                } else {
                    if (!DRY) {
#pragma unroll
                    for (int j = 0; j < 8; ++j) { u32x2 xw; xw.x = cvt_pk_bf16(v[k][j][0], v[k][j][1]); xw.y = cvt_pk_bf16(v[k][j][2], v[k][j][3]); *(u32x2*)(XB + (size_t)rr[k] * DM + j * 256 + lane * 4) = xw; } }
                    norm_store_row(v[k], c.in[1] + (size_t)(l + 1) * DM, c.HB() + (size_t)rr[k] * DM, lane);
                }
            }
        }
    }
}

__device__ __forceinline__ void phase_router_mfma(const Ctx& c, int l, float* lds) {
    float* LG = lds; float* SS = lds + 6656; float* RS = lds + 6784; int* LC = (int*)(lds + 6848); int* LB = (int*)(lds + 6880);
    const int tid = otid(), lane = tid & 63, wv = tid >> 6, rt = wv & 3, kh = wv >> 2, q = lane >> 4, l15 = lane & 15;
    const float* WR = c.WR(l); const float* X = c.in[0]; const bf16_t* XB = c.XB(); const bf16_t* DBp = c.DB();
    for (int tile = obid(); tile < T / 64; tile += gridDim.x) {
        const int r0 = tile * 64;
        f32x4 acc[3];
#pragma unroll
        for (int ct = 0; ct < 3; ++ct) acc[ct] = (f32x4){0.f, 0.f, 0.f, 0.f};
        const int lr = lane >> 4, kc = lane & 15;
        float* TB = lds + 8192 + wv * 1088;
        const size_t rowb = (size_t)(r0 + 16 * rt + lr) * DM + kh * 1024 + 4 * kc;
        const float* wp = WR + (size_t)l15 * DM + kh * 1024 + 4 * q;
        const float* gp = c.in[15] + (size_t)l * DM + kh * 1024 + 4 * kc;
        bf16_t* HBp = c.HB(); bf16_t* X1p = c.X1();
        float ssr[4] = {0.f, 0.f, 0.f, 0.f};
        f32x4 xn[4]; u32x2 xbn[4], dn[4];
#define RT_LOAD(b_) do { _Pragma("unroll") for (int i = 0; i < 4; ++i) { const size_t o_ = rowb + (size_t)(4 * i) * DM + 64 * (b_); \
            if (l == 0) xn[i] = *(const f32x4*)(X + o_); else xbn[i] = *(const u32x2*)(XB + o_); dn[i] = *(const u32x2*)(DBp + o_); } } while (0)
        RT_LOAD(0);
#pragma unroll 1
        for (int bk = 0; bk < 16; ++bk) {
            f32x4 x1[4];
#pragma unroll
            for (int i = 0; i < 4; ++i) {
                if (l == 0) x1[i] = xn[i]; else x1[i] = (f32x4){bflo(xbn[i].x), bfhi(xbn[i].x), bflo(xbn[i].y), bfhi(xbn[i].y)};
                x1[i][0] += bflo(dn[i].x); x1[i][1] += bfhi(dn[i].x); x1[i][2] += bflo(dn[i].y); x1[i][3] += bfhi(dn[i].y);
            }
            if (bk < 15) RT_LOAD(bk + 1);
#pragma unroll
            for (int i = 0; i < 4; ++i) {
                ssr[i] += x1[i][0] * x1[i][0] + x1[i][1] * x1[i][1] + x1[i][2] * x1[i][2] + x1[i][3] * x1[i][3];
                { u32x2 xw; xw.x = cvt_pk_bf16(x1[i][0], x1[i][1]); xw.y = cvt_pk_bf16(x1[i][2], x1[i][3]); *(u32x2*)(X1p + rowb + (size_t)(4 * i) * DM + 64 * bk) = xw; }
                *(f32x4*)(TB + (4 * i + lr) * 68 + 4 * kc) = x1[i];
            }
#pragma unroll
            for (int cc = 0; cc < 4; ++cc) {
                const f32x4 xv = *(const f32x4*)(TB + l15 * 68 + 16 * cc + 4 * q);
                f32x4 wv[3];
#pragma unroll
                for (int ct = 0; ct < 3; ++ct) wv[ct] = *(const f32x4*)(wp + (size_t)(16 * ct) * DM + 64 * bk + 16 * cc);
#pragma unroll
                for (int j = 0; j < 4; ++j)
#pragma unroll
                    for (int ct = 0; ct < 3; ++ct) acc[ct] = __builtin_amdgcn_mfma_f32_16x16x4f32(xv[j], wv[ct][j], acc[ct], 0, 0, 0);
            }
        }
#undef RT_LOAD
#pragma unroll
        for (int i = 0; i < 4; ++i) { float v = ssr[i]; v += __shfl_xor(v, 1); v += __shfl_xor(v, 2); v += __shfl_xor(v, 4); v += __shfl_xor(v, 8); if (kc == 0) SS[kh * 64 + 16 * rt + 4 * i + lr] = v; }

#pragma unroll
        for (int ct = 0; ct < 3; ++ct)
#pragma unroll
            for (int i = 0; i < 4; ++i) LG[(kh * 64 + 16 * rt + 4 * q + i) * 52 + 16 * ct + l15] = acc[ct][i];
        if (tid < NEXP) LC[tid] = 0;
        __syncthreads();
        int e0 = 0, e1 = 0, k0_ = 0, k1_ = 0; float rstd_ = 0.f, g0_ = 0.f, g1_ = 0.f;
        if (tid < 64) {
            const float rstd = rsqrtf((SS[tid] + SS[64 + tid]) * (1.0f / DM) + EPS);
            RS[tid] = rstd;
            float gl[4], el[8];
#pragma unroll
            for (int i = 0; i < 4; ++i) gl[i] = (LG[tid * 52 + i] + LG[(64 + tid) * 52 + i]) * rstd + c.in[17][l * 4 + i];
            int gi = 0; float gm = gl[0];
#pragma unroll
            for (int i = 1; i < 4; ++i) if (gl[i] > gm) { gm = gl[i]; gi = i; }
            float gs = 0.f;
#pragma unroll
            for (int i = 0; i < 4; ++i) gs += __expf(gl[i] - gm);
            const float pg = 1.0f / gs;
#pragma unroll
            for (int i = 0; i < 8; ++i) { const int n = 4 + gi * 8 + i; el[i] = (LG[tid * 52 + n] + LG[(64 + tid) * 52 + n]) * rstd + c.in[19][l * 32 + gi * 8 + i]; }
            int i0 = 0; float m0 = el[0];
#pragma unroll
            for (int i = 1; i < 8; ++i) if (el[i] > m0) { m0 = el[i]; i0 = i; }
            int i1 = -1; float m1 = -3.0e38f;
#pragma unroll
            for (int i = 0; i < 8; ++i) if (i != i0 && el[i] > m1) { m1 = el[i]; i1 = i; }
            const float ex1 = __expf(m1 - m0), den = 1.0f + ex1;
            const float g0 = pg / den, g1 = pg * ex1 / den;
            e0 = gi * 8 + i0; e1 = gi * 8 + i1; rstd_ = rstd; g0_ = g0; g1_ = g1;
            k0_ = (int)__hip_atomic_fetch_add(&LC[e0], 1, __ATOMIC_RELAXED, __HIP_MEMORY_SCOPE_WORKGROUP);
            k1_ = (int)__hip_atomic_fetch_add(&LC[e1], 1, __ATOMIC_RELAXED, __HIP_MEMORY_SCOPE_WORKGROUP);
        }
        __syncthreads();
        if (tid < NEXP) { const int n = LC[tid]; LB[tid] = n > 0 ? (int)__hip_atomic_fetch_add(c.CNT(l) + tid * 64, (unsigned)n, __ATOMIC_RELAXED, __HIP_MEMORY_SCOPE_AGENT) : 0; }
        __syncthreads();
        if (tid < 64) {
            const int r = r0 + tid, p0 = LB[e0] + k0_, p1 = LB[e1] + k1_;
            c.LIST()[(size_t)e0 * T + p0] = r; c.LIST()[(size_t)e1 * T + p1] = r;
            c.LISTR()[(size_t)e0 * T + p0] = rstd_; c.LISTR()[(size_t)e1 * T + p1] = rstd_;
            unsigned* ro = c.ROUTE() + (size_t)r * 8;
            *(u32x4*)ro = (u32x4){(unsigned)e0, (unsigned)p0, __float_as_uint(g0_), (unsigned)e1};
            *(u32x2*)(ro + 4) = (u32x2){(unsigned)p1, __float_as_uint(g1_)};
        }
        __syncthreads();
    }
}

#define LAS __attribute__((address_space(3)))
typedef short bf16x8 __attribute__((ext_vector_type(8)));
namespace g8 {
constexpr int BM = 256, BK = 64, HALF = 128, HTB = HALF * BK * 2, STAGE_BYTES = 8 * HTB, NXCD = 8, WGM = 8;
__device__ __forceinline__ int lds_byte(int r, int c) { const int st = (r >> 4) * 2 + (c >> 5), rr = r & 15, cc = c & 31, ob = rr * 64 + cc * 2; return st * 1024 + (ob ^ (((ob >> 9) & 1) << 5)); }
__device__ __forceinline__ void stage_rc(int b, int& R, int& C) { const int st = b / 1024, sb = b % 1024, swz = sb ^ (((sb >> 9) & 1) << 5); R = (st >> 1) * 16 + swz / 64; C = (st & 1) * 32 + (swz % 64) / 2; }
__device__ __forceinline__ int perm32(int rho) { const int n = rho >> 4, i = rho & 15; return 8 * (i >> 2) + 4 * n + (i & 3); }
struct Unit { int pm, pn; const char* B; };
typedef f32x4 Acc[2][2][4][2];

struct DenseOrder {
    static constexpr bool GATHER = false;
    int nM, nN, nwg, G, c; const char* Bt; size_t tstrideB; int rsh = 0, lim = 0x7fffffff;
    __device__ __forceinline__ void init(int M, int N, int G_, int c_, const bf16_t* Bt_, int ldb) { nM = M / BM; nN = N / BM; nwg = nM * nN; G = G_; c = c_; Bt = (const char*)Bt_; tstrideB = (size_t)BM * ldb * 2; }
    __device__ __forceinline__ bool next(int i, Unit& u) const {
        const long L = (long)(i >> rsh) * G + c; if (L >= nwg || L >= lim) return false;
        int wgid = (int)L; { const int q = nwg / NXCD, r = nwg % NXCD, xcd = wgid % NXCD, off = wgid / NXCD; wgid = (xcd < r ? xcd * (q + 1) : r * (q + 1) + (xcd - r) * q) + off; }
        const int nig = WGM * nN, gid = wgid / nig, fm = gid * WGM, gsz = (nM - fm) < WGM ? (nM - fm) : WGM;
        u.pm = fm + ((wgid % nig) % gsz); u.pn = (wgid % nig) / gsz; u.B = Bt + (size_t)u.pn * tstrideB; return true;
    }
    __device__ __forceinline__ unsigned arow_off(int) const { return 0u; }
};
struct SplitKOrder {
    static constexpr bool GATHER = false;
    int c; const char* Bt;
    __device__ __forceinline__ bool next(int i, Unit& u) const { if (i > 0) return false; u.pm = c >> 2; u.pn = c & 3; u.B = Bt; return true; }
    __device__ __forceinline__ unsigned arow_off(int) const { return 0u; }
};
template <bool GATHER_, int NCT, int LDA, size_t ESTRIDE, size_t TSTRIDE> struct MoeOrder {
    static constexpr bool GATHER = GATHER_;
    const MoeTab* mt; const int* LIST; int G, c; const char* W; int rsh = 0;
    __device__ __forceinline__ bool next(int i, Unit& u) const {
        const int L = (i >> rsh) * G + c; const int total = __builtin_amdgcn_readfirstlane(mt->tstart[NEXP]) * NCT; if (L >= total) return false;
        const int rt = L / NCT, ct = L % NCT; u.pm = rt; u.pn = ct; const int e = __builtin_amdgcn_readfirstlane(mt->texp[rt]); u.B = W + (size_t)e * ESTRIDE + (size_t)ct * TSTRIDE; return true;
    }
    __device__ __forceinline__ unsigned arow_off(int r) const {
        const int e = mt->texp[r >> 8]; const int pos = r - mt->tstart[e] * 256; const int tok = pos < mt->cnt[e] ? LIST[(size_t)e * T + pos] : 0; return (unsigned)tok * (unsigned)(LDA * 2);
    }
};

struct MoeOrder2 {
    static constexpr bool GATHER = false;
    const MoeTab* mt; int G, c, R, rtA; const char* W; int rsh = 0;
    __device__ __forceinline__ bool next(int i0, Unit& u) const {
        const int i = i0 >> rsh; int u2;
        if (c < R) { if (i >= 2) return false; u2 = rtA * 8 + 2 * c + i; }
        else { u2 = (c - R) + i * (G - R); if (u2 >= rtA * 8) return false; }
        const int rt = u2 >> 3, ct = u2 & 7; u.pm = rt; u.pn = ct; const int e = __builtin_amdgcn_readfirstlane(mt->texp[rt]);
        u.B = W + (size_t)e * ((size_t)DM * DEXP * 2) + (size_t)ct * ((size_t)256 * DEXP * 2); return true;
    }
    __device__ __forceinline__ unsigned arow_off(int) const { return 0u; }
};
__device__ __forceinline__ void moe_wait_dep(unsigned* rtc, int c, int G, int R, int rtA) {
    const int tid = otid();
    if (tid < 64) {
        int rt = -1;
        if (c < R) { if (tid < 2) rt = rtA + ((2 * c + tid) >> 3); } else if (tid < 32) { const int u2 = (c - R) + tid * (G - R); if (u2 < rtA * 8) rt = u2 >> 3; }
        unsigned spins = 0;
        for (;;) {
            const bool ok = rt < 0 || __hip_atomic_load(rtc + (rt < 0 ? 0 : rt) * 32, __ATOMIC_RELAXED, __HIP_MEMORY_SCOPE_AGENT) >= 32u;
            if (__all(ok)) break;
            __builtin_amdgcn_s_sleep(2); if (++spins > (1u << 22)) break;
        }
        __builtin_amdgcn_fence(__ATOMIC_ACQUIRE, "agent");
        asm volatile("s_waitcnt vmcnt(0)" ::: "memory");
    }
    __syncthreads();
}

template <class Epi, class Sched>
__device__ __forceinline__ void gemm_mfma(LAS unsigned char* lds, const bf16_t* A, int lda, int ldb, int K, const Sched& S, const Epi& E) {
    constexpr bool GATHER = Sched::GATHER;
    const int tid = otid(), wid = __builtin_amdgcn_readfirstlane(tid >> 6), lane = tid & 63, wr = wid >> 2, wc = wid & 3, fr = lane & 15, fq = lane >> 4;
    const int nt = K / BK;
    int Rst[2], Cst[2]; unsigned voffB[2], voA[2][2], voAn[2][2];
#pragma unroll
    for (int i = 0; i < 2; ++i) { stage_rc(tid * 16 + i * 8192, Rst[i], Cst[i]); const int Rb = Epi::PERM ? ((Rst[i] & ~31) + perm32(Rst[i] & 31)) : Rst[i];
        voffB[i] = (unsigned)(Rb * ldb + Cst[i]) * 2u;
#pragma unroll
        for (int h = 0; h < 2; ++h) { voA[h][i] = (unsigned)((h * HALF + Rst[i]) * lda + Cst[i]) * 2u; voAn[h][i] = voA[h][i]; } }
    const size_t kstep = (size_t)(BK * 2), hstepB = (size_t)HALF * ldb * 2, tstepA = (size_t)BM * lda * 2;
    const unsigned ldsw = (unsigned)wid * 1024u;
    const int aoff = lds_byte(wr * 64 + fr, fq * 8), boff = lds_byte(wc * 32 + fr, fq * 8);
#define G8_SA(b, h) (((b) * 2 + (h)) * HTB)
#define G8_SB(b, h) ((4 + (b) * 2 + (h)) * HTB)
#define G8_STAGE_B(bufoff, gbase) do { _Pragma("unroll") for (int _i = 0; _i < 2; ++_i) \
        __builtin_amdgcn_global_load_lds((const unsigned*)((const char*)(gbase) + voffB[_i]), (LAS unsigned*)(lds + (bufoff) + ldsw + _i * 8192), 16, 0, 0); } while (0)
#define G8_STAGE_A(bufoff, gbase, o0, o1) do { \
        __builtin_amdgcn_global_load_lds((const unsigned*)((const char*)(gbase) + (o0)), (LAS unsigned*)(lds + (bufoff) + ldsw), 16, 0, 0); \
        __builtin_amdgcn_global_load_lds((const unsigned*)((const char*)(gbase) + (o1)), (LAS unsigned*)(lds + (bufoff) + ldsw + 8192), 16, 0, 0); } while (0)
#define G8_LDA(dst, b, h) do { _Pragma("unroll") for (int m = 0; m < 4; ++m) _Pragma("unroll") for (int k = 0; k < 2; ++k) dst[m][k] = *(const LAS bf16x8*)(lds + G8_SA(b, h) + aoff + m * 2048 + k * 1024); } while (0)
#define G8_LDB(dst, b, h) do { _Pragma("unroll") for (int n = 0; n < 2; ++n) _Pragma("unroll") for (int k = 0; k < 2; ++k) dst[n][k] = *(const LAS bf16x8*)(lds + G8_SB(b, h) + boff + n * 2048 + k * 1024); } while (0)
#define G8_MMA(ai, bj, At, Bt) do { __builtin_amdgcn_s_setprio(1); _Pragma("unroll") for (int m = 0; m < 4; ++m) _Pragma("unroll") for (int n = 0; n < 2; ++n) _Pragma("unroll") for (int k = 0; k < 2; ++k) \
        acc[ai][bj][m][n] = __builtin_amdgcn_mfma_f32_16x16x32_bf16(Bt[n][k], At[m][k], acc[ai][bj][m][n], 0, 0, 0); __builtin_amdgcn_s_setprio(0); } while (0)
#define G8_WAIT_V(n) asm volatile("s_waitcnt vmcnt(" #n ")" ::: "memory")
#define G8_WAIT_L(n) asm volatile("s_waitcnt lgkmcnt(" #n ")" ::: "memory")
#define G8_BAR __builtin_amdgcn_s_barrier()
#define G8_SCHED __builtin_amdgcn_sched_barrier(0)
    Unit cur, nxt; int ui = 0, prev_pm = -1;
    if (!S.next(0, cur)) return;
    Acc acc;
#pragma unroll
    for (int a = 0; a < 2; ++a)
#pragma unroll
        for (int b = 0; b < 2; ++b)
#pragma unroll
            for (int m = 0; m < 4; ++m)
#pragma unroll
                for (int n = 0; n < 2; ++n) acc[a][b][m][n] = (f32x4){0.f, 0.f, 0.f, 0.f};
    bf16x8 At[4][2], B0[2][2], B1[2][2];
    const char* cA; const char* cB = cur.B;
    if (GATHER) { cA = (const char*)A;
#pragma unroll
        for (int h = 0; h < 2; ++h)
#pragma unroll
            for (int i = 0; i < 2; ++i) voA[h][i] = S.arow_off(cur.pm * BM + h * HALF + Rst[i]) + (unsigned)Cst[i] * 2u;
    } else cA = (const char*)A + (size_t)cur.pm * tstepA;
    G8_STAGE_B(G8_SB(0, 0), cB); G8_STAGE_A(G8_SA(0, 0), cA, voA[0][0], voA[0][1]); G8_STAGE_B(G8_SB(0, 1), cB + hstepB); G8_STAGE_A(G8_SA(0, 1), cA, voA[1][0], voA[1][1]);
    if (wr == 1) G8_BAR;
    G8_WAIT_V(4); G8_BAR;
    G8_STAGE_B(G8_SB(1, 0), cB + kstep); G8_STAGE_A(G8_SA(1, 0), cA + kstep, voA[0][0], voA[0][1]); G8_STAGE_B(G8_SB(1, 1), cB + hstepB + kstep);
    G8_WAIT_V(6); G8_BAR;
    for (;;) {
        const bool has_next = S.next(ui + 1, nxt);
        const char* nA; const char* nB = has_next ? nxt.B : cB;
        if (GATHER) { nA = cA;
            if (has_next) {
#pragma unroll
                for (int h = 0; h < 2; ++h)
#pragma unroll
                    for (int i = 0; i < 2; ++i) voAn[h][i] = S.arow_off(nxt.pm * BM + h * HALF + Rst[i]) + (unsigned)Cst[i] * 2u;
            } else {
#pragma unroll
                for (int h = 0; h < 2; ++h)
#pragma unroll
                    for (int i = 0; i < 2; ++i) voAn[h][i] = voA[h][i];
            }
        } else nA = has_next ? (const char*)A + (size_t)nxt.pm * tstepA : cA;
        for (int t = 0; t < nt; t += 2) {
            const bool last = (t == nt - 2);
            const char* a1 = cA + (size_t)(t + 1) * kstep;
            const char* a2 = last ? nA : cA + (size_t)(t + 2) * kstep; const char* b2 = last ? nB : cB + (size_t)(t + 2) * kstep;
            const char* a3 = a2 + kstep; const char* b3 = b2 + kstep;
            unsigned o00 = voA[0][0], o01 = voA[0][1], o10 = voA[1][0], o11 = voA[1][1];
            if (GATHER) { if (last) { o00 = voAn[0][0]; o01 = voAn[0][1]; o10 = voAn[1][0]; o11 = voAn[1][1]; } }
            G8_LDB(B0, 0, 0); G8_SCHED; G8_LDA(At, 0, 0); G8_STAGE_A(G8_SA(1, 1), a1, voA[1][0], voA[1][1]);
            G8_WAIT_L(8); G8_BAR; G8_WAIT_L(0); G8_MMA(0, 0, At, B0); G8_BAR; G8_SCHED;
            G8_LDB(B1, 0, 1); G8_STAGE_B(G8_SB(0, 0), b2);
            G8_BAR; G8_WAIT_L(0); G8_MMA(0, 1, At, B1); G8_BAR;
            G8_LDA(At, 0, 1); G8_STAGE_A(G8_SA(0, 0), a2, o00, o01);
            G8_BAR; G8_WAIT_L(0); G8_MMA(1, 0, At, B0); G8_BAR; G8_SCHED;
            G8_STAGE_B(G8_SB(0, 1), b2 + hstepB);
            G8_WAIT_V(6);
            if constexpr (Epi::PUBLISH) { if (prev_pm >= 0) { E.publish(prev_pm); prev_pm = -1; } }
            G8_BAR; G8_MMA(1, 1, At, B1); G8_BAR;
            G8_LDB(B0, 1, 0); G8_SCHED; G8_LDA(At, 1, 0); G8_STAGE_A(G8_SA(0, 1), a2, o10, o11);
            G8_WAIT_L(8); G8_BAR; G8_WAIT_L(0); G8_MMA(0, 0, At, B0); G8_BAR; G8_SCHED;
            G8_LDB(B1, 1, 1); G8_STAGE_B(G8_SB(1, 0), b3);
            G8_BAR; G8_WAIT_L(0); G8_MMA(0, 1, At, B1); G8_BAR;
            G8_LDA(At, 1, 1); G8_STAGE_A(G8_SA(1, 0), a3, o00, o01);
            G8_BAR; G8_WAIT_L(0); G8_MMA(1, 0, At, B0); G8_BAR; G8_SCHED;
            G8_STAGE_B(G8_SB(1, 1), b3 + hstepB);
            G8_WAIT_V(6); G8_BAR; G8_MMA(1, 1, At, B1); G8_BAR;
        }
        E(acc, cur, wr, wc, fr, fq);
        if constexpr (Epi::PUBLISH) prev_pm = cur.pm;
        if (!has_next) break;
#pragma unroll
        for (int a = 0; a < 2; ++a)
#pragma unroll
            for (int b = 0; b < 2; ++b)
#pragma unroll
                for (int m = 0; m < 4; ++m)
#pragma unroll
                    for (int n = 0; n < 2; ++n) acc[a][b][m][n] = (f32x4){0.f, 0.f, 0.f, 0.f};
        cur = nxt; cA = nA; cB = nB; ++ui;
        if (GATHER) {
#pragma unroll
            for (int h = 0; h < 2; ++h)
#pragma unroll
                for (int i = 0; i < 2; ++i) voA[h][i] = voAn[h][i];
        }
    }
    G8_WAIT_V(0);
    if constexpr (Epi::PUBLISH) { if (prev_pm >= 0) { E.publish(prev_pm); prev_pm = -1; } }
    if (wr == 0) G8_BAR;
    G8_BAR;
#undef G8_SA
#undef G8_SB
#undef G8_STAGE_A
#undef G8_STAGE_B
#undef G8_LDA
#undef G8_LDB
#undef G8_MMA
#undef G8_WAIT_V
#undef G8_WAIT_L
#undef G8_BAR
#undef G8_SCHED
}

__device__ __forceinline__ u32x4 pack8(const f32x4& a, const f32x4& b) { u32x4 w; w.x = cvt_pk_bf16(a[0], a[1]); w.y = cvt_pk_bf16(a[2], a[3]); w.z = cvt_pk_bf16(b[0], b[1]); w.w = cvt_pk_bf16(b[2], b[3]); return w; }
struct MEpiProj { static constexpr bool PERM = true, PUBLISH = false; bf16_t* PROJ; bf16_t* VT; LAS float* KX; const float* gq; const float* gk;
    __device__ __forceinline__ void operator()(const Acc& acc, const Unit& u, int wr, int wc, int fr, int fq) const {
        const int row0 = u.pm * BM + wr * 64 + fr;
        if (u.pn >= C_K / 256 && u.pn < DPROJ / 256) {
#pragma unroll
            for (int ai = 0; ai < 2; ++ai)
#pragma unroll
                for (int m = 0; m < 4; ++m)
#pragma unroll
                    for (int bj = 0; bj < 2; ++bj) {
                        const f32x4 a = acc[ai][bj][m][0], b = acc[ai][bj][m][1];
                        float ss = a[0] * a[0] + a[1] * a[1] + a[2] * a[2] + a[3] * a[3] + b[0] * b[0] + b[1] * b[1] + b[2] * b[2] + b[3] * b[3];
                        ss += __shfl_xor(ss, 16); ss += __shfl_xor(ss, 32);
                        if (fq == 0) KX[((ai * HALF + wr * 64 + m * 16 + fr) * 2 + bj) * 4 + wc] = ss;
                    }
            asm volatile("s_waitcnt lgkmcnt(0)" ::: "memory"); __builtin_amdgcn_s_barrier(); asm volatile("" ::: "memory");
            const int col0 = u.pn * BM + wc * 32 + 8 * fq;
            f32x4 g0[2], g1[2];
#pragma unroll
            for (int bj = 0; bj < 2; ++bj) { const int d0 = wc * 32 + 8 * fq; g0[bj] = *(const f32x4*)(gq + d0) * *(const f32x4*)(gk + d0); g1[bj] = *(const f32x4*)(gq + d0 + 4) * *(const f32x4*)(gk + d0 + 4); }
#pragma unroll
            for (int ai = 0; ai < 2; ++ai)
#pragma unroll
                for (int m = 0; m < 4; ++m) { bf16_t* rowp = PROJ + (size_t)(row0 + ai * HALF + m * 16) * DPROJ + col0;
#pragma unroll
                    for (int bj = 0; bj < 2; ++bj) { const f32x4 p4 = *(const LAS f32x4*)(KX + ((ai * HALF + wr * 64 + m * 16 + fr) * 2 + bj) * 4);
                        const float rs = rsqrtf(((p4[0] + p4[1]) + (p4[2] + p4[3])) * (1.0f / HD) + EPS);
                        *(u32x4*)(rowp + bj * HALF) = pack8(acc[ai][bj][m][0] * g0[bj] * rs, acc[ai][bj][m][1] * g1[bj] * rs); } }
            return;
        }
        if (u.pn < DPROJ / 256) {
            const int col0 = u.pn * BM + wc * 32 + 8 * fq;
#pragma unroll
            for (int ai = 0; ai < 2; ++ai)
#pragma unroll
                for (int m = 0; m < 4; ++m) { bf16_t* rowp = PROJ + (size_t)(row0 + ai * HALF + m * 16) * DPROJ + col0;
#pragma unroll
                    for (int bj = 0; bj < 2; ++bj) *(u32x4*)(rowp + bj * HALF) = pack8(acc[ai][bj][m][0], acc[ai][bj][m][1]); }
        } else {
            const int cc0 = (u.pn - DPROJ / 256) * BM + wc * 32 + 8 * fq;
#pragma unroll
            for (int ai = 0; ai < 2; ++ai)
#pragma unroll
                for (int m = 0; m < 4; ++m) { const int row = row0 + ai * HALF + m * 16, b = row >> 12, s = row & (SEQ - 1);
#pragma unroll
                    for (int bj = 0; bj < 2; ++bj) { const int cc = cc0 + bj * HALF; bf16_t* base = VT + ((size_t)(b * NHS + (cc >> 7)) * HD + (cc & 127)) * VTS + s;
#pragma unroll
                        for (int j = 0; j < 4; ++j) { base[(size_t)j * VTS] = f2bf(acc[ai][bj][m][0][j]); base[(size_t)(4 + j) * VTS] = f2bf(acc[ai][bj][m][1][j]); } } }
        }
    } };
struct MEpiPart { static constexpr bool PERM = true, PUBLISH = false; bf16_t* PT;
    __device__ __forceinline__ void operator()(const Acc& acc, const Unit& u, int wr, int wc, int fr, int fq) const {
        bf16_t* base0 = PT + (size_t)(u.pm * 4 + u.pn) * 65536 + (wr * 64 + fr);
#pragma unroll
        for (int ai = 0; ai < 2; ++ai)
#pragma unroll
            for (int m = 0; m < 4; ++m)
#pragma unroll
                for (int bj = 0; bj < 2; ++bj) { bf16_t* base = base0 + (size_t)(bj * HALF + wc * 32 + 8 * fq) * 256 + ai * HALF + m * 16;
#pragma unroll
                    for (int j = 0; j < 4; ++j) { base[(size_t)j * 256] = f2bf(acc[ai][bj][m][0][j]); base[(size_t)(4 + j) * 256] = f2bf(acc[ai][bj][m][1][j]); } }
    } };
__device__ __forceinline__ f32x4 silu_mul(const f32x4& g, const f32x4& u) { f32x4 r;
#pragma unroll
    for (int j = 0; j < 4; ++j) r[j] = g[j] / (1.0f + __expf(-g[j])) * u[j];
    return r; }
struct MEpiGU { static constexpr bool PERM = true, PUBLISH = true; bf16_t* HID; const float* LISTR; const MoeTab* mt; unsigned* rtc; int n1early;
    __device__ __forceinline__ void operator()(const Acc& acc, const Unit& u, int wr, int wc, int fr, int fq) const {
        const int row0 = u.pm * BM + wr * 64 + fr, col0 = u.pn * HALF + wc * 32 + 8 * fq;
        const int e = __builtin_amdgcn_readfirstlane(mt->texp[u.pm]), cnt = __builtin_amdgcn_readfirstlane(mt->cnt[e]), pb = __builtin_amdgcn_readfirstlane(mt->tstart[e]) * 256;
        const float* lr = LISTR + (size_t)e * T;
        const __amdgpu_buffer_rsrc_t rsrc = __builtin_amdgcn_make_buffer_rsrc(HID, 0, (int)((size_t)PADROWS * DEXP * 2), 0x00020000);
#pragma unroll
        for (int ai = 0; ai < 2; ++ai)
#pragma unroll
            for (int m = 0; m < 4; ++m) {
                const int row = row0 + ai * HALF + m * 16, pos = row - pb;
                const float rs = pos < cnt ? lr[pos] : 0.f;
                __builtin_amdgcn_raw_buffer_store_b128(pack8(silu_mul(acc[ai][0][m][0] * rs, acc[ai][1][m][0] * rs), silu_mul(acc[ai][0][m][1] * rs, acc[ai][1][m][1] * rs)), rsrc, (row * DEXP + col0) * 2, 0, 16);
            }
    }
    __device__ __forceinline__ void publish(int pm) const {
        if ((otid() & 63) == 0) __hip_atomic_fetch_add(rtc + pm * 32, 1u, __ATOMIC_RELAXED, __HIP_MEMORY_SCOPE_AGENT);
    } };
struct MEpiDown { static constexpr bool PERM = true, PUBLISH = false; bf16_t* YPAD;
    __device__ __forceinline__ void operator()(const Acc& acc, const Unit& u, int wr, int wc, int fr, int fq) const {
        const int row0 = u.pm * BM + wr * 64 + fr, col0 = u.pn * BM + wc * 32 + 8 * fq;
#pragma unroll
        for (int ai = 0; ai < 2; ++ai)
#pragma unroll
            for (int m = 0; m < 4; ++m) { bf16_t* rowp = YPAD + (size_t)(row0 + ai * HALF + m * 16) * DM + col0;
#pragma unroll
                for (int bj = 0; bj < 2; ++bj) *(u32x4*)(rowp + bj * HALF) = pack8(acc[ai][bj][m][0], acc[ai][bj][m][1]); }
    } };
constexpr float YSCALE = YSCALE_G;
struct MEpiDown8 { static constexpr bool PERM = true, PUBLISH = false; unsigned char* Y8;
    __device__ __forceinline__ void operator()(const Acc& acc, const Unit& u, int wr, int wc, int fr, int fq) const {
        const int row0 = u.pm * BM + wr * 64 + fr, col0 = u.pn * BM + wc * 32 + 8 * fq;
#pragma unroll
        for (int ai = 0; ai < 2; ++ai)
#pragma unroll
            for (int m = 0; m < 4; ++m) { unsigned char* rowp = Y8 + (size_t)(row0 + ai * HALF + m * 16) * DM + col0;
#pragma unroll
                for (int bj = 0; bj < 2; ++bj) { const f32x4 a = acc[ai][bj][m][0] * YSCALE, b = acc[ai][bj][m][1] * YSCALE; int w0 = 0, w1 = 0;
                    w0 = __builtin_amdgcn_cvt_pk_fp8_f32(a[0], a[1], w0, false); w0 = __builtin_amdgcn_cvt_pk_fp8_f32(a[2], a[3], w0, true);
                    w1 = __builtin_amdgcn_cvt_pk_fp8_f32(b[0], b[1], w1, false); w1 = __builtin_amdgcn_cvt_pk_fp8_f32(b[2], b[3], w1, true);
                    *(u32x2*)(rowp + bj * HALF) = (u32x2){(unsigned)w0, (unsigned)w1}; } }
    } };
}

__device__ __forceinline__ void phase_convb(const Ctx& c, int l) {
    const int gt = obid() * 512 + otid(), ng = gridDim.x * 512, sub = gt & 15;
    const float* cw = c.in[10] + (size_t)l * 3 * DCONV; const bf16_t* PROJ = c.PROJ();
#pragma unroll 2
    for (int item = gt >> 4; item < T * 4; item += ng >> 4) {
        const int t = item >> 2, hh = item & 3, ch = hh * HD + sub * 8, s = t & (SEQ - 1);
        u32x4 cg[3], xb[3];
#pragma unroll
        for (int tap = 0; tap < 3; ++tap) { const int ds = (s + tap - 2 >= 0) ? tap - 2 : 0; const bf16_t* row = PROJ + (size_t)(t + ds) * DPROJ; cg[tap] = *(const u32x4*)(row + C_CG + ch); xb[tap] = *(const u32x4*)(row + C_XB + ch); }
        const u32x4 bg = *(const u32x4*)(PROJ + (size_t)t * DPROJ + C_BG + ch);
        float acc[8] = {0, 0, 0, 0, 0, 0, 0, 0};
#pragma unroll
        for (int tap = 0; tap < 3; ++tap) {
            if (s + tap - 2 >= 0) {
                const f32x4 w0 = *(const f32x4*)(cw + tap * DCONV + ch), w1 = *(const f32x4*)(cw + tap * DCONV + ch + 4);
                acc[0] += w0[0] * bflo(cg[tap].x) * bflo(xb[tap].x); acc[1] += w0[1] * bfhi(cg[tap].x) * bfhi(xb[tap].x); acc[2] += w0[2] * bflo(cg[tap].y) * bflo(xb[tap].y); acc[3] += w0[3] * bfhi(cg[tap].y) * bfhi(xb[tap].y);
                acc[4] += w1[0] * bflo(cg[tap].z) * bflo(xb[tap].z); acc[5] += w1[1] * bfhi(cg[tap].z) * bfhi(xb[tap].z); acc[6] += w1[2] * bflo(cg[tap].w) * bflo(xb[tap].w); acc[7] += w1[3] * bfhi(cg[tap].w) * bfhi(xb[tap].w);
            }
        }
        acc[0] *= bflo(bg.x); acc[1] *= bfhi(bg.x); acc[2] *= bflo(bg.y); acc[3] *= bfhi(bg.y); acc[4] *= bflo(bg.z); acc[5] *= bfhi(bg.z); acc[6] *= bflo(bg.w); acc[7] *= bfhi(bg.w);
        float ss = 0.f;
#pragma unroll
        for (int i = 0; i < 8; ++i) ss += acc[i] * acc[i];
        ss += __shfl_xor(ss, 1); ss += __shfl_xor(ss, 2); ss += __shfl_xor(ss, 4); ss += __shfl_xor(ss, 8);
        const float rstd = rsqrtf(ss * (1.0f / HD) + EPS);
        const float* mg = c.in[13] + (size_t)l * DM + DLRU + ch;
        const f32x4 m0 = *(const f32x4*)mg, m1 = *(const f32x4*)(mg + 4);
        u32x4 o; o.x = cvt_pk_bf16(acc[0] * rstd * m0[0], acc[1] * rstd * m0[1]); o.y = cvt_pk_bf16(acc[2] * rstd * m0[2], acc[3] * rstd * m0[3]);
        o.z = cvt_pk_bf16(acc[4] * rstd * m1[0], acc[5] * rstd * m1[1]); o.w = cvt_pk_bf16(acc[6] * rstd * m1[2], acc[7] * rstd * m1[3]);
        *(u32x4*)(c.YMIX() + (size_t)t * DM + DLRU + ch) = o;
    }
}
typedef float f32x16 __attribute__((ext_vector_type(16)));
#define MFMA32(a, b, c) __builtin_amdgcn_mfma_f32_32x32x16_bf16((a), (b), (c), 0, 0, 0)
constexpr int XCS = 776;
__device__ __forceinline__ void phase_lruA(const Ctx& c, int l, unsigned char* ldsb) {
    constexpr bool PASS2 = false;
    bf16_t* XC = (bf16_t*)ldsb; bf16_t* PR = (bf16_t*)(ldsb + 99328); bf16_t* HL = c.HL(); bf16_t* PL = c.PL();
    const int tid = otid(), lane = tid & 63, wv = tid >> 6, hh = lane >> 5, l31 = lane & 31;
    const float* cw = c.in[3] + (size_t)l * 4 * DLRU; const float* cb = c.in[4] + (size_t)l * DLRU;
    const bf16_t* PROJ = c.PROJ(); float* AGG = c.AGG();
    typedef float f32x2_t __attribute__((ext_vector_type(2)));
    for (int tile = obid(); tile < T / 64; tile += gridDim.x) {
        const int t0 = tile * 64, s0 = t0 & (SEQ - 1), tb = tile & 63;
        if (tid < 480) {
            const int cg = tid % 48, tslot = tid / 48, ch = cg * 16;
            float w[4][16], bias[16];
#pragma unroll
            for (int i = 0; i < 16; i += 4) { *(f32x4*)&bias[i] = *(const f32x4*)(cb + ch + i);
#pragma unroll
                for (int tap = 0; tap < 4; ++tap) *(f32x4*)&w[tap][i] = *(const f32x4*)(cw + tap * DLRU + ch + i); }
#pragma unroll
            for (int it = 0; it < 7; ++it) {
                const int tokr = tslot + 10 * it, tok = tokr < 64 ? tokr : 63;
                u32x4 x0[4], x1[4]; float msk[4];
#pragma unroll
                for (int tap = 0; tap < 4; ++tap) {
                    const int ds = tap - 3; const bool ok = (s0 + tok + ds >= 0); msk[tap] = ok ? 1.0f : 0.0f;
                    const bf16_t* row = PROJ + (size_t)(t0 + tok + (ok ? ds : 0)) * DPROJ + C_XA + ch;
                    x0[tap] = *(const u32x4*)row; x1[tap] = *(const u32x4*)(row + 8);
                }
                float a[16];
#pragma unroll
                for (int i = 0; i < 16; ++i) a[i] = bias[i];
#pragma unroll
                for (int tap = 0; tap < 4; ++tap) {
                    const float m = msk[tap];
                    a[0] += m * w[tap][0] * bflo(x0[tap].x); a[1] += m * w[tap][1] * bfhi(x0[tap].x); a[2] += m * w[tap][2] * bflo(x0[tap].y); a[3] += m * w[tap][3] * bfhi(x0[tap].y);
                    a[4] += m * w[tap][4] * bflo(x0[tap].z); a[5] += m * w[tap][5] * bfhi(x0[tap].z); a[6] += m * w[tap][6] * bflo(x0[tap].w); a[7] += m * w[tap][7] * bfhi(x0[tap].w);
                    a[8] += m * w[tap][8] * bflo(x1[tap].x); a[9] += m * w[tap][9] * bfhi(x1[tap].x); a[10] += m * w[tap][10] * bflo(x1[tap].y); a[11] += m * w[tap][11] * bfhi(x1[tap].y);
                    a[12] += m * w[tap][12] * bflo(x1[tap].z); a[13] += m * w[tap][13] * bfhi(x1[tap].z); a[14] += m * w[tap][14] * bflo(x1[tap].w); a[15] += m * w[tap][15] * bfhi(x1[tap].w);
                }
                u32x4 o0, o1; o0.x = cvt_pk_bf16(a[0], a[1]); o0.y = cvt_pk_bf16(a[2], a[3]); o0.z = cvt_pk_bf16(a[4], a[5]); o0.w = cvt_pk_bf16(a[6], a[7]);
                o1.x = cvt_pk_bf16(a[8], a[9]); o1.y = cvt_pk_bf16(a[10], a[11]); o1.z = cvt_pk_bf16(a[12], a[13]); o1.w = cvt_pk_bf16(a[14], a[15]);
                if (tokr < 64) { *(u32x4*)(XC + tok * XCS + ch) = o0; *(u32x4*)(XC + tok * XCS + ch + 8) = o1; }
            }
        }
        __syncthreads();
#pragma unroll 1
        for (int i = 0; i < 3; ++i) {
            const int hd = 2 * i + (wv >> 2), ntw = wv & 3, chl = 32 * ntw + l31, ch = hd * HD + chl;
            const bf16_t* wa = c.WA(l) + ((size_t)hd * HD + chl) * HD + 8 * hh; const bf16_t* wx = c.WX(l) + ((size_t)hd * HD + chl) * HD + 8 * hh;
            const float ba = c.in[6][l * DLRU + ch], bx = c.in[8][l * DLRU + ch], c8 = -8.0f * softplusf_(-c.in[9][l * DLRU + ch]);
            float sst = 0.f, Pt = 1.f;
            float hreg[2][16], preg[2][16];
            bf16x8 bRf[8], bIf[8];
#pragma unroll
            for (int s = 0; s < 8; ++s) { bRf[s] = *(const bf16x8*)(wa + 16 * s); bIf[s] = *(const bf16x8*)(wx + 16 * s); }
            __builtin_amdgcn_sched_barrier(0);
#pragma unroll
            for (int half = 0; half < 2; ++half) {
                float av[16], uv[16];
                {
                    f32x16 accR, accI;
#pragma unroll
                    for (int r = 0; r < 16; ++r) { accR[r] = 0.f; accI[r] = 0.f; }
#pragma unroll
                    for (int s = 0; s < 8; ++s) {
                        const bf16x8 a = *(const bf16x8*)(XC + (32 * half + l31) * XCS + hd * HD + 16 * s + 8 * hh);
                        accR = MFMA32(a, bRf[s], accR); accI = MFMA32(a, bIf[s], accI);
                    }
#pragma unroll
                    for (int r = 0; r < 16; ++r) {
                        const int tok = 32 * half + (r & 3) + 8 * (r >> 2) + 4 * hh;
                        const float xc = bf2f(XC[tok * XCS + ch]);
                        const float rg = sigmoidf_(accR[r] + ba), ig = sigmoidf_(accI[r] + bx);
                        const float la = c8 * rg;
                        av[r] = fast_exp(la); uv[r] = __builtin_amdgcn_sqrtf(one_minus_exp(2.0f * la)) * (ig * xc);
                    }
                }
                float Pp[4], Hp[4];
#pragma unroll
                for (int g = 0; g < 4; ++g) { float P = 1.f, H = 0.f;
#pragma unroll
                    for (int r = 4 * g; r < 4 * g + 4; ++r) { H = av[r] * H + uv[r]; P *= av[r]; }
                    Pp[g] = __shfl_xor(P, 32); Hp[g] = __shfl_xor(H, 32); }
#pragma unroll
                for (int g = 0; g < 4; ++g) {
                    if (hh == 0) {
#pragma unroll
                        for (int r = 4 * g; r < 4 * g + 4; ++r) { sst = av[r] * sst + uv[r]; Pt *= av[r]; hreg[half][r] = sst; preg[half][r] = Pt; }
                        sst = Pp[g] * sst + Hp[g]; Pt *= Pp[g];
                    } else {
                        sst = Pp[g] * sst + Hp[g]; Pt *= Pp[g];
#pragma unroll
                        for (int r = 4 * g; r < 4 * g + 4; ++r) { sst = av[r] * sst + uv[r]; Pt *= av[r]; hreg[half][r] = sst; preg[half][r] = Pt; }
                    }
                }
            }
            if (hh == 0) { f32x2_t o; o.x = Pt; o.y = sst; ((f32x2_t*)AGG)[(size_t)tile * DLRU + ch] = o; }
            __syncthreads();
#pragma unroll
            for (int half = 0; half < 2; ++half)
#pragma unroll
                for (int r = 0; r < 16; ++r) { const int tok = 32 * half + (r & 3) + 8 * (r >> 2) + 4 * hh;
                    XC[tok * XCS + ch] = f2bf(hreg[half][r]); PR[tok * 264 + (wv >> 2) * HD + chl] = f2bf(preg[half][r]); }
            __syncthreads();
#pragma unroll
            for (int k = 0; k < 4; ++k) {
                const int item = tid + 512 * k, tok = item >> 5, g = item & 31, hs = g >> 4, sub = g & 15, cc = (2 * i + hs) * HD + sub * 8;
                *(u32x4*)(HL + (size_t)(t0 + tok) * DLRU + cc) = *(const u32x4*)(XC + tok * XCS + cc);
                *(u32x4*)(PL + (size_t)(t0 + tok) * DLRU + cc) = *(const u32x4*)(PR + tok * 264 + hs * HD + sub * 8);
            }
        }
        __syncthreads();
    }
}

__device__ __forceinline__ void phase_lruB(const Ctx& c, int l, unsigned char* ldsb) {
    float* HIN = (float*)ldsb;
    const int tid = otid();
    const bf16_t* PROJ = c.PROJ(); const float* AGG = c.AGG(); const bf16_t* HL = c.HL(); const bf16_t* PL = c.PL();
    typedef float f32x2_t __attribute__((ext_vector_type(2)));
    for (int tile = obid(); tile < T / 64; tile += gridDim.x) {
        const int t0 = tile * 64, tb = tile & 63;
        {
            const f32x2_t* ag = (const f32x2_t*)AGG + (size_t)(tile - tb) * DLRU;
            const int chb = 512 + (tid & 255);
            float ha = 0.f, hb = 0.f;
#pragma unroll 8
            for (int k = 0; k < tb; ++k) { const f32x2_t pa = ag[(size_t)k * DLRU + tid], pb_ = ag[(size_t)k * DLRU + chb]; ha = pa.x * ha + pa.y; hb = pb_.x * hb + pb_.y; }
            HIN[tid] = ha; if (tid < 256) HIN[chb] = hb;
        }
        __syncthreads();
        const int wv_ = tid >> 6, wit0 = wv_ < 4 ? 8 * wv_ : 32 + 16 * (wv_ - 4), wcnt = wv_ < 4 ? 8 : 16;
#pragma unroll 2
        for (int it = 0; it < wcnt; ++it) {
            const int item = (wit0 + it) * 64 + (tid & 63), tok = item / 96, rem = item % 96, hd = rem >> 4, sub = rem & 15, cc = hd * HD + sub * 8;
            const u32x4 hv = *(const u32x4*)(HL + (size_t)(t0 + tok) * DLRU + cc), pv = *(const u32x4*)(PL + (size_t)(t0 + tok) * DLRU + cc);
            const u32x4 ga = *(const u32x4*)(PROJ + (size_t)(t0 + tok) * DPROJ + C_GA + cc);
            const f32x4 i0 = *(const f32x4*)(HIN + cc), i1 = *(const f32x4*)(HIN + cc + 4);
            float y[8] = {(bflo(hv.x) + bflo(pv.x) * i0[0]) * gelu_tanh(bflo(ga.x)), (bfhi(hv.x) + bfhi(pv.x) * i0[1]) * gelu_tanh(bfhi(ga.x)),
                          (bflo(hv.y) + bflo(pv.y) * i0[2]) * gelu_tanh(bflo(ga.y)), (bfhi(hv.y) + bfhi(pv.y) * i0[3]) * gelu_tanh(bfhi(ga.y)),
                          (bflo(hv.z) + bflo(pv.z) * i1[0]) * gelu_tanh(bflo(ga.z)), (bfhi(hv.z) + bfhi(pv.z) * i1[1]) * gelu_tanh(bfhi(ga.z)),
                          (bflo(hv.w) + bflo(pv.w) * i1[2]) * gelu_tanh(bflo(ga.w)), (bfhi(hv.w) + bfhi(pv.w) * i1[3]) * gelu_tanh(bfhi(ga.w))};
            float ss = 0.f;
#pragma unroll
            for (int k = 0; k < 8; ++k) ss += y[k] * y[k];
            ss += __shfl_xor(ss, 1); ss += __shfl_xor(ss, 2); ss += __shfl_xor(ss, 4); ss += __shfl_xor(ss, 8);
            const float rstd = rsqrtf(ss * (1.0f / HD) + EPS);
            const float* mg = c.in[13] + (size_t)l * DM + cc;
            const f32x4 m0 = *(const f32x4*)mg, m1 = *(const f32x4*)(mg + 4);
            u32x4 o; o.x = cvt_pk_bf16(y[0] * rstd * m0[0], y[1] * rstd * m0[1]); o.y = cvt_pk_bf16(y[2] * rstd * m0[2], y[3] * rstd * m0[3]);
            o.z = cvt_pk_bf16(y[4] * rstd * m1[0], y[5] * rstd * m1[1]); o.w = cvt_pk_bf16(y[6] * rstd * m1[2], y[7] * rstd * m1[3]);
            *(u32x4*)(c.YMIX() + (size_t)(t0 + tok) * DM + cc) = o;
        }
        __syncthreads();
    }
}

__device__ __forceinline__ void phase_vreduce(const Ctx& c) {
    const bf16_t* PT = c.PT(); bf16_t* VT = c.VT();
    for (int item = obid() * 512 + otid(); item < 64 * 256 * 32; item += gridDim.x * 512) {
        const int ro = item & 31, col = (item >> 5) & 255, u = item >> 13;
        const bf16_t* p = PT + (size_t)(u * 4) * 65536 + col * 256 + ro * 8;
        float a[8] = {0, 0, 0, 0, 0, 0, 0, 0};
#pragma unroll
        for (int kq = 0; kq < 4; ++kq) { const u32x4 w = *(const u32x4*)(p + (size_t)kq * 65536);
            a[0] += bflo(w.x); a[1] += bfhi(w.x); a[2] += bflo(w.y); a[3] += bfhi(w.y); a[4] += bflo(w.z); a[5] += bfhi(w.z); a[6] += bflo(w.w); a[7] += bfhi(w.w); }
        const int b = u >> 4, s0 = (u & 15) * 256 + ro * 8, h = 4 + (col >> 7), d = col & 127;
        u32x4 o; o.x = cvt_pk_bf16(a[0], a[1]); o.y = cvt_pk_bf16(a[2], a[3]); o.z = cvt_pk_bf16(a[4], a[5]); o.w = cvt_pk_bf16(a[6], a[7]);
        *(u32x4*)(VT + ((size_t)(b * NHS + h) * HD + d) * VTS + s0) = o;
    }
}

__device__ __forceinline__ void phase_attn(const Ctx& c, int l, unsigned char* ldsb) {
    const int lane = otid() & 63, wv = otid() >> 6, hh = lane >> 5, l31 = lane & 31;
    const bf16_t* PROJ = c.PROJ(); const bf16_t* VT = c.VT();
    const int prow = (l31 & ~12) | ((l31 & 4) << 1) | ((l31 & 8) >> 1);
    unsigned char* wl = ldsb + wv * 16384;
    const int kwbase = (lane >> 4) * 256 + (((lane & 15) ^ (lane >> 4)) * 16);
    const int vwoff = (lane >> 2) * 64 + (((lane & 3) ^ (lane >> 4)) * 16);
    const int kroff = prow * 256;
    const int nwt = NB * NHS * (SEQ / 32);
    const int nper = (nwt + (int)gridDim.x - 1) / (int)gridDim.x, wt0 = obid() * nper, wt1 = (wt0 + nper < nwt) ? wt0 + nper : nwt;
    for (int wt = wt0 + wv; wt < wt1; wt += 8) {
        const int qt = wt % (SEQ / 32), bh = wt / (SEQ / 32), b = bh / NHS, h = bh % NHS, q0 = qt * 32;
        const bf16_t* qp = PROJ + (size_t)(b * SEQ + q0 + l31) * DPROJ + C_Q + h * HD + 8 * hh;
        bf16x8 bq[8];
#pragma unroll
        for (int s = 0; s < 8; ++s) bq[s] = *(const bf16x8*)(qp + 16 * s);
        {
            float qs = 0.f;
#pragma unroll
            for (int s = 0; s < 8; ++s) { const u32x4 w = __builtin_bit_cast(u32x4, bq[s]);
                qs += bflo(w.x) * bflo(w.x) + bfhi(w.x) * bfhi(w.x) + bflo(w.y) * bflo(w.y) + bfhi(w.y) * bfhi(w.y) + bflo(w.z) * bflo(w.z) + bfhi(w.z) * bfhi(w.z) + bflo(w.w) * bflo(w.w) + bfhi(w.w) * bfhi(w.w); }
            qs += __shfl_xor(qs, 32);
            const float sc = rsqrtf(qs * (1.0f / HD) + EPS) * (1.4426950408889634f * 0.08838834764831845f);
#pragma unroll
            for (int s = 0; s < 8; ++s) { const u32x4 w = __builtin_bit_cast(u32x4, bq[s]); u32x4 o;
                o.x = cvt_pk_bf16(bflo(w.x) * sc, bfhi(w.x) * sc); o.y = cvt_pk_bf16(bflo(w.y) * sc, bfhi(w.y) * sc); o.z = cvt_pk_bf16(bflo(w.z) * sc, bfhi(w.z) * sc); o.w = cvt_pk_bf16(bflo(w.w) * sc, bfhi(w.w) * sc);
                bq[s] = __builtin_bit_cast(bf16x8, o); }
        }
        f32x16 O[4];
#pragma unroll
        for (int m = 0; m < 4; ++m)
#pragma unroll
            for (int r = 0; r < 16; ++r) O[m][r] = 0.f;
        float carry = 0.f;
        const bf16_t* kgl = PROJ + (size_t)(b * SEQ + (lane >> 4)) * DPROJ + C_K + h * HD + (lane & 15) * 8;
        const bf16_t* vgl = VT + ((size_t)bh * HD + (lane >> 2)) * VTS + (lane & 3) * 8;
        u32x4 stK[8], stV[8];
#define ATT_LOAD(kk0) do { _Pragma("unroll") for (int j = 0; j < 8; ++j) { \
            stK[j] = *(const u32x4*)(kgl + (size_t)((kk0) + 4 * j) * DPROJ); stV[j] = *(const u32x4*)(vgl + (size_t)(16 * j) * VTS + (kk0)); } } while (0)
        ATT_LOAD(q0);
        for (int k0 = q0; k0 >= 0; k0 -= 32) {
#pragma unroll
            for (int j = 0; j < 8; ++j) { *(u32x4*)(wl + j * 1024 + (kwbase ^ (64 * (j & 3)))) = stK[j]; *(u32x4*)(wl + 8192 + vwoff + j * 1024) = stV[j]; }
            const int kn = k0 >= 32 ? k0 - 32 : k0;
            ATT_LOAD(kn);
            __builtin_amdgcn_sched_barrier(0);
            f32x16 S;
#pragma unroll
            for (int r = 0; r < 16; ++r) S[r] = 0.f;
#pragma unroll
            for (int s = 0; s < 8; ++s) { const bf16x8 ak = *(const bf16x8*)(wl + kroff + (((2 * s + hh) ^ (prow & 15)) * 16)); S = MFMA32(ak, bq[s], S); }
            const bool diag = (k0 == q0);
            float sp[16];
            float R0 = 0.f, R1 = 0.f;
#pragma unroll
            for (int r = 0; r < 16; ++r) {
                const int kk = 16 * (r >> 3) + 8 * hh + (r & 7);
                const float z = S[r];
                float v = fmaxf(z, 0.f) + __builtin_amdgcn_logf(1.0f + __builtin_amdgcn_exp2f(-fabsf(z)));
                if (diag && kk >= l31) v = 0.f;
                sp[r] = v;
                if (r < 8) R0 += v; else R1 += v;
            }
            const float R0p = __shfl_xor(R0, 32), R1p = __shfl_xor(R1, 32);
            float suf_hi = carry - (hh == 0 ? R1p : 0.f);
            float suf_lo = carry - R1 - R1p - (hh == 0 ? R0p : 0.f);
            float w[16];
#pragma unroll
            for (int r = 15; r >= 8; --r) { w[r] = __builtin_amdgcn_exp2f(S[r] - sp[r] + suf_hi); suf_hi -= sp[r]; }
#pragma unroll
            for (int r = 7; r >= 0; --r) { w[r] = __builtin_amdgcn_exp2f(S[r] - sp[r] + suf_lo); suf_lo -= sp[r]; }
            if (diag) {
#pragma unroll
                for (int r = 0; r < 16; ++r) { const int kk = 16 * (r >> 3) + 8 * hh + (r & 7); if (kk >= l31) w[r] = 0.f; }
            }
            carry -= (R0 + R1 + R0p + R1p);
            bf16x8 wb[2];
            __builtin_amdgcn_sched_barrier(0);
#pragma unroll
            for (int s = 0; s < 2; ++s) { u32x4 pk; pk.x = cvt_pk_bf16(w[8 * s + 0], w[8 * s + 1]); pk.y = cvt_pk_bf16(w[8 * s + 2], w[8 * s + 3]); pk.z = cvt_pk_bf16(w[8 * s + 4], w[8 * s + 5]); pk.w = cvt_pk_bf16(w[8 * s + 6], w[8 * s + 7]);
                wb[s] = __builtin_bit_cast(bf16x8, pk); }
#pragma unroll
            for (int m = 0; m < 4; ++m)
#pragma unroll
                for (int s = 0; s < 2; ++s) { const bf16x8 vtf = *(const bf16x8*)(wl + 8192 + (32 * m + l31) * 64 + (((2 * s + hh) ^ (((32 * m + l31) >> 2) & 3)) * 16)); O[m] = MFMA32(vtf, wb[s], O[m]); }
            if (!__any(carry >= -150.1f)) break;
        }
        float ss = 0.f;
#pragma unroll
        for (int m = 0; m < 4; ++m)
#pragma unroll
            for (int r = 0; r < 16; ++r) ss += O[m][r] * O[m][r];
        ss += __shfl_xor(ss, 32);
        const float rstd = rsqrtf(ss * (1.0f / HD) + EPS);
        const float* mg = c.in[13] + (size_t)l * DM + DLRU + DCONV + h * HD + 4 * hh;
        bf16_t* yp = c.YMIX() + (size_t)(b * SEQ + q0 + l31) * DM + DLRU + DCONV + h * HD + 4 * hh;
#pragma unroll
        for (int m = 0; m < 4; ++m)
#pragma unroll
            for (int g = 0; g < 4; ++g) {
                const f32x4 gg = *(const f32x4*)(mg + 32 * m + 8 * g);
                u32x2 o; o.x = cvt_pk_bf16(O[m][4 * g] * rstd * gg[0], O[m][4 * g + 1] * rstd * gg[1]); o.y = cvt_pk_bf16(O[m][4 * g + 2] * rstd * gg[2], O[m][4 * g + 3] * rstd * gg[3]);
                *(u32x2*)(yp + 32 * m + 8 * g) = o;
            }
    }
}

#define XB_TMO      128
#define XB_XCNT(j)  (256  + 64 * (j))
#define XB_XSUB(j)  (1280 + 64 * (j))
#define XB_XGEN(j)  (2304 + 64 * (j))
#define XB_TOP      3328
#define XB_TOPGEN   3392
#define XCD_BAR_WORDS 3456
#define XB_SPIN_CAP (1u << 18)
__device__ __forceinline__ unsigned xb_ld(unsigned* p)              { return __hip_atomic_load(p, __ATOMIC_RELAXED, __HIP_MEMORY_SCOPE_AGENT); }
__device__ __forceinline__ unsigned xb_add(unsigned* p, unsigned v) { return __hip_atomic_fetch_add(p, v, __ATOMIC_RELAXED, __HIP_MEMORY_SCOPE_AGENT); }
__device__ __forceinline__ unsigned xb_xcc_id() { return (unsigned)__builtin_amdgcn_s_getreg((3 << 11) | 20) & 0xFu; }
#define XB_SPIN(cond, bar) do { unsigned _sp = 0; while (cond) { __builtin_amdgcn_s_sleep(1); \
    if ((++_sp & 255u) == 0u) { if (xb_ld(&(bar)[XB_TMO])) break; if (_sp > XB_SPIN_CAP) { atomicAdd(&(bar)[XB_TMO], 1u); break; } } } } while (0)
struct XcdBarrier { unsigned* bar; unsigned x; volatile LAS unsigned* st; };
__device__ __forceinline__ XcdBarrier xcd_barrier_post(unsigned* bar, volatile LAS unsigned* st) {
    XcdBarrier b; b.bar = bar; b.x = xb_xcc_id(); b.st = st;
    if (threadIdx.x == 0) (void)xb_add(&bar[XB_XCNT(b.x)], 1u);
    return b;
}
__device__ __forceinline__ void xcd_barrier_complete(unsigned* bar, unsigned x, unsigned& nloc, unsigned& nx) {
    const unsigned G = gridDim.x * gridDim.y * gridDim.z;
    unsigned sum, cnt, mine, sp = 0u;
    for (;;) {
        sum = 0u; cnt = 0u; mine = 0u;
#pragma unroll
        for (unsigned j = 0; j < 16; ++j) { const unsigned c = xb_ld(&bar[XB_XCNT(j)]); sum += c; cnt += (c > 0u) ? 1u : 0u; mine = (j == x) ? c : mine; }
        if (sum == G) break;
        __builtin_amdgcn_s_sleep(1);
        if ((++sp & 255u) == 0u) { if (xb_ld(&bar[XB_TMO])) break; if (sp > XB_SPIN_CAP) { atomicAdd(&bar[XB_TMO], 1u); break; } }
    }
    nloc = mine > 0u ? mine : 1u; nx = cnt > 0u ? cnt : 1u;
}
__device__ __forceinline__ void xcd_barrier(const XcdBarrier& b) {
    asm volatile("s_waitcnt vmcnt(0)" ::: "memory");
    __syncthreads();
    if (threadIdx.x == 0) {
        unsigned* bar = b.bar;
        __builtin_amdgcn_s_waitcnt(0);
        unsigned nloc = b.st[0], nx = b.st[1];
        if (nloc == 0u) { xcd_barrier_complete(bar, b.x, nloc, nx); b.st[0] = nloc; b.st[1] = nx; }
        const unsigned old = xb_add(&bar[XB_XSUB(b.x)], 1u);
        const unsigned gen = old / nloc;
        if (old + 1u == (gen + 1u) * nloc) {
            __builtin_amdgcn_fence(__ATOMIC_RELEASE, "agent");
            asm volatile("s_waitcnt vmcnt(0)" ::: "memory");
            const unsigned og = xb_add(&bar[XB_TOP], 1u);
            const unsigned tg = og / nx;
            if (og + 1u == (tg + 1u) * nx) xb_add(&bar[XB_TOPGEN], 1u);
            else XB_SPIN(xb_ld(&bar[XB_TOPGEN]) == tg, bar);
            __builtin_amdgcn_fence(__ATOMIC_ACQUIRE, "agent");
            xb_add(&bar[XB_XGEN(b.x)], 1u);
            asm volatile("s_waitcnt vmcnt(0)" ::: "memory");
        } else {
            XB_SPIN(xb_ld(&bar[XB_XGEN(b.x)]) == gen, bar);
            __builtin_amdgcn_fence(__ATOMIC_ACQUIRE, "agent");
            asm volatile("s_waitcnt vmcnt(0)" ::: "memory");
        }
    }
    __syncthreads();
}

constexpr int NPH_LAYER = 7, NPH = 1 + DEPTH * NPH_LAYER;
constexpr int LDS_TAB = g8::STAGE_BYTES, LDS_BARW = g8::STAGE_BYTES + 2048, LDS_KX = g8::STAGE_BYTES + 4096, LDS_BYTES = g8::STAGE_BYTES + 4096 + 8192;
__global__ void __launch_bounds__(512, 2) mega(Params p) {
    extern __shared__ __attribute__((aligned(16))) unsigned char lds_raw[];
    float* lds = (float*)lds_raw;
    LAS unsigned char* ldsl = (LAS unsigned char*)lds_raw;
    MoeTab* mt = (MoeTab*)(lds_raw + LDS_TAB);
    Ctx c0; c0.in.p = p.in; c0.in.z = 0; c0.out = p.out; c0.ws = p.ws;
    const int lo = p.ph_lo, hi = p.ph_hi;
    if (threadIdx.x == 0) *(uint4*)(lds_raw + LDS_BARW) = make_uint4(0u, 0u, 0u, 0u);
    __syncthreads();
    XcdBarrier bar = xcd_barrier_post(c0.ctl(), (volatile LAS unsigned*)(ldsl + LDS_BARW));
#ifndef PH_MASK
#define PH_MASK 0x1ff
#endif
#define PHT(k) ((k) == 0 ? 0 : 1 + ((k) - 1) % NPH_LAYER)
#define IN(k) (((PH_MASK >> PHT(k)) & 1) && lo <= (k) && (k) < hi)
#define SEAM(k) do { if (IN(k) && IN((k) + 1)) xcd_barrier(bar); } while (0)
#ifndef PROBE_RSH
#define PROBE_RSH 0
#endif
#ifndef PROBE_DUP
#define PROBE_DUP 0x0
#endif
#define REP(k) for (int rep_ = 0; rep_ < (((PROBE_DUP >> PHT(k)) & 1) ? 2 : 1); ++rep_)
    REP(0) if (IN(0)) { if (rep_) xcd_barrier(bar); const Ctx c = octx(c0); phase_convert(c, lds); phase_norm_in(c, 0); }
    SEAM(0);
#define LAYER_BODY(l) { \
        const int pb = 1 + l * NPH_LAYER; \
        REP(pb + 0) if (IN(pb + 0)) { if (rep_) xcd_barrier(bar); const Ctx c = octx(c0); const bool split_ = (gridDim.x == 256); \
            { g8::DenseOrder S; S.init(T, DIN, gridDim.x, obid(), c.WIN(l), DM); if (split_) S.lim = 1280; g8::MEpiProj E{c.PROJ(), c.VT(), (LAS float*)(ldsl + LDS_KX), c.in[11] + l * HD, c.in[12] + l * HD}; g8::gemm_mfma(ldsl, c.HB(), DM, DM, DM, S, E); } \
            if (split_) { const int cb_ = obid(), kq_ = cb_ & 3; g8::SplitKOrder S{cb_, (const char*)(c.WIN(l) + (size_t)(20 * 256) * DM + kq_ * 512)}; g8::MEpiPart E{c.PT()}; g8::gemm_mfma(ldsl, c.HB() + kq_ * 512, DM, DM, 512, S, E); } } \
        SEAM(pb + 0); \
        REP(pb + 1) if (IN(pb + 1)) { if (rep_) xcd_barrier(bar); const Ctx c = octx(c0); if (gridDim.x == 256) phase_vreduce(c); phase_convb(c, l); if (PROBE_SUB == 4) phase_convb(c, l); phase_lruA(c, l, lds_raw); if (PROBE_SUB == 3) phase_lruA(c, l, lds_raw); } \
        SEAM(pb + 1); \
        REP(pb + 2) if (IN(pb + 2)) { if (rep_) xcd_barrier(bar); const Ctx c = octx(c0); phase_lruB(c, l, lds_raw); if (PROBE_SUB == 2) phase_lruB(c, l, lds_raw); phase_attn(c, l, lds_raw); if (PROBE_SUB == 1) phase_attn(c, l, lds_raw); } \
        SEAM(pb + 2); \
        REP(pb + 3) if (IN(pb + 3)) { if (rep_) xcd_barrier(bar); const Ctx c = octx(c0); g8::DenseOrder S; S.init(T, DM, gridDim.x, obid(), c.WOUT(l), DM); if (PROBE_RSH == 3 && l == 0) S.rsh = 1; g8::MEpiDown E{c.DB()}; g8::gemm_mfma(ldsl, c.YMIX(), DM, DM, DM, S, E);       } \
        SEAM(pb + 3); \
        REP(pb + 4) if (IN(pb + 4)) { if (rep_) xcd_barrier(bar); const Ctx c = octx(c0); phase_router_mfma(c, l, lds); } \
        SEAM(pb + 4); \
        REP(pb + 5) if (IN(pb + 5)) { if (rep_) xcd_barrier(bar); const Ctx c = octx(c0); build_moe_tab(c, l, mt); \
            const int G_ = (int)gridDim.x, cb_ = obid(), n1_ = __builtin_amdgcn_readfirstlane(mt->tstart[NEXP]) * 4, R_ = n1_ % G_, n1e_ = n1_ - R_, rtA_ = n1e_ >> 2; \
            { g8::MoeOrder<true, 4, DM, (size_t)1024 * DM * 2, (size_t)256 * DM * 2> S{mt, c.LIST(), G_, cb_, (const char*)c.WGU(l)}; g8::MEpiGU E{c.HID(), c.LISTR(), mt, c.RTC(l), n1e_}; g8::gemm_mfma(ldsl, c.X1(), DM, DM, DM, S, E); } \
            g8::moe_wait_dep(c.RTC(l), cb_, G_, R_, rtA_); \
            { g8::MoeOrder2 S{mt, G_, cb_, R_, rtA_, (const char*)c.WD(l)}; if (PROBE_RSH == 6) S.rsh = 1; g8::MEpiDown8 E{c.YPAD8()}; g8::gemm_mfma(ldsl, c.HID(), DEXP, DEXP, DEXP, S, E); } } \
        SEAM(pb + 5); \
        REP(pb + 6) if (IN(pb + 6)) { if (rep_) xcd_barrier(bar); const Ctx c = octx(c0); build_moe_tab(c, l, mt); if (PROBE_SUB == 6) { phase_combine<true>(c, l, mt); xcd_barrier(bar); } phase_combine<false>(c, l, mt); } \
        SEAM(pb + 6); \
    }
    LAYER_BODY(0)
    LAYER_BODY(1)
#undef LAYER_BODY
#undef IN
#undef SEAM
}

#ifndef N_LAUNCH_SPLIT
#define N_LAUNCH_SPLIT 0
#endif
extern "C" void kernel_launch(void* const* d_in, const int* in_sizes, int n_in, void* d_out, int out_size, void* d_ws, size_t ws_size, hipStream_t stream) {
    static int grid = 0;
    if (grid == 0) {
        if (n_in != 23 || out_size != T * DM || ws_size < WS_END) { fprintf(stderr, "kernel_launch: unexpected problem (n_in %d out %d ws %zu need %zu)\n", n_in, out_size, ws_size, (size_t)WS_END); grid = -1; return; }
        int dev = 0, cus = 0, per_cu = 0;
        if (hipGetDevice(&dev) != hipSuccess || hipDeviceGetAttribute(&cus, hipDeviceAttributeMultiprocessorCount, dev) != hipSuccess) { fprintf(stderr, "kernel_launch: device query failed\n"); grid = -1; return; }
        if (hipFuncSetAttribute((const void*)mega, hipFuncAttributeMaxDynamicSharedMemorySize, LDS_BYTES) != hipSuccess) { fprintf(stderr, "kernel_launch: hipFuncSetAttribute failed\n"); grid = -1; return; }
        if (hipOccupancyMaxActiveBlocksPerMultiprocessor(&per_cu, (const void*)mega, 512, LDS_BYTES) != hipSuccess || per_cu < 1) { fprintf(stderr, "kernel_launch: occupancy query says %d blocks per CU\n", per_cu); }
        (void)hipGetLastError();
        grid = cus;
    }
    if (grid < 0) return;
    (void)hipMemsetAsync((char*)d_ws + OFF_CTL, 0, SZ_CTL, stream);
    Params p{};
    for (int i = 0; i < 23; ++i) p.in[i] = (const float*)d_in[i];
    p.out = (float*)d_out; p.ws = (unsigned char*)d_ws;
    if (N_LAUNCH_SPLIT) { for (int ph = 0; ph < NPH; ++ph) { p.ph_lo = ph; p.ph_hi = ph + 1; hipLaunchKernelGGL(mega, dim3(grid), dim3(512), LDS_BYTES, stream, p); } }
    else { p.ph_lo = 0; p.ph_hi = NPH; hipLaunchKernelGGL(mega, dim3(grid), dim3(512), LDS_BYTES, stream, p); }
}
```

```cpp
#include <hip/hip_runtime.h>
#include <stdint.h>
#include <stdio.h>

typedef unsigned short bf16_t;
typedef float f32x4 __attribute__((ext_vector_type(4)));
typedef unsigned u32x4 __attribute__((ext_vector_type(4)));
typedef unsigned u32x2 __attribute__((ext_vector_type(2)));
typedef short bf16x8 __attribute__((ext_vector_type(8)));

constexpr int T = 16384, DM = 2048, DIN = 5376, DPROJ = 4608, SEQ = 4096, NB = 4, DEPTH = 2;
constexpr int DLRU = 768, DCONV = 512, DSB = 768, HD = 128, NHL = 6, NHS = 6;
constexpr int NEXP = 32, DEXP = 512, MAXTILES = 160, PADROWS = MAXTILES * 256;
constexpr float EPS = 1e-6f;
constexpr float YSCALE_G = 8.0f;
constexpr float SX8 = 8.0f, SW1 = 64.0f, SH8 = 8.0f, SW2 = 32.0f;
#ifndef F8_INPROJ_MASK
#define F8_INPROJ_MASK 2
#endif
constexpr bool f8in(int l) { return ((F8_INPROJ_MASK >> l) & 1) != 0; }
constexpr float SHB = 16.0f, SWI = 64.0f;
#ifndef PITCH_PAD
#define PITCH_PAD 128
#endif
constexpr int pb_in(int l) { return (f8in(l) ? DM : DM * 2) + PITCH_PAD; }
constexpr int VTS = SEQ + 64;
constexpr int C_XA = 0, C_GA = 768, C_BG = 1536, C_CG = 2048, C_XB = 2560, C_Q = 3072, C_K = 3840, C_V = 4608;

constexpr size_t AL(size_t x) { return (x + 255) & ~(size_t)255; }
constexpr size_t SZ_WIN = (size_t)DIN * (DM * 2 + 256), SZ_WOUT = (size_t)DM * DM * 2, SZ_WGU = (size_t)NEXP * 1024 * DM * 2, SZ_WD = (size_t)NEXP * DM * DEXP * 2;
constexpr size_t SZ_WA = (size_t)NHL * HD * HD * 2, SZ_WR = (size_t)48 * DM * 4;
constexpr size_t OFF_CTL = 0, SZ_CTL = 131072;
constexpr size_t OFF_WIN = OFF_CTL + SZ_CTL;
constexpr size_t OFF_WOUT = OFF_WIN + DEPTH * SZ_WIN;
constexpr size_t OFF_WGU = OFF_WOUT + DEPTH * SZ_WOUT;
constexpr size_t OFF_WD = OFF_WGU + DEPTH * SZ_WGU;
constexpr size_t OFF_WA = OFF_WD + DEPTH * SZ_WD;
constexpr size_t OFF_WX = OFF_WA + DEPTH * SZ_WA;
constexpr size_t OFF_WR = OFF_WX + DEPTH * SZ_WA;
constexpr size_t OFF_HB = OFF_WR + DEPTH * SZ_WR;
constexpr size_t OFF_PROJ = OFF_HB + (size_t)T * (DM * 2 + 256);
constexpr size_t OFF_VT = OFF_PROJ + (size_t)T * DPROJ * 2;
constexpr size_t OFF_YPAD = OFF_PROJ;
constexpr size_t OFF_YMIX = OFF_VT + (size_t)NB * NHS * HD * VTS * 2;
constexpr size_t OFF_X = OFF_YMIX + (size_t)T * DM * 2;
constexpr size_t OFF_HID = OFF_X + (size_t)T * DM * 4;
constexpr size_t OFF_AGG = OFF_HID + (size_t)PADROWS * DEXP * 2;
constexpr size_t OFF_ROUTE = OFF_AGG + (size_t)256 * DLRU * 8;
constexpr size_t OFF_LIST = OFF_ROUTE + (size_t)T * 8 * 4;
constexpr size_t OFF_LISTR = OFF_LIST + (size_t)NEXP * T * 4;
constexpr size_t OFF_DB = OFF_LISTR + (size_t)NEXP * T * 4;
constexpr size_t WS_END = OFF_DB + (size_t)T * DM * 2;
static_assert((size_t)PADROWS * DM * 2 <= (size_t)T * DPROJ * 2 + (size_t)NB * NHS * HD * VTS * 2, "YPAD alias");
constexpr int CW_RT = 16384;
constexpr int CW_CNT = 8192;

typedef __bf16 bf16v2_t __attribute__((ext_vector_type(2)));
typedef float f32v2_t __attribute__((ext_vector_type(2)));
__device__ __forceinline__ unsigned cvt_pk_bf16(float lo, float hi) { const f32v2_t f = {lo, hi}; const bf16v2_t b = __builtin_convertvector(f, bf16v2_t); return __builtin_bit_cast(unsigned, b); }
__device__ __forceinline__ bf16_t f2bf(float f) { return (bf16_t)(cvt_pk_bf16(f, 0.f) & 0xffffu); }
__device__ __forceinline__ float bf2f(bf16_t b) { return __uint_as_float(((unsigned)b) << 16); }
__device__ __forceinline__ float bflo(unsigned w) { return __uint_as_float(w << 16); }
__device__ __forceinline__ float bfhi(unsigned w) { return __uint_as_float(w & 0xffff0000u); }
__device__ __forceinline__ float wave_sum(float v) {
#pragma unroll
    for (int o = 32; o >= 1; o >>= 1) v += __shfl_xor(v, o);
    return v;
}
__device__ __forceinline__ float fast_exp(float x) { return __builtin_amdgcn_exp2f(x * 1.4426950408889634f); }
__device__ __forceinline__ float sigmoidf_(float x) { return __builtin_amdgcn_rcpf(1.0f + fast_exp(-x)); }
__device__ __forceinline__ float one_minus_exp(float x) { const float s = -x * (1.0f + x * (0.5f + x * 0.16666667f)); const float d = 1.0f - fast_exp(x); return x > -0.02f ? s : d; }
__device__ __forceinline__ float softplusf_(float x) { return fmaxf(x, 0.f) + log1pf(__expf(-fabsf(x))); }
__device__ __forceinline__ float gelu_tanh(float x) { const float u2 = 1.5957691216057308f * (x + 0.044715f * x * x * x); return x * sigmoidf_(u2); }

__device__ __forceinline__ int otid() { int t = (int)threadIdx.x; asm volatile("" : "+v"(t)); return t; }
__device__ __forceinline__ int obid() { int b = (int)blockIdx.x; asm volatile("" : "+s"(b)); return b; }
#ifndef PROBE_SUB
#define PROBE_SUB 0
#endif
struct Params { const float* in[23]; float* out; unsigned char* ws; int ph_lo, ph_hi; };

struct InProxy { const float* const* p; int z; __device__ __forceinline__ const float* operator[](int k) const { return p[k + z]; } };
struct Ctx {
    InProxy in; float* out; unsigned char* ws;
    __device__ __forceinline__ unsigned* ctl() const { return (unsigned*)(ws + OFF_CTL); }
    __device__ __forceinline__ bf16_t* WIN(int l) const { return (bf16_t*)(ws + OFF_WIN + l * SZ_WIN); }
    __device__ __forceinline__ bf16_t* WOUT(int l) const { return (bf16_t*)(ws + OFF_WOUT + l * SZ_WOUT); }
    __device__ __forceinline__ bf16_t* WGU(int l) const { return (bf16_t*)(ws + OFF_WGU + l * SZ_WGU); }
    __device__ __forceinline__ bf16_t* WD(int l) const { return (bf16_t*)(ws + OFF_WD + l * SZ_WD); }
    __device__ __forceinline__ bf16_t* WA(int l) const { return (bf16_t*)(ws + OFF_WA + l * SZ_WA); }
    __device__ __forceinline__ bf16_t* WX(int l) const { return (bf16_t*)(ws + OFF_WX + l * SZ_WA); }
    __device__ __forceinline__ float* WR(int l) const { return (float*)(ws + OFF_WR + l * SZ_WR); }
    __device__ __forceinline__ unsigned* RTC(int l) const { return ctl() + CW_RT + l * 8192; }
    __device__ __forceinline__ unsigned* CNT(int l) const { return ctl() + CW_CNT + l * 2048; }
#define WSP(name, type, off) __device__ __forceinline__ type* name() const { return (type*)(ws + (off)); }
    WSP(HB, bf16_t, OFF_HB) WSP(PROJ, bf16_t, OFF_PROJ) WSP(VT, bf16_t, OFF_VT) WSP(YPAD, bf16_t, OFF_YPAD) WSP(YPAD8, unsigned char, OFF_YPAD) WSP(YMIX, bf16_t, OFF_YMIX) WSP(HID, bf16_t, OFF_HID)
    WSP(X, float, OFF_X) WSP(XB, bf16_t, OFF_X) WSP(AGG, float, OFF_AGG) WSP(ROUTE, unsigned, OFF_ROUTE) WSP(LIST, int, OFF_LIST) WSP(LISTR, float, OFF_LISTR) WSP(PT, bf16_t, OFF_X + (size_t)T * DM * 2) WSP(X1, bf16_t, OFF_X + (size_t)T * DM * 2) WSP(X1F8, unsigned char, OFF_HB) WSP(HID8, unsigned char, OFF_HID) WSP(DB, bf16_t, OFF_DB) WSP(HL, bf16_t, OFF_DB) WSP(PL, bf16_t, OFF_DB + (size_t)T * DLRU * 2)
#undef WSP
};

__device__ __forceinline__ Ctx octx(const Ctx& c) { int z = 0; asm volatile("" : "+s"(z)); Ctx r; r.in.p = c.in.p; r.in.z = z; r.out = c.out + z; r.ws = c.ws + z; return r; }

__device__ __forceinline__ void cvt_tile_out(const float* tile, int st, int r0, bf16_t* dst, int ld_dst, int drow0, bool f8) {
    const int rr = (st & 7) * 8;
    if (f8) {
#pragma unroll
        for (int p = 0; p < 2; ++p) {
            const int c = (st >> 3) + 32 * p; int w0 = 0, w1 = 0;
            w0 = __builtin_amdgcn_cvt_pk_fp8_f32(tile[(rr + 0) * 65 + c], tile[(rr + 1) * 65 + c], w0, false); w0 = __builtin_amdgcn_cvt_pk_fp8_f32(tile[(rr + 2) * 65 + c], tile[(rr + 3) * 65 + c], w0, true);
            w1 = __builtin_amdgcn_cvt_pk_fp8_f32(tile[(rr + 4) * 65 + c], tile[(rr + 5) * 65 + c], w1, false); w1 = __builtin_amdgcn_cvt_pk_fp8_f32(tile[(rr + 6) * 65 + c], tile[(rr + 7) * 65 + c], w1, true);
            *(u32x2*)((unsigned char*)dst + (size_t)(drow0 + c) * ld_dst + r0 + rr) = (u32x2){(unsigned)w0, (unsigned)w1};
        }
        return;
    }
#pragma unroll
    for (int p = 0; p < 2; ++p) {
        const int c = (st >> 3) + 32 * p;
        u32x4 w;
        w.x = cvt_pk_bf16(tile[(rr + 0) * 65 + c], tile[(rr + 1) * 65 + c]); w.y = cvt_pk_bf16(tile[(rr + 2) * 65 + c], tile[(rr + 3) * 65 + c]);
        w.z = cvt_pk_bf16(tile[(rr + 4) * 65 + c], tile[(rr + 5) * 65 + c]); w.w = cvt_pk_bf16(tile[(rr + 6) * 65 + c], tile[(rr + 7) * 65 + c]);
        *(u32x4*)(dst + (size_t)(drow0 + c) * ld_dst + r0 + rr) = w;
    }
}
constexpr int CV_WIN = 32 * 84, CV_WOUT = 32 * 32, CV_EXP = 32 * 8  , CV_G = NEXP * CV_EXP, CV_LRU = NHL * 4;
constexpr int CV_PER_LAYER = CV_WIN + CV_WOUT + 3 * CV_G + 2 * CV_LRU;
struct CvtTile { const float* src; bf16_t* dst; const float* gk; int ld_src, ld_dst, r0, c0, drow0; float sc; };
__device__ __forceinline__ void cvt_decode(const Ctx& c, int id, CvtTile& t) {
    const int l = id / CV_PER_LAYER; int j = id % CV_PER_LAYER; t.gk = nullptr; t.sc = 1.0f;
    if (j < CV_WIN) { t.src = c.in[2] + (size_t)l * DM * DIN; t.ld_src = DIN; { const int g = j >> 3, kp = g / 21, nq = g % 21; t.r0 = (2 * kp + ((j >> 2) & 1)) * 64; t.c0 = (4 * nq + (j & 3)) * 64; } t.dst = c.WIN(l); t.ld_dst = f8in(l) ? pb_in(l) : pb_in(l) / 2; t.drow0 = t.c0; if (f8in(l)) t.sc = -SWI; }
    else if ((j -= CV_WIN) < CV_WOUT) { t.src = c.in[14] + (size_t)l * DM * DM; t.ld_src = DM; { const int g = j >> 3, kp = g / 8, nq = g % 8; t.r0 = (2 * kp + ((j >> 2) & 1)) * 64; t.c0 = (4 * nq + (j & 3)) * 64; } t.dst = c.WOUT(l); t.ld_dst = DM; t.drow0 = t.c0; }
    else if ((j -= CV_WOUT) < 2 * CV_G) {
        const int isup = j / CV_G; j %= CV_G; const int e = j / CV_EXP; j %= CV_EXP;
        t.src = c.in[isup ? 21 : 20] + ((size_t)l * NEXP + e) * DM * DEXP; t.ld_src = DEXP; { const int g = j >> 3, kp = g / 2, nq = g % 2; t.r0 = (2 * kp + ((j >> 2) & 1)) * 64; t.c0 = (4 * nq + (j & 3)) * 64; }
        t.dst = (bf16_t*)((unsigned char*)c.WGU(l) + (size_t)e * 1024 * DM); t.ld_dst = DM; t.drow0 = 256 * (t.c0 / 128) + 128 * isup + (t.c0 % 128); t.gk = c.in[15] + (size_t)l * DM; t.sc = -SW1;
    } else if ((j -= 2 * CV_G) < CV_G) {
        const int e = j / CV_EXP; j %= CV_EXP;
        t.src = c.in[22] + ((size_t)l * NEXP + e) * DEXP * DM; t.ld_src = DM; { const int g = j >> 3, kp = g / 8, nq = g % 8; t.r0 = (2 * kp + ((j >> 2) & 1)) * 64; t.c0 = (4 * nq + (j & 3)) * 64; }
        t.dst = (bf16_t*)((unsigned char*)c.WD(l) + (size_t)e * DM * DEXP); t.ld_dst = DEXP; t.drow0 = t.c0; t.sc = -SW2;
    } else { j -= CV_G; const int isx = j / CV_LRU; j %= CV_LRU; const int h = j / 4; j %= 4;
        t.src = c.in[isx ? 7 : 5] + ((size_t)l * NHL + h) * HD * HD; t.ld_src = HD; t.r0 = (j / 2) * 64; t.c0 = (j % 2) * 64;
        t.dst = (isx ? c.WX(l) : c.WA(l)) + (size_t)h * HD * HD; t.ld_dst = HD; t.drow0 = t.c0; }
}
constexpr int CVT_NT = 4;
__device__ __forceinline__ void phase_convert(const Ctx& c, float* lds) {
    const int tid = otid(), sb = tid >> 8, st = tid & 255;
    float* tile0 = lds + sb * (CVT_NT * 64 * 65);
    const int total = DEPTH * CV_PER_LAYER;
    const int nsub = gridDim.x * 2 * CVT_NT;
    const int idb = (obid() * 2 + sb) * CVT_NT;
    CvtTile tA[CVT_NT]; f32x4 vA[CVT_NT][4];
#define CVT_LOAD(T_, V_, base_) do { _Pragma("unroll") for (int k = 0; k < CVT_NT; ++k) { const int id_ = (base_) + idb + k; cvt_decode(c, id_ < total ? id_ : 0, T_[k]); \
        _Pragma("unroll") for (int i = 0; i < 4; ++i) V_[k][i] = __builtin_nontemporal_load((const f32x4*)(T_[k].src + (size_t)(T_[k].r0 + (st >> 4) + 16 * i) * T_[k].ld_src + T_[k].c0 + (st & 15) * 4)); } } while (0)
#define CVT_FLUSH(T_, V_, base_) do { _Pragma("unroll") for (int k = 0; k < CVT_NT; ++k) _Pragma("unroll") for (int i = 0; i < 4; ++i) { \
            float* p = tile0 + k * (64 * 65) + ((st >> 4) + 16 * i) * 65 + (st & 15) * 4; const float gs_ = (T_[k].gk ? T_[k].gk[T_[k].r0 + (st >> 4) + 16 * i] : 1.0f) * fabsf(T_[k].sc); \
            p[0] = V_[k][i][0] * gs_; p[1] = V_[k][i][1] * gs_; p[2] = V_[k][i][2] * gs_; p[3] = V_[k][i][3] * gs_; } \
        __syncthreads(); \
        _Pragma("unroll") for (int k = 0; k < CVT_NT; ++k) if ((base_) + idb + k < total) cvt_tile_out(tile0 + k * (64 * 65), st, T_[k].r0, T_[k].dst, T_[k].ld_dst, T_[k].drow0, T_[k].sc < 0.f); \
        __syncthreads(); } while (0)
    for (int base = 0; base < total; base += nsub) { CVT_LOAD(tA, vA, base); CVT_FLUSH(tA, vA, base); }
#undef CVT_LOAD
#undef CVT_FLUSH
    for (int i = obid() * blockDim.x + tid; i < DEPTH * 48 * DM; i += gridDim.x * blockDim.x) {
        const int l = i / (48 * DM), n = (i / DM) % 48, k = i % DM;
        float v = 0.f;
        if (n < 4) v = c.in[16][((size_t)l * DM + k) * 4 + n]; else if (n < 36) v = c.in[18][((size_t)l * DM + k) * 32 + (n - 4)];
        const float wg = v * c.in[15][(size_t)l * DM + k]; const bf16_t hi = f2bf(wg);
        bf16_t* wr = (bf16_t*)c.WR(l); wr[(size_t)n * DM + k] = hi; wr[(size_t)(48 + n) * DM + k] = f2bf(wg - bf2f(hi));
    }
}

__device__ __forceinline__ void norm_store_row(const f32x4 (&v)[8], const float* g, bf16_t* dst, int lane) {
    float s = 0.f;
#pragma unroll
    for (int j = 0; j < 8; ++j) s += v[j][0] * v[j][0] + v[j][1] * v[j][1] + v[j][2] * v[j][2] + v[j][3] * v[j][3];
    s = wave_sum(s);
    const float rstd = rsqrtf(s * (1.0f / DM) + EPS);
#pragma unroll
    for (int j = 0; j < 8; ++j) {
        const f32x4 gg = *(const f32x4*)(g + j * 256 + lane * 4);
        u32x2 w; w.x = cvt_pk_bf16(v[j][0] * rstd * gg[0], v[j][1] * rstd * gg[1]); w.y = cvt_pk_bf16(v[j][2] * rstd * gg[2], v[j][3] * rstd * gg[3]);
        *(u32x2*)(dst + j * 256 + lane * 4) = w;
    }
}
__device__ __forceinline__ void norm_store_row8(const f32x4 (&v)[8], const float* g, unsigned char* dst, int lane) {
    float s = 0.f;
#pragma unroll
    for (int j = 0; j < 8; ++j) s += v[j][0] * v[j][0] + v[j][1] * v[j][1] + v[j][2] * v[j][2] + v[j][3] * v[j][3];
    s = wave_sum(s);
    const float rstd = rsqrtf(s * (1.0f / DM) + EPS) * SHB;
#pragma unroll
    for (int j = 0; j < 8; ++j) {
        const f32x4 gg = *(const f32x4*)(g + j * 256 + lane * 4);
        int w = 0; w = __builtin_amdgcn_cvt_pk_fp8_f32(v[j][0] * rstd * gg[0], v[j][1] * rstd * gg[1], w, false); w = __builtin_amdgcn_cvt_pk_fp8_f32(v[j][2] * rstd * gg[2], v[j][3] * rstd * gg[3], w, true);
        *(int*)(dst + j * 256 + lane * 4) = w;
    }
}
__device__ __forceinline__ void phase_norm_in(const Ctx& c, int l) {
    const int tid = otid(), lane = tid & 63, wv = tid >> 6, stride = gridDim.x * 8;
    for (int r = obid() * 8 + wv; r < T; r += 4 * stride) {
        f32x4 v[4][8];
#pragma unroll
        for (int k = 0; k < 4; ++k) { const int rr = (r + k * stride < T) ? r + k * stride : r;
#pragma unroll
            for (int j = 0; j < 8; ++j) v[k][j] = *(const f32x4*)(c.in[0] + (size_t)rr * DM + j * 256 + lane * 4); }
#pragma unroll
        for (int k = 0; k < 4; ++k) if (k == 0 || r + k * stride < T) norm_store_row(v[k], c.in[1] + (size_t)l * DM, (bf16_t*)((unsigned char*)c.HB() + (size_t)(r + k * stride) * pb_in(0)), lane);
    }
}

struct MoeTab { int cnt[NEXP]; int tstart[NEXP + 1]; int texp[MAXTILES]; };
__device__ __forceinline__ void build_moe_tab(const Ctx& c, int l, MoeTab* mt) {
    __syncthreads();
    const int tid = otid();
    if (tid < 64) {
        const int n = tid < NEXP ? (int)__hip_atomic_load(c.CNT(l) + tid * 64, __ATOMIC_RELAXED, __HIP_MEMORY_SCOPE_AGENT) : 0;
        const int nt = (n + 255) >> 8;
        int incl = nt;
#pragma unroll
        for (int o = 1; o < 32; o <<= 1) { const int v = __shfl_up(incl, o); if (tid >= o) incl += v; }
        const int excl = incl - nt;
        if (tid < NEXP) { mt->cnt[tid] = n; mt->tstart[tid] = excl; for (int i = 0; i < nt; ++i) if (excl + i < MAXTILES) mt->texp[excl + i] = tid; }
        if (tid == NEXP - 1) mt->tstart[NEXP] = incl < MAXTILES ? incl : MAXTILES;
    }
    __syncthreads();
}

template <bool DRY> __device__ __forceinline__ void phase_combine(const Ctx& c, int l, const MoeTab* mt) {
    const int tid = otid(), lane = tid & 63, wv = tid >> 6, stride = gridDim.x * 8;
    bf16_t* XB = c.XB(); const bf16_t* X1 = c.X1(); const unsigned char* YPAD = c.YPAD8(); const unsigned* ROUTE = c.ROUTE();
    for (int r = obid() * 8 + wv; r < T; r += 2 * stride) {
        f32x4 v[2][8]; unsigned ya[2][8], yb[2][8]; u32x2 yd[2][8]; float g0[2], g1[2]; int rr[2];
#pragma unroll
        for (int k = 0; k < 2; ++k) {
            rr[k] = (r + k * stride < T) ? r + k * stride : r;
            const u32x4 ra = *(const u32x4*)(ROUTE + (size_t)rr[k] * 8); const u32x2 rb = *(const u32x2*)(ROUTE + (size_t)rr[k] * 8 + 4);
            const int e0 = ra.x, p0 = ra.y, e1 = ra.w, p1 = rb.x; g0[k] = __uint_as_float(ra.z) * (1.0f / YSCALE_G); g1[k] = __uint_as_float(rb.y) * (1.0f / YSCALE_G);
            const unsigned char* y0 = YPAD + ((size_t)mt->tstart[e0] * 256 + p0) * DM + lane * 4; const unsigned char* y1 = YPAD + ((size_t)mt->tstart[e1] * 256 + p1) * DM + lane * 4;
            const bf16_t* dp = X1 + (size_t)rr[k] * DM + lane * 4;
#pragma unroll
            for (int j = 0; j < 8; ++j) { v[k][j] = (f32x4){0.f, 0.f, 0.f, 0.f};
                ya[k][j] = *(const unsigned*)(y0 + j * 256); yb[k][j] = *(const unsigned*)(y1 + j * 256); yd[k][j] = *(const u32x2*)(dp + j * 256); }
        }
        __builtin_amdgcn_sched_barrier(0);
#pragma unroll
        for (int k = 0; k < 2; ++k) {
            if (k == 0 || r + stride < T) {
#pragma unroll
                for (int j = 0; j < 8; ++j) {
                    typedef float f32x2_t __attribute__((ext_vector_type(2)));
                    const f32x2_t a01 = __builtin_amdgcn_cvt_pk_f32_fp8((int)ya[k][j], false), a23 = __builtin_amdgcn_cvt_pk_f32_fp8((int)ya[k][j], true);
                    const f32x2_t b01 = __builtin_amdgcn_cvt_pk_f32_fp8((int)yb[k][j], false), b23 = __builtin_amdgcn_cvt_pk_f32_fp8((int)yb[k][j], true);
                    v[k][j][0] += bflo(yd[k][j].x) + g0[k] * a01.x + g1[k] * b01.x; v[k][j][1] += bfhi(yd[k][j].x) + g0[k] * a01.y + g1[k] * b01.y;
                    v[k][j][2] += bflo(yd[k][j].y) + g0[k] * a23.x + g1[k] * b23.x; v[k][j][3] += bfhi(yd[k][j].y) + g0[k] * a23.y + g1[k] * b23.y;
                }
                if (l == DEPTH - 1) {
                    if (!DRY) {
#pragma unroll
                    for (int j = 0; j < 8; ++j) *(f32x4*)(c.out + (size_t)rr[k] * DM + j * 256 + lane * 4) = v[k][j]; }
                    else norm_store_row(v[k], c.in[1], c.HB() + (size_t)rr[k] * DM, lane);
                } else {
                    if (!DRY) {
#pragma unroll
                    for (int j = 0; j < 8; ++j) { u32x2 xw; xw.x = cvt_pk_bf16(v[k][j][0], v[k][j][1]); xw.y = cvt_pk_bf16(v[k][j][2], v[k][j][3]); *(u32x2*)(XB + (size_t)rr[k] * DM + j * 256 + lane * 4) = xw; } }
                    if (f8in(l + 1)) norm_store_row8(v[k], c.in[1] + (size_t)(l + 1) * DM, (unsigned char*)c.HB() + (size_t)rr[k] * pb_in(l + 1), lane);
                    else norm_store_row(v[k], c.in[1] + (size_t)(l + 1) * DM, (bf16_t*)((unsigned char*)c.HB() + (size_t)rr[k] * pb_in(l + 1)), lane);
                }
            }
        }
    }
}

__device__ __forceinline__ void phase_router_mfma(const Ctx& c, int l, float* lds) {
    float* LG = lds; float* SS = lds + 26624; float* RS = lds + 27136; int* LC = (int*)(lds + 27200); int* LB = (int*)(lds + 27232);
    const int tid = otid(), lane = tid & 63, wv = tid >> 6, rt = wv & 3, kh = wv >> 2, q = lane >> 4, l15 = lane & 15;
    const float* WR = c.WR(l);
    for (int tile = obid(); tile < T / 64; tile += gridDim.x) {
        const int r0 = tile * 64;
        f32x4 acc[4][3];
#pragma unroll
        for (int g = 0; g < 4; ++g)
#pragma unroll
            for (int ct = 0; ct < 3; ++ct) acc[g][ct] = (f32x4){0.f, 0.f, 0.f, 0.f};
        const bf16_t* xp = c.X1() + (size_t)(r0 + l15) * DM + wv * 256 + 8 * q;
        const bf16_t* wh = (const bf16_t*)WR + (size_t)l15 * DM + wv * 256 + 8 * q; const bf16_t* wl = wh + (size_t)48 * DM;
        float ssq[4] = {0.f, 0.f, 0.f, 0.f};
        bf16x8 xa[2][4], bh[2][3], bl[2][3];
#pragma unroll
        for (int st = 0; st < 2; ++st)
#pragma unroll
            for (int g = 0; g < 4; ++g) xa[st][g] = *(const bf16x8*)(xp + (size_t)(16 * g) * DM + 32 * st);
#pragma unroll
        for (int ct = 0; ct < 3; ++ct) { bh[0][ct] = *(const bf16x8*)(wh + (size_t)(16 * ct) * DM); bl[0][ct] = *(const bf16x8*)(wl + (size_t)(16 * ct) * DM); }
#define RT_STEP(st_, cur_, nxt_, ldb_, ldx_) do { \
            if (ldb_) { _Pragma("unroll") for (int ct = 0; ct < 3; ++ct) { bh[nxt_][ct] = *(const bf16x8*)(wh + (size_t)(16 * ct) * DM + 32 * ((st_) + 1)); bl[nxt_][ct] = *(const bf16x8*)(wl + (size_t)(16 * ct) * DM + 32 * ((st_) + 1)); } } \
            __builtin_amdgcn_sched_barrier(0); \
            _Pragma("unroll") for (int g = 0; g < 4; ++g) { \
                const bf16x8 xv = xa[cur_][g]; \
                _Pragma("unroll") for (int j = 0; j < 8; ++j) { const float xf = __uint_as_float(((unsigned)(unsigned short)xv[j]) << 16); ssq[g] += xf * xf; } \
                _Pragma("unroll") for (int ct = 0; ct < 3; ++ct) { acc[g][ct] = __builtin_amdgcn_mfma_f32_16x16x32_bf16(xv, bh[cur_][ct], acc[g][ct], 0, 0, 0); acc[g][ct] = __builtin_amdgcn_mfma_f32_16x16x32_bf16(xv, bl[cur_][ct], acc[g][ct], 0, 0, 0); } \
                if (ldx_) xa[cur_][g] = *(const bf16x8*)(xp + (size_t)(16 * g) * DM + 32 * ((st_) + 2)); } \
            __builtin_amdgcn_sched_barrier(0); } while (0)
#pragma unroll 1
        for (int sp = 0; sp < 4; ++sp) {
            RT_STEP(2 * sp, 0, 1, true, sp < 3);
            RT_STEP(2 * sp + 1, 1, 0, sp < 3, sp < 3);
        }
#undef RT_STEP
#pragma unroll
        for (int g = 0; g < 4; ++g) { float v = ssq[g]; v += __shfl_xor(v, 16); v += __shfl_xor(v, 32); if (q == 0) SS[wv * 64 + 16 * g + l15] = v; }
#pragma unroll
        for (int g = 0; g < 4; ++g)
#pragma unroll
            for (int ct = 0; ct < 3; ++ct)
#pragma unroll
                for (int i = 0; i < 4; ++i) LG[(wv * 64 + 16 * g + 4 * q + i) * 52 + 16 * ct + l15] = acc[g][ct][i];
        if (tid < NEXP) LC[tid] = 0;
        __syncthreads();
        int e0 = 0, e1 = 0, k0_ = 0, k1_ = 0; float rstd_ = 0.f, g0_ = 0.f, g1_ = 0.f;
        if (tid < 64) {
            float sst_ = 0.f;
#pragma unroll
            for (int w = 0; w < 8; ++w) sst_ += SS[w * 64 + tid];
            const float rstd = rsqrtf(sst_ * (1.0f / DM) + EPS);
            RS[tid] = rstd;
            float gl[4], el[8];
#pragma unroll
            for (int i = 0; i < 4; ++i) { float a_ = 0.f;
#pragma unroll
                for (int w = 0; w < 8; ++w) a_ += LG[(w * 64 + tid) * 52 + i];
                gl[i] = a_ * rstd + c.in[17][l * 4 + i]; }
            int gi = 0; float gm = gl[0];
#pragma unroll
            for (int i = 1; i < 4; ++i) if (gl[i] > gm) { gm = gl[i]; gi = i; }
            float gs = 0.f;
#pragma unroll
            for (int i = 0; i < 4; ++i) gs += __expf(gl[i] - gm);
            const float pg = 1.0f / gs;
#pragma unroll
            for (int i = 0; i < 8; ++i) { const int n = 4 + gi * 8 + i; float a_ = 0.f;
#pragma unroll
                for (int w = 0; w < 8; ++w) a_ += LG[(w * 64 + tid) * 52 + n];
                el[i] = a_ * rstd + c.in[19][l * 32 + gi * 8 + i]; }
            int i0 = 0; float m0 = el[0];
#pragma unroll
            for (int i = 1; i < 8; ++i) if (el[i] > m0) { m0 = el[i]; i0 = i; }
            int i1 = -1; float m1 = -3.0e38f;
#pragma unroll
            for (int i = 0; i < 8; ++i) if (i != i0 && el[i] > m1) { m1 = el[i]; i1 = i; }
            const float ex1 = __expf(m1 - m0), den = 1.0f + ex1;
            const float g0 = pg / den, g1 = pg * ex1 / den;
            e0 = gi * 8 + i0; e1 = gi * 8 + i1; rstd_ = rstd; g0_ = g0; g1_ = g1;
            k0_ = (int)__hip_atomic_fetch_add(&LC[e0], 1, __ATOMIC_RELAXED, __HIP_MEMORY_SCOPE_WORKGROUP);
            k1_ = (int)__hip_atomic_fetch_add(&LC[e1], 1, __ATOMIC_RELAXED, __HIP_MEMORY_SCOPE_WORKGROUP);
        }
        __syncthreads();
        if (tid < NEXP) { const int n = LC[tid]; LB[tid] = n > 0 ? (int)__hip_atomic_fetch_add(c.CNT(l) + tid * 64, (unsigned)n, __ATOMIC_RELAXED, __HIP_MEMORY_SCOPE_AGENT) : 0; }
        __syncthreads();
        if (tid < 64) {
            const int r = r0 + tid, p0 = LB[e0] + k0_, p1 = LB[e1] + k1_;
            c.LIST()[(size_t)e0 * T + p0] = r; c.LIST()[(size_t)e1 * T + p1] = r;
            c.LISTR()[(size_t)e0 * T + p0] = rstd_; c.LISTR()[(size_t)e1 * T + p1] = rstd_;
            unsigned* ro = c.ROUTE() + (size_t)r * 8;
            *(u32x4*)ro = (u32x4){(unsigned)e0, (unsigned)p0, __float_as_uint(g0_), (unsigned)e1};
            *(u32x2*)(ro + 4) = (u32x2){(unsigned)p1, __float_as_uint(g1_)};
        }
        __syncthreads();
    }
}

#define LAS __attribute__((address_space(3)))
typedef int i32x4_t __attribute__((ext_vector_type(4)));
typedef int i32x8_t __attribute__((ext_vector_type(8)));
__device__ __forceinline__ i32x8_t cat8(const bf16x8 a, const bf16x8 b) { const i32x4_t x = __builtin_bit_cast(i32x4_t, a), y = __builtin_bit_cast(i32x4_t, b); return __builtin_shufflevector(x, y, 0, 1, 2, 3, 4, 5, 6, 7); }
__device__ __forceinline__ void mfma_f8(f32x4& acc, const i32x8_t& a, const i32x8_t& b) { asm volatile("v_mfma_f32_16x16x128_f8f6f4 %0, %1, %2, %0" : "+v"(acc) : "v"(a), "v"(b)); }
__device__ __forceinline__ bf16x8 half8(const i32x8_t& v, int k) { const i32x4_t h = k ? __builtin_shufflevector(v, v, 4, 5, 6, 7) : __builtin_shufflevector(v, v, 0, 1, 2, 3); return __builtin_bit_cast(bf16x8, h); }
namespace g8 {
constexpr int BM = 256, BK = 64, HALF = 128, HTB = HALF * BK * 2, STAGE_BYTES = 8 * HTB, NXCD = 8, WGM = 8;
__device__ __forceinline__ int lds_byte(int r, int c) { const int st = (r >> 4) * 2 + (c >> 5), rr = r & 15, cc = c & 31, ob = rr * 64 + cc * 2; return st * 1024 + (ob ^ (((ob >> 9) & 1) << 5)); }
__device__ __forceinline__ void stage_rc(int b, int& R, int& C) { const int st = b / 1024, sb = b % 1024, swz = sb ^ (((sb >> 9) & 1) << 5); R = (st >> 1) * 16 + swz / 64; C = (st & 1) * 32 + (swz % 64) / 2; }
__device__ __forceinline__ int perm32(int rho) { const int n = rho >> 4, i = rho & 15; return 8 * (i >> 2) + 4 * n + (i & 3); }
struct Unit { int pm, pn; const char* B; };
typedef f32x4 Acc[2][2][4][2];

struct DenseOrder {
    static constexpr bool GATHER = false;
    int nM, nN, nwg, G, c; const char* Bt; size_t tstrideB; int rsh = 0, lim = 0x7fffffff;
    __device__ __forceinline__ void init(int M, int N, int G_, int c_, const bf16_t* Bt_, int ldb) { nM = M / BM; nN = N / BM; nwg = nM * nN; G = G_; c = c_; Bt = (const char*)Bt_; tstrideB = (size_t)BM * ldb * 2; }
    __device__ __forceinline__ bool next(int i, Unit& u) const {
        const long L = (long)(i >> rsh) * G + c; if (L >= nwg || L >= lim) return false;
        int wgid = (int)L; { const int q = nwg / NXCD, r = nwg % NXCD, xcd = wgid % NXCD, off = wgid / NXCD; wgid = (xcd < r ? xcd * (q + 1) : r * (q + 1) + (xcd - r) * q) + off; }
        const int nig = WGM * nN, gid = wgid / nig, fm = gid * WGM, gsz = (nM - fm) < WGM ? (nM - fm) : WGM;
        u.pm = fm + ((wgid % nig) % gsz); u.pn = (wgid % nig) / gsz; u.B = Bt + (size_t)u.pn * tstrideB; return true;
    }
    __device__ __forceinline__ unsigned arow_off(int) const { return 0u; }
};
struct SplitKOrder {
    static constexpr bool GATHER = false;
    int c; const char* Bt;
    __device__ __forceinline__ bool next(int i, Unit& u) const { if (i > 0) return false; u.pm = c >> 2; u.pn = c & 3; u.B = Bt; return true; }
    __device__ __forceinline__ unsigned arow_off(int) const { return 0u; }
};
template <bool GATHER_, int NCT, int LDA, size_t ESTRIDE, size_t TSTRIDE> struct MoeOrder {
    static constexpr bool GATHER = GATHER_;
    const MoeTab* mt; const int* LIST; int G, c; const char* W; int rsh = 0;
    __device__ __forceinline__ bool next(int i, Unit& u) const {
        const int L = (i >> rsh) * G + c; const int total = __builtin_amdgcn_readfirstlane(mt->tstart[NEXP]) * NCT; if (L >= total) return false;
        const int rt = L / NCT, ct = L % NCT; u.pm = rt; u.pn = ct; const int e = __builtin_amdgcn_readfirstlane(mt->texp[rt]); u.B = W + (size_t)e * ESTRIDE + (size_t)ct * TSTRIDE; return true;
    }
    __device__ __forceinline__ unsigned arow_off(int r) const {
        const int e = mt->texp[r >> 8]; const int pos = r - mt->tstart[e] * 256; const int tok = pos < mt->cnt[e] ? LIST[(size_t)e * T + pos] : 0; return (unsigned)tok * (unsigned)(LDA * 2);
    }
};

struct MoeOrder2 {
    static constexpr bool GATHER = false;
    const MoeTab* mt; int G, c, R, rtA; const char* W; int rsh = 0;
    __device__ __forceinline__ bool next(int i0, Unit& u) const {
        const int i = i0 >> rsh; int u2;
        if (c < R) { if (i >= 2) return false; u2 = rtA * 8 + 2 * c + i; }
        else { u2 = (c - R) + i * (G - R); if (u2 >= rtA * 8) return false; }
        const int rt = u2 >> 3, ct = u2 & 7; u.pm = rt; u.pn = ct; const int e = __builtin_amdgcn_readfirstlane(mt->texp[rt]);
        u.B = W + (size_t)e * ((size_t)DM * DEXP) + (size_t)ct * ((size_t)256 * DEXP); return true;
    }
    __device__ __forceinline__ unsigned arow_off(int) const { return 0u; }
};
__device__ __forceinline__ void moe_wait_dep(unsigned* rtc, int c, int G, int R, int rtA) {
    const int tid = otid();
    if (tid < 64) {
        int rt = -1;
        if (c < R) { if (tid < 2) rt = rtA + ((2 * c + tid) >> 3); } else if (tid < 32) { const int u2 = (c - R) + tid * (G - R); if (u2 < rtA * 8) rt = u2 >> 3; }
        unsigned spins = 0;
        for (;;) {
            const bool ok = rt < 0 || __hip_atomic_load(rtc + (rt < 0 ? 0 : rt) * 32, __ATOMIC_RELAXED, __HIP_MEMORY_SCOPE_AGENT) >= 32u;
            if (__all(ok)) break;
            __builtin_amdgcn_s_sleep(2); if (++spins > (1u << 22)) break;
        }
        __builtin_amdgcn_fence(__ATOMIC_ACQUIRE, "agent");
        asm volatile("s_waitcnt vmcnt(0)" ::: "memory");
    }
    __syncthreads();
}

template <class Epi, class Sched>
__device__ __forceinline__ void gemm_mfma(LAS unsigned char* lds, const bf16_t* A, int lda, int ldb, int K, const Sched& S, const Epi& E) {
    constexpr bool GATHER = Sched::GATHER;
    const int tid = otid(), wid = __builtin_amdgcn_readfirstlane(tid >> 6), lane = tid & 63, wr = wid >> 2, wc = wid & 3, fr = lane & 15, fq = lane >> 4;
    const int nt = K / BK;
    int Rst[2], Cst[2]; unsigned voffB[2], voA[2][2], voAn[2][2];
#pragma unroll
    for (int i = 0; i < 2; ++i) { stage_rc(tid * 16 + i * 8192, Rst[i], Cst[i]); const int Rb = Epi::PERM ? ((Rst[i] & ~31) + perm32(Rst[i] & 31)) : Rst[i];
        voffB[i] = (unsigned)(Rb * ldb + Cst[i]) * 2u;
#pragma unroll
        for (int h = 0; h < 2; ++h) { voA[h][i] = (unsigned)((h * HALF + Rst[i]) * lda + Cst[i]) * 2u; voAn[h][i] = voA[h][i]; } }
    const size_t kstep = (size_t)(BK * 2), hstepB = (size_t)HALF * ldb * 2, tstepA = (size_t)BM * lda * 2;
    const unsigned ldsw = (unsigned)wid * 1024u;
    const int aoff = lds_byte(wr * 64 + fr, fq * 8), boff = lds_byte(wc * 32 + fr, fq * 8);
#define G8_SA(b, h) (((b) * 2 + (h)) * HTB)
#define G8_SB(b, h) ((4 + (b) * 2 + (h)) * HTB)
#define G8_OPQ(x) ({ unsigned _o = (x); asm volatile("" : "+v"(_o)); _o; })
#define G8_STAGE_B(bufoff, gbase) do { _Pragma("unroll") for (int _i = 0; _i < 2; ++_i) \
        __builtin_amdgcn_global_load_lds((const unsigned*)((const char*)(gbase) + G8_OPQ(voffB[_i])), (LAS unsigned*)(lds + (bufoff) + ldsw + _i * 8192), 16, 0, 0); } while (0)
#define G8_STAGE_A(bufoff, gbase, o0, o1) do { \
        __builtin_amdgcn_global_load_lds((const unsigned*)((const char*)(gbase) + G8_OPQ(o0)), (LAS unsigned*)(lds + (bufoff) + ldsw), 16, 0, 0); \
        __builtin_amdgcn_global_load_lds((const unsigned*)((const char*)(gbase) + G8_OPQ(o1)), (LAS unsigned*)(lds + (bufoff) + ldsw + 8192), 16, 0, 0); } while (0)
#define G8_LDA(dst, b, h) do { _Pragma("unroll") for (int m = 0; m < 4; ++m) dst[m] = cat8(*(const LAS bf16x8*)(lds + G8_SA(b, h) + aoff + m * 2048), *(const LAS bf16x8*)(lds + G8_SA(b, h) + aoff + m * 2048 + 1024)); } while (0)
#define G8_LDB(dst, b, h) do { _Pragma("unroll") for (int n = 0; n < 2; ++n) dst[n] = cat8(*(const LAS bf16x8*)(lds + G8_SB(b, h) + boff + n * 2048), *(const LAS bf16x8*)(lds + G8_SB(b, h) + boff + n * 2048 + 1024)); } while (0)
#define G8_MMA(ai, bj, At, Bt) do { __builtin_amdgcn_s_setprio(1); \
        if constexpr (Epi::F8) { _Pragma("unroll") for (int m = 0; m < 4; ++m) _Pragma("unroll") for (int n = 0; n < 2; ++n) \
            mfma_f8(acc[ai][bj][m][n], Bt[n], At[m]); } \
        else { _Pragma("unroll") for (int m = 0; m < 4; ++m) _Pragma("unroll") for (int n = 0; n < 2; ++n) _Pragma("unroll") for (int k = 0; k < 2; ++k) \
            acc[ai][bj][m][n] = __builtin_amdgcn_mfma_f32_16x16x32_bf16(half8(Bt[n], k), half8(At[m], k), acc[ai][bj][m][n], 0, 0, 0); } \
        __builtin_amdgcn_s_setprio(0); } while (0)
#define G8_WAIT_V(n) asm volatile("s_waitcnt vmcnt(" #n ")" ::: "memory")
#define G8_WAIT_L(n) asm volatile("s_waitcnt lgkmcnt(" #n ")" ::: "memory")
#define G8_BAR __builtin_amdgcn_s_barrier()
#define G8_SCHED __builtin_amdgcn_sched_barrier(0)
    Unit cur, nxt; int ui = 0, prev_pm = -1;
    if (!S.next(0, cur)) return;
    Acc acc;
#pragma unroll
    for (int a = 0; a < 2; ++a)
#pragma unroll
        for (int b = 0; b < 2; ++b)
#pragma unroll
            for (int m = 0; m < 4; ++m)
#pragma unroll
                for (int n = 0; n < 2; ++n) acc[a][b][m][n] = (f32x4){0.f, 0.f, 0.f, 0.f};
    i32x8_t At[4], B0[2], B1[2];
    const char* cA; const char* cB = cur.B;
    if (GATHER) { cA = (const char*)A;
#pragma unroll
        for (int h = 0; h < 2; ++h)
#pragma unroll
            for (int i = 0; i < 2; ++i) voA[h][i] = S.arow_off(cur.pm * BM + h * HALF + Rst[i]) + (unsigned)Cst[i] * 2u;
    } else cA = (const char*)A + (size_t)cur.pm * tstepA;
    G8_STAGE_B(G8_SB(0, 0), cB); G8_STAGE_A(G8_SA(0, 0), cA, voA[0][0], voA[0][1]); G8_STAGE_B(G8_SB(0, 1), cB + hstepB); G8_STAGE_A(G8_SA(0, 1), cA, voA[1][0], voA[1][1]);
    if (wr == 1) G8_BAR;
    G8_WAIT_V(4); G8_BAR;
    G8_STAGE_B(G8_SB(1, 0), cB + kstep); G8_STAGE_A(G8_SA(1, 0), cA + kstep, voA[0][0], voA[0][1]); G8_STAGE_B(G8_SB(1, 1), cB + hstepB + kstep);
    G8_WAIT_V(6); G8_BAR;
    for (;;) {
        const bool has_next = S.next(ui + 1, nxt);
        const char* nA; const char* nB = has_next ? nxt.B : cB;
        if (GATHER) { nA = cA;
            if (has_next) {
#pragma unroll
                for (int h = 0; h < 2; ++h)
#pragma unroll
                    for (int i = 0; i < 2; ++i) voAn[h][i] = S.arow_off(nxt.pm * BM + h * HALF + Rst[i]) + (unsigned)Cst[i] * 2u;
            } else {
#pragma unroll
                for (int h = 0; h < 2; ++h)
#pragma unroll
                    for (int i = 0; i < 2; ++i) voAn[h][i] = voA[h][i];
            }
        } else nA = has_next ? (const char*)A + (size_t)nxt.pm * tstepA : cA;
        for (int t = 0; t < nt; t += 2) {
            const bool last = (t == nt - 2);
            const char* a1 = cA + (size_t)(t + 1) * kstep;
            const char* a2 = last ? nA : cA + (size_t)(t + 2) * kstep; const char* b2 = last ? nB : cB + (size_t)(t + 2) * kstep;
            const char* a3 = a2 + kstep; const char* b3 = b2 + kstep;
            unsigned o00 = voA[0][0], o01 = voA[0][1], o10 = voA[1][0], o11 = voA[1][1];
            if (GATHER) { if (last) { o00 = voAn[0][0]; o01 = voAn[0][1]; o10 = voAn[1][0]; o11 = voAn[1][1]; } }
            G8_LDB(B0, 0, 0); G8_SCHED; G8_LDA(At, 0, 0); G8_STAGE_A(G8_SA(1, 1), a1, voA[1][0], voA[1][1]);
            G8_WAIT_L(8); G8_BAR; G8_WAIT_L(0); G8_MMA(0, 0, At, B0); G8_BAR; G8_SCHED;
            G8_LDB(B1, 0, 1); G8_STAGE_B(G8_SB(0, 0), b2);
            G8_BAR; G8_WAIT_L(0); G8_MMA(0, 1, At, B1); G8_BAR;
            G8_LDA(At, 0, 1); G8_STAGE_A(G8_SA(0, 0), a2, o00, o01);
            G8_BAR; G8_WAIT_L(0); G8_MMA(1, 0, At, B0); G8_BAR; G8_SCHED;
            G8_STAGE_B(G8_SB(0, 1), b2 + hstepB);
            G8_WAIT_V(6);
            if constexpr (Epi::PUBLISH) { if (prev_pm >= 0) { E.publish(prev_pm); prev_pm = -1; } }
            G8_BAR; G8_MMA(1, 1, At, B1); G8_BAR;
            G8_LDB(B0, 1, 0); G8_SCHED; G8_LDA(At, 1, 0); G8_STAGE_A(G8_SA(0, 1), a2, o10, o11);
            G8_WAIT_L(8); G8_BAR; G8_WAIT_L(0); G8_MMA(0, 0, At, B0); G8_BAR; G8_SCHED;
            G8_LDB(B1, 1, 1); G8_STAGE_B(G8_SB(1, 0), b3);
            G8_BAR; G8_WAIT_L(0); G8_MMA(0, 1, At, B1); G8_BAR;
            G8_LDA(At, 1, 1); G8_STAGE_A(G8_SA(1, 0), a3, o00, o01);
            G8_BAR; G8_WAIT_L(0); G8_MMA(1, 0, At, B0); G8_BAR; G8_SCHED;
            G8_STAGE_B(G8_SB(1, 1), b3 + hstepB);
            G8_WAIT_V(6); G8_BAR; G8_MMA(1, 1, At, B1); G8_BAR;
        }
        if constexpr (Epi::F8) {
#define G8_TIE(a, b, txt) asm volatile(txt : "+v"(acc[a][b][0][0]), "+v"(acc[a][b][0][1]), "+v"(acc[a][b][1][0]), "+v"(acc[a][b][1][1]), "+v"(acc[a][b][2][0]), "+v"(acc[a][b][2][1]), "+v"(acc[a][b][3][0]), "+v"(acc[a][b][3][1]))
            G8_TIE(0, 0, ""); G8_TIE(0, 1, ""); G8_TIE(1, 0, "s_nop 7"); G8_TIE(1, 1, "s_nop 15\n\ts_nop 7");
#undef G8_TIE
        }
        if constexpr (Epi::ASCALE != 1.0f) {
#pragma unroll
            for (int a = 0; a < 2; ++a)
#pragma unroll
                for (int b = 0; b < 2; ++b)
#pragma unroll
                    for (int m = 0; m < 4; ++m)
#pragma unroll
                        for (int n = 0; n < 2; ++n) acc[a][b][m][n] *= Epi::ASCALE;
        }
        E(acc, cur, wr, wc, fr, fq);
        if constexpr (Epi::PUBLISH) prev_pm = cur.pm;
        if (!has_next) break;
#pragma unroll
        for (int a = 0; a < 2; ++a)
#pragma unroll
            for (int b = 0; b < 2; ++b)
#pragma unroll
                for (int m = 0; m < 4; ++m)
#pragma unroll
                    for (int n = 0; n < 2; ++n) acc[a][b][m][n] = (f32x4){0.f, 0.f, 0.f, 0.f};
        cur = nxt; cA = nA; cB = nB; ++ui;
        if (GATHER) {
#pragma unroll
            for (int h = 0; h < 2; ++h)
#pragma unroll
                for (int i = 0; i < 2; ++i) voA[h][i] = voAn[h][i];
        }
    }
    G8_WAIT_V(0);
    if constexpr (Epi::PUBLISH) { if (prev_pm >= 0) { E.publish(prev_pm); prev_pm = -1; } }
    if (wr == 0) G8_BAR;
    G8_BAR;
#undef G8_SA
#undef G8_SB
#undef G8_STAGE_A
#undef G8_STAGE_B
#undef G8_OPQ
#undef G8_LDA
#undef G8_LDB
#undef G8_MMA
#undef G8_WAIT_V
#undef G8_WAIT_L
#undef G8_BAR
#undef G8_SCHED
}

__device__ __forceinline__ u32x4 pack8(const f32x4& a, const f32x4& b) { u32x4 w; w.x = cvt_pk_bf16(a[0], a[1]); w.y = cvt_pk_bf16(a[2], a[3]); w.z = cvt_pk_bf16(b[0], b[1]); w.w = cvt_pk_bf16(b[2], b[3]); return w; }
__device__ __forceinline__ u32x4 subtile_T(LAS bf16_t* Tw, const f32x4& a, const f32x4& b, int fr, int fq, int lane) {
#pragma unroll
    for (int j = 0; j < 4; ++j) { Tw[(8 * fq + j) * 16 + fr] = f2bf(a[j]); Tw[(8 * fq + 4 + j) * 16 + fr] = f2bf(b[j]); }
    return *(const LAS u32x4*)(Tw + (lane >> 1) * 16 + (lane & 1) * 8);
}
template <bool F8_> struct MEpiProjT { static constexpr bool PERM = true, PUBLISH = false, F8 = F8_; static constexpr float ASCALE = F8_ ? 1.0f / (SHB * SWI) : 1.0f; bf16_t* PROJ; bf16_t* VT; LAS float* KX; const float* gq; const float* gk;
    __device__ __forceinline__ void operator()(const Acc& acc, const Unit& u, int wr, int wc, int fr, int fq) const {
        const int row0 = u.pm * BM + wr * 64 + fr;
        if (u.pn >= C_K / 256 && u.pn < DPROJ / 256) {
#pragma unroll
            for (int ai = 0; ai < 2; ++ai)
#pragma unroll
                for (int m = 0; m < 4; ++m)
#pragma unroll
                    for (int bj = 0; bj < 2; ++bj) {
                        const f32x4 a = acc[ai][bj][m][0], b = acc[ai][bj][m][1];
                        float ss = a[0] * a[0] + a[1] * a[1] + a[2] * a[2] + a[3] * a[3] + b[0] * b[0] + b[1] * b[1] + b[2] * b[2] + b[3] * b[3];
                        ss += __shfl_xor(ss, 16); ss += __shfl_xor(ss, 32);
                        if (fq == 0) KX[((ai * HALF + wr * 64 + m * 16 + fr) * 2 + bj) * 4 + wc] = ss;
                    }
            asm volatile("s_waitcnt lgkmcnt(0)" ::: "memory"); __builtin_amdgcn_s_barrier(); asm volatile("" ::: "memory");
            const int col0 = u.pn * BM + wc * 32 + 8 * fq;
            f32x4 g0[2], g1[2];
#pragma unroll
            for (int bj = 0; bj < 2; ++bj) { const int d0 = wc * 32 + 8 * fq; g0[bj] = *(const f32x4*)(gq + d0) * *(const f32x4*)(gk + d0); g1[bj] = *(const f32x4*)(gq + d0 + 4) * *(const f32x4*)(gk + d0 + 4); }
#pragma unroll
            for (int ai = 0; ai < 2; ++ai)
#pragma unroll
                for (int m = 0; m < 4; ++m) { bf16_t* rowp = PROJ + (size_t)(row0 + ai * HALF + m * 16) * DPROJ + col0;
#pragma unroll
                    for (int bj = 0; bj < 2; ++bj) { const f32x4 p4 = *(const LAS f32x4*)(KX + ((ai * HALF + wr * 64 + m * 16 + fr) * 2 + bj) * 4);
                        const float rs = rsqrtf(((p4[0] + p4[1]) + (p4[2] + p4[3])) * (1.0f / HD) + EPS);
                        *(u32x4*)(rowp + bj * HALF) = pack8(acc[ai][bj][m][0] * g0[bj] * rs, acc[ai][bj][m][1] * g1[bj] * rs); } }
            return;
        }
        if (u.pn < DPROJ / 256) {
            const int col0 = u.pn * BM + wc * 32 + 8 * fq;
#pragma unroll
            for (int ai = 0; ai < 2; ++ai)
#pragma unroll
                for (int m = 0; m < 4; ++m) { bf16_t* rowp = PROJ + (size_t)(row0 + ai * HALF + m * 16) * DPROJ + col0;
#pragma unroll
                    for (int bj = 0; bj < 2; ++bj) *(u32x4*)(rowp + bj * HALF) = pack8(acc[ai][bj][m][0], acc[ai][bj][m][1]); }
        } else {
            const int lane = fq * 16 + fr, cl = lane >> 1, hf = lane & 1; LAS bf16_t* Tw = (LAS bf16_t*)KX + (wr * 4 + wc) * 512;
            const int cc0 = (u.pn - DPROJ / 256) * BM + wc * 32 + cl;
#pragma unroll
            for (int ai = 0; ai < 2; ++ai)
#pragma unroll
                for (int m = 0; m < 4; ++m) { const int rowb = u.pm * BM + wr * 64 + ai * HALF + m * 16, b = rowb >> 12, s = (rowb & (SEQ - 1)) + hf * 8;
#pragma unroll
                    for (int bj = 0; bj < 2; ++bj) { const int cc = cc0 + bj * HALF;
                        const u32x4 w = subtile_T(Tw, acc[ai][bj][m][0], acc[ai][bj][m][1], fr, fq, lane);
                        *(u32x4*)(VT + ((size_t)(b * NHS + (cc >> 7)) * HD + (cc & 127)) * VTS + s) = w; } }
        }
    } };
template <bool F8_> struct MEpiPartT { static constexpr bool PERM = true, PUBLISH = false, F8 = F8_; static constexpr float ASCALE = F8_ ? 1.0f / (SHB * SWI) : 1.0f; bf16_t* PT; LAS float* KX;
    __device__ __forceinline__ void operator()(const Acc& acc, const Unit& u, int wr, int wc, int fr, int fq) const {
        const int lane = fq * 16 + fr, cl = lane >> 1, hf = lane & 1; LAS bf16_t* Tw = (LAS bf16_t*)KX + (wr * 4 + wc) * 512;
        bf16_t* base0 = PT + (size_t)(u.pm * 4 + u.pn) * 65536 + (size_t)(wc * 32 + cl) * 256 + wr * 64 + hf * 8;
#pragma unroll
        for (int ai = 0; ai < 2; ++ai)
#pragma unroll
            for (int m = 0; m < 4; ++m)
#pragma unroll
                for (int bj = 0; bj < 2; ++bj) {
                    const u32x4 w = subtile_T(Tw, acc[ai][bj][m][0], acc[ai][bj][m][1], fr, fq, lane);
                    *(u32x4*)(base0 + (size_t)(bj * HALF) * 256 + ai * HALF + m * 16) = w; }
    } };
__device__ __forceinline__ f32x4 silu_mul(const f32x4& g, const f32x4& u) { f32x4 r;
#pragma unroll
    for (int j = 0; j < 4; ++j) r[j] = g[j] / (1.0f + __expf(-g[j])) * u[j];
    return r; }
struct MEpiGU { static constexpr bool PERM = true, PUBLISH = true, F8 = true; static constexpr float ASCALE = 1.0f; unsigned char* HID; const float* LISTR; const MoeTab* mt; unsigned* rtc; int n1early;
    __device__ __forceinline__ void operator()(const Acc& acc, const Unit& u, int wr, int wc, int fr, int fq) const {
        const int row0 = u.pm * BM + wr * 64 + fr, col0 = u.pn * HALF + wc * 32 + 8 * fq;
        const int e = __builtin_amdgcn_readfirstlane(mt->texp[u.pm]), cnt = __builtin_amdgcn_readfirstlane(mt->cnt[e]), pb = __builtin_amdgcn_readfirstlane(mt->tstart[e]) * 256;
        const float* lr = LISTR + (size_t)e * T;
        const __amdgpu_buffer_rsrc_t rsrc = __builtin_amdgcn_make_buffer_rsrc(HID, 0, (int)((size_t)PADROWS * DEXP), 0x00020000);
#pragma unroll
        for (int ai = 0; ai < 2; ++ai)
#pragma unroll
            for (int m = 0; m < 4; ++m) {
                const int row = row0 + ai * HALF + m * 16, pos = row - pb;
                const float rs = pos < cnt ? lr[pos] * (1.0f / (SX8 * SW1)) : 0.f;
                const f32x4 h0 = silu_mul(acc[ai][0][m][0] * rs, acc[ai][1][m][0] * rs) * SH8, h1 = silu_mul(acc[ai][0][m][1] * rs, acc[ai][1][m][1] * rs) * SH8;
                int w0 = 0, w1 = 0;
                w0 = __builtin_amdgcn_cvt_pk_fp8_f32(__builtin_amdgcn_fmed3f(h0[0], -448.f, 448.f), __builtin_amdgcn_fmed3f(h0[1], -448.f, 448.f), w0, false); w0 = __builtin_amdgcn_cvt_pk_fp8_f32(__builtin_amdgcn_fmed3f(h0[2], -448.f, 448.f), __builtin_amdgcn_fmed3f(h0[3], -448.f, 448.f), w0, true);
                w1 = __builtin_amdgcn_cvt_pk_fp8_f32(__builtin_amdgcn_fmed3f(h1[0], -448.f, 448.f), __builtin_amdgcn_fmed3f(h1[1], -448.f, 448.f), w1, false); w1 = __builtin_amdgcn_cvt_pk_fp8_f32(__builtin_amdgcn_fmed3f(h1[2], -448.f, 448.f), __builtin_amdgcn_fmed3f(h1[3], -448.f, 448.f), w1, true);
                __builtin_amdgcn_raw_buffer_store_b64((u32x2){(unsigned)w0, (unsigned)w1}, rsrc, row * DEXP + col0, 0, 16);
            }
    }
    __device__ __forceinline__ void publish(int pm) const {
        if ((otid() & 63) == 0) __hip_atomic_fetch_add(rtc + pm * 32, 1u, __ATOMIC_RELAXED, __HIP_MEMORY_SCOPE_AGENT);
    } };
struct MEpiDown { static constexpr bool PERM = true, PUBLISH = false, F8 = false; static constexpr float ASCALE = 1.0f; bf16_t* YPAD;
    __device__ __forceinline__ void operator()(const Acc& acc, const Unit& u, int wr, int wc, int fr, int fq) const {
        const int row0 = u.pm * BM + wr * 64 + fr, col0 = u.pn * BM + wc * 32 + 8 * fq;
#pragma unroll
        for (int ai = 0; ai < 2; ++ai)
#pragma unroll
            for (int m = 0; m < 4; ++m) { bf16_t* rowp = YPAD + (size_t)(row0 + ai * HALF + m * 16) * DM + col0;
#pragma unroll
                for (int bj = 0; bj < 2; ++bj) *(u32x4*)(rowp + bj * HALF) = pack8(acc[ai][bj][m][0], acc[ai][bj][m][1]); }
    } };
template <bool XF32> struct MEpiOut { static constexpr bool STAMP = false, PERM = true, PUBLISH = false, F8 = false; static constexpr float ASCALE = 1.0f; const float* Xf; const bf16_t* Xb; bf16_t* X1; unsigned char* X18;
    __device__ __forceinline__ void operator()(const Acc& acc, const Unit& u, int wr, int wc, int fr, int fq) const {
        const int row0 = u.pm * BM + wr * 64 + fr, col0 = u.pn * BM + wc * 32 + 8 * fq;
#pragma unroll
        for (int ai = 0; ai < 2; ++ai) {
            f32x4 xa[4][2][2]; u32x4 xh[4][2];
#pragma unroll
            for (int m = 0; m < 4; ++m)
#pragma unroll
                for (int bj = 0; bj < 2; ++bj) { const size_t o = (size_t)(row0 + ai * HALF + m * 16) * DM + col0 + bj * HALF;
                    if (XF32) { xa[m][bj][0] = *(const f32x4*)(Xf + o); xa[m][bj][1] = *(const f32x4*)(Xf + o + 4); } else xh[m][bj] = *(const u32x4*)(Xb + o); }
            __builtin_amdgcn_sched_barrier(0);
#pragma unroll
            for (int m = 0; m < 4; ++m)
#pragma unroll
                for (int bj = 0; bj < 2; ++bj) { const size_t o = (size_t)(row0 + ai * HALF + m * 16) * DM + col0 + bj * HALF;
                    f32x4 a = acc[ai][bj][m][0], b = acc[ai][bj][m][1];
                    if (XF32) { a += xa[m][bj][0]; b += xa[m][bj][1]; }
                    else { const u32x4 w = xh[m][bj]; a[0] += bflo(w.x); a[1] += bfhi(w.x); a[2] += bflo(w.y); a[3] += bfhi(w.y); b[0] += bflo(w.z); b[1] += bfhi(w.z); b[2] += bflo(w.w); b[3] += bfhi(w.w); }
                    *(u32x4*)(X1 + o) = pack8(a, b);
                    int w0 = 0, w1 = 0;
                    w0 = __builtin_amdgcn_cvt_pk_fp8_f32(a[0] * SX8, a[1] * SX8, w0, false); w0 = __builtin_amdgcn_cvt_pk_fp8_f32(a[2] * SX8, a[3] * SX8, w0, true);
                    w1 = __builtin_amdgcn_cvt_pk_fp8_f32(b[0] * SX8, b[1] * SX8, w1, false); w1 = __builtin_amdgcn_cvt_pk_fp8_f32(b[2] * SX8, b[3] * SX8, w1, true);
                    *(u32x2*)(X18 + o) = (u32x2){(unsigned)w0, (unsigned)w1}; }
        }
    } };
constexpr float YSCALE = YSCALE_G;
struct MEpiDown8 { static constexpr bool PERM = true, PUBLISH = false, F8 = true; static constexpr float ASCALE = 1.0f; unsigned char* Y8;
    __device__ __forceinline__ void operator()(const Acc& acc, const Unit& u, int wr, int wc, int fr, int fq) const {
        const int row0 = u.pm * BM + wr * 64 + fr, col0 = u.pn * BM + wc * 32 + 8 * fq;
#pragma unroll
        for (int ai = 0; ai < 2; ++ai)
#pragma unroll
            for (int m = 0; m < 4; ++m) { unsigned char* rowp = Y8 + (size_t)(row0 + ai * HALF + m * 16) * DM + col0;
#pragma unroll
                for (int bj = 0; bj < 2; ++bj) { const f32x4 a = acc[ai][bj][m][0] * (YSCALE / (SH8 * SW2)), b = acc[ai][bj][m][1] * (YSCALE / (SH8 * SW2)); int w0 = 0, w1 = 0;
                    w0 = __builtin_amdgcn_cvt_pk_fp8_f32(a[0], a[1], w0, false); w0 = __builtin_amdgcn_cvt_pk_fp8_f32(a[2], a[3], w0, true);
                    w1 = __builtin_amdgcn_cvt_pk_fp8_f32(b[0], b[1], w1, false); w1 = __builtin_amdgcn_cvt_pk_fp8_f32(b[2], b[3], w1, true);
                    *(u32x2*)(rowp + bj * HALF) = (u32x2){(unsigned)w0, (unsigned)w1}; } }
    } };
}

__device__ __forceinline__ void phase_convb(const Ctx& c, int l) {
    const int gt = obid() * 512 + otid(), ng = gridDim.x * 512, sub = gt & 15;
    const float* cw = c.in[10] + (size_t)l * 3 * DCONV; const bf16_t* PROJ = c.PROJ();
#pragma unroll 2
    for (int item = gt >> 4; item < T * 4; item += ng >> 4) {
        const int t = item >> 2, hh = item & 3, ch = hh * HD + sub * 8, s = t & (SEQ - 1);
        u32x4 cg[3], xb[3];
#pragma unroll
        for (int tap = 0; tap < 3; ++tap) { const int ds = (s + tap - 2 >= 0) ? tap - 2 : 0; const bf16_t* row = PROJ + (size_t)(t + ds) * DPROJ; cg[tap] = *(const u32x4*)(row + C_CG + ch); xb[tap] = *(const u32x4*)(row + C_XB + ch); }
        const u32x4 bg = *(const u32x4*)(PROJ + (size_t)t * DPROJ + C_BG + ch);
        float acc[8] = {0, 0, 0, 0, 0, 0, 0, 0};
#pragma unroll
        for (int tap = 0; tap < 3; ++tap) {
            if (s + tap - 2 >= 0) {
                const f32x4 w0 = *(const f32x4*)(cw + tap * DCONV + ch), w1 = *(const f32x4*)(cw + tap * DCONV + ch + 4);
                acc[0] += w0[0] * bflo(cg[tap].x) * bflo(xb[tap].x); acc[1] += w0[1] * bfhi(cg[tap].x) * bfhi(xb[tap].x); acc[2] += w0[2] * bflo(cg[tap].y) * bflo(xb[tap].y); acc[3] += w0[3] * bfhi(cg[tap].y) * bfhi(xb[tap].y);
                acc[4] += w1[0] * bflo(cg[tap].z) * bflo(xb[tap].z); acc[5] += w1[1] * bfhi(cg[tap].z) * bfhi(xb[tap].z); acc[6] += w1[2] * bflo(cg[tap].w) * bflo(xb[tap].w); acc[7] += w1[3] * bfhi(cg[tap].w) * bfhi(xb[tap].w);
            }
        }
        acc[0] *= bflo(bg.x); acc[1] *= bfhi(bg.x); acc[2] *= bflo(bg.y); acc[3] *= bfhi(bg.y); acc[4] *= bflo(bg.z); acc[5] *= bfhi(bg.z); acc[6] *= bflo(bg.w); acc[7] *= bfhi(bg.w);
        float ss = 0.f;
#pragma unroll
        for (int i = 0; i < 8; ++i) ss += acc[i] * acc[i];
        ss += __shfl_xor(ss, 1); ss += __shfl_xor(ss, 2); ss += __shfl_xor(ss, 4); ss += __shfl_xor(ss, 8);
        const float rstd = rsqrtf(ss * (1.0f / HD) + EPS);
        const float* mg = c.in[13] + (size_t)l * DM + DLRU + ch;
        const f32x4 m0 = *(const f32x4*)mg, m1 = *(const f32x4*)(mg + 4);
        u32x4 o; o.x = cvt_pk_bf16(acc[0] * rstd * m0[0], acc[1] * rstd * m0[1]); o.y = cvt_pk_bf16(acc[2] * rstd * m0[2], acc[3] * rstd * m0[3]);
        o.z = cvt_pk_bf16(acc[4] * rstd * m1[0], acc[5] * rstd * m1[1]); o.w = cvt_pk_bf16(acc[6] * rstd * m1[2], acc[7] * rstd * m1[3]);
        *(u32x4*)(c.YMIX() + (size_t)t * DM + DLRU + ch) = o;
    }
}
typedef float f32x16 __attribute__((ext_vector_type(16)));
#define MFMA32(a, b, c) __builtin_amdgcn_mfma_f32_32x32x16_bf16((a), (b), (c), 0, 0, 0)
constexpr int XCS = 776;
__device__ __forceinline__ void phase_lruA(const Ctx& c, int l, unsigned char* ldsb) {
    constexpr bool PASS2 = false;
    bf16_t* XC = (bf16_t*)ldsb; bf16_t* PR = (bf16_t*)(ldsb + 99328); bf16_t* HL = c.HL(); bf16_t* PL = c.PL();
    const int tid = otid(), lane = tid & 63, wv = tid >> 6, hh = lane >> 5, l31 = lane & 31;
    const float* cw = c.in[3] + (size_t)l * 4 * DLRU; const float* cb = c.in[4] + (size_t)l * DLRU;
    const bf16_t* PROJ = c.PROJ(); float* AGG = c.AGG();
    typedef float f32x2_t __attribute__((ext_vector_type(2)));
    for (int tile = obid(); tile < T / 64; tile += gridDim.x) {
        const int t0 = tile * 64, s0 = t0 & (SEQ - 1), tb = tile & 63;
        if (tid < 480) {
            const int cg = tid % 48, tslot = tid / 48, ch = cg * 16;
            float w[4][16], bias[16];
#pragma unroll
            for (int i = 0; i < 16; i += 4) { *(f32x4*)&bias[i] = *(const f32x4*)(cb + ch + i);
#pragma unroll
                for (int tap = 0; tap < 4; ++tap) *(f32x4*)&w[tap][i] = *(const f32x4*)(cw + tap * DLRU + ch + i); }
#pragma unroll
            for (int it = 0; it < 7; ++it) {
                const int tokr = tslot + 10 * it, tok = tokr < 64 ? tokr : 63;
                u32x4 x0[4], x1[4]; float msk[4];
#pragma unroll
                for (int tap = 0; tap < 4; ++tap) {
                    const int ds = tap - 3; const bool ok = (s0 + tok + ds >= 0); msk[tap] = ok ? 1.0f : 0.0f;
                    const bf16_t* row = PROJ + (size_t)(t0 + tok + (ok ? ds : 0)) * DPROJ + C_XA + ch;
                    x0[tap] = *(const u32x4*)row; x1[tap] = *(const u32x4*)(row + 8);
                }
                float a[16];
#pragma unroll
                for (int i = 0; i < 16; ++i) a[i] = bias[i];
#pragma unroll
                for (int tap = 0; tap < 4; ++tap) {
                    const float m = msk[tap];
                    a[0] += m * w[tap][0] * bflo(x0[tap].x); a[1] += m * w[tap][1] * bfhi(x0[tap].x); a[2] += m * w[tap][2] * bflo(x0[tap].y); a[3] += m * w[tap][3] * bfhi(x0[tap].y);
                    a[4] += m * w[tap][4] * bflo(x0[tap].z); a[5] += m * w[tap][5] * bfhi(x0[tap].z); a[6] += m * w[tap][6] * bflo(x0[tap].w); a[7] += m * w[tap][7] * bfhi(x0[tap].w);
                    a[8] += m * w[tap][8] * bflo(x1[tap].x); a[9] += m * w[tap][9] * bfhi(x1[tap].x); a[10] += m * w[tap][10] * bflo(x1[tap].y); a[11] += m * w[tap][11] * bfhi(x1[tap].y);
                    a[12] += m * w[tap][12] * bflo(x1[tap].z); a[13] += m * w[tap][13] * bfhi(x1[tap].z); a[14] += m * w[tap][14] * bflo(x1[tap].w); a[15] += m * w[tap][15] * bfhi(x1[tap].w);
                }
                u32x4 o0, o1; o0.x = cvt_pk_bf16(a[0], a[1]); o0.y = cvt_pk_bf16(a[2], a[3]); o0.z = cvt_pk_bf16(a[4], a[5]); o0.w = cvt_pk_bf16(a[6], a[7]);
                o1.x = cvt_pk_bf16(a[8], a[9]); o1.y = cvt_pk_bf16(a[10], a[11]); o1.z = cvt_pk_bf16(a[12], a[13]); o1.w = cvt_pk_bf16(a[14], a[15]);
                if (tokr < 64) { *(u32x4*)(XC + tok * XCS + ch) = o0; *(u32x4*)(XC + tok * XCS + ch + 8) = o1; }
            }
        }
        __syncthreads();
#pragma unroll 1
        for (int i = 0; i < 3; ++i) {
            const int hd = 2 * i + (wv >> 2), ntw = wv & 3, chl = 32 * ntw + l31, ch = hd * HD + chl;
            const bf16_t* wa = c.WA(l) + ((size_t)hd * HD + chl) * HD + 8 * hh; const bf16_t* wx = c.WX(l) + ((size_t)hd * HD + chl) * HD + 8 * hh;
            const float ba = c.in[6][l * DLRU + ch], bx = c.in[8][l * DLRU + ch], c8 = -8.0f * softplusf_(-c.in[9][l * DLRU + ch]);
            float sst = 0.f, Pt = 1.f;
            float hreg[2][16], preg[2][16];
            bf16x8 bRf[8], bIf[8];
#pragma unroll
            for (int s = 0; s < 8; ++s) { bRf[s] = *(const bf16x8*)(wa + 16 * s); bIf[s] = *(const bf16x8*)(wx + 16 * s); }
            __builtin_amdgcn_sched_barrier(0);
#pragma unroll
            for (int half = 0; half < 2; ++half) {
                float av[16], uv[16];
                {
                    f32x16 accR, accI;
#pragma unroll
                    for (int r = 0; r < 16; ++r) { accR[r] = 0.f; accI[r] = 0.f; }
#pragma unroll
                    for (int s = 0; s < 8; ++s) {
                        const bf16x8 a = *(const bf16x8*)(XC + (32 * half + l31) * XCS + hd * HD + 16 * s + 8 * hh);
                        accR = MFMA32(a, bRf[s], accR); accI = MFMA32(a, bIf[s], accI);
                    }
#pragma unroll
                    for (int r = 0; r < 16; ++r) {
                        const int tok = 32 * half + (r & 3) + 8 * (r >> 2) + 4 * hh;
                        const float xc = bf2f(XC[tok * XCS + ch]);
                        const float rg = sigmoidf_(accR[r] + ba), ig = sigmoidf_(accI[r] + bx);
                        const float la = c8 * rg;
                        av[r] = fast_exp(la); uv[r] = __builtin_amdgcn_sqrtf(one_minus_exp(2.0f * la)) * (ig * xc);
                    }
                }
                float Pp[4], Hp[4];
#pragma unroll
                for (int g = 0; g < 4; ++g) { float P = 1.f, H = 0.f;
#pragma unroll
                    for (int r = 4 * g; r < 4 * g + 4; ++r) { H = av[r] * H + uv[r]; P *= av[r]; }
                    Pp[g] = __shfl_xor(P, 32); Hp[g] = __shfl_xor(H, 32); }
#pragma unroll
                for (int g = 0; g < 4; ++g) {
                    if (hh == 0) {
#pragma unroll
                        for (int r = 4 * g; r < 4 * g + 4; ++r) { sst = av[r] * sst + uv[r]; Pt *= av[r]; hreg[half][r] = sst; preg[half][r] = Pt; }
                        sst = Pp[g] * sst + Hp[g]; Pt *= Pp[g];
                    } else {
                        sst = Pp[g] * sst + Hp[g]; Pt *= Pp[g];
#pragma unroll
                        for (int r = 4 * g; r < 4 * g + 4; ++r) { sst = av[r] * sst + uv[r]; Pt *= av[r]; hreg[half][r] = sst; preg[half][r] = Pt; }
                    }
                }
            }
            if (hh == 0) { f32x2_t o; o.x = Pt; o.y = sst; ((f32x2_t*)AGG)[(size_t)tile * DLRU + ch] = o; }
            __syncthreads();
#pragma unroll
            for (int half = 0; half < 2; ++half)
#pragma unroll
                for (int r = 0; r < 16; ++r) { const int tok = 32 * half + (r & 3) + 8 * (r >> 2) + 4 * hh;
                    XC[tok * XCS + ch] = f2bf(hreg[half][r]); PR[tok * 264 + (wv >> 2) * HD + chl] = f2bf(preg[half][r]); }
            __syncthreads();
#pragma unroll
            for (int k = 0; k < 4; ++k) {
                const int item = tid + 512 * k, tok = item >> 5, g = item & 31, hs = g >> 4, sub = g & 15, cc = (2 * i + hs) * HD + sub * 8;
                *(u32x4*)(HL + (size_t)(t0 + tok) * DLRU + cc) = *(const u32x4*)(XC + tok * XCS + cc);
                *(u32x4*)(PL + (size_t)(t0 + tok) * DLRU + cc) = *(const u32x4*)(PR + tok * 264 + hs * HD + sub * 8);
            }
        }
        __syncthreads();
    }
}

__device__ __forceinline__ void phase_lruB(const Ctx& c, int l, unsigned char* ldsb) {
    float* HIN = (float*)ldsb;
    const int tid = otid();
    const bf16_t* PROJ = c.PROJ(); const float* AGG = c.AGG(); const bf16_t* HL = c.HL(); const bf16_t* PL = c.PL();
    typedef float f32x2_t __attribute__((ext_vector_type(2)));
    for (int tile = obid(); tile < T / 64; tile += gridDim.x) {
        const int t0 = tile * 64, tb = tile & 63;
        {
            const f32x2_t* ag = (const f32x2_t*)AGG + (size_t)(tile - tb) * DLRU;
            const int chb = 512 + (tid & 255);
            float ha = 0.f, hb = 0.f;
#pragma unroll 8
            for (int k = 0; k < tb; ++k) { const f32x2_t pa = ag[(size_t)k * DLRU + tid], pb_ = ag[(size_t)k * DLRU + chb]; ha = pa.x * ha + pa.y; hb = pb_.x * hb + pb_.y; }
            HIN[tid] = ha; if (tid < 256) HIN[chb] = hb;
        }
        __syncthreads();
        const int wv_ = tid >> 6, wit0 = wv_ < 4 ? 8 * wv_ : 32 + 16 * (wv_ - 4), wcnt = wv_ < 4 ? 8 : 16;
#define LB_ADDR(it_, tok_, cc_) const int item_##it_ = (wit0 + (it_)) * 64 + (tid & 63), tok_ = item_##it_ / 96, rem_##it_ = item_##it_ % 96, cc_ = (rem_##it_ >> 4) * HD + (rem_##it_ & 15) * 8
#define LB_LOAD(H_, P_, G_, tok_, cc_) do { H_ = *(const u32x4*)(HL + (size_t)(t0 + tok_) * DLRU + cc_); P_ = *(const u32x4*)(PL + (size_t)(t0 + tok_) * DLRU + cc_); G_ = *(const u32x4*)(PROJ + (size_t)(t0 + tok_) * DPROJ + C_GA + cc_); } while (0)
#define LB_BODY(hv, pv, ga, tok, cc) do { \
            const f32x4 i0 = *(const f32x4*)(HIN + cc), i1 = *(const f32x4*)(HIN + cc + 4); \
            float y[8] = {(bflo(hv.x) + bflo(pv.x) * i0[0]) * gelu_tanh(bflo(ga.x)), (bfhi(hv.x) + bfhi(pv.x) * i0[1]) * gelu_tanh(bfhi(ga.x)), \
                          (bflo(hv.y) + bflo(pv.y) * i0[2]) * gelu_tanh(bflo(ga.y)), (bfhi(hv.y) + bfhi(pv.y) * i0[3]) * gelu_tanh(bfhi(ga.y)), \
                          (bflo(hv.z) + bflo(pv.z) * i1[0]) * gelu_tanh(bflo(ga.z)), (bfhi(hv.z) + bfhi(pv.z) * i1[1]) * gelu_tanh(bfhi(ga.z)), \
                          (bflo(hv.w) + bflo(pv.w) * i1[2]) * gelu_tanh(bflo(ga.w)), (bfhi(hv.w) + bfhi(pv.w) * i1[3]) * gelu_tanh(bfhi(ga.w))}; \
            float ss = 0.f; \
            _Pragma("unroll") for (int k = 0; k < 8; ++k) ss += y[k] * y[k]; \
            ss += __shfl_xor(ss, 1); ss += __shfl_xor(ss, 2); ss += __shfl_xor(ss, 4); ss += __shfl_xor(ss, 8); \
            const float rstd = rsqrtf(ss * (1.0f / HD) + EPS); \
            const float* mg = c.in[13] + (size_t)l * DM + cc; \
            const f32x4 m0 = *(const f32x4*)mg, m1 = *(const f32x4*)(mg + 4); \
            u32x4 o; o.x = cvt_pk_bf16(y[0] * rstd * m0[0], y[1] * rstd * m0[1]); o.y = cvt_pk_bf16(y[2] * rstd * m0[2], y[3] * rstd * m0[3]); \
            o.z = cvt_pk_bf16(y[4] * rstd * m1[0], y[5] * rstd * m1[1]); o.w = cvt_pk_bf16(y[6] * rstd * m1[2], y[7] * rstd * m1[3]); \
            *(u32x4*)(c.YMIX() + (size_t)(t0 + tok) * DM + cc) = o; } while (0)
        {
            u32x4 hA, pA, gA, hB, pB, gB;
            { LB_ADDR(0, tk_, cc_); LB_LOAD(hA, pA, gA, tk_, cc_); }
#pragma unroll 1
            for (int it = 0; it < wcnt; it += 2) {
                LB_ADDR(it, tkA, ccA); const int itb = it + 1; LB_ADDR(itb, tkB, ccB);
                LB_LOAD(hB, pB, gB, tkB, ccB); __builtin_amdgcn_sched_barrier(0);
                LB_BODY(hA, pA, gA, tkA, ccA);
                if (it + 2 < wcnt) { const int itc = it + 2; LB_ADDR(itc, tkC, ccC); LB_LOAD(hA, pA, gA, tkC, ccC); } __builtin_amdgcn_sched_barrier(0);
                LB_BODY(hB, pB, gB, tkB, ccB);
            }
        }
#undef LB_ADDR
#undef LB_LOAD
#undef LB_BODY
        __syncthreads();
    }
}

__device__ __forceinline__ void phase_vreduce(const Ctx& c) {
    const bf16_t* PT = c.PT(); bf16_t* VT = c.VT();
    for (int item = obid() * 512 + otid(); item < 64 * 256 * 32; item += gridDim.x * 512) {
        const int ro = item & 31, col = (item >> 5) & 255, u = item >> 13;
        const bf16_t* p = PT + (size_t)(u * 4) * 65536 + col * 256 + ro * 8;
        float a[8] = {0, 0, 0, 0, 0, 0, 0, 0};
#pragma unroll
        for (int kq = 0; kq < 4; ++kq) { const u32x4 w = *(const u32x4*)(p + (size_t)kq * 65536);
            a[0] += bflo(w.x); a[1] += bfhi(w.x); a[2] += bflo(w.y); a[3] += bfhi(w.y); a[4] += bflo(w.z); a[5] += bfhi(w.z); a[6] += bflo(w.w); a[7] += bfhi(w.w); }
        const int b = u >> 4, s0 = (u & 15) * 256 + ro * 8, h = 4 + (col >> 7), d = col & 127;
        u32x4 o; o.x = cvt_pk_bf16(a[0], a[1]); o.y = cvt_pk_bf16(a[2], a[3]); o.z = cvt_pk_bf16(a[4], a[5]); o.w = cvt_pk_bf16(a[6], a[7]);
        *(u32x4*)(VT + ((size_t)(b * NHS + h) * HD + d) * VTS + s0) = o;
    }
}

__device__ __forceinline__ void phase_attn(const Ctx& c, int l, unsigned char* ldsb) {
    const int lane = otid() & 63, wv = otid() >> 6, hh = lane >> 5, l31 = lane & 31;
    const bf16_t* PROJ = c.PROJ(); const bf16_t* VT = c.VT();
    const int prow = (l31 & ~12) | ((l31 & 4) << 1) | ((l31 & 8) >> 1);
    unsigned char* wl = ldsb + wv * 16384;
    const int kwbase = (lane >> 4) * 256 + (((lane & 15) ^ (lane >> 4)) * 16);
    const int vwoff = (lane >> 2) * 64 + (((lane & 3) ^ (lane >> 4)) * 16);
    const int kroff = prow * 256;
    const int nwt = NB * NHS * (SEQ / 32);
    const int nper = (nwt + (int)gridDim.x - 1) / (int)gridDim.x, wt0 = obid() * nper, wt1 = (wt0 + nper < nwt) ? wt0 + nper : nwt;
    for (int wt = wt0 + wv; wt < wt1; wt += 8) {
        const int qt = wt % (SEQ / 32), bh = wt / (SEQ / 32), b = bh / NHS, h = bh % NHS, q0 = qt * 32;
        const bf16_t* qp = PROJ + (size_t)(b * SEQ + q0 + l31) * DPROJ + C_Q + h * HD + 8 * hh;
        bf16x8 bq[8];
#pragma unroll
        for (int s = 0; s < 8; ++s) bq[s] = *(const bf16x8*)(qp + 16 * s);
        {
            float qs = 0.f;
#pragma unroll
            for (int s = 0; s < 8; ++s) { const u32x4 w = __builtin_bit_cast(u32x4, bq[s]);
                qs += bflo(w.x) * bflo(w.x) + bfhi(w.x) * bfhi(w.x) + bflo(w.y) * bflo(w.y) + bfhi(w.y) * bfhi(w.y) + bflo(w.z) * bflo(w.z) + bfhi(w.z) * bfhi(w.z) + bflo(w.w) * bflo(w.w) + bfhi(w.w) * bfhi(w.w); }
            qs += __shfl_xor(qs, 32);
            const float sc = rsqrtf(qs * (1.0f / HD) + EPS) * (1.4426950408889634f * 0.08838834764831845f);
#pragma unroll
            for (int s = 0; s < 8; ++s) { const u32x4 w = __builtin_bit_cast(u32x4, bq[s]); u32x4 o;
                o.x = cvt_pk_bf16(bflo(w.x) * sc, bfhi(w.x) * sc); o.y = cvt_pk_bf16(bflo(w.y) * sc, bfhi(w.y) * sc); o.z = cvt_pk_bf16(bflo(w.z) * sc, bfhi(w.z) * sc); o.w = cvt_pk_bf16(bflo(w.w) * sc, bfhi(w.w) * sc);
                bq[s] = __builtin_bit_cast(bf16x8, o); }
        }
        f32x16 O[4];
#pragma unroll
        for (int m = 0; m < 4; ++m)
#pragma unroll
            for (int r = 0; r < 16; ++r) O[m][r] = 0.f;
        float carry = 0.f;
        const bf16_t* kgl = PROJ + (size_t)(b * SEQ + (lane >> 4)) * DPROJ + C_K + h * HD + (lane & 15) * 8;
        const bf16_t* vgl = VT + ((size_t)bh * HD + (lane >> 2)) * VTS + (lane & 3) * 8;
        u32x4 stK[8], stV[8];
#define ATT_LOAD(kk0) do { _Pragma("unroll") for (int j = 0; j < 8; ++j) { \
            stK[j] = *(const u32x4*)(kgl + (size_t)((kk0) + 4 * j) * DPROJ); stV[j] = *(const u32x4*)(vgl + (size_t)(16 * j) * VTS + (kk0)); } } while (0)
        ATT_LOAD(q0);
        for (int k0 = q0; k0 >= 0; k0 -= 32) {
#pragma unroll
            for (int j = 0; j < 8; ++j) { *(u32x4*)(wl + j * 1024 + (kwbase ^ (64 * (j & 3)))) = stK[j]; *(u32x4*)(wl + 8192 + vwoff + j * 1024) = stV[j]; }
            const int kn = k0 >= 32 ? k0 - 32 : k0;
            ATT_LOAD(kn);
            __builtin_amdgcn_sched_barrier(0);
            f32x16 S;
#pragma unroll
            for (int r = 0; r < 16; ++r) S[r] = 0.f;
#pragma unroll
            for (int s = 0; s < 8; ++s) { const bf16x8 ak = *(const bf16x8*)(wl + kroff + (((2 * s + hh) ^ (prow & 15)) * 16)); S = MFMA32(ak, bq[s], S); }
            const bool diag = (k0 == q0);
            float sp[16];
            float R0 = 0.f, R1 = 0.f;
#pragma unroll
            for (int r = 0; r < 16; ++r) {
                const int kk = 16 * (r >> 3) + 8 * hh + (r & 7);
                const float z = S[r];
                float v = fmaxf(z, 0.f) + __builtin_amdgcn_logf(1.0f + __builtin_amdgcn_exp2f(-fabsf(z)));
                if (diag && kk >= l31) v = 0.f;
                sp[r] = v;
                if (r < 8) R0 += v; else R1 += v;
            }
            const float R0p = __shfl_xor(R0, 32), R1p = __shfl_xor(R1, 32);
            float suf_hi = carry - (hh == 0 ? R1p : 0.f);
            float suf_lo = carry - R1 - R1p - (hh == 0 ? R0p : 0.f);
            float w[16];
#pragma unroll
            for (int r = 15; r >= 8; --r) { w[r] = __builtin_amdgcn_exp2f(S[r] - sp[r] + suf_hi); suf_hi -= sp[r]; }
#pragma unroll
            for (int r = 7; r >= 0; --r) { w[r] = __builtin_amdgcn_exp2f(S[r] - sp[r] + suf_lo); suf_lo -= sp[r]; }
            if (diag) {
#pragma unroll
                for (int r = 0; r < 16; ++r) { const int kk = 16 * (r >> 3) + 8 * hh + (r & 7); if (kk >= l31) w[r] = 0.f; }
            }
            carry -= (R0 + R1 + R0p + R1p);
            bf16x8 wb[2];
            __builtin_amdgcn_sched_barrier(0);
#pragma unroll
            for (int s = 0; s < 2; ++s) { u32x4 pk; pk.x = cvt_pk_bf16(w[8 * s + 0], w[8 * s + 1]); pk.y = cvt_pk_bf16(w[8 * s + 2], w[8 * s + 3]); pk.z = cvt_pk_bf16(w[8 * s + 4], w[8 * s + 5]); pk.w = cvt_pk_bf16(w[8 * s + 6], w[8 * s + 7]);
                wb[s] = __builtin_bit_cast(bf16x8, pk); }
#pragma unroll
            for (int m = 0; m < 4; ++m)
#pragma unroll
                for (int s = 0; s < 2; ++s) { const bf16x8 vtf = *(const bf16x8*)(wl + 8192 + (32 * m + l31) * 64 + (((2 * s + hh) ^ (((32 * m + l31) >> 2) & 3)) * 16)); O[m] = MFMA32(vtf, wb[s], O[m]); }
            if (!__any(carry >= -150.1f)) break;
        }
        float ss = 0.f;
#pragma unroll
        for (int m = 0; m < 4; ++m)
#pragma unroll
            for (int r = 0; r < 16; ++r) ss += O[m][r] * O[m][r];
        ss += __shfl_xor(ss, 32);
        const float rstd = rsqrtf(ss * (1.0f / HD) + EPS);
        const float* mg = c.in[13] + (size_t)l * DM + DLRU + DCONV + h * HD + 4 * hh;
        bf16_t* yp = c.YMIX() + (size_t)(b * SEQ + q0 + l31) * DM + DLRU + DCONV + h * HD + 4 * hh;
#pragma unroll
        for (int m = 0; m < 4; ++m)
#pragma unroll
            for (int g = 0; g < 4; ++g) {
                const f32x4 gg = *(const f32x4*)(mg + 32 * m + 8 * g);
                u32x2 o; o.x = cvt_pk_bf16(O[m][4 * g] * rstd * gg[0], O[m][4 * g + 1] * rstd * gg[1]); o.y = cvt_pk_bf16(O[m][4 * g + 2] * rstd * gg[2], O[m][4 * g + 3] * rstd * gg[3]);
                *(u32x2*)(yp + 32 * m + 8 * g) = o;
            }
    }
}

#define XB_TMO      128
#define XB_XCNT(j)  (256  + 64 * (j))
#define XB_XSUB(j)  (1280 + 64 * (j))
#define XB_XGEN(j)  (2304 + 64 * (j))
#define XB_TOP      3328
#define XB_TOPGEN   3392
#define XCD_BAR_WORDS 3456
#define XB_SPIN_CAP (1u << 18)
__device__ __forceinline__ unsigned xb_ld(unsigned* p)              { return __hip_atomic_load(p, __ATOMIC_RELAXED, __HIP_MEMORY_SCOPE_AGENT); }
__device__ __forceinline__ unsigned xb_add(unsigned* p, unsigned v) { return __hip_atomic_fetch_add(p, v, __ATOMIC_RELAXED, __HIP_MEMORY_SCOPE_AGENT); }
__device__ __forceinline__ unsigned xb_xcc_id() { return (unsigned)__builtin_amdgcn_s_getreg((3 << 11) | 20) & 0xFu; }
#define XB_SPIN(cond, bar) do { unsigned _sp = 0; while (cond) { __builtin_amdgcn_s_sleep(1); \
    if ((++_sp & 255u) == 0u) { if (xb_ld(&(bar)[XB_TMO])) break; if (_sp > XB_SPIN_CAP) { atomicAdd(&(bar)[XB_TMO], 1u); break; } } } } while (0)
struct XcdBarrier { unsigned* bar; unsigned x; volatile LAS unsigned* st; };
__device__ __forceinline__ XcdBarrier xcd_barrier_post(unsigned* bar, volatile LAS unsigned* st) {
    XcdBarrier b; b.bar = bar; b.x = xb_xcc_id(); b.st = st;
    if (threadIdx.x == 0) (void)xb_add(&bar[XB_XCNT(b.x)], 1u);
    return b;
}
__device__ __forceinline__ void xcd_barrier_complete(unsigned* bar, unsigned x, unsigned& nloc, unsigned& nx) {
    const unsigned G = gridDim.x * gridDim.y * gridDim.z;
    unsigned sum, cnt, mine, sp = 0u;
    for (;;) {
        sum = 0u; cnt = 0u; mine = 0u;
#pragma unroll
        for (unsigned j = 0; j < 16; ++j) { const unsigned c = xb_ld(&bar[XB_XCNT(j)]); sum += c; cnt += (c > 0u) ? 1u : 0u; mine = (j == x) ? c : mine; }
        if (sum == G) break;
        __builtin_amdgcn_s_sleep(1);
        if ((++sp & 255u) == 0u) { if (xb_ld(&bar[XB_TMO])) break; if (sp > XB_SPIN_CAP) { atomicAdd(&bar[XB_TMO], 1u); break; } }
    }
    nloc = mine > 0u ? mine : 1u; nx = cnt > 0u ? cnt : 1u;
}
__device__ __forceinline__ void xcd_barrier(const XcdBarrier& b) {
    asm volatile("s_waitcnt vmcnt(0)" ::: "memory");
    __syncthreads();
    if (threadIdx.x == 0) {
        unsigned* bar = b.bar;
        __builtin_amdgcn_s_waitcnt(0);
        unsigned nloc = b.st[0], nx = b.st[1];
        if (nloc == 0u) { xcd_barrier_complete(bar, b.x, nloc, nx); b.st[0] = nloc; b.st[1] = nx; }
        const unsigned old = xb_add(&bar[XB_XSUB(b.x)], 1u);
        const unsigned gen = old / nloc;
        if (old + 1u == (gen + 1u) * nloc) {
            __builtin_amdgcn_fence(__ATOMIC_RELEASE, "agent");
            asm volatile("s_waitcnt vmcnt(0)" ::: "memory");
            const unsigned og = xb_add(&bar[XB_TOP], 1u);
            const unsigned tg = og / nx;
            if (og + 1u == (tg + 1u) * nx) xb_add(&bar[XB_TOPGEN], 1u);
            else XB_SPIN(xb_ld(&bar[XB_TOPGEN]) == tg, bar);
            __builtin_amdgcn_fence(__ATOMIC_ACQUIRE, "agent");
            xb_add(&bar[XB_XGEN(b.x)], 1u);
            asm volatile("s_waitcnt vmcnt(0)" ::: "memory");
        } else {
            XB_SPIN(xb_ld(&bar[XB_XGEN(b.x)]) == gen, bar);
            __builtin_amdgcn_fence(__ATOMIC_ACQUIRE, "agent");
            asm volatile("s_waitcnt vmcnt(0)" ::: "memory");
        }
    }
    __syncthreads();
}

constexpr int NPH_LAYER = 7, NPH = 1 + DEPTH * NPH_LAYER;
constexpr int LDS_TAB = g8::STAGE_BYTES, LDS_BARW = g8::STAGE_BYTES + 2048, LDS_KX = g8::STAGE_BYTES + 4096, LDS_BYTES = g8::STAGE_BYTES + 4096 + 8192;
__global__ void __launch_bounds__(512, 2) mega(Params p) {
    extern __shared__ __attribute__((aligned(16))) unsigned char lds_raw[];
    float* lds = (float*)lds_raw;
    LAS unsigned char* ldsl = (LAS unsigned char*)lds_raw;
    MoeTab* mt = (MoeTab*)(lds_raw + LDS_TAB);
    Ctx c0; c0.in.p = p.in; c0.in.z = 0; c0.out = p.out; c0.ws = p.ws;
    const int lo = p.ph_lo, hi = p.ph_hi;
    if (threadIdx.x == 0) *(uint4*)(lds_raw + LDS_BARW) = make_uint4(0u, 0u, 0u, 0u);
    __syncthreads();
    XcdBarrier bar = xcd_barrier_post(c0.ctl(), (volatile LAS unsigned*)(ldsl + LDS_BARW));
#ifndef PH_MASK
#define PH_MASK 0x1ff
#endif
#define PHT(k) ((k) == 0 ? 0 : 1 + ((k) - 1) % NPH_LAYER)
#define IN(k) (((PH_MASK >> PHT(k)) & 1) && lo <= (k) && (k) < hi)
#define SEAM(k) do { if (IN(k) && IN((k) + 1)) xcd_barrier(bar); } while (0)
#ifndef PROBE_RSH
#define PROBE_RSH 0
#endif
#ifndef PROBE_DUP
#define PROBE_DUP 0x0
#endif
#define REP(k) for (int rep_ = 0; rep_ < (((PROBE_DUP >> PHT(k)) & 1) ? 2 : 1); ++rep_)
    REP(0) if (IN(0)) { if (rep_) xcd_barrier(bar); const Ctx c = octx(c0); phase_convert(c, lds); phase_norm_in(c, 0); }
    SEAM(0);
#define INP_MAIN_(l) { g8::DenseOrder S; S.init(T, DIN, gridDim.x, obid(), c.WIN(l), ld_); if (split_) S.lim = 1280; g8::MEpiProjT<f8_> E{c.PROJ(), c.VT(), (LAS float*)(ldsl + LDS_KX), c.in[11] + l * HD, c.in[12] + l * HD}; g8::gemm_mfma(ldsl, c.HB(), ld_, ld_, ku_, S, E); }
#define INP_SPLIT_(l) { const int cb_ = obid(), kq_ = cb_ & 3; int k4_ = ku_ / 4; asm volatile("" : "+s"(k4_)); g8::SplitKOrder S{cb_, (const char*)(c.WIN(l) + (size_t)(20 * 256) * ld_ + kq_ * (ku_ / 4))}; g8::MEpiPartT<f8_> E{c.PT(), (LAS float*)(ldsl + LDS_KX)}; g8::gemm_mfma(ldsl, c.HB() + kq_ * (ku_ / 4), ld_, ld_, k4_, S, E); }
#define LAYER_BODY(l) { \
        const int pb = 1 + l * NPH_LAYER; \
        REP(pb + 0) if (IN(pb + 0)) { if (rep_) xcd_barrier(bar); const Ctx c = octx(c0); const bool split_ = (gridDim.x == 256); \
            constexpr bool f8_ = f8in(l); constexpr int ku_ = f8_ ? DM / 2 : DM, ld_ = pb_in(l) / 2;        \
              \
            if (split_ && ((obid() >> 3) & 1)) { INP_SPLIT_(l) INP_MAIN_(l) } else { INP_MAIN_(l) if (split_) INP_SPLIT_(l) } } \
        SEAM(pb + 0); \
        REP(pb + 1) if (IN(pb + 1)) { if (rep_) xcd_barrier(bar); const Ctx c = octx(c0); if (gridDim.x == 256) phase_vreduce(c); phase_convb(c, l); if (PROBE_SUB == 4) phase_convb(c, l); phase_lruA(c, l, lds_raw); if (PROBE_SUB == 3) phase_lruA(c, l, lds_raw); } \
        SEAM(pb + 1); \
        REP(pb + 2) if (IN(pb + 2)) { if (rep_) xcd_barrier(bar); const Ctx c = octx(c0); phase_lruB(c, l, lds_raw); if (PROBE_SUB == 2) phase_lruB(c, l, lds_raw); phase_attn(c, l, lds_raw); if (PROBE_SUB == 1) phase_attn(c, l, lds_raw); } \
        SEAM(pb + 2); \
        REP(pb + 3) if (IN(pb + 3)) { if (rep_) xcd_barrier(bar); const Ctx c = octx(c0); g8::DenseOrder S; S.init(T, DM, gridDim.x, obid(), c.WOUT(l), DM); if (PROBE_RSH == 3 && l == 0) S.rsh = 1; g8::MEpiOut<l == 0> E{c.in[0], c.XB(), c.X1(), c.X1F8()}; g8::gemm_mfma(ldsl, c.YMIX(), DM, DM, DM, S, E);       } \
        SEAM(pb + 3); \
        REP(pb + 4) if (IN(pb + 4)) { if (rep_) xcd_barrier(bar); const Ctx c = octx(c0); phase_router_mfma(c, l, lds); } \
        SEAM(pb + 4); \
        REP(pb + 5) if (IN(pb + 5)) { if (rep_) xcd_barrier(bar); const Ctx c = octx(c0); build_moe_tab(c, l, mt); \
            const int G_ = (int)gridDim.x, cb_ = obid(), n1_ = __builtin_amdgcn_readfirstlane(mt->tstart[NEXP]) * 4, R_ = n1_ % G_, n1e_ = n1_ - R_, rtA_ = n1e_ >> 2; \
            { g8::MoeOrder<true, 4, DM / 2, (size_t)1024 * DM, (size_t)256 * DM> S{mt, c.LIST(), G_, cb_, (const char*)c.WGU(l)}; g8::MEpiGU E{c.HID8(), c.LISTR(), mt, c.RTC(l), n1e_}; g8::gemm_mfma(ldsl, (const bf16_t*)c.X1F8(), DM / 2, DM / 2, DM / 2, S, E); }       \
            g8::moe_wait_dep(c.RTC(l), cb_, G_, R_, rtA_); \
            { g8::MoeOrder2 S{mt, G_, cb_, R_, rtA_, (const char*)c.WD(l)}; if (PROBE_RSH == 6) S.rsh = 1; g8::MEpiDown8 E{c.YPAD8()}; int k2_ = DEXP / 2; asm volatile("" : "+s"(k2_)); g8::gemm_mfma(ldsl, (const bf16_t*)c.HID8(), DEXP / 2, DEXP / 2, k2_, S, E); } }       \
        SEAM(pb + 5); \
        REP(pb + 6) if (IN(pb + 6)) { if (rep_) xcd_barrier(bar); const Ctx c = octx(c0); build_moe_tab(c, l, mt); if (PROBE_SUB == 6) { phase_combine<true>(c, l, mt); xcd_barrier(bar); } phase_combine<false>(c, l, mt); } \
        SEAM(pb + 6); \
    }
    LAYER_BODY(0)
    LAYER_BODY(1)
#undef LAYER_BODY
#undef IN
#undef SEAM
}

#ifndef N_LAUNCH_SPLIT
#define N_LAUNCH_SPLIT 0
#endif
extern "C" void kernel_launch(void* const* d_in, const int* in_sizes, int n_in, void* d_out, int out_size, void* d_ws, size_t ws_size, hipStream_t stream) {
    static int grid = 0;
    if (grid == 0) {
        if (n_in != 23 || out_size != T * DM || ws_size < WS_END) { fprintf(stderr, "kernel_launch: unexpected problem (n_in %d out %d ws %zu need %zu)\n", n_in, out_size, ws_size, (size_t)WS_END); grid = -1; return; }
        int dev = 0, cus = 0, per_cu = 0;
        if (hipGetDevice(&dev) != hipSuccess || hipDeviceGetAttribute(&cus, hipDeviceAttributeMultiprocessorCount, dev) != hipSuccess) { fprintf(stderr, "kernel_launch: device query failed\n"); grid = -1; return; }
        if (hipFuncSetAttribute((const void*)mega, hipFuncAttributeMaxDynamicSharedMemorySize, LDS_BYTES) != hipSuccess) { fprintf(stderr, "kernel_launch: hipFuncSetAttribute failed\n"); grid = -1; return; }
        if (hipOccupancyMaxActiveBlocksPerMultiprocessor(&per_cu, (const void*)mega, 512, LDS_BYTES) != hipSuccess || per_cu < 1) { fprintf(stderr, "kernel_launch: occupancy query says %d blocks per CU\n", per_cu); }
        (void)hipGetLastError();
        grid = cus;
    }
    if (grid < 0) return;
    (void)hipMemsetAsync((char*)d_ws + OFF_CTL, 0, SZ_CTL, stream);
    Params p{};
    for (int i = 0; i < 23; ++i) p.in[i] = (const float*)d_in[i];
    p.out = (float*)d_out; p.ws = (unsigned char*)d_ws;
    if (N_LAUNCH_SPLIT) { for (int ph = 0; ph < NPH; ++ph) { p.ph_lo = ph; p.ph_hi = ph + 1; hipLaunchKernelGGL(mega, dim3(grid), dim3(512), LDS_BYTES, stream, p); } }
    else { p.ph_lo = 0; p.ph_hi = NPH; hipLaunchKernelGGL(mega, dim3(grid), dim3(512), LDS_BYTES, stream, p); }
}
```

```cpp
#include <hip/hip_runtime.h>
#include <stdint.h>
#include <stdio.h>

typedef unsigned short bf16_t;
typedef float f32x4 __attribute__((ext_vector_type(4)));
typedef unsigned u32x4 __attribute__((ext_vector_type(4)));
typedef unsigned u32x2 __attribute__((ext_vector_type(2)));
typedef short bf16x8 __attribute__((ext_vector_type(8)));

constexpr int T = 16384, DM = 2048, DIN = 5376, DPROJ = 4608, SEQ = 4096, NB = 4, DEPTH = 2;
constexpr int DLRU = 768, DCONV = 512, DSB = 768, HD = 128, NHL = 6, NHS = 6;
constexpr int NEXP = 32, DEXP = 512, MAXTILES = 160, PADROWS = MAXTILES * 256;
constexpr float EPS = 1e-6f;
constexpr float YSCALE_G = 8.0f;
constexpr float SX8 = 8.0f, SW1 = 64.0f, SH8 = 8.0f, SW2 = 32.0f;
#ifndef F8_INPROJ_MASK
#define F8_INPROJ_MASK 2
#endif
constexpr bool f8in(int l) { return ((F8_INPROJ_MASK >> l) & 1) != 0; }
constexpr float SHB = 16.0f, SWI = 64.0f;
#ifndef PITCH_PAD
#define PITCH_PAD 128
#endif
constexpr int pb_in(int l) { return (f8in(l) ? DM : DM * 2) + PITCH_PAD; }
constexpr int VTS = SEQ + 64;
constexpr int C_XA = 0, C_GA = 768, C_BG = 1536, C_CG = 2048, C_XB = 2560, C_Q = 3072, C_K = 3840, C_V = 4608;

constexpr size_t AL(size_t x) { return (x + 255) & ~(size_t)255; }
constexpr size_t SZ_WIN = (size_t)DIN * (DM * 2 + 256), SZ_WOUT = (size_t)DM * DM * 2, SZ_WGU = (size_t)NEXP * 1024 * DM * 2, SZ_WD = (size_t)NEXP * DM * DEXP * 2;
constexpr size_t SZ_WA = (size_t)NHL * HD * HD * 2, SZ_WR = (size_t)48 * DM * 4;
constexpr size_t OFF_CTL = 0, SZ_CTL = 131072;
constexpr size_t OFF_WIN = OFF_CTL + SZ_CTL;
constexpr size_t OFF_WOUT = OFF_WIN + DEPTH * SZ_WIN;
constexpr size_t OFF_WGU = OFF_WOUT + DEPTH * SZ_WOUT;
constexpr size_t OFF_WD = OFF_WGU + DEPTH * SZ_WGU;
constexpr size_t OFF_WA = OFF_WD + DEPTH * SZ_WD;
constexpr size_t OFF_WX = OFF_WA + DEPTH * SZ_WA;
constexpr size_t OFF_WR = OFF_WX + DEPTH * SZ_WA;
constexpr size_t OFF_HB = OFF_WR + DEPTH * SZ_WR;
constexpr size_t OFF_PROJ = OFF_HB + (size_t)T * (DM * 2 + 256);
constexpr size_t OFF_VT = OFF_PROJ + (size_t)T * DPROJ * 2;
constexpr size_t OFF_YPAD = OFF_PROJ;
constexpr size_t OFF_YMIX = OFF_VT + (size_t)NB * NHS * HD * VTS * 2;
constexpr size_t OFF_X = OFF_YMIX + (size_t)T * DM * 2;
constexpr size_t OFF_HID = OFF_X + (size_t)T * DM * 4;
constexpr size_t OFF_AGG = OFF_HID + (size_t)PADROWS * DEXP * 2;
constexpr size_t OFF_ROUTE = OFF_AGG + (size_t)256 * DLRU * 8;
constexpr size_t OFF_LIST = OFF_ROUTE + (size_t)T * 8 * 4;
constexpr size_t OFF_LISTR = OFF_LIST + (size_t)NEXP * T * 4;
constexpr size_t OFF_DB = OFF_LISTR + (size_t)NEXP * T * 4;
constexpr size_t WS_END = OFF_DB + (size_t)T * DM * 2;
static_assert((size_t)PADROWS * DM * 2 <= (size_t)T * DPROJ * 2 + (size_t)NB * NHS * HD * VTS * 2, "YPAD alias");
constexpr int CW_RT = 16384;
constexpr int CW_CNT = 8192;

typedef __bf16 bf16v2_t __attribute__((ext_vector_type(2)));
typedef float f32v2_t __attribute__((ext_vector_type(2)));
__device__ __forceinline__ unsigned cvt_pk_bf16(float lo, float hi) { const f32v2_t f = {lo, hi}; const bf16v2_t b = __builtin_convertvector(f, bf16v2_t); return __builtin_bit_cast(unsigned, b); }
__device__ __forceinline__ bf16_t f2bf(float f) { return (bf16_t)(cvt_pk_bf16(f, 0.f) & 0xffffu); }
__device__ __forceinline__ float bf2f(bf16_t b) { return __uint_as_float(((unsigned)b) << 16); }
__device__ __forceinline__ float bflo(unsigned w) { return __uint_as_float(w << 16); }
__device__ __forceinline__ float bfhi(unsigned w) { return __uint_as_float(w & 0xffff0000u); }
__device__ __forceinline__ float wave_sum(float v) {
#pragma unroll
    for (int o = 32; o >= 1; o >>= 1) v += __shfl_xor(v, o);
    return v;
}
__device__ __forceinline__ float fast_exp(float x) { return __builtin_amdgcn_exp2f(x * 1.4426950408889634f); }
__device__ __forceinline__ float sigmoidf_(float x) { return __builtin_amdgcn_rcpf(1.0f + fast_exp(-x)); }
__device__ __forceinline__ float one_minus_exp(float x) { const float s = -x * (1.0f + x * (0.5f + x * 0.16666667f)); const float d = 1.0f - fast_exp(x); return x > -0.02f ? s : d; }
__device__ __forceinline__ float softplusf_(float x) { return fmaxf(x, 0.f) + log1pf(__expf(-fabsf(x))); }
__device__ __forceinline__ float gelu_tanh(float x) { const float u2 = 1.5957691216057308f * (x + 0.044715f * x * x * x); return x * sigmoidf_(u2); }

__device__ __forceinline__ int otid() { int t = (int)threadIdx.x; asm volatile("" : "+v"(t)); return t; }
__device__ __forceinline__ int obid() { int b = (int)blockIdx.x; asm volatile("" : "+s"(b)); return b; }
#ifndef PROBE_SUB
#define PROBE_SUB 0
#endif
struct Params { const float* in[23]; float* out; unsigned char* ws; int ph_lo, ph_hi; };

struct InProxy { const float* const* p; int z; __device__ __forceinline__ const float* operator[](int k) const { return p[k + z]; } };
struct Ctx {
    InProxy in; float* out; unsigned char* ws;
    __device__ __forceinline__ unsigned* ctl() const { return (unsigned*)(ws + OFF_CTL); }
    __device__ __forceinline__ bf16_t* WIN(int l) const { return (bf16_t*)(ws + OFF_WIN + l * SZ_WIN); }
    __device__ __forceinline__ bf16_t* WOUT(int l) const { return (bf16_t*)(ws + OFF_WOUT + l * SZ_WOUT); }
    __device__ __forceinline__ bf16_t* WGU(int l) const { return (bf16_t*)(ws + OFF_WGU + l * SZ_WGU); }
    __device__ __forceinline__ bf16_t* WD(int l) const { return (bf16_t*)(ws + OFF_WD + l * SZ_WD); }
    __device__ __forceinline__ bf16_t* WA(int l) const { return (bf16_t*)(ws + OFF_WA + l * SZ_WA); }
    __device__ __forceinline__ bf16_t* WX(int l) const { return (bf16_t*)(ws + OFF_WX + l * SZ_WA); }
    __device__ __forceinline__ float* WR(int l) const { return (float*)(ws + OFF_WR + l * SZ_WR); }
    __device__ __forceinline__ unsigned* RTC(int l) const { return ctl() + CW_RT + l * 8192; }
    __device__ __forceinline__ unsigned* CNT(int l) const { return ctl() + CW_CNT + l * 2048; }
#define WSP(name, type, off) __device__ __forceinline__ type* name() const { return (type*)(ws + (off)); }
    WSP(HB, bf16_t, OFF_HB) WSP(PROJ, bf16_t, OFF_PROJ) WSP(VT, bf16_t, OFF_VT) WSP(YPAD, bf16_t, OFF_YPAD) WSP(YPAD8, unsigned char, OFF_YPAD) WSP(YMIX, bf16_t, OFF_YMIX) WSP(HID, bf16_t, OFF_HID)
    WSP(X, float, OFF_X) WSP(XB, bf16_t, OFF_X) WSP(AGG, float, OFF_AGG) WSP(ROUTE, unsigned, OFF_ROUTE) WSP(LIST, int, OFF_LIST) WSP(LISTR, float, OFF_LISTR) WSP(PT, bf16_t, OFF_X + (size_t)T * DM * 2) WSP(X1, bf16_t, OFF_X + (size_t)T * DM * 2) WSP(X1F8, unsigned char, OFF_HB) WSP(HID8, unsigned char, OFF_HID) WSP(DB, bf16_t, OFF_DB) WSP(HL, bf16_t, OFF_DB) WSP(PL, bf16_t, OFF_DB + (size_t)T * DLRU * 2)
#undef WSP
};

__device__ __forceinline__ Ctx octx(const Ctx& c) { int z = 0; asm volatile("" : "+s"(z)); Ctx r; r.in.p = c.in.p; r.in.z = z; r.out = c.out + z; r.ws = c.ws + z; return r; }

__device__ __forceinline__ void cvt_tile_out(const float* tile, int st, int r0, bf16_t* dst, int ld_dst, int drow0, bool f8) {
    const int rr = (st & 7) * 8;
    if (f8) {
#pragma unroll
        for (int p = 0; p < 2; ++p) {
            const int c = (st >> 3) + 32 * p; int w0 = 0, w1 = 0;
            w0 = __builtin_amdgcn_cvt_pk_fp8_f32(tile[(rr + 0) * 65 + c], tile[(rr + 1) * 65 + c], w0, false); w0 = __builtin_amdgcn_cvt_pk_fp8_f32(tile[(rr + 2) * 65 + c], tile[(rr + 3) * 65 + c], w0, true);
            w1 = __builtin_amdgcn_cvt_pk_fp8_f32(tile[(rr + 4) * 65 + c], tile[(rr + 5) * 65 + c], w1, false); w1 = __builtin_amdgcn_cvt_pk_fp8_f32(tile[(rr + 6) * 65 + c], tile[(rr + 7) * 65 + c], w1, true);
            *(u32x2*)((unsigned char*)dst + (size_t)(drow0 + c) * ld_dst + r0 + rr) = (u32x2){(unsigned)w0, (unsigned)w1};
        }
        return;
    }
#pragma unroll
    for (int p = 0; p < 2; ++p) {
        const int c = (st >> 3) + 32 * p;
        u32x4 w;
        w.x = cvt_pk_bf16(tile[(rr + 0) * 65 + c], tile[(rr + 1) * 65 + c]); w.y = cvt_pk_bf16(tile[(rr + 2) * 65 + c], tile[(rr + 3) * 65 + c]);
        w.z = cvt_pk_bf16(tile[(rr + 4) * 65 + c], tile[(rr + 5) * 65 + c]); w.w = cvt_pk_bf16(tile[(rr + 6) * 65 + c], tile[(rr + 7) * 65 + c]);
        *(u32x4*)(dst + (size_t)(drow0 + c) * ld_dst + r0 + rr) = w;
    }
}
constexpr int CV_WIN = 32 * 84, CV_WOUT = 32 * 32, CV_EXP = 32 * 8  , CV_G = NEXP * CV_EXP, CV_LRU = NHL * 4;
constexpr int CV_PER_LAYER = CV_WIN + CV_WOUT + 3 * CV_G + 2 * CV_LRU;
struct CvtTile { const float* src; bf16_t* dst; const float* gk; int ld_src, ld_dst, r0, c0, drow0; float sc; };
__device__ __forceinline__ void cvt_decode(const Ctx& c, int id, CvtTile& t) {
    const int l = id / CV_PER_LAYER; int j = id % CV_PER_LAYER; t.gk = nullptr; t.sc = 1.0f;
    if (j < CV_WIN) { t.src = c.in[2] + (size_t)l * DM * DIN; t.ld_src = DIN; { const int g = j >> 3, kp = g / 21, nq = g % 21; t.r0 = (2 * kp + ((j >> 2) & 1)) * 64; t.c0 = (4 * nq + (j & 3)) * 64; } t.dst = c.WIN(l); t.ld_dst = f8in(l) ? pb_in(l) : pb_in(l) / 2; t.drow0 = t.c0; if (f8in(l)) t.sc = -SWI; }
    else if ((j -= CV_WIN) < CV_WOUT) { t.src = c.in[14] + (size_t)l * DM * DM; t.ld_src = DM; { const int g = j >> 3, kp = g / 8, nq = g % 8; t.r0 = (2 * kp + ((j >> 2) & 1)) * 64; t.c0 = (4 * nq + (j & 3)) * 64; } t.dst = c.WOUT(l); t.ld_dst = DM; t.drow0 = t.c0; }
    else if ((j -= CV_WOUT) < 2 * CV_G) {
        const int isup = j / CV_G; j %= CV_G; const int e = j / CV_EXP; j %= CV_EXP;
        t.src = c.in[isup ? 21 : 20] + ((size_t)l * NEXP + e) * DM * DEXP; t.ld_src = DEXP; { const int g = j >> 3, kp = g / 2, nq = g % 2; t.r0 = (2 * kp + ((j >> 2) & 1)) * 64; t.c0 = (4 * nq + (j & 3)) * 64; }
        t.dst = (bf16_t*)((unsigned char*)c.WGU(l) + (size_t)e * 1024 * DM); t.ld_dst = DM; t.drow0 = 256 * (t.c0 / 128) + 128 * isup + (t.c0 % 128); t.gk = c.in[15] + (size_t)l * DM; t.sc = -SW1;
    } else if ((j -= 2 * CV_G) < CV_G) {
        const int e = j / CV_EXP; j %= CV_EXP;
        t.src = c.in[22] + ((size_t)l * NEXP + e) * DEXP * DM; t.ld_src = DM; { const int g = j >> 3, kp = g / 8, nq = g % 8; t.r0 = (2 * kp + ((j >> 2) & 1)) * 64; t.c0 = (4 * nq + (j & 3)) * 64; }
        t.dst = (bf16_t*)((unsigned char*)c.WD(l) + (size_t)e * DM * DEXP); t.ld_dst = DEXP; t.drow0 = t.c0; t.sc = -SW2;
    } else { j -= CV_G; const int isx = j / CV_LRU; j %= CV_LRU; const int h = j / 4; j %= 4;
        t.src = c.in[isx ? 7 : 5] + ((size_t)l * NHL + h) * HD * HD; t.ld_src = HD; t.r0 = (j / 2) * 64; t.c0 = (j % 2) * 64;
        t.dst = (isx ? c.WX(l) : c.WA(l)) + (size_t)h * HD * HD; t.ld_dst = HD; t.drow0 = t.c0; }
}
constexpr int CVT_NT = 4;
__device__ __forceinline__ void phase_convert(const Ctx& c, float* lds) {
    const int tid = otid(), sb = tid >> 8, st = tid & 255;
    float* tile0 = lds + sb * (CVT_NT * 64 * 65);
    const int total = DEPTH * CV_PER_LAYER;
    const int nsub = gridDim.x * 2 * CVT_NT;
    const int idb = (obid() * 2 + sb) * CVT_NT;
    CvtTile tA[CVT_NT]; f32x4 vA[CVT_NT][4];
#define CVT_LOAD(T_, V_, base_) do { _Pragma("unroll") for (int k = 0; k < CVT_NT; ++k) { const int id_ = (base_) + idb + k; cvt_decode(c, id_ < total ? id_ : 0, T_[k]); \
        _Pragma("unroll") for (int i = 0; i < 4; ++i) V_[k][i] = __builtin_nontemporal_load((const f32x4*)(T_[k].src + (size_t)(T_[k].r0 + (st >> 4) + 16 * i) * T_[k].ld_src + T_[k].c0 + (st & 15) * 4)); } } while (0)
#define CVT_FLUSH(T_, V_, base_) do { _Pragma("unroll") for (int k = 0; k < CVT_NT; ++k) _Pragma("unroll") for (int i = 0; i < 4; ++i) { \
            float* p = tile0 + k * (64 * 65) + ((st >> 4) + 16 * i) * 65 + (st & 15) * 4; const float gs_ = (T_[k].gk ? T_[k].gk[T_[k].r0 + (st >> 4) + 16 * i] : 1.0f) * fabsf(T_[k].sc); \
            p[0] = V_[k][i][0] * gs_; p[1] = V_[k][i][1] * gs_; p[2] = V_[k][i][2] * gs_; p[3] = V_[k][i][3] * gs_; } \
        __syncthreads(); \
        _Pragma("unroll") for (int k = 0; k < CVT_NT; ++k) if ((base_) + idb + k < total) cvt_tile_out(tile0 + k * (64 * 65), st, T_[k].r0, T_[k].dst, T_[k].ld_dst, T_[k].drow0, T_[k].sc < 0.f); \
        __syncthreads(); } while (0)
    for (int base = 0; base < total; base += nsub) { CVT_LOAD(tA, vA, base); CVT_FLUSH(tA, vA, base); }
#undef CVT_LOAD
#undef CVT_FLUSH
    for (int i = obid() * blockDim.x + tid; i < DEPTH * 48 * DM; i += gridDim.x * blockDim.x) {
        const int l = i / (48 * DM), n = (i / DM) % 48, k = i % DM;
        float v = 0.f;
        if (n < 4) v = c.in[16][((size_t)l * DM + k) * 4 + n]; else if (n < 36) v = c.in[18][((size_t)l * DM + k) * 32 + (n - 4)];
        const float wg = v * c.in[15][(size_t)l * DM + k]; const bf16_t hi = f2bf(wg);
        bf16_t* wr = (bf16_t*)c.WR(l); wr[(size_t)n * DM + k] = hi; wr[(size_t)(48 + n) * DM + k] = f2bf(wg - bf2f(hi));
    }
}

__device__ __forceinline__ void norm_store_row(const f32x4 (&v)[8], const float* g, bf16_t* dst, int lane) {
    float s = 0.f;
#pragma unroll
    for (int j = 0; j < 8; ++j) s += v[j][0] * v[j][0] + v[j][1] * v[j][1] + v[j][2] * v[j][2] + v[j][3] * v[j][3];
    s = wave_sum(s);
    const float rstd = rsqrtf(s * (1.0f / DM) + EPS);
#pragma unroll
    for (int j = 0; j < 8; ++j) {
        const f32x4 gg = *(const f32x4*)(g + j * 256 + lane * 4);
        u32x2 w; w.x = cvt_pk_bf16(v[j][0] * rstd * gg[0], v[j][1] * rstd * gg[1]); w.y = cvt_pk_bf16(v[j][2] * rstd * gg[2], v[j][3] * rstd * gg[3]);
        *(u32x2*)(dst + j * 256 + lane * 4) = w;
    }
}
__device__ __forceinline__ void norm_store_row8(const f32x4 (&v)[8], const float* g, unsigned char* dst, int lane) {
    float s = 0.f;
#pragma unroll
    for (int j = 0; j < 8; ++j) s += v[j][0] * v[j][0] + v[j][1] * v[j][1] + v[j][2] * v[j][2] + v[j][3] * v[j][3];
    s = wave_sum(s);
    const float rstd = rsqrtf(s * (1.0f / DM) + EPS) * SHB;
#pragma unroll
    for (int j = 0; j < 8; ++j) {
        const f32x4 gg = *(const f32x4*)(g + j * 256 + lane * 4);
        int w = 0; w = __builtin_amdgcn_cvt_pk_fp8_f32(v[j][0] * rstd * gg[0], v[j][1] * rstd * gg[1], w, false); w = __builtin_amdgcn_cvt_pk_fp8_f32(v[j][2] * rstd * gg[2], v[j][3] * rstd * gg[3], w, true);
        *(int*)(dst + j * 256 + lane * 4) = w;
    }
}
__device__ __forceinline__ void phase_norm_in(const Ctx& c, int l) {
    const int tid = otid(), lane = tid & 63, wv = tid >> 6, stride = gridDim.x * 8;
    for (int r = obid() * 8 + wv; r < T; r += 4 * stride) {
        f32x4 v[4][8];
#pragma unroll
        for (int k = 0; k < 4; ++k) { const int rr = (r + k * stride < T) ? r + k * stride : r;
#pragma unroll
            for (int j = 0; j < 8; ++j) v[k][j] = *(const f32x4*)(c.in[0] + (size_t)rr * DM + j * 256 + lane * 4); }
#pragma unroll
        for (int k = 0; k < 4; ++k) if (k == 0 || r + k * stride < T) norm_store_row(v[k], c.in[1] + (size_t)l * DM, (bf16_t*)((unsigned char*)c.HB() + (size_t)(r + k * stride) * pb_in(0)), lane);
    }
}

struct MoeTab { int cnt[NEXP]; int tstart[NEXP + 1]; int texp[MAXTILES]; };
__device__ __forceinline__ void build_moe_tab(const Ctx& c, int l, MoeTab* mt) {
    __syncthreads();
    const int tid = otid();
    if (tid < 64) {
        const int n = tid < NEXP ? (int)__hip_atomic_load(c.CNT(l) + tid * 64, __ATOMIC_RELAXED, __HIP_MEMORY_SCOPE_AGENT) : 0;
        const int nt = (n + 255) >> 8;
        int incl = nt;
#pragma unroll
        for (int o = 1; o < 32; o <<= 1) { const int v = __shfl_up(incl, o); if (tid >= o) incl += v; }
        const int excl = incl - nt;
        if (tid < NEXP) { mt->cnt[tid] = n; mt->tstart[tid] = excl; for (int i = 0; i < nt; ++i) if (excl + i < MAXTILES) mt->texp[excl + i] = tid; }
        if (tid == NEXP - 1) mt->tstart[NEXP] = incl < MAXTILES ? incl : MAXTILES;
    }
    __syncthreads();
}

template <bool DRY> __device__ __forceinline__ void phase_combine(const Ctx& c, int l, const MoeTab* mt) {
    const int tid = otid(), lane = tid & 63, wv = tid >> 6, stride = gridDim.x * 8;
    bf16_t* XB = c.XB(); const bf16_t* X1 = c.X1(); const unsigned char* YPAD = c.YPAD8(); const unsigned* ROUTE = c.ROUTE();
    for (int r = obid() * 8 + wv; r < T; r += 2 * stride) {
        f32x4 v[2][8]; unsigned ya[2][8], yb[2][8]; u32x2 yd[2][8]; float g0[2], g1[2]; int rr[2];
#pragma unroll
        for (int k = 0; k < 2; ++k) {
            rr[k] = (r + k * stride < T) ? r + k * stride : r;
            const u32x4 ra = *(const u32x4*)(ROUTE + (size_t)rr[k] * 8); const u32x2 rb = *(const u32x2*)(ROUTE + (size_t)rr[k] * 8 + 4);
            const int e0 = ra.x, p0 = ra.y, e1 = ra.w, p1 = rb.x; g0[k] = __uint_as_float(ra.z) * (1.0f / YSCALE_G); g1[k] = __uint_as_float(rb.y) * (1.0f / YSCALE_G);
            const unsigned char* y0 = YPAD + ((size_t)mt->tstart[e0] * 256 + p0) * DM + lane * 4; const unsigned char* y1 = YPAD + ((size_t)mt->tstart[e1] * 256 + p1) * DM + lane * 4;
            const bf16_t* dp = X1 + (size_t)rr[k] * DM + lane * 4;
#pragma unroll
            for (int j = 0; j < 8; ++j) { v[k][j] = (f32x4){0.f, 0.f, 0.f, 0.f};
                ya[k][j] = *(const unsigned*)(y0 + j * 256); yb[k][j] = *(const unsigned*)(y1 + j * 256); yd[k][j] = *(const u32x2*)(dp + j * 256); }
        }
        __builtin_amdgcn_sched_barrier(0);
#pragma unroll
        for (int k = 0; k < 2; ++k) {
            if (k == 0 || r + stride < T) {
#pragma unroll
                for (int j = 0; j < 8; ++j) {
                    typedef float f32x2_t __attribute__((ext_vector_type(2)));
                    const f32x2_t a01 = __builtin_amdgcn_cvt_pk_f32_fp8((int)ya[k][j], false), a23 = __builtin_amdgcn_cvt_pk_f32_fp8((int)ya[k][j], true);
                    const f32x2_t b01 = __builtin_amdgcn_cvt_pk_f32_fp8((int)yb[k][j], false), b23 = __builtin_amdgcn_cvt_pk_f32_fp8((int)yb[k][j], true);
                    v[k][j][0] += bflo(yd[k][j].x) + g0[k] * a01.x + g1[k] * b01.x; v[k][j][1] += bfhi(yd[k][j].x) + g0[k] * a01.y + g1[k] * b01.y;
                    v[k][j][2] += bflo(yd[k][j].y) + g0[k] * a23.x + g1[k] * b23.x; v[k][j][3] += bfhi(yd[k][j].y) + g0[k] * a23.y + g1[k] * b23.y;
                }
                if (l == DEPTH - 1) {
                    if (!DRY) {
#pragma unroll
                    for (int j = 0; j < 8; ++j) *(f32x4*)(c.out + (size_t)rr[k] * DM + j * 256 + lane * 4) = v[k][j]; }
                    else norm_store_row(v[k], c.in[1], c.HB() + (size_t)rr[k] * DM, lane);
                } else {
                    if (!DRY) {
#pragma unroll
                    for (int j = 0; j < 8; ++j) { u32x2 xw; xw.x = cvt_pk_bf16(v[k][j][0], v[k][j][1]); xw.y = cvt_pk_bf16(v[k][j][2], v[k][j][3]); *(u32x2*)(XB + (size_t)rr[k] * DM + j * 256 + lane * 4) = xw; } }
                    if (f8in(l + 1)) norm_store_row8(v[k], c.in[1] + (size_t)(l + 1) * DM, (unsigned char*)c.HB() + (size_t)rr[k] * pb_in(l + 1), lane);
                    else norm_store_row(v[k], c.in[1] + (size_t)(l + 1) * DM, (bf16_t*)((unsigned char*)c.HB() + (size_t)rr[k] * pb_in(l + 1)), lane);
                }
            }
        }
    }
}

__device__ __forceinline__ void phase_router_mfma(const Ctx& c, int l, float* lds) {
    float* LG = lds; float* SS = lds + 26624; float* RS = lds + 27136; int* LC = (int*)(lds + 27200); int* LB = (int*)(lds + 27232);
    const int tid = otid(), lane = tid & 63, wv = tid >> 6, rt = wv & 3, kh = wv >> 2, q = lane >> 4, l15 = lane & 15;
    const float* WR = c.WR(l);
    for (int tile = obid(); tile < T / 64; tile += gridDim.x) {
        const int r0 = tile * 64;
        f32x4 acc[4][3];
#pragma unroll
        for (int g = 0; g < 4; ++g)
#pragma unroll
            for (int ct = 0; ct < 3; ++ct) acc[g][ct] = (f32x4){0.f, 0.f, 0.f, 0.f};
        const bf16_t* xp = c.X1() + (size_t)(r0 + l15) * DM + wv * 256 + 8 * q;
        const bf16_t* wh = (const bf16_t*)WR + (size_t)l15 * DM + wv * 256 + 8 * q; const bf16_t* wl = wh + (size_t)48 * DM;
        float ssq[4] = {0.f, 0.f, 0.f, 0.f};
        bf16x8 xa[2][4], bh[2][3], bl[2][3];
#pragma unroll
        for (int st = 0; st < 2; ++st)
#pragma unroll
            for (int g = 0; g < 4; ++g) xa[st][g] = *(const bf16x8*)(xp + (size_t)(16 * g) * DM + 32 * st);
#pragma unroll
        for (int ct = 0; ct < 3; ++ct) { bh[0][ct] = *(const bf16x8*)(wh + (size_t)(16 * ct) * DM); bl[0][ct] = *(const bf16x8*)(wl + (size_t)(16 * ct) * DM); }
#define RT_STEP(st_, cur_, nxt_, ldb_, ldx_) do { \
            if (ldb_) { _Pragma("unroll") for (int ct = 0; ct < 3; ++ct) { bh[nxt_][ct] = *(const bf16x8*)(wh + (size_t)(16 * ct) * DM + 32 * ((st_) + 1)); bl[nxt_][ct] = *(const bf16x8*)(wl + (size_t)(16 * ct) * DM + 32 * ((st_) + 1)); } } \
            __builtin_amdgcn_sched_barrier(0); \
            _Pragma("unroll") for (int g = 0; g < 4; ++g) { \
                const bf16x8 xv = xa[cur_][g]; \
                _Pragma("unroll") for (int j = 0; j < 8; ++j) { const float xf = __uint_as_float(((unsigned)(unsigned short)xv[j]) << 16); ssq[g] += xf * xf; } \
                _Pragma("unroll") for (int ct = 0; ct < 3; ++ct) { acc[g][ct] = __builtin_amdgcn_mfma_f32_16x16x32_bf16(xv, bh[cur_][ct], acc[g][ct], 0, 0, 0); acc[g][ct] = __builtin_amdgcn_mfma_f32_16x16x32_bf16(xv, bl[cur_][ct], acc[g][ct], 0, 0, 0); } \
                if (ldx_) xa[cur_][g] = *(const bf16x8*)(xp + (size_t)(16 * g) * DM + 32 * ((st_) + 2)); } \
            __builtin_amdgcn_sched_barrier(0); } while (0)
#pragma unroll 1
        for (int sp = 0; sp < 4; ++sp) {
            RT_STEP(2 * sp, 0, 1, true, sp < 3);
            RT_STEP(2 * sp + 1, 1, 0, sp < 3, sp < 3);
        }
#undef RT_STEP
#pragma unroll
        for (int g = 0; g < 4; ++g) { float v = ssq[g]; v += __shfl_xor(v, 16); v += __shfl_xor(v, 32); if (q == 0) SS[wv * 64 + 16 * g + l15] = v; }
#pragma unroll
        for (int g = 0; g < 4; ++g)
#pragma unroll
            for (int ct = 0; ct < 3; ++ct)
#pragma unroll
                for (int i = 0; i < 4; ++i) LG[(wv * 64 + 16 * g + 4 * q + i) * 52 + 16 * ct + l15] = acc[g][ct][i];
        if (tid < NEXP) LC[tid] = 0;
        __syncthreads();
        int e0 = 0, e1 = 0, k0_ = 0, k1_ = 0; float rstd_ = 0.f, g0_ = 0.f, g1_ = 0.f;
        if (tid < 64) {
            float sst_ = 0.f;
#pragma unroll
            for (int w = 0; w < 8; ++w) sst_ += SS[w * 64 + tid];
            const float rstd = rsqrtf(sst_ * (1.0f / DM) + EPS);
            RS[tid] = rstd;
            float gl[4], el[8];
#pragma unroll
            for (int i = 0; i < 4; ++i) { float a_ = 0.f;
#pragma unroll
                for (int w = 0; w < 8; ++w) a_ += LG[(w * 64 + tid) * 52 + i];
                gl[i] = a_ * rstd + c.in[17][l * 4 + i]; }
            int gi = 0; float gm = gl[0];
#pragma unroll
            for (int i = 1; i < 4; ++i) if (gl[i] > gm) { gm = gl[i]; gi = i; }
            float gs = 0.f;
#pragma unroll
            for (int i = 0; i < 4; ++i) gs += __expf(gl[i] - gm);
            const float pg = 1.0f / gs;
#pragma unroll
            for (int i = 0; i < 8; ++i) { const int n = 4 + gi * 8 + i; float a_ = 0.f;
#pragma unroll
                for (int w = 0; w < 8; ++w) a_ += LG[(w * 64 + tid) * 52 + n];
                el[i] = a_ * rstd + c.in[19][l * 32 + gi * 8 + i]; }
            int i0 = 0; float m0 = el[0];
#pragma unroll
            for (int i = 1; i < 8; ++i) if (el[i] > m0) { m0 = el[i]; i0 = i; }
            int i1 = -1; float m1 = -3.0e38f;
#pragma unroll
            for (int i = 0; i < 8; ++i) if (i != i0 && el[i] > m1) { m1 = el[i]; i1 = i; }
            const float ex1 = __expf(m1 - m0), den = 1.0f + ex1;
            const float g0 = pg / den, g1 = pg * ex1 / den;
            e0 = gi * 8 + i0; e1 = gi * 8 + i1; rstd_ = rstd; g0_ = g0; g1_ = g1;
            k0_ = (int)__hip_atomic_fetch_add(&LC[e0], 1, __ATOMIC_RELAXED, __HIP_MEMORY_SCOPE_WORKGROUP);
            k1_ = (int)__hip_atomic_fetch_add(&LC[e1], 1, __ATOMIC_RELAXED, __HIP_MEMORY_SCOPE_WORKGROUP);
        }
        __syncthreads();
        if (tid < NEXP) { const int n = LC[tid]; LB[tid] = n > 0 ? (int)__hip_atomic_fetch_add(c.CNT(l) + tid * 64, (unsigned)n, __ATOMIC_RELAXED, __HIP_MEMORY_SCOPE_AGENT) : 0; }
        __syncthreads();
        if (tid < 64) {
            const int r = r0 + tid, p0 = LB[e0] + k0_, p1 = LB[e1] + k1_;
            c.LIST()[(size_t)e0 * T + p0] = r; c.LIST()[(size_t)e1 * T + p1] = r;
            c.LISTR()[(size_t)e0 * T + p0] = rstd_; c.LISTR()[(size_t)e1 * T + p1] = rstd_;
            unsigned* ro = c.ROUTE() + (size_t)r * 8;
            *(u32x4*)ro = (u32x4){(unsigned)e0, (unsigned)p0, __float_as_uint(g0_), (unsigned)e1};
            *(u32x2*)(ro + 4) = (u32x2){(unsigned)p1, __float_as_uint(g1_)};
        }
        __syncthreads();
    }
}

#define LAS __attribute__((address_space(3)))
typedef int i32x4_t __attribute__((ext_vector_type(4)));
typedef int i32x8_t __attribute__((ext_vector_type(8)));
__device__ __forceinline__ i32x8_t cat8(const bf16x8 a, const bf16x8 b) { const i32x4_t x = __builtin_bit_cast(i32x4_t, a), y = __builtin_bit_cast(i32x4_t, b); return __builtin_shufflevector(x, y, 0, 1, 2, 3, 4, 5, 6, 7); }
__device__ __forceinline__ void mfma_f8(f32x4& acc, const i32x8_t& a, const i32x8_t& b) { asm volatile("v_mfma_f32_16x16x128_f8f6f4 %0, %1, %2, %0" : "+v"(acc) : "v"(a), "v"(b)); }
__device__ __forceinline__ bf16x8 half8(const i32x8_t& v, int k) { const i32x4_t h = k ? __builtin_shufflevector(v, v, 4, 5, 6, 7) : __builtin_shufflevector(v, v, 0, 1, 2, 3); return __builtin_bit_cast(bf16x8, h); }
namespace g8 {
constexpr int BM = 256, BK = 64, HALF = 128, HTB = HALF * BK * 2, STAGE_BYTES = 8 * HTB, NXCD = 8, WGM = 8;
__device__ __forceinline__ int lds_byte(int r, int c) { const int st = (r >> 4) * 2 + (c >> 5), rr = r & 15, cc = c & 31, ob = rr * 64 + cc * 2; return st * 1024 + (ob ^ (((ob >> 9) & 1) << 5)); }
__device__ __forceinline__ void stage_rc(int b, int& R, int& C) { const int st = b / 1024, sb = b % 1024, swz = sb ^ (((sb >> 9) & 1) << 5); R = (st >> 1) * 16 + swz / 64; C = (st & 1) * 32 + (swz % 64) / 2; }
__device__ __forceinline__ int perm32(int rho) { const int n = rho >> 4, i = rho & 15; return 8 * (i >> 2) + 4 * n + (i & 3); }
struct Unit { int pm, pn; const char* B; };
typedef f32x4 Acc[2][2][4][2];

struct DenseOrder {
    static constexpr bool GATHER = false;
    int nM, nN, nwg, G, c; const char* Bt; size_t tstrideB; int rsh = 0, lim = 0x7fffffff;
    __device__ __forceinline__ void init(int M, int N, int G_, int c_, const bf16_t* Bt_, int ldb) { nM = M / BM; nN = N / BM; nwg = nM * nN; G = G_; c = c_; Bt = (const char*)Bt_; tstrideB = (size_t)BM * ldb * 2; }
    __device__ __forceinline__ bool next(int i, Unit& u) const {
        const long L = (long)(i >> rsh) * G + c; if (L >= nwg || L >= lim) return false;
        int wgid = (int)L; { const int q = nwg / NXCD, r = nwg % NXCD, xcd = wgid % NXCD, off = wgid / NXCD; wgid = (xcd < r ? xcd * (q + 1) : r * (q + 1) + (xcd - r) * q) + off; }
        const int nig = WGM * nN, gid = wgid / nig, fm = gid * WGM, gsz = (nM - fm) < WGM ? (nM - fm) : WGM;
        u.pm = fm + ((wgid % nig) % gsz); u.pn = (wgid % nig) / gsz; u.B = Bt + (size_t)u.pn * tstrideB; return true;
    }
    __device__ __forceinline__ unsigned arow_off(int) const { return 0u; }
};
struct SplitKOrder {
    static constexpr bool GATHER = false;
    int c; const char* Bt;
    __device__ __forceinline__ bool next(int i, Unit& u) const { if (i > 0) return false; u.pm = c >> 2; u.pn = c & 3; u.B = Bt; return true; }
    __device__ __forceinline__ unsigned arow_off(int) const { return 0u; }
};
template <bool GATHER_, int NCT, int LDA, size_t ESTRIDE, size_t TSTRIDE> struct MoeOrder {
    static constexpr bool GATHER = GATHER_;
    const MoeTab* mt; const int* LIST; int G, c; const char* W; int rsh = 0;
    __device__ __forceinline__ bool next(int i, Unit& u) const {
        const int L = (i >> rsh) * G + c; const int total = __builtin_amdgcn_readfirstlane(mt->tstart[NEXP]) * NCT; if (L >= total) return false;
        const int rt = L / NCT, ct = L % NCT; u.pm = rt; u.pn = ct; const int e = __builtin_amdgcn_readfirstlane(mt->texp[rt]); u.B = W + (size_t)e * ESTRIDE + (size_t)ct * TSTRIDE; return true;
    }
    __device__ __forceinline__ unsigned arow_off(int r) const {
        const int e = mt->texp[r >> 8]; const int pos = r - mt->tstart[e] * 256; const int tok = pos < mt->cnt[e] ? LIST[(size_t)e * T + pos] : 0; return (unsigned)tok * (unsigned)(LDA * 2);
    }
};

struct MoeOrder2 {
    static constexpr bool GATHER = false;
    const MoeTab* mt; int G, c, R, rtA; const char* W; int rsh = 0;
    __device__ __forceinline__ bool next(int i0, Unit& u) const {
        const int i = i0 >> rsh; int u2;
        if (c < R) { if (i >= 2) return false; u2 = rtA * 8 + 2 * c + i; }
        else { u2 = (c - R) + i * (G - R); if (u2 >= rtA * 8) return false; }
        const int rt = u2 >> 3, ct = u2 & 7; u.pm = rt; u.pn = ct; const int e = __builtin_amdgcn_readfirstlane(mt->texp[rt]);
        u.B = W + (size_t)e * ((size_t)DM * DEXP) + (size_t)ct * ((size_t)256 * DEXP); return true;
    }
    __device__ __forceinline__ unsigned arow_off(int) const { return 0u; }
};
__device__ __forceinline__ void moe_wait_dep(unsigned* rtc, int c, int G, int R, int rtA) {
    const int tid = otid();
    if (tid < 64) {
        int rt = -1;
        if (c < R) { if (tid < 2) rt = rtA + ((2 * c + tid) >> 3); } else if (tid < 32) { const int u2 = (c - R) + tid * (G - R); if (u2 < rtA * 8) rt = u2 >> 3; }
        unsigned spins = 0;
        for (;;) {
            const bool ok = rt < 0 || __hip_atomic_load(rtc + (rt < 0 ? 0 : rt) * 32, __ATOMIC_RELAXED, __HIP_MEMORY_SCOPE_AGENT) >= 32u;
            if (__all(ok)) break;
            __builtin_amdgcn_s_sleep(2); if (++spins > (1u << 22)) break;
        }
        __builtin_amdgcn_fence(__ATOMIC_ACQUIRE, "agent");
        asm volatile("s_waitcnt vmcnt(0)" ::: "memory");
    }
    __syncthreads();
}

template <class Epi, class Sched>
__device__ __forceinline__ void gemm_mfma(LAS unsigned char* lds, const bf16_t* A, int lda, int ldb, int K, const Sched& S, const Epi& E) {
    constexpr bool GATHER = Sched::GATHER;
    const int tid = otid(), wid = __builtin_amdgcn_readfirstlane(tid >> 6), lane = tid & 63, wr = wid >> 2, wc = wid & 3, fr = lane & 15, fq = lane >> 4;
    const int nt = K / BK;
    int Rst[2], Cst[2]; unsigned voffB[2], voA[2][2], voAn[2][2];
#pragma unroll
    for (int i = 0; i < 2; ++i) { stage_rc(tid * 16 + i * 8192, Rst[i], Cst[i]); const int Rb = Epi::PERM ? ((Rst[i] & ~31) + perm32(Rst[i] & 31)) : Rst[i];
        voffB[i] = (unsigned)(Rb * ldb + Cst[i]) * 2u;
#pragma unroll
        for (int h = 0; h < 2; ++h) { voA[h][i] = (unsigned)((h * HALF + Rst[i]) * lda + Cst[i]) * 2u; voAn[h][i] = voA[h][i]; } }
    const size_t kstep = (size_t)(BK * 2), hstepB = (size_t)HALF * ldb * 2, tstepA = (size_t)BM * lda * 2;
    const unsigned ldsw = (unsigned)wid * 1024u;
    const int aoff = lds_byte(wr * 64 + fr, fq * 8), boff = lds_byte(wc * 32 + fr, fq * 8);
#define G8_SA(b, h) (((b) * 2 + (h)) * HTB)
#define G8_SB(b, h) ((4 + (b) * 2 + (h)) * HTB)
#define G8_OPQ(x) ({ unsigned _o = (x); asm volatile("" : "+v"(_o)); _o; })
#define G8_STAGE_B(bufoff, gbase) do { _Pragma("unroll") for (int _i = 0; _i < 2; ++_i) \
        __builtin_amdgcn_global_load_lds((const unsigned*)((const char*)(gbase) + G8_OPQ(voffB[_i])), (LAS unsigned*)(lds + (bufoff) + ldsw + _i * 8192), 16, 0, 0); } while (0)
#define G8_STAGE_A(bufoff, gbase, o0, o1) do { \
        __builtin_amdgcn_global_load_lds((const unsigned*)((const char*)(gbase) + G8_OPQ(o0)), (LAS unsigned*)(lds + (bufoff) + ldsw), 16, 0, 0); \
        __builtin_amdgcn_global_load_lds((const unsigned*)((const char*)(gbase) + G8_OPQ(o1)), (LAS unsigned*)(lds + (bufoff) + ldsw + 8192), 16, 0, 0); } while (0)
#define G8_LDA(dst, b, h) do { _Pragma("unroll") for (int m = 0; m < 4; ++m) dst[m] = cat8(*(const LAS bf16x8*)(lds + G8_SA(b, h) + aoff + m * 2048), *(const LAS bf16x8*)(lds + G8_SA(b, h) + aoff + m * 2048 + 1024)); } while (0)
#define G8_LDB(dst, b, h) do { _Pragma("unroll") for (int n = 0; n < 2; ++n) dst[n] = cat8(*(const LAS bf16x8*)(lds + G8_SB(b, h) + boff + n * 2048), *(const LAS bf16x8*)(lds + G8_SB(b, h) + boff + n * 2048 + 1024)); } while (0)
#define G8_MMA(ai, bj, At, Bt) do { __builtin_amdgcn_s_setprio(1); \
        if constexpr (Epi::F8) { _Pragma("unroll") for (int m = 0; m < 4; ++m) _Pragma("unroll") for (int n = 0; n < 2; ++n) \
            mfma_f8(acc[ai][bj][m][n], Bt[n], At[m]); } \
        else { _Pragma("unroll") for (int m = 0; m < 4; ++m) _Pragma("unroll") for (int n = 0; n < 2; ++n) _Pragma("unroll") for (int k = 0; k < 2; ++k) \
            acc[ai][bj][m][n] = __builtin_amdgcn_mfma_f32_16x16x32_bf16(half8(Bt[n], k), half8(At[m], k), acc[ai][bj][m][n], 0, 0, 0); } \
        __builtin_amdgcn_s_setprio(0); } while (0)
#define G8_WAIT_V(n) asm volatile("s_waitcnt vmcnt(" #n ")" ::: "memory")
#define G8_WAIT_L(n) asm volatile("s_waitcnt lgkmcnt(" #n ")" ::: "memory")
#define G8_BAR __builtin_amdgcn_s_barrier()
#define G8_SCHED __builtin_amdgcn_sched_barrier(0)
    Unit cur, nxt; int ui = 0, prev_pm = -1;
    if (!S.next(0, cur)) return;
    Acc acc;
#pragma unroll
    for (int a = 0; a < 2; ++a)
#pragma unroll
        for (int b = 0; b < 2; ++b)
#pragma unroll
            for (int m = 0; m < 4; ++m)
#pragma unroll
                for (int n = 0; n < 2; ++n) acc[a][b][m][n] = (f32x4){0.f, 0.f, 0.f, 0.f};
    i32x8_t At[4], B0[2], B1[2];
    const char* cA; const char* cB = cur.B;
    if (GATHER) { cA = (const char*)A;
#pragma unroll
        for (int h = 0; h < 2; ++h)
#pragma unroll
            for (int i = 0; i < 2; ++i) voA[h][i] = S.arow_off(cur.pm * BM + h * HALF + Rst[i]) + (unsigned)Cst[i] * 2u;
    } else cA = (const char*)A + (size_t)cur.pm * tstepA;
    G8_STAGE_B(G8_SB(0, 0), cB); G8_STAGE_A(G8_SA(0, 0), cA, voA[0][0], voA[0][1]); G8_STAGE_B(G8_SB(0, 1), cB + hstepB); G8_STAGE_A(G8_SA(0, 1), cA, voA[1][0], voA[1][1]);
    if (wr == 1) G8_BAR;
    G8_WAIT_V(4); G8_BAR;
    G8_STAGE_B(G8_SB(1, 0), cB + kstep); G8_STAGE_A(G8_SA(1, 0), cA + kstep, voA[0][0], voA[0][1]); G8_STAGE_B(G8_SB(1, 1), cB + hstepB + kstep);
    G8_WAIT_V(6); G8_BAR;
    for (;;) {
        const bool has_next = S.next(ui + 1, nxt);
        const char* nA; const char* nB = has_next ? nxt.B : cB;
        if (GATHER) { nA = cA;
            if (has_next) {
#pragma unroll
                for (int h = 0; h < 2; ++h)
#pragma unroll
                    for (int i = 0; i < 2; ++i) voAn[h][i] = S.arow_off(nxt.pm * BM + h * HALF + Rst[i]) + (unsigned)Cst[i] * 2u;
            } else {
#pragma unroll
                for (int h = 0; h < 2; ++h)
#pragma unroll
                    for (int i = 0; i < 2; ++i) voAn[h][i] = voA[h][i];
            }
        } else nA = has_next ? (const char*)A + (size_t)nxt.pm * tstepA : cA;
        for (int t = 0; t < nt; t += 2) {
            const bool last = (t == nt - 2);
            const char* a1 = cA + (size_t)(t + 1) * kstep;
            const char* a2 = last ? nA : cA + (size_t)(t + 2) * kstep; const char* b2 = last ? nB : cB + (size_t)(t + 2) * kstep;
            const char* a3 = a2 + kstep; const char* b3 = b2 + kstep;
            unsigned o00 = voA[0][0], o01 = voA[0][1], o10 = voA[1][0], o11 = voA[1][1];
            if (GATHER) { if (last) { o00 = voAn[0][0]; o01 = voAn[0][1]; o10 = voAn[1][0]; o11 = voAn[1][1]; } }
            G8_LDB(B0, 0, 0); G8_SCHED; G8_LDA(At, 0, 0); G8_STAGE_A(G8_SA(1, 1), a1, voA[1][0], voA[1][1]);
            G8_WAIT_L(8); G8_BAR; G8_WAIT_L(0); G8_MMA(0, 0, At, B0); G8_BAR; G8_SCHED;
            G8_LDB(B1, 0, 1); G8_STAGE_B(G8_SB(0, 0), b2);
            G8_BAR; G8_WAIT_L(0); G8_MMA(0, 1, At, B1); G8_BAR;
            G8_LDA(At, 0, 1); G8_STAGE_A(G8_SA(0, 0), a2, o00, o01);
            G8_BAR; G8_WAIT_L(0); G8_MMA(1, 0, At, B0); G8_BAR; G8_SCHED;
            G8_STAGE_B(G8_SB(0, 1), b2 + hstepB);
            G8_WAIT_V(6);
            if constexpr (Epi::PUBLISH) { if (prev_pm >= 0) { E.publish(prev_pm); prev_pm = -1; } }
            G8_BAR; G8_MMA(1, 1, At, B1); G8_BAR;
            G8_LDB(B0, 1, 0); G8_SCHED; G8_LDA(At, 1, 0); G8_STAGE_A(G8_SA(0, 1), a2, o10, o11);
            G8_WAIT_L(8); G8_BAR; G8_WAIT_L(0); G8_MMA(0, 0, At, B0); G8_BAR; G8_SCHED;
            G8_LDB(B1, 1, 1); G8_STAGE_B(G8_SB(1, 0), b3);
            G8_BAR; G8_WAIT_L(0); G8_MMA(0, 1, At, B1); G8_BAR;
            G8_LDA(At, 1, 1); G8_STAGE_A(G8_SA(1, 0), a3, o00, o01);
            G8_BAR; G8_WAIT_L(0); G8_MMA(1, 0, At, B0); G8_BAR; G8_SCHED;
            G8_STAGE_B(G8_SB(1, 1), b3 + hstepB);
            G8_WAIT_V(6); G8_BAR; G8_MMA(1, 1, At, B1); G8_BAR;
        }
        if constexpr (Epi::F8) {
#define G8_TIE(a, b, txt) asm volatile(txt : "+v"(acc[a][b][0][0]), "+v"(acc[a][b][0][1]), "+v"(acc[a][b][1][0]), "+v"(acc[a][b][1][1]), "+v"(acc[a][b][2][0]), "+v"(acc[a][b][2][1]), "+v"(acc[a][b][3][0]), "+v"(acc[a][b][3][1]))
            G8_TIE(0, 0, ""); G8_TIE(0, 1, ""); G8_TIE(1, 0, "s_nop 7"); G8_TIE(1, 1, "s_nop 15\n\ts_nop 7");
#undef G8_TIE
        }
        if constexpr (Epi::ASCALE != 1.0f) {
#pragma unroll
            for (int a = 0; a < 2; ++a)
#pragma unroll
                for (int b = 0; b < 2; ++b)
#pragma unroll
                    for (int m = 0; m < 4; ++m)
#pragma unroll
                        for (int n = 0; n < 2; ++n) acc[a][b][m][n] *= Epi::ASCALE;
        }
        E(acc, cur, wr, wc, fr, fq);
        if constexpr (Epi::PUBLISH) prev_pm = cur.pm;
        if (!has_next) break;
#pragma unroll
        for (int a = 0; a < 2; ++a)
#pragma unroll
            for (int b = 0; b < 2; ++b)
#pragma unroll
                for (int m = 0; m < 4; ++m)
#pragma unroll
                    for (int n = 0; n < 2; ++n) acc[a][b][m][n] = (f32x4){0.f, 0.f, 0.f, 0.f};
        cur = nxt; cA = nA; cB = nB; ++ui;
        if (GATHER) {
#pragma unroll
            for (int h = 0; h < 2; ++h)
#pragma unroll
                for (int i = 0; i < 2; ++i) voA[h][i] = voAn[h][i];
        }
    }
    G8_WAIT_V(0);
    if constexpr (Epi::PUBLISH) { if (prev_pm >= 0) { E.publish(prev_pm); prev_pm = -1; } }
    if (wr == 0) G8_BAR;
    G8_BAR;
#undef G8_SA
#undef G8_SB
#undef G8_STAGE_A
#undef G8_STAGE_B
#undef G8_OPQ
#undef G8_LDA
#undef G8_LDB
#undef G8_MMA
#undef G8_WAIT_V
#undef G8_WAIT_L
#undef G8_BAR
#undef G8_SCHED
}

__device__ __forceinline__ u32x4 pack8(const f32x4& a, const f32x4& b) { u32x4 w; w.x = cvt_pk_bf16(a[0], a[1]); w.y = cvt_pk_bf16(a[2], a[3]); w.z = cvt_pk_bf16(b[0], b[1]); w.w = cvt_pk_bf16(b[2], b[3]); return w; }
__device__ __forceinline__ u32x4 subtile_T(LAS bf16_t* Tw, const f32x4& a, const f32x4& b, int fr, int fq, int lane) {
#pragma unroll
    for (int j = 0; j < 4; ++j) { Tw[(8 * fq + j) * 16 + fr] = f2bf(a[j]); Tw[(8 * fq + 4 + j) * 16 + fr] = f2bf(b[j]); }
    return *(const LAS u32x4*)(Tw + (lane >> 1) * 16 + (lane & 1) * 8);
}
template <bool F8_> struct MEpiProjT { static constexpr bool PERM = true, PUBLISH = false, F8 = F8_; static constexpr float ASCALE = F8_ ? 1.0f / (SHB * SWI) : 1.0f; bf16_t* PROJ; bf16_t* VT; LAS float* KX; const float* gq; const float* gk;
    __device__ __forceinline__ void operator()(const Acc& acc, const Unit& u, int wr, int wc, int fr, int fq) const {
        const int row0 = u.pm * BM + wr * 64 + fr;
        if (u.pn >= C_K / 256 && u.pn < DPROJ / 256) {
#pragma unroll
            for (int ai = 0; ai < 2; ++ai)
#pragma unroll
                for (int m = 0; m < 4; ++m)
#pragma unroll
                    for (int bj = 0; bj < 2; ++bj) {
                        const f32x4 a = acc[ai][bj][m][0], b = acc[ai][bj][m][1];
                        float ss = a[0] * a[0] + a[1] * a[1] + a[2] * a[2] + a[3] * a[3] + b[0] * b[0] + b[1] * b[1] + b[2] * b[2] + b[3] * b[3];
                        ss += __shfl_xor(ss, 16); ss += __shfl_xor(ss, 32);
                        if (fq == 0) KX[((ai * HALF + wr * 64 + m * 16 + fr) * 2 + bj) * 4 + wc] = ss;
                    }
            asm volatile("s_waitcnt lgkmcnt(0)" ::: "memory"); __builtin_amdgcn_s_barrier(); asm volatile("" ::: "memory");
            const int col0 = u.pn * BM + wc * 32 + 8 * fq;
            f32x4 g0[2], g1[2];
#pragma unroll
            for (int bj = 0; bj < 2; ++bj) { const int d0 = wc * 32 + 8 * fq; g0[bj] = *(const f32x4*)(gq + d0) * *(const f32x4*)(gk + d0); g1[bj] = *(const f32x4*)(gq + d0 + 4) * *(const f32x4*)(gk + d0 + 4); }
#pragma unroll
            for (int ai = 0; ai < 2; ++ai)
#pragma unroll
                for (int m = 0; m < 4; ++m) { bf16_t* rowp = PROJ + (size_t)(row0 + ai * HALF + m * 16) * DPROJ + col0;
#pragma unroll
                    for (int bj = 0; bj < 2; ++bj) { const f32x4 p4 = *(const LAS f32x4*)(KX + ((ai * HALF + wr * 64 + m * 16 + fr) * 2 + bj) * 4);
                        const float rs = rsqrtf(((p4[0] + p4[1]) + (p4[2] + p4[3])) * (1.0f / HD) + EPS);
                        *(u32x4*)(rowp + bj * HALF) = pack8(acc[ai][bj][m][0] * g0[bj] * rs, acc[ai][bj][m][1] * g1[bj] * rs); } }
            return;
        }
        if (u.pn < DPROJ / 256) {
            const int col0 = u.pn * BM + wc * 32 + 8 * fq;
#pragma unroll
            for (int ai = 0; ai < 2; ++ai)
#pragma unroll
                for (int m = 0; m < 4; ++m) { bf16_t* rowp = PROJ + (size_t)(row0 + ai * HALF + m * 16) * DPROJ + col0;
#pragma unroll
                    for (int bj = 0; bj < 2; ++bj) *(u32x4*)(rowp + bj * HALF) = pack8(acc[ai][bj][m][0], acc[ai][bj][m][1]); }
        } else {
            const int lane = fq * 16 + fr, cl = lane >> 1, hf = lane & 1; LAS bf16_t* Tw = (LAS bf16_t*)KX + (wr * 4 + wc) * 512;
            const int cc0 = (u.pn - DPROJ / 256) * BM + wc * 32 + cl;
#pragma unroll
            for (int ai = 0; ai < 2; ++ai)
#pragma unroll
                for (int m = 0; m < 4; ++m) { const int rowb = u.pm * BM + wr * 64 + ai * HALF + m * 16, b = rowb >> 12, s = (rowb & (SEQ - 1)) + hf * 8;
#pragma unroll
                    for (int bj = 0; bj < 2; ++bj) { const int cc = cc0 + bj * HALF;
                        const u32x4 w = subtile_T(Tw, acc[ai][bj][m][0], acc[ai][bj][m][1], fr, fq, lane);
                        *(u32x4*)(VT + ((size_t)(b * NHS + (cc >> 7)) * HD + (cc & 127)) * VTS + s) = w; } }
        }
    } };
template <bool F8_> struct MEpiPartT { static constexpr bool PERM = true, PUBLISH = false, F8 = F8_; static constexpr float ASCALE = F8_ ? 1.0f / (SHB * SWI) : 1.0f; bf16_t* PT; LAS float* KX;
    __device__ __forceinline__ void operator()(const Acc& acc, const Unit& u, int wr, int wc, int fr, int fq) const {
        const int lane = fq * 16 + fr, cl = lane >> 1, hf = lane & 1; LAS bf16_t* Tw = (LAS bf16_t*)KX + (wr * 4 + wc) * 512;
        bf16_t* base0 = PT + (size_t)(u.pm * 4 + u.pn) * 65536 + (size_t)(wc * 32 + cl) * 256 + wr * 64 + hf * 8;
#pragma unroll
        for (int ai = 0; ai < 2; ++ai)
#pragma unroll
            for (int m = 0; m < 4; ++m)
#pragma unroll
                for (int bj = 0; bj < 2; ++bj) {
                    const u32x4 w = subtile_T(Tw, acc[ai][bj][m][0], acc[ai][bj][m][1], fr, fq, lane);
                    *(u32x4*)(base0 + (size_t)(bj * HALF) * 256 + ai * HALF + m * 16) = w; }
    } };
__device__ __forceinline__ u32x4 pair16(unsigned a0, unsigned a1, unsigned b0, unsigned b1) {
    const auto s0 = __builtin_amdgcn_permlane16_swap(a0, b0, false, false); const auto s1 = __builtin_amdgcn_permlane16_swap(a1, b1, false, false);
    return (u32x4){s0[0], s1[0], s0[1], s1[1]};
}
__device__ __forceinline__ f32x4 silu_mul(const f32x4& g, const f32x4& u) { f32x4 r;
#pragma unroll
    for (int j = 0; j < 4; ++j) r[j] = g[j] / (1.0f + __expf(-g[j])) * u[j];
    return r; }
struct MEpiGU { static constexpr bool PERM = true, PUBLISH = true, F8 = true; static constexpr float ASCALE = 1.0f; unsigned char* HID; const float* LISTR; const MoeTab* mt; unsigned* rtc; int n1early;
    __device__ __forceinline__ void operator()(const Acc& acc, const Unit& u, int wr, int wc, int fr, int fq) const {
        const int row0 = u.pm * BM + wr * 64 + fr, col0 = u.pn * HALF + wc * 32 + 8 * fq;
        const int e = __builtin_amdgcn_readfirstlane(mt->texp[u.pm]), cnt = __builtin_amdgcn_readfirstlane(mt->cnt[e]), pb = __builtin_amdgcn_readfirstlane(mt->tstart[e]) * 256;
        const float* lr = LISTR + (size_t)e * T;
        const __amdgpu_buffer_rsrc_t rsrc = __builtin_amdgcn_make_buffer_rsrc(HID, 0, (int)((size_t)PADROWS * DEXP), 0x00020000);
#pragma unroll
        for (int ai = 0; ai < 2; ++ai)
#pragma unroll
            for (int mp = 0; mp < 2; ++mp) { int w[2][2];
#pragma unroll
                for (int mm = 0; mm < 2; ++mm) { const int m = 2 * mp + mm;
                    const int row = row0 + ai * HALF + m * 16, pos = row - pb;
                    const float rs = pos < cnt ? lr[pos] * (1.0f / (SX8 * SW1)) : 0.f;
                    const f32x4 h0 = silu_mul(acc[ai][0][m][0] * rs, acc[ai][1][m][0] * rs) * SH8, h1 = silu_mul(acc[ai][0][m][1] * rs, acc[ai][1][m][1] * rs) * SH8;
                    int w0 = 0, w1 = 0;
                    w0 = __builtin_amdgcn_cvt_pk_fp8_f32(__builtin_amdgcn_fmed3f(h0[0], -448.f, 448.f), __builtin_amdgcn_fmed3f(h0[1], -448.f, 448.f), w0, false); w0 = __builtin_amdgcn_cvt_pk_fp8_f32(__builtin_amdgcn_fmed3f(h0[2], -448.f, 448.f), __builtin_amdgcn_fmed3f(h0[3], -448.f, 448.f), w0, true);
                    w1 = __builtin_amdgcn_cvt_pk_fp8_f32(__builtin_amdgcn_fmed3f(h1[0], -448.f, 448.f), __builtin_amdgcn_fmed3f(h1[1], -448.f, 448.f), w1, false); w1 = __builtin_amdgcn_cvt_pk_fp8_f32(__builtin_amdgcn_fmed3f(h1[2], -448.f, 448.f), __builtin_amdgcn_fmed3f(h1[3], -448.f, 448.f), w1, true);
                    w[mm][0] = w0; w[mm][1] = w1; }
                __builtin_amdgcn_raw_buffer_store_b128(pair16((unsigned)w[0][0], (unsigned)w[0][1], (unsigned)w[1][0], (unsigned)w[1][1]), rsrc, (row0 + ai * HALF + mp * 32 + 16 * (fq & 1)) * DEXP + (u.pn * HALF + wc * 32 + 16 * (fq >> 1)), 0, 16);
            }
    }
    __device__ __forceinline__ void publish(int pm) const {
        if ((otid() & 63) == 0) __hip_atomic_fetch_add(rtc + pm * 32, 1u, __ATOMIC_RELAXED, __HIP_MEMORY_SCOPE_AGENT);
    } };
struct MEpiDown { static constexpr bool PERM = true, PUBLISH = false, F8 = false; static constexpr float ASCALE = 1.0f; bf16_t* YPAD;
    __device__ __forceinline__ void operator()(const Acc& acc, const Unit& u, int wr, int wc, int fr, int fq) const {
        const int row0 = u.pm * BM + wr * 64 + fr, col0 = u.pn * BM + wc * 32 + 8 * fq;
#pragma unroll
        for (int ai = 0; ai < 2; ++ai)
#pragma unroll
            for (int m = 0; m < 4; ++m) { bf16_t* rowp = YPAD + (size_t)(row0 + ai * HALF + m * 16) * DM + col0;
#pragma unroll
                for (int bj = 0; bj < 2; ++bj) *(u32x4*)(rowp + bj * HALF) = pack8(acc[ai][bj][m][0], acc[ai][bj][m][1]); }
    } };
template <bool XF32> struct MEpiOut { static constexpr bool STAMP = false, PERM = true, PUBLISH = false, F8 = false; static constexpr float ASCALE = 1.0f; const float* Xf; const bf16_t* Xb; bf16_t* X1; unsigned char* X18;
    __device__ __forceinline__ void operator()(const Acc& acc, const Unit& u, int wr, int wc, int fr, int fq) const {
        const int row0 = u.pm * BM + wr * 64 + fr, col0 = u.pn * BM + wc * 32 + 8 * fq;
        const int row8 = u.pm * BM + wr * 64 + fr + 16 * (fq & 1), col8 = u.pn * BM + wc * 32 + 16 * (fq >> 1);
#pragma unroll
        for (int ai = 0; ai < 2; ++ai) {
            f32x4 xa[4][2][2]; u32x4 xh[4][2];
#pragma unroll
            for (int m = 0; m < 4; ++m)
#pragma unroll
                for (int bj = 0; bj < 2; ++bj) { const size_t o = (size_t)(row0 + ai * HALF + m * 16) * DM + col0 + bj * HALF;
                    if (XF32) { xa[m][bj][0] = *(const f32x4*)(Xf + o); xa[m][bj][1] = *(const f32x4*)(Xf + o + 4); } else xh[m][bj] = *(const u32x4*)(Xb + o); }
            __builtin_amdgcn_sched_barrier(0);
#pragma unroll
            for (int mp = 0; mp < 2; ++mp)
#pragma unroll
                for (int bj = 0; bj < 2; ++bj) { int w8[2][2];
#pragma unroll
                    for (int mm = 0; mm < 2; ++mm) { const int m = 2 * mp + mm; const size_t o = (size_t)(row0 + ai * HALF + m * 16) * DM + col0 + bj * HALF;
                        f32x4 a = acc[ai][bj][m][0], b = acc[ai][bj][m][1];
                        if (XF32) { a += xa[m][bj][0]; b += xa[m][bj][1]; }
                        else { const u32x4 w = xh[m][bj]; a[0] += bflo(w.x); a[1] += bfhi(w.x); a[2] += bflo(w.y); a[3] += bfhi(w.y); b[0] += bflo(w.z); b[1] += bfhi(w.z); b[2] += bflo(w.w); b[3] += bfhi(w.w); }
                        *(u32x4*)(X1 + o) = pack8(a, b);
                        int w0 = 0, w1 = 0;
                        w0 = __builtin_amdgcn_cvt_pk_fp8_f32(a[0] * SX8, a[1] * SX8, w0, false); w0 = __builtin_amdgcn_cvt_pk_fp8_f32(a[2] * SX8, a[3] * SX8, w0, true);
                        w1 = __builtin_amdgcn_cvt_pk_fp8_f32(b[0] * SX8, b[1] * SX8, w1, false); w1 = __builtin_amdgcn_cvt_pk_fp8_f32(b[2] * SX8, b[3] * SX8, w1, true);
                        w8[mm][0] = w0; w8[mm][1] = w1; }
                    *(u32x4*)(X18 + (size_t)(row8 + ai * HALF + mp * 32) * DM + col8 + bj * HALF) = pair16((unsigned)w8[0][0], (unsigned)w8[0][1], (unsigned)w8[1][0], (unsigned)w8[1][1]); }
        }
    } };
constexpr float YSCALE = YSCALE_G;
struct MEpiDown8 { static constexpr bool PERM = true, PUBLISH = false, F8 = true; static constexpr float ASCALE = 1.0f; unsigned char* Y8;
    __device__ __forceinline__ void operator()(const Acc& acc, const Unit& u, int wr, int wc, int fr, int fq) const {
        const int row0 = u.pm * BM + wr * 64 + fr + 16 * (fq & 1), col0 = u.pn * BM + wc * 32 + 16 * (fq >> 1);
#pragma unroll
        for (int ai = 0; ai < 2; ++ai)
#pragma unroll
            for (int mp = 0; mp < 2; ++mp)
#pragma unroll
                for (int bj = 0; bj < 2; ++bj) { int w[2][2];
#pragma unroll
                    for (int mm = 0; mm < 2; ++mm) { const int m = 2 * mp + mm; const f32x4 a = acc[ai][bj][m][0] * (YSCALE / (SH8 * SW2)), b = acc[ai][bj][m][1] * (YSCALE / (SH8 * SW2)); int w0 = 0, w1 = 0;
                        w0 = __builtin_amdgcn_cvt_pk_fp8_f32(a[0], a[1], w0, false); w0 = __builtin_amdgcn_cvt_pk_fp8_f32(a[2], a[3], w0, true);
                        w1 = __builtin_amdgcn_cvt_pk_fp8_f32(b[0], b[1], w1, false); w1 = __builtin_amdgcn_cvt_pk_fp8_f32(b[2], b[3], w1, true); w[mm][0] = w0; w[mm][1] = w1; }
                    *(u32x4*)(Y8 + (size_t)(row0 + ai * HALF + mp * 32) * DM + col0 + bj * HALF) = pair16((unsigned)w[0][0], (unsigned)w[0][1], (unsigned)w[1][0], (unsigned)w[1][1]); }
    } };
}

__device__ __forceinline__ void phase_convb(const Ctx& c, int l) {
    const int gt = obid() * 512 + otid(), ng = gridDim.x * 512, sub = gt & 15;
    const float* cw = c.in[10] + (size_t)l * 3 * DCONV; const bf16_t* PROJ = c.PROJ();
#pragma unroll 2
    for (int item = gt >> 4; item < T * 4; item += ng >> 4) {
        const int t = item >> 2, hh = item & 3, ch = hh * HD + sub * 8, s = t & (SEQ - 1);
        u32x4 cg[3], xb[3];
#pragma unroll
        for (int tap = 0; tap < 3; ++tap) { const int ds = (s + tap - 2 >= 0) ? tap - 2 : 0; const bf16_t* row = PROJ + (size_t)(t + ds) * DPROJ; cg[tap] = *(const u32x4*)(row + C_CG + ch); xb[tap] = *(const u32x4*)(row + C_XB + ch); }
        const u32x4 bg = *(const u32x4*)(PROJ + (size_t)t * DPROJ + C_BG + ch);
        float acc[8] = {0, 0, 0, 0, 0, 0, 0, 0};
#pragma unroll
        for (int tap = 0; tap < 3; ++tap) {
            if (s + tap - 2 >= 0) {
                const f32x4 w0 = *(const f32x4*)(cw + tap * DCONV + ch), w1 = *(const f32x4*)(cw + tap * DCONV + ch + 4);
                acc[0] += w0[0] * bflo(cg[tap].x) * bflo(xb[tap].x); acc[1] += w0[1] * bfhi(cg[tap].x) * bfhi(xb[tap].x); acc[2] += w0[2] * bflo(cg[tap].y) * bflo(xb[tap].y); acc[3] += w0[3] * bfhi(cg[tap].y) * bfhi(xb[tap].y);
                acc[4] += w1[0] * bflo(cg[tap].z) * bflo(xb[tap].z); acc[5] += w1[1] * bfhi(cg[tap].z) * bfhi(xb[tap].z); acc[6] += w1[2] * bflo(cg[tap].w) * bflo(xb[tap].w); acc[7] += w1[3] * bfhi(cg[tap].w) * bfhi(xb[tap].w);
            }
        }
        acc[0] *= bflo(bg.x); acc[1] *= bfhi(bg.x); acc[2] *= bflo(bg.y); acc[3] *= bfhi(bg.y); acc[4] *= bflo(bg.z); acc[5] *= bfhi(bg.z); acc[6] *= bflo(bg.w); acc[7] *= bfhi(bg.w);
        float ss = 0.f;
#pragma unroll
        for (int i = 0; i < 8; ++i) ss += acc[i] * acc[i];
        ss += __shfl_xor(ss, 1); ss += __shfl_xor(ss, 2); ss += __shfl_xor(ss, 4); ss += __shfl_xor(ss, 8);
        const float rstd = rsqrtf(ss * (1.0f / HD) + EPS);
        const float* mg = c.in[13] + (size_t)l * DM + DLRU + ch;
        const f32x4 m0 = *(const f32x4*)mg, m1 = *(const f32x4*)(mg + 4);
        u32x4 o; o.x = cvt_pk_bf16(acc[0] * rstd * m0[0], acc[1] * rstd * m0[1]); o.y = cvt_pk_bf16(acc[2] * rstd * m0[2], acc[3] * rstd * m0[3]);
        o.z = cvt_pk_bf16(acc[4] * rstd * m1[0], acc[5] * rstd * m1[1]); o.w = cvt_pk_bf16(acc[6] * rstd * m1[2], acc[7] * rstd * m1[3]);
        *(u32x4*)(c.YMIX() + (size_t)t * DM + DLRU + ch) = o;
    }
}
typedef float f32x16 __attribute__((ext_vector_type(16)));
#define MFMA32(a, b, c) __builtin_amdgcn_mfma_f32_32x32x16_bf16((a), (b), (c), 0, 0, 0)
constexpr int XCS = 776;
__device__ __forceinline__ void phase_lruA(const Ctx& c, int l, unsigned char* ldsb) {
    constexpr bool PASS2 = false;
    bf16_t* XC = (bf16_t*)ldsb; bf16_t* PR = (bf16_t*)(ldsb + 99328); bf16_t* HL = c.HL(); bf16_t* PL = c.PL();
    const int tid = otid(), lane = tid & 63, wv = tid >> 6, hh = lane >> 5, l31 = lane & 31;
    const float* cw = c.in[3] + (size_t)l * 4 * DLRU; const float* cb = c.in[4] + (size_t)l * DLRU;
    const bf16_t* PROJ = c.PROJ(); float* AGG = c.AGG();
    typedef float f32x2_t __attribute__((ext_vector_type(2)));
    for (int tile = obid(); tile < T / 64; tile += gridDim.x) {
        const int t0 = tile * 64, s0 = t0 & (SEQ - 1), tb = tile & 63;
        if (tid < 480) {
            const int cg = tid % 48, tslot = tid / 48, ch = cg * 16;
            float w[4][16], bias[16];
#pragma unroll
            for (int i = 0; i < 16; i += 4) { *(f32x4*)&bias[i] = *(const f32x4*)(cb + ch + i);
#pragma unroll
                for (int tap = 0; tap < 4; ++tap) *(f32x4*)&w[tap][i] = *(const f32x4*)(cw + tap * DLRU + ch + i); }
#pragma unroll
            for (int it = 0; it < 7; ++it) {
                const int tokr = tslot + 10 * it, tok = tokr < 64 ? tokr : 63;
                u32x4 x0[4], x1[4]; float msk[4];
#pragma unroll
                for (int tap = 0; tap < 4; ++tap) {
                    const int ds = tap - 3; const bool ok = (s0 + tok + ds >= 0); msk[tap] = ok ? 1.0f : 0.0f;
                    const bf16_t* row = PROJ + (size_t)(t0 + tok + (ok ? ds : 0)) * DPROJ + C_XA + ch;
                    x0[tap] = *(const u32x4*)row; x1[tap] = *(const u32x4*)(row + 8);
                }
                float a[16];
#pragma unroll
                for (int i = 0; i < 16; ++i) a[i] = bias[i];
#pragma unroll
                for (int tap = 0; tap < 4; ++tap) {
                    const float m = msk[tap];
                    a[0] += m * w[tap][0] * bflo(x0[tap].x); a[1] += m * w[tap][1] * bfhi(x0[tap].x); a[2] += m * w[tap][2] * bflo(x0[tap].y); a[3] += m * w[tap][3] * bfhi(x0[tap].y);
                    a[4] += m * w[tap][4] * bflo(x0[tap].z); a[5] += m * w[tap][5] * bfhi(x0[tap].z); a[6] += m * w[tap][6] * bflo(x0[tap].w); a[7] += m * w[tap][7] * bfhi(x0[tap].w);
                    a[8] += m * w[tap][8] * bflo(x1[tap].x); a[9] += m * w[tap][9] * bfhi(x1[tap].x); a[10] += m * w[tap][10] * bflo(x1[tap].y); a[11] += m * w[tap][11] * bfhi(x1[tap].y);
                    a[12] += m * w[tap][12] * bflo(x1[tap].z); a[13] += m * w[tap][13] * bfhi(x1[tap].z); a[14] += m * w[tap][14] * bflo(x1[tap].w); a[15] += m * w[tap][15] * bfhi(x1[tap].w);
                }
                u32x4 o0, o1; o0.x = cvt_pk_bf16(a[0], a[1]); o0.y = cvt_pk_bf16(a[2], a[3]); o0.z = cvt_pk_bf16(a[4], a[5]); o0.w = cvt_pk_bf16(a[6], a[7]);
                o1.x = cvt_pk_bf16(a[8], a[9]); o1.y = cvt_pk_bf16(a[10], a[11]); o1.z = cvt_pk_bf16(a[12], a[13]); o1.w = cvt_pk_bf16(a[14], a[15]);
                if (tokr < 64) { *(u32x4*)(XC + tok * XCS + ch) = o0; *(u32x4*)(XC + tok * XCS + ch + 8) = o1; }
            }
        }
        __syncthreads();
#pragma unroll 1
        for (int i = 0; i < 3; ++i) {
            const int hd = 2 * i + (wv >> 2), ntw = wv & 3, chl = 32 * ntw + l31, ch = hd * HD + chl;
            const bf16_t* wa = c.WA(l) + ((size_t)hd * HD + chl) * HD + 8 * hh; const bf16_t* wx = c.WX(l) + ((size_t)hd * HD + chl) * HD + 8 * hh;
            const float ba = c.in[6][l * DLRU + ch], bx = c.in[8][l * DLRU + ch], c8 = -8.0f * softplusf_(-c.in[9][l * DLRU + ch]);
            float sst = 0.f, Pt = 1.f;
            float hreg[2][16], preg[2][16];
            bf16x8 bRf[8], bIf[8];
#pragma unroll
            for (int s = 0; s < 8; ++s) { bRf[s] = *(const bf16x8*)(wa + 16 * s); bIf[s] = *(const bf16x8*)(wx + 16 * s); }
            __builtin_amdgcn_sched_barrier(0);
#pragma unroll
            for (int half = 0; half < 2; ++half) {
                float av[16], uv[16];
                {
                    f32x16 accR, accI;
#pragma unroll
                    for (int r = 0; r < 16; ++r) { accR[r] = 0.f; accI[r] = 0.f; }
#pragma unroll
                    for (int s = 0; s < 8; ++s) {
                        const bf16x8 a = *(const bf16x8*)(XC + (32 * half + l31) * XCS + hd * HD + 16 * s + 8 * hh);
                        accR = MFMA32(a, bRf[s], accR); accI = MFMA32(a, bIf[s], accI);
                    }
#pragma unroll
                    for (int r = 0; r < 16; ++r) {
                        const int tok = 32 * half + (r & 3) + 8 * (r >> 2) + 4 * hh;
                        const float xc = bf2f(XC[tok * XCS + ch]);
                        const float rg = sigmoidf_(accR[r] + ba), ig = sigmoidf_(accI[r] + bx);
                        const float la = c8 * rg;
                        av[r] = fast_exp(la); uv[r] = __builtin_amdgcn_sqrtf(one_minus_exp(2.0f * la)) * (ig * xc);
                    }
                }
                float Pp[4], Hp[4];
#pragma unroll
                for (int g = 0; g < 4; ++g) { float P = 1.f, H = 0.f;
#pragma unroll
                    for (int r = 4 * g; r < 4 * g + 4; ++r) { H = av[r] * H + uv[r]; P *= av[r]; }
                    Pp[g] = __shfl_xor(P, 32); Hp[g] = __shfl_xor(H, 32); }
#pragma unroll
                for (int g = 0; g < 4; ++g) {
                    if (hh == 0) {
#pragma unroll
                        for (int r = 4 * g; r < 4 * g + 4; ++r) { sst = av[r] * sst + uv[r]; Pt *= av[r]; hreg[half][r] = sst; preg[half][r] = Pt; }
                        sst = Pp[g] * sst + Hp[g]; Pt *= Pp[g];
                    } else {
                        sst = Pp[g] * sst + Hp[g]; Pt *= Pp[g];
#pragma unroll
                        for (int r = 4 * g; r < 4 * g + 4; ++r) { sst = av[r] * sst + uv[r]; Pt *= av[r]; hreg[half][r] = sst; preg[half][r] = Pt; }
                    }
                }
            }
            if (hh == 0) { f32x2_t o; o.x = Pt; o.y = sst; ((f32x2_t*)AGG)[(size_t)tile * DLRU + ch] = o; }
            __syncthreads();
#pragma unroll
            for (int half = 0; half < 2; ++half)
#pragma unroll
                for (int r = 0; r < 16; ++r) { const int tok = 32 * half + (r & 3) + 8 * (r >> 2) + 4 * hh;
                    XC[tok * XCS + ch] = f2bf(hreg[half][r]); PR[tok * 264 + (wv >> 2) * HD + chl] = f2bf(preg[half][r]); }
            __syncthreads();
#pragma unroll
            for (int k = 0; k < 4; ++k) {
                const int item = tid + 512 * k, tok = item >> 5, g = item & 31, hs = g >> 4, sub = g & 15, cc = (2 * i + hs) * HD + sub * 8;
                *(u32x4*)(HL + (size_t)(t0 + tok) * DLRU + cc) = *(const u32x4*)(XC + tok * XCS + cc);
                *(u32x4*)(PL + (size_t)(t0 + tok) * DLRU + cc) = *(const u32x4*)(PR + tok * 264 + hs * HD + sub * 8);
            }
        }
        __syncthreads();
    }
}

__device__ __forceinline__ void phase_lruB(const Ctx& c, int l, unsigned char* ldsb) {
    float* HIN = (float*)ldsb;
    const int tid = otid();
    const bf16_t* PROJ = c.PROJ(); const float* AGG = c.AGG(); const bf16_t* HL = c.HL(); const bf16_t* PL = c.PL();
    typedef float f32x2_t __attribute__((ext_vector_type(2)));
    for (int tile = obid(); tile < T / 64; tile += gridDim.x) {
        const int t0 = tile * 64, tb = tile & 63;
        {
            const f32x2_t* ag = (const f32x2_t*)AGG + (size_t)(tile - tb) * DLRU;
            const int chb = 512 + (tid & 255);
            float ha = 0.f, hb = 0.f;
#pragma unroll 8
            for (int k = 0; k < tb; ++k) { const f32x2_t pa = ag[(size_t)k * DLRU + tid], pb_ = ag[(size_t)k * DLRU + chb]; ha = pa.x * ha + pa.y; hb = pb_.x * hb + pb_.y; }
            HIN[tid] = ha; if (tid < 256) HIN[chb] = hb;
        }
        __syncthreads();
        const int wv_ = tid >> 6, wit0 = wv_ < 4 ? 8 * wv_ : 32 + 16 * (wv_ - 4), wcnt = wv_ < 4 ? 8 : 16;
#define LB_ADDR(it_, tok_, cc_) const int item_##it_ = (wit0 + (it_)) * 64 + (tid & 63), tok_ = item_##it_ / 96, rem_##it_ = item_##it_ % 96, cc_ = (rem_##it_ >> 4) * HD + (rem_##it_ & 15) * 8
#define LB_LOAD(H_, P_, G_, tok_, cc_) do { H_ = *(const u32x4*)(HL + (size_t)(t0 + tok_) * DLRU + cc_); P_ = *(const u32x4*)(PL + (size_t)(t0 + tok_) * DLRU + cc_); G_ = *(const u32x4*)(PROJ + (size_t)(t0 + tok_) * DPROJ + C_GA + cc_); } while (0)
#define LB_BODY(hv, pv, ga, tok, cc) do { \
            const f32x4 i0 = *(const f32x4*)(HIN + cc), i1 = *(const f32x4*)(HIN + cc + 4); \
            float y[8] = {(bflo(hv.x) + bflo(pv.x) * i0[0]) * gelu_tanh(bflo(ga.x)), (bfhi(hv.x) + bfhi(pv.x) * i0[1]) * gelu_tanh(bfhi(ga.x)), \
                          (bflo(hv.y) + bflo(pv.y) * i0[2]) * gelu_tanh(bflo(ga.y)), (bfhi(hv.y) + bfhi(pv.y) * i0[3]) * gelu_tanh(bfhi(ga.y)), \
                          (bflo(hv.z) + bflo(pv.z) * i1[0]) * gelu_tanh(bflo(ga.z)), (bfhi(hv.z) + bfhi(pv.z) * i1[1]) * gelu_tanh(bfhi(ga.z)), \
                          (bflo(hv.w) + bflo(pv.w) * i1[2]) * gelu_tanh(bflo(ga.w)), (bfhi(hv.w) + bfhi(pv.w) * i1[3]) * gelu_tanh(bfhi(ga.w))}; \
            float ss = 0.f; \
            _Pragma("unroll") for (int k = 0; k < 8; ++k) ss += y[k] * y[k]; \
            ss += __shfl_xor(ss, 1); ss += __shfl_xor(ss, 2); ss += __shfl_xor(ss, 4); ss += __shfl_xor(ss, 8); \
            const float rstd = rsqrtf(ss * (1.0f / HD) + EPS); \
            const float* mg = c.in[13] + (size_t)l * DM + cc; \
            const f32x4 m0 = *(const f32x4*)mg, m1 = *(const f32x4*)(mg + 4); \
            u32x4 o; o.x = cvt_pk_bf16(y[0] * rstd * m0[0], y[1] * rstd * m0[1]); o.y = cvt_pk_bf16(y[2] * rstd * m0[2], y[3] * rstd * m0[3]); \
            o.z = cvt_pk_bf16(y[4] * rstd * m1[0], y[5] * rstd * m1[1]); o.w = cvt_pk_bf16(y[6] * rstd * m1[2], y[7] * rstd * m1[3]); \
            *(u32x4*)(c.YMIX() + (size_t)(t0 + tok) * DM + cc) = o; } while (0)
        {
            u32x4 hA, pA, gA, hB, pB, gB;
            { LB_ADDR(0, tk_, cc_); LB_LOAD(hA, pA, gA, tk_, cc_); }
#pragma unroll 1
            for (int it = 0; it < wcnt; it += 2) {
                LB_ADDR(it, tkA, ccA); const int itb = it + 1; LB_ADDR(itb, tkB, ccB);
                LB_LOAD(hB, pB, gB, tkB, ccB); __builtin_amdgcn_sched_barrier(0);
                LB_BODY(hA, pA, gA, tkA, ccA);
                if (it + 2 < wcnt) { const int itc = it + 2; LB_ADDR(itc, tkC, ccC); LB_LOAD(hA, pA, gA, tkC, ccC); } __builtin_amdgcn_sched_barrier(0);
                LB_BODY(hB, pB, gB, tkB, ccB);
            }
        }
#undef LB_ADDR
#undef LB_LOAD
#undef LB_BODY
        __syncthreads();
    }
}

__device__ __forceinline__ void phase_vreduce(const Ctx& c) {
    const bf16_t* PT = c.PT(); bf16_t* VT = c.VT();
    for (int item = obid() * 512 + otid(); item < 64 * 256 * 32; item += gridDim.x * 512) {
        const int ro = item & 31, col = (item >> 5) & 255, u = item >> 13;
        const bf16_t* p = PT + (size_t)(u * 4) * 65536 + col * 256 + ro * 8;
        float a[8] = {0, 0, 0, 0, 0, 0, 0, 0};
#pragma unroll
        for (int kq = 0; kq < 4; ++kq) { const u32x4 w = *(const u32x4*)(p + (size_t)kq * 65536);
            a[0] += bflo(w.x); a[1] += bfhi(w.x); a[2] += bflo(w.y); a[3] += bfhi(w.y); a[4] += bflo(w.z); a[5] += bfhi(w.z); a[6] += bflo(w.w); a[7] += bfhi(w.w); }
        const int b = u >> 4, s0 = (u & 15) * 256 + ro * 8, h = 4 + (col >> 7), d = col & 127;
        u32x4 o; o.x = cvt_pk_bf16(a[0], a[1]); o.y = cvt_pk_bf16(a[2], a[3]); o.z = cvt_pk_bf16(a[4], a[5]); o.w = cvt_pk_bf16(a[6], a[7]);
        *(u32x4*)(VT + ((size_t)(b * NHS + h) * HD + d) * VTS + s0) = o;
    }
}

__device__ __forceinline__ void phase_attn(const Ctx& c, int l, unsigned char* ldsb) {
    const int lane = otid() & 63, wv = otid() >> 6, hh = lane >> 5, l31 = lane & 31;
    const bf16_t* PROJ = c.PROJ(); const bf16_t* VT = c.VT();
    const int prow = (l31 & ~12) | ((l31 & 4) << 1) | ((l31 & 8) >> 1);
    unsigned char* wl = ldsb + wv * 16384;
    const int kwbase = (lane >> 4) * 256 + (((lane & 15) ^ (lane >> 4)) * 16);
    const int vwoff = (lane >> 2) * 64 + (((lane & 3) ^ (lane >> 4)) * 16);
    const int kroff = prow * 256;
    const int nwt = NB * NHS * (SEQ / 32);
    const int nper = (nwt + (int)gridDim.x - 1) / (int)gridDim.x, wt0 = obid() * nper, wt1 = (wt0 + nper < nwt) ? wt0 + nper : nwt;
    for (int wt = wt0 + wv; wt < wt1; wt += 8) {
        const int qt = wt % (SEQ / 32), bh = wt / (SEQ / 32), b = bh / NHS, h = bh % NHS, q0 = qt * 32;
        const bf16_t* qp = PROJ + (size_t)(b * SEQ + q0 + l31) * DPROJ + C_Q + h * HD + 8 * hh;
        bf16x8 bq[8];
#pragma unroll
        for (int s = 0; s < 8; ++s) bq[s] = *(const bf16x8*)(qp + 16 * s);
        {
            float qs = 0.f;
#pragma unroll
            for (int s = 0; s < 8; ++s) { const u32x4 w = __builtin_bit_cast(u32x4, bq[s]);
                qs += bflo(w.x) * bflo(w.x) + bfhi(w.x) * bfhi(w.x) + bflo(w.y) * bflo(w.y) + bfhi(w.y) * bfhi(w.y) + bflo(w.z) * bflo(w.z) + bfhi(w.z) * bfhi(w.z) + bflo(w.w) * bflo(w.w) + bfhi(w.w) * bfhi(w.w); }
            qs += __shfl_xor(qs, 32);
            const float sc = rsqrtf(qs * (1.0f / HD) + EPS) * (1.4426950408889634f * 0.08838834764831845f);
#pragma unroll
            for (int s = 0; s < 8; ++s) { const u32x4 w = __builtin_bit_cast(u32x4, bq[s]); u32x4 o;
                o.x = cvt_pk_bf16(bflo(w.x) * sc, bfhi(w.x) * sc); o.y = cvt_pk_bf16(bflo(w.y) * sc, bfhi(w.y) * sc); o.z = cvt_pk_bf16(bflo(w.z) * sc, bfhi(w.z) * sc); o.w = cvt_pk_bf16(bflo(w.w) * sc, bfhi(w.w) * sc);
                bq[s] = __builtin_bit_cast(bf16x8, o); }
        }
        f32x16 O[4];
#pragma unroll
        for (int m = 0; m < 4; ++m)
#pragma unroll
            for (int r = 0; r < 16; ++r) O[m][r] = 0.f;
        float carry = 0.f;
        const bf16_t* kgl = PROJ + (size_t)(b * SEQ + (lane >> 4)) * DPROJ + C_K + h * HD + (lane & 15) * 8;
        const bf16_t* vgl = VT + ((size_t)bh * HD + (lane >> 2)) * VTS + (lane & 3) * 8;
        u32x4 stK[8], stV[8];
#define ATT_LOAD(kk0) do { _Pragma("unroll") for (int j = 0; j < 8; ++j) { \
            stK[j] = *(const u32x4*)(kgl + (size_t)((kk0) + 4 * j) * DPROJ); stV[j] = *(const u32x4*)(vgl + (size_t)(16 * j) * VTS + (kk0)); } } while (0)
        ATT_LOAD(q0);
        for (int k0 = q0; k0 >= 0; k0 -= 32) {
#pragma unroll
            for (int j = 0; j < 8; ++j) { *(u32x4*)(wl + j * 1024 + (kwbase ^ (64 * (j & 3)))) = stK[j]; *(u32x4*)(wl + 8192 + vwoff + j * 1024) = stV[j]; }
            const int kn = k0 >= 32 ? k0 - 32 : k0;
            ATT_LOAD(kn);
            __builtin_amdgcn_sched_barrier(0);
            f32x16 S;
#pragma unroll
            for (int r = 0; r < 16; ++r) S[r] = 0.f;
#pragma unroll
            for (int s = 0; s < 8; ++s) { const bf16x8 ak = *(const bf16x8*)(wl + kroff + (((2 * s + hh) ^ (prow & 15)) * 16)); S = MFMA32(ak, bq[s], S); }
            const bool diag = (k0 == q0);
            float sp[16];
            float R0 = 0.f, R1 = 0.f;
#pragma unroll
            for (int r = 0; r < 16; ++r) {
                const int kk = 16 * (r >> 3) + 8 * hh + (r & 7);
                const float z = S[r];
                float v = fmaxf(z, 0.f) + __builtin_amdgcn_logf(1.0f + __builtin_amdgcn_exp2f(-fabsf(z)));
                if (diag && kk >= l31) v = 0.f;
                sp[r] = v;
                if (r < 8) R0 += v; else R1 += v;
            }
            const float R0p = __shfl_xor(R0, 32), R1p = __shfl_xor(R1, 32);
            float suf_hi = carry - (hh == 0 ? R1p : 0.f);
            float suf_lo = carry - R1 - R1p - (hh == 0 ? R0p : 0.f);
            float w[16];
#pragma unroll
            for (int r = 15; r >= 8; --r) { w[r] = __builtin_amdgcn_exp2f(S[r] - sp[r] + suf_hi); suf_hi -= sp[r]; }
#pragma unroll
            for (int r = 7; r >= 0; --r) { w[r] = __builtin_amdgcn_exp2f(S[r] - sp[r] + suf_lo); suf_lo -= sp[r]; }
            if (diag) {
#pragma unroll
                for (int r = 0; r < 16; ++r) { const int kk = 16 * (r >> 3) + 8 * hh + (r & 7); if (kk >= l31) w[r] = 0.f; }
            }
            carry -= (R0 + R1 + R0p + R1p);
            bf16x8 wb[2];
            __builtin_amdgcn_sched_barrier(0);
#pragma unroll
            for (int s = 0; s < 2; ++s) { u32x4 pk; pk.x = cvt_pk_bf16(w[8 * s + 0], w[8 * s + 1]); pk.y = cvt_pk_bf16(w[8 * s + 2], w[8 * s + 3]); pk.z = cvt_pk_bf16(w[8 * s + 4], w[8 * s + 5]); pk.w = cvt_pk_bf16(w[8 * s + 6], w[8 * s + 7]);
                wb[s] = __builtin_bit_cast(bf16x8, pk); }
#pragma unroll
            for (int m = 0; m < 4; ++m)
#pragma unroll
                for (int s = 0; s < 2; ++s) { const bf16x8 vtf = *(const bf16x8*)(wl + 8192 + (32 * m + l31) * 64 + (((2 * s + hh) ^ (((32 * m + l31) >> 2) & 3)) * 16)); O[m] = MFMA32(vtf, wb[s], O[m]); }
            if (!__any(carry >= -150.1f)) break;
        }
        float ss = 0.f;
#pragma unroll
        for (int m = 0; m < 4; ++m)
#pragma unroll
            for (int r = 0; r < 16; ++r) ss += O[m][r] * O[m][r];
        ss += __shfl_xor(ss, 32);
        const float rstd = rsqrtf(ss * (1.0f / HD) + EPS);
        const float* mg = c.in[13] + (size_t)l * DM + DLRU + DCONV + h * HD + 4 * hh;
        bf16_t* yp = c.YMIX() + (size_t)(b * SEQ + q0 + l31) * DM + DLRU + DCONV + h * HD + 4 * hh;
#pragma unroll
        for (int m = 0; m < 4; ++m)
#pragma unroll
            for (int g = 0; g < 4; ++g) {
                const f32x4 gg = *(const f32x4*)(mg + 32 * m + 8 * g);
                u32x2 o; o.x = cvt_pk_bf16(O[m][4 * g] * rstd * gg[0], O[m][4 * g + 1] * rstd * gg[1]); o.y = cvt_pk_bf16(O[m][4 * g + 2] * rstd * gg[2], O[m][4 * g + 3] * rstd * gg[3]);
                *(u32x2*)(yp + 32 * m + 8 * g) = o;
            }
    }
}

#define XB_TMO      128
#define XB_XCNT(j)  (256  + 64 * (j))
#define XB_XSUB(j)  (1280 + 64 * (j))
#define XB_XGEN(j)  (2304 + 64 * (j))
#define XB_TOP      3328
#define XB_TOPGEN   3392
#define XCD_BAR_WORDS 3456
#define XB_SPIN_CAP (1u << 18)
__device__ __forceinline__ unsigned xb_ld(unsigned* p)              { return __hip_atomic_load(p, __ATOMIC_RELAXED, __HIP_MEMORY_SCOPE_AGENT); }
__device__ __forceinline__ unsigned xb_add(unsigned* p, unsigned v) { return __hip_atomic_fetch_add(p, v, __ATOMIC_RELAXED, __HIP_MEMORY_SCOPE_AGENT); }
__device__ __forceinline__ unsigned xb_xcc_id() { return (unsigned)__builtin_amdgcn_s_getreg((3 << 11) | 20) & 0xFu; }
#define XB_SPIN(cond, bar) do { unsigned _sp = 0; while (cond) { __builtin_amdgcn_s_sleep(1); \
    if ((++_sp & 255u) == 0u) { if (xb_ld(&(bar)[XB_TMO])) break; if (_sp > XB_SPIN_CAP) { atomicAdd(&(bar)[XB_TMO], 1u); break; } } } } while (0)
struct XcdBarrier { unsigned* bar; unsigned x; volatile LAS unsigned* st; };
__device__ __forceinline__ XcdBarrier xcd_barrier_post(unsigned* bar, volatile LAS unsigned* st) {
    XcdBarrier b; b.bar = bar; b.x = xb_xcc_id(); b.st = st;
    if (threadIdx.x == 0) (void)xb_add(&bar[XB_XCNT(b.x)], 1u);
    return b;
}
__device__ __forceinline__ void xcd_barrier_complete(unsigned* bar, unsigned x, unsigned& nloc, unsigned& nx) {
    const unsigned G = gridDim.x * gridDim.y * gridDim.z;
    unsigned sum, cnt, mine, sp = 0u;
    for (;;) {
        sum = 0u; cnt = 0u; mine = 0u;
#pragma unroll
        for (unsigned j = 0; j < 16; ++j) { const unsigned c = xb_ld(&bar[XB_XCNT(j)]); sum += c; cnt += (c > 0u) ? 1u : 0u; mine = (j == x) ? c : mine; }
        if (sum == G) break;
        __builtin_amdgcn_s_sleep(1);
        if ((++sp & 255u) == 0u) { if (xb_ld(&bar[XB_TMO])) break; if (sp > XB_SPIN_CAP) { atomicAdd(&bar[XB_TMO], 1u); break; } }
    }
    nloc = mine > 0u ? mine : 1u; nx = cnt > 0u ? cnt : 1u;
}
__device__ __forceinline__ void xcd_barrier(const XcdBarrier& b) {
    asm volatile("s_waitcnt vmcnt(0)" ::: "memory");
    __syncthreads();
    if (threadIdx.x == 0) {
        unsigned* bar = b.bar;
        __builtin_amdgcn_s_waitcnt(0);
        unsigned nloc = b.st[0], nx = b.st[1];
        if (nloc == 0u) { xcd_barrier_complete(bar, b.x, nloc, nx); b.st[0] = nloc; b.st[1] = nx; }
        const unsigned old = xb_add(&bar[XB_XSUB(b.x)], 1u);
        const unsigned gen = old / nloc;
        if (old + 1u == (gen + 1u) * nloc) {
            __builtin_amdgcn_fence(__ATOMIC_RELEASE, "agent");
            asm volatile("s_waitcnt vmcnt(0)" ::: "memory");
            const unsigned og = xb_add(&bar[XB_TOP], 1u);
            const unsigned tg = og / nx;
            if (og + 1u == (tg + 1u) * nx) xb_add(&bar[XB_TOPGEN], 1u);
            else XB_SPIN(xb_ld(&bar[XB_TOPGEN]) == tg, bar);
            __builtin_amdgcn_fence(__ATOMIC_ACQUIRE, "agent");
            xb_add(&bar[XB_XGEN(b.x)], 1u);
            asm volatile("s_waitcnt vmcnt(0)" ::: "memory");
        } else {
            XB_SPIN(xb_ld(&bar[XB_XGEN(b.x)]) == gen, bar);
            __builtin_amdgcn_fence(__ATOMIC_ACQUIRE, "agent");
            asm volatile("s_waitcnt vmcnt(0)" ::: "memory");
        }
    }
    __syncthreads();
}

constexpr int NPH_LAYER = 7, NPH = 1 + DEPTH * NPH_LAYER;
constexpr int LDS_TAB = g8::STAGE_BYTES, LDS_BARW = g8::STAGE_BYTES + 2048, LDS_KX = g8::STAGE_BYTES + 4096, LDS_BYTES = g8::STAGE_BYTES + 4096 + 8192;
__global__ void __launch_bounds__(512, 2) mega(Params p) {
    extern __shared__ __attribute__((aligned(16))) unsigned char lds_raw[];
    float* lds = (float*)lds_raw;
    LAS unsigned char* ldsl = (LAS unsigned char*)lds_raw;
    MoeTab* mt = (MoeTab*)(lds_raw + LDS_TAB);
    Ctx c0; c0.in.p = p.in; c0.in.z = 0; c0.out = p.out; c0.ws = p.ws;
    const int lo = p.ph_lo, hi = p.ph_hi;
    if (threadIdx.x == 0) *(uint4*)(lds_raw + LDS_BARW) = make_uint4(0u, 0u, 0u, 0u);
    __syncthreads();
    XcdBarrier bar = xcd_barrier_post(c0.ctl(), (volatile LAS unsigned*)(ldsl + LDS_BARW));
#ifndef PH_MASK
#define PH_MASK 0x1ff
#endif
#define PHT(k) ((k) == 0 ? 0 : 1 + ((k) - 1) % NPH_LAYER)
#define IN(k) (((PH_MASK >> PHT(k)) & 1) && lo <= (k) && (k) < hi)
#define SEAM(k) do { if (IN(k) && IN((k) + 1)) xcd_barrier(bar); } while (0)
#ifndef PROBE_RSH
#define PROBE_RSH 0
#endif
#ifndef PROBE_DUP
#define PROBE_DUP 0x0
#endif
#define REP(k) for (int rep_ = 0; rep_ < (((PROBE_DUP >> PHT(k)) & 1) ? 2 : 1); ++rep_)
    REP(0) if (IN(0)) { if (rep_) xcd_barrier(bar); const Ctx c = octx(c0); phase_convert(c, lds); phase_norm_in(c, 0); }
    SEAM(0);
#define LAYER_BODY(l) { \
        const int pb = 1 + l * NPH_LAYER; \
        REP(pb + 0) if (IN(pb + 0)) { if (rep_) xcd_barrier(bar); const Ctx c = octx(c0); const bool split_ = (gridDim.x == 256); \
            constexpr bool f8_ = f8in(l); constexpr int ku_ = f8_ ? DM / 2 : DM, ld_ = pb_in(l) / 2;        \
            { g8::DenseOrder S; S.init(T, DIN, gridDim.x, obid(), c.WIN(l), ld_); if (split_) S.lim = 1280; g8::MEpiProjT<f8_> E{c.PROJ(), c.VT(), (LAS float*)(ldsl + LDS_KX), c.in[11] + l * HD, c.in[12] + l * HD}; g8::gemm_mfma(ldsl, c.HB(), ld_, ld_, ku_, S, E); } \
            if (split_) { const int cb_ = obid(), kq_ = cb_ & 3; int k4_ = ku_ / 4; asm volatile("" : "+s"(k4_)); g8::SplitKOrder S{cb_, (const char*)(c.WIN(l) + (size_t)(20 * 256) * ld_ + kq_ * (ku_ / 4))}; g8::MEpiPartT<f8_> E{c.PT(), (LAS float*)(ldsl + LDS_KX)}; g8::gemm_mfma(ldsl, c.HB() + kq_ * (ku_ / 4), ld_, ld_, k4_, S, E); } } \
        SEAM(pb + 0); \
        REP(pb + 1) if (IN(pb + 1)) { if (rep_) xcd_barrier(bar); const Ctx c = octx(c0); if (gridDim.x == 256) phase_vreduce(c); phase_convb(c, l); if (PROBE_SUB == 4) phase_convb(c, l); phase_lruA(c, l, lds_raw); if (PROBE_SUB == 3) phase_lruA(c, l, lds_raw); } \
        SEAM(pb + 1); \
        REP(pb + 2) if (IN(pb + 2)) { if (rep_) xcd_barrier(bar); const Ctx c = octx(c0); phase_lruB(c, l, lds_raw); if (PROBE_SUB == 2) phase_lruB(c, l, lds_raw); phase_attn(c, l, lds_raw); if (PROBE_SUB == 1) phase_attn(c, l, lds_raw); } \
        SEAM(pb + 2); \
        REP(pb + 3) if (IN(pb + 3)) { if (rep_) xcd_barrier(bar); const Ctx c = octx(c0); g8::DenseOrder S; S.init(T, DM, gridDim.x, obid(), c.WOUT(l), DM); if (PROBE_RSH == 3 && l == 0) S.rsh = 1; g8::MEpiOut<l == 0> E{c.in[0], c.XB(), c.X1(), c.X1F8()}; g8::gemm_mfma(ldsl, c.YMIX(), DM, DM, DM, S, E);       } \
        SEAM(pb + 3); \
        REP(pb + 4) if (IN(pb + 4)) { if (rep_) xcd_barrier(bar); const Ctx c = octx(c0); phase_router_mfma(c, l, lds); } \
        SEAM(pb + 4); \
        REP(pb + 5) if (IN(pb + 5)) { if (rep_) xcd_barrier(bar); const Ctx c = octx(c0); build_moe_tab(c, l, mt); \
            const int G_ = (int)gridDim.x, cb_ = obid(), n1_ = __builtin_amdgcn_readfirstlane(mt->tstart[NEXP]) * 4, R_ = n1_ % G_, n1e_ = n1_ - R_, rtA_ = n1e_ >> 2; \
            { g8::MoeOrder<true, 4, DM / 2, (size_t)1024 * DM, (size_t)256 * DM> S{mt, c.LIST(), G_, cb_, (const char*)c.WGU(l)}; g8::MEpiGU E{c.HID8(), c.LISTR(), mt, c.RTC(l), n1e_}; g8::gemm_mfma(ldsl, (const bf16_t*)c.X1F8(), DM / 2, DM / 2, DM / 2, S, E); }       \
            g8::moe_wait_dep(c.RTC(l), cb_, G_, R_, rtA_); \
            { g8::MoeOrder2 S{mt, G_, cb_, R_, rtA_, (const char*)c.WD(l)}; if (PROBE_RSH == 6) S.rsh = 1; g8::MEpiDown8 E{c.YPAD8()}; int k2_ = DEXP / 2; asm volatile("" : "+s"(k2_)); g8::gemm_mfma(ldsl, (const bf16_t*)c.HID8(), DEXP / 2, DEXP / 2, k2_, S, E); } }       \
        SEAM(pb + 5); \
        REP(pb + 6) if (IN(pb + 6)) { if (rep_) xcd_barrier(bar); const Ctx c = octx(c0); build_moe_tab(c, l, mt); if (PROBE_SUB == 6) { phase_combine<true>(c, l, mt); xcd_barrier(bar); } phase_combine<false>(c, l, mt); } \
        SEAM(pb + 6); \
    }
    LAYER_BODY(0)
    LAYER_BODY(1)
#undef LAYER_BODY
#undef IN
#undef SEAM
}

#ifndef N_LAUNCH_SPLIT
#define N_LAUNCH_SPLIT 0
#endif
extern "C" void kernel_launch(void* const* d_in, const int* in_sizes, int n_in, void* d_out, int out_size, void* d_ws, size_t ws_size, hipStream_t stream) {
    static int grid = 0;
    if (grid == 0) {
        if (n_in != 23 || out_size != T * DM || ws_size < WS_END) { fprintf(stderr, "kernel_launch: unexpected problem (n_in %d out %d ws %zu need %zu)\n", n_in, out_size, ws_size, (size_t)WS_END); grid = -1; return; }
        int dev = 0, cus = 0, per_cu = 0;
        if (hipGetDevice(&dev) != hipSuccess || hipDeviceGetAttribute(&cus, hipDeviceAttributeMultiprocessorCount, dev) != hipSuccess) { fprintf(stderr, "kernel_launch: device query failed\n"); grid = -1; return; }
        if (hipFuncSetAttribute((const void*)mega, hipFuncAttributeMaxDynamicSharedMemorySize, LDS_BYTES) != hipSuccess) { fprintf(stderr, "kernel_launch: hipFuncSetAttribute failed\n"); grid = -1; return; }
        if (hipOccupancyMaxActiveBlocksPerMultiprocessor(&per_cu, (const void*)mega, 512, LDS_BYTES) != hipSuccess || per_cu < 1) { fprintf(stderr, "kernel_launch: occupancy query says %d blocks per CU\n", per_cu); }
        (void)hipGetLastError();
        grid = cus;
    }
    if (grid < 0) return;
    (void)hipMemsetAsync((char*)d_ws + OFF_CTL, 0, SZ_CTL, stream);
    Params p{};
    for (int i = 0; i < 23; ++i) p.in[i] = (const float*)d_in[i];
    p.out = (float*)d_out; p.ws = (unsigned char*)d_ws;
    if (N_LAUNCH_SPLIT) { for (int ph = 0; ph < NPH; ++ph) { p.ph_lo = ph; p.ph_hi = ph + 1; hipLaunchKernelGGL(mega, dim3(grid), dim3(512), LDS_BYTES, stream, p); } }
    else { p.ph_lo = 0; p.ph_hi = NPH; hipLaunchKernelGGL(mega, dim3(grid), dim3(512), LDS_BYTES, stream, p); }
}
```

```cpp
#include <hip/hip_runtime.h>
#include <stdint.h>
#include <stdio.h>

typedef unsigned short bf16_t;
typedef float f32x4 __attribute__((ext_vector_type(4)));
typedef unsigned u32x4 __attribute__((ext_vector_type(4)));
typedef unsigned u32x2 __attribute__((ext_vector_type(2)));
typedef short bf16x8 __attribute__((ext_vector_type(8)));

constexpr int T = 16384, DM = 2048, DIN = 5376, DPROJ = 4608, SEQ = 4096, NB = 4, DEPTH = 2;
constexpr int DLRU = 768, DCONV = 512, DSB = 768, HD = 128, NHL = 6, NHS = 6;
constexpr int NEXP = 32, DEXP = 512, MAXTILES = 160, PADROWS = MAXTILES * 256;
constexpr float EPS = 1e-6f;
constexpr float YSCALE_G = 8.0f;
constexpr float SX8 = 8.0f, SW1 = 64.0f, SH8 = 8.0f, SW2 = 32.0f;
#ifndef F8_INPROJ_MASK
#define F8_INPROJ_MASK 2
#endif
constexpr bool f8in(int l) { return ((F8_INPROJ_MASK >> l) & 1) != 0; }
constexpr float SHB = 16.0f, SWI = 64.0f;
#ifndef PITCH_PAD
#define PITCH_PAD 128
#endif
constexpr int pb_in(int l) { return (f8in(l) ? DM : DM * 2) + PITCH_PAD; }
constexpr int VTS = SEQ + 64;
constexpr int C_XA = 0, C_GA = 768, C_BG = 1536, C_CG = 2048, C_XB = 2560, C_Q = 3072, C_K = 3840, C_V = 4608;

constexpr size_t AL(size_t x) { return (x + 255) & ~(size_t)255; }
constexpr size_t SZ_WIN = (size_t)DIN * (DM * 2 + 256), SZ_WOUT = (size_t)DM * DM * 2, SZ_WGU = (size_t)NEXP * 1024 * DM * 2, SZ_WD = (size_t)NEXP * DM * DEXP * 2;
constexpr size_t SZ_WA = (size_t)NHL * HD * HD * 2, SZ_WR = (size_t)48 * DM * 4;
constexpr size_t OFF_CTL = 0, SZ_CTL = 131072;
constexpr size_t OFF_WIN = OFF_CTL + SZ_CTL;
constexpr size_t OFF_WOUT = OFF_WIN + DEPTH * SZ_WIN;
constexpr size_t OFF_WGU = OFF_WOUT + DEPTH * SZ_WOUT;
constexpr size_t OFF_WD = OFF_WGU + DEPTH * SZ_WGU;
constexpr size_t OFF_WA = OFF_WD + DEPTH * SZ_WD;
constexpr size_t OFF_WX = OFF_WA + DEPTH * SZ_WA;
constexpr size_t OFF_WR = OFF_WX + DEPTH * SZ_WA;
constexpr size_t OFF_HB = OFF_WR + DEPTH * SZ_WR;
constexpr size_t OFF_PROJ = OFF_HB + (size_t)T * (DM * 2 + 256);
constexpr size_t OFF_VT = OFF_PROJ + (size_t)T * DPROJ * 2;
constexpr size_t OFF_YPAD = OFF_PROJ;
constexpr size_t OFF_YMIX = OFF_VT + (size_t)NB * NHS * HD * VTS * 2;
constexpr size_t OFF_X = OFF_YMIX + (size_t)T * DM * 2;
constexpr size_t OFF_HID = OFF_X + (size_t)T * DM * 4;
constexpr size_t OFF_AGG = OFF_HID + (size_t)PADROWS * DEXP * 2;
constexpr size_t OFF_ROUTE = OFF_AGG + (size_t)256 * DLRU * 8;
constexpr size_t OFF_LIST = OFF_ROUTE + (size_t)T * 8 * 4;
constexpr size_t OFF_LISTR = OFF_LIST + (size_t)NEXP * T * 4;
constexpr size_t OFF_DB = OFF_LISTR + (size_t)NEXP * T * 4;
constexpr size_t WS_END = OFF_DB + (size_t)T * DM * 2;
static_assert((size_t)PADROWS * DM * 2 <= (size_t)T * DPROJ * 2 + (size_t)NB * NHS * HD * VTS * 2, "YPAD alias");
constexpr int CW_RT = 16384;
constexpr int CW_CNT = 8192;

typedef __bf16 bf16v2_t __attribute__((ext_vector_type(2)));
typedef float f32v2_t __attribute__((ext_vector_type(2)));
__device__ __forceinline__ unsigned cvt_pk_bf16(float lo, float hi) { const f32v2_t f = {lo, hi}; const bf16v2_t b = __builtin_convertvector(f, bf16v2_t); return __builtin_bit_cast(unsigned, b); }
__device__ __forceinline__ bf16_t f2bf(float f) { return (bf16_t)(cvt_pk_bf16(f, 0.f) & 0xffffu); }
__device__ __forceinline__ float bf2f(bf16_t b) { return __uint_as_float(((unsigned)b) << 16); }
__device__ __forceinline__ float bflo(unsigned w) { return __uint_as_float(w << 16); }
__device__ __forceinline__ float bfhi(unsigned w) { return __uint_as_float(w & 0xffff0000u); }
__device__ __forceinline__ float wave_sum(float v) {
#pragma unroll
    for (int o = 32; o >= 1; o >>= 1) v += __shfl_xor(v, o);
    return v;
}
__device__ __forceinline__ float fast_exp(float x) { return __builtin_amdgcn_exp2f(x * 1.4426950408889634f); }
__device__ __forceinline__ float sigmoidf_(float x) { return __builtin_amdgcn_rcpf(1.0f + fast_exp(-x)); }
__device__ __forceinline__ float one_minus_exp(float x) { const float s = -x * (1.0f + x * (0.5f + x * 0.16666667f)); const float d = 1.0f - fast_exp(x); return x > -0.02f ? s : d; }
__device__ __forceinline__ float softplusf_(float x) { return fmaxf(x, 0.f) + log1pf(__expf(-fabsf(x))); }
__device__ __forceinline__ float gelu_tanh(float x) { const float u2 = 1.5957691216057308f * (x + 0.044715f * x * x * x); return x * sigmoidf_(u2); }

__device__ __forceinline__ int otid() { int t = (int)threadIdx.x; asm volatile("" : "+v"(t)); return t; }
__device__ __forceinline__ int obid() { int b = (int)blockIdx.x; asm volatile("" : "+s"(b)); return b; }
#ifndef PROBE_SUB
#define PROBE_SUB 0
#endif
struct Params { const float* in[23]; float* out; unsigned char* ws; int ph_lo, ph_hi; };

struct InProxy { const float* const* p; int z; __device__ __forceinline__ const float* operator[](int k) const { return p[k + z]; } };
struct Ctx {
    InProxy in; float* out; unsigned char* ws;
    __device__ __forceinline__ unsigned* ctl() const { return (unsigned*)(ws + OFF_CTL); }
    __device__ __forceinline__ bf16_t* WIN(int l) const { return (bf16_t*)(ws + OFF_WIN + l * SZ_WIN); }
    __device__ __forceinline__ bf16_t* WOUT(int l) const { return (bf16_t*)(ws + OFF_WOUT + l * SZ_WOUT); }
    __device__ __forceinline__ bf16_t* WGU(int l) const { return (bf16_t*)(ws + OFF_WGU + l * SZ_WGU); }
    __device__ __forceinline__ bf16_t* WD(int l) const { return (bf16_t*)(ws + OFF_WD + l * SZ_WD); }
    __device__ __forceinline__ bf16_t* WA(int l) const { return (bf16_t*)(ws + OFF_WA + l * SZ_WA); }
    __device__ __forceinline__ bf16_t* WX(int l) const { return (bf16_t*)(ws + OFF_WX + l * SZ_WA); }
    __device__ __forceinline__ float* WR(int l) const { return (float*)(ws + OFF_WR + l * SZ_WR); }
    __device__ __forceinline__ unsigned* RTC(int l) const { return ctl() + CW_RT + l * 8192; }
    __device__ __forceinline__ unsigned* CNT(int l) const { return ctl() + CW_CNT + l * 2048; }
#define WSP(name, type, off) __device__ __forceinline__ type* name() const { return (type*)(ws + (off)); }
    WSP(HB, bf16_t, OFF_HB) WSP(PROJ, bf16_t, OFF_PROJ) WSP(VT, bf16_t, OFF_VT) WSP(YPAD, bf16_t, OFF_YPAD) WSP(YPAD8, unsigned char, OFF_YPAD) WSP(YMIX, bf16_t, OFF_YMIX) WSP(HID, bf16_t, OFF_HID)
    WSP(X, float, OFF_X) WSP(XB, bf16_t, OFF_X) WSP(AGG, float, OFF_AGG) WSP(ROUTE, unsigned, OFF_ROUTE) WSP(LIST, int, OFF_LIST) WSP(LISTR, float, OFF_LISTR) WSP(PT, bf16_t, OFF_X + (size_t)T * DM * 2) WSP(X1, bf16_t, OFF_X + (size_t)T * DM * 2) WSP(X1F8, unsigned char, OFF_HB) WSP(HID8, unsigned char, OFF_HID) WSP(DB, bf16_t, OFF_DB) WSP(HL, bf16_t, OFF_DB) WSP(PL, bf16_t, OFF_DB + (size_t)T * DLRU * 2)
#undef WSP
};

__device__ __forceinline__ Ctx octx(const Ctx& c) { int z = 0; asm volatile("" : "+s"(z)); Ctx r; r.in.p = c.in.p; r.in.z = z; r.out = c.out + z; r.ws = c.ws + z; return r; }

__device__ __forceinline__ void cvt_tile_out(const float* tile, int st, int r0, bf16_t* dst, int ld_dst, int drow0, bool f8) {
    const int rr = (st & 7) * 8;
    if (f8) {
#pragma unroll
        for (int p = 0; p < 2; ++p) {
            const int c = (st >> 3) + 32 * p; int w0 = 0, w1 = 0;
            w0 = __builtin_amdgcn_cvt_pk_fp8_f32(tile[(rr + 0) * 65 + c], tile[(rr + 1) * 65 + c], w0, false); w0 = __builtin_amdgcn_cvt_pk_fp8_f32(tile[(rr + 2) * 65 + c], tile[(rr + 3) * 65 + c], w0, true);
            w1 = __builtin_amdgcn_cvt_pk_fp8_f32(tile[(rr + 4) * 65 + c], tile[(rr + 5) * 65 + c], w1, false); w1 = __builtin_amdgcn_cvt_pk_fp8_f32(tile[(rr + 6) * 65 + c], tile[(rr + 7) * 65 + c], w1, true);
            *(u32x2*)((unsigned char*)dst + (size_t)(drow0 + c) * ld_dst + r0 + rr) = (u32x2){(unsigned)w0, (unsigned)w1};
        }
        return;
    }
#pragma unroll
    for (int p = 0; p < 2; ++p) {
        const int c = (st >> 3) + 32 * p;
        u32x4 w;
        w.x = cvt_pk_bf16(tile[(rr + 0) * 65 + c], tile[(rr + 1) * 65 + c]); w.y = cvt_pk_bf16(tile[(rr + 2) * 65 + c], tile[(rr + 3) * 65 + c]);
        w.z = cvt_pk_bf16(tile[(rr + 4) * 65 + c], tile[(rr + 5) * 65 + c]); w.w = cvt_pk_bf16(tile[(rr + 6) * 65 + c], tile[(rr + 7) * 65 + c]);
        *(u32x4*)(dst + (size_t)(drow0 + c) * ld_dst + r0 + rr) = w;
    }
}
constexpr int CV_WIN = 32 * 84, CV_WOUT = 32 * 32, CV_EXP = 32 * 8  , CV_G = NEXP * CV_EXP, CV_LRU = NHL * 4;
constexpr int CV_PER_LAYER = CV_WIN + CV_WOUT + 3 * CV_G + 2 * CV_LRU;
struct CvtTile { const float* src; bf16_t* dst; const float* gk; int ld_src, ld_dst, r0, c0, drow0; float sc; };
__device__ __forceinline__ void cvt_decode(const Ctx& c, int id, CvtTile& t) {
    const int l = id / CV_PER_LAYER; int j = id % CV_PER_LAYER; t.gk = nullptr; t.sc = 1.0f;
    if (j < CV_WIN) { t.src = c.in[2] + (size_t)l * DM * DIN; t.ld_src = DIN; { const int g = j >> 3, kp = g / 21, nq = g % 21; t.r0 = (2 * kp + ((j >> 2) & 1)) * 64; t.c0 = (4 * nq + (j & 3)) * 64; } t.dst = c.WIN(l); t.ld_dst = f8in(l) ? pb_in(l) : pb_in(l) / 2; t.drow0 = t.c0; if (f8in(l)) t.sc = -SWI; }
    else if ((j -= CV_WIN) < CV_WOUT) { t.src = c.in[14] + (size_t)l * DM * DM; t.ld_src = DM; { const int g = j >> 3, kp = g / 8, nq = g % 8; t.r0 = (2 * kp + ((j >> 2) & 1)) * 64; t.c0 = (4 * nq + (j & 3)) * 64; } t.dst = c.WOUT(l); t.ld_dst = DM; t.drow0 = t.c0; }
    else if ((j -= CV_WOUT) < 2 * CV_G) {
        const int isup = j / CV_G; j %= CV_G; const int e = j / CV_EXP; j %= CV_EXP;
        t.src = c.in[isup ? 21 : 20] + ((size_t)l * NEXP + e) * DM * DEXP; t.ld_src = DEXP; { const int g = j >> 3, kp = g / 2, nq = g % 2; t.r0 = (2 * kp + ((j >> 2) & 1)) * 64; t.c0 = (4 * nq + (j & 3)) * 64; }
        t.dst = (bf16_t*)((unsigned char*)c.WGU(l) + (size_t)e * 1024 * DM); t.ld_dst = DM; t.drow0 = 256 * (t.c0 / 128) + 128 * isup + (t.c0 % 128); t.gk = c.in[15] + (size_t)l * DM; t.sc = -SW1;
    } else if ((j -= 2 * CV_G) < CV_G) {
        const int e = j / CV_EXP; j %= CV_EXP;
        t.src = c.in[22] + ((size_t)l * NEXP + e) * DEXP * DM; t.ld_src = DM; { const int g = j >> 3, kp = g / 8, nq = g % 8; t.r0 = (2 * kp + ((j >> 2) & 1)) * 64; t.c0 = (4 * nq + (j & 3)) * 64; }
        t.dst = (bf16_t*)((unsigned char*)c.WD(l) + (size_t)e * DM * DEXP); t.ld_dst = DEXP; t.drow0 = t.c0; t.sc = -SW2;
    } else { j -= CV_G; const int isx = j / CV_LRU; j %= CV_LRU; const int h = j / 4; j %= 4;
        t.src = c.in[isx ? 7 : 5] + ((size_t)l * NHL + h) * HD * HD; t.ld_src = HD; t.r0 = (j / 2) * 64; t.c0 = (j % 2) * 64;
        t.dst = (isx ? c.WX(l) : c.WA(l)) + (size_t)h * HD * HD; t.ld_dst = HD; t.drow0 = t.c0; }
}
constexpr int CVT_NT = 4;
__device__ __forceinline__ void phase_convert(const Ctx& c, float* lds) {
    const int tid = otid(), sb = tid >> 8, st = tid & 255;
    float* tile0 = lds + sb * (CVT_NT * 64 * 65);
    const int total = DEPTH * CV_PER_LAYER;
    const int nsub = gridDim.x * 2 * CVT_NT;
    const int idb = (obid() * 2 + sb) * CVT_NT;
    CvtTile tA[CVT_NT]; f32x4 vA[CVT_NT][4];
#define CVT_LOAD(T_, V_, base_) do { _Pragma("unroll") for (int k = 0; k < CVT_NT; ++k) { const int id_ = (base_) + idb + k; cvt_decode(c, id_ < total ? id_ : 0, T_[k]); \
        _Pragma("unroll") for (int i = 0; i < 4; ++i) V_[k][i] = __builtin_nontemporal_load((const f32x4*)(T_[k].src + (size_t)(T_[k].r0 + (st >> 4) + 16 * i) * T_[k].ld_src + T_[k].c0 + (st & 15) * 4)); } } while (0)
#define CVT_FLUSH(T_, V_, base_) do { _Pragma("unroll") for (int k = 0; k < CVT_NT; ++k) _Pragma("unroll") for (int i = 0; i < 4; ++i) { \
            float* p = tile0 + k * (64 * 65) + ((st >> 4) + 16 * i) * 65 + (st & 15) * 4; const float gs_ = (T_[k].gk ? T_[k].gk[T_[k].r0 + (st >> 4) + 16 * i] : 1.0f) * fabsf(T_[k].sc); \
            p[0] = V_[k][i][0] * gs_; p[1] = V_[k][i][1] * gs_; p[2] = V_[k][i][2] * gs_; p[3] = V_[k][i][3] * gs_; } \
        __syncthreads(); \
        _Pragma("unroll") for (int k = 0; k < CVT_NT; ++k) if ((base_) + idb + k < total) cvt_tile_out(tile0 + k * (64 * 65), st, T_[k].r0, T_[k].dst, T_[k].ld_dst, T_[k].drow0, T_[k].sc < 0.f); \
        __syncthreads(); } while (0)
    for (int base = 0; base < total; base += nsub) { CVT_LOAD(tA, vA, base); CVT_FLUSH(tA, vA, base); }
#undef CVT_LOAD
#undef CVT_FLUSH
    for (int i = obid() * blockDim.x + tid; i < DEPTH * 48 * DM; i += gridDim.x * blockDim.x) {
        const int l = i / (48 * DM), n = (i / DM) % 48, k = i % DM;
        float v = 0.f;
        if (n < 4) v = c.in[16][((size_t)l * DM + k) * 4 + n]; else if (n < 36) v = c.in[18][((size_t)l * DM + k) * 32 + (n - 4)];
        const float wg = v * c.in[15][(size_t)l * DM + k]; const bf16_t hi = f2bf(wg);
        bf16_t* wr = (bf16_t*)c.WR(l); wr[(size_t)n * DM + k] = hi; wr[(size_t)(48 + n) * DM + k] = f2bf(wg - bf2f(hi));
    }
}

__device__ __forceinline__ void norm_store_row(const f32x4 (&v)[8], const float* g, bf16_t* dst, int lane) {
    float s = 0.f;
#pragma unroll
    for (int j = 0; j < 8; ++j) s += v[j][0] * v[j][0] + v[j][1] * v[j][1] + v[j][2] * v[j][2] + v[j][3] * v[j][3];
    s = wave_sum(s);
    const float rstd = rsqrtf(s * (1.0f / DM) + EPS);
#pragma unroll
    for (int j = 0; j < 8; ++j) {
        const f32x4 gg = *(const f32x4*)(g + j * 256 + lane * 4);
        u32x2 w; w.x = cvt_pk_bf16(v[j][0] * rstd * gg[0], v[j][1] * rstd * gg[1]); w.y = cvt_pk_bf16(v[j][2] * rstd * gg[2], v[j][3] * rstd * gg[3]);
        *(u32x2*)(dst + j * 256 + lane * 4) = w;
    }
}
__device__ __forceinline__ void norm_store_row8(const f32x4 (&v)[8], const float* g, unsigned char* dst, int lane) {
    float s = 0.f;
#pragma unroll
    for (int j = 0; j < 8; ++j) s += v[j][0] * v[j][0] + v[j][1] * v[j][1] + v[j][2] * v[j][2] + v[j][3] * v[j][3];
    s = wave_sum(s);
    const float rstd = rsqrtf(s * (1.0f / DM) + EPS) * SHB;
#pragma unroll
    for (int j = 0; j < 8; ++j) {
        const f32x4 gg = *(const f32x4*)(g + j * 256 + lane * 4);
        int w = 0; w = __builtin_amdgcn_cvt_pk_fp8_f32(v[j][0] * rstd * gg[0], v[j][1] * rstd * gg[1], w, false); w = __builtin_amdgcn_cvt_pk_fp8_f32(v[j][2] * rstd * gg[2], v[j][3] * rstd * gg[3], w, true);
        *(int*)(dst + j * 256 + lane * 4) = w;
    }
}
__device__ __forceinline__ void phase_norm_in(const Ctx& c, int l) {
    const int tid = otid(), lane = tid & 63, wv = tid >> 6, stride = gridDim.x * 8;
    for (int r = obid() * 8 + wv; r < T; r += 4 * stride) {
        f32x4 v[4][8];
#pragma unroll
        for (int k = 0; k < 4; ++k) { const int rr = (r + k * stride < T) ? r + k * stride : r;
#pragma unroll
            for (int j = 0; j < 8; ++j) v[k][j] = *(const f32x4*)(c.in[0] + (size_t)rr * DM + j * 256 + lane * 4); }
#pragma unroll
        for (int k = 0; k < 4; ++k) if (k == 0 || r + k * stride < T) norm_store_row(v[k], c.in[1] + (size_t)l * DM, (bf16_t*)((unsigned char*)c.HB() + (size_t)(r + k * stride) * pb_in(0)), lane);
    }
}

struct MoeTab { int cnt[NEXP]; int tstart[NEXP + 1]; int texp[MAXTILES]; };
__device__ __forceinline__ void build_moe_tab(const Ctx& c, int l, MoeTab* mt) {
    __syncthreads();
    const int tid = otid();
    if (tid < 64) {
        const int n = tid < NEXP ? (int)__hip_atomic_load(c.CNT(l) + tid * 64, __ATOMIC_RELAXED, __HIP_MEMORY_SCOPE_AGENT) : 0;
        const int nt = (n + 255) >> 8;
        int incl = nt;
#pragma unroll
        for (int o = 1; o < 32; o <<= 1) { const int v = __shfl_up(incl, o); if (tid >= o) incl += v; }
        const int excl = incl - nt;
        if (tid < NEXP) { mt->cnt[tid] = n; mt->tstart[tid] = excl; for (int i = 0; i < nt; ++i) if (excl + i < MAXTILES) mt->texp[excl + i] = tid; }
        if (tid == NEXP - 1) mt->tstart[NEXP] = incl < MAXTILES ? incl : MAXTILES;
    }
    __syncthreads();
}

template <bool DRY> __device__ __forceinline__ void phase_combine(const Ctx& c, int l, const MoeTab* mt) {
    const int tid = otid(), lane = tid & 63, wv = tid >> 6, stride = gridDim.x * 8;
    bf16_t* XB = c.XB(); const bf16_t* X1 = c.X1(); const unsigned char* YPAD = c.YPAD8(); const unsigned* ROUTE = c.ROUTE();
    for (int r = obid() * 8 + wv; r < T; r += 2 * stride) {
        f32x4 v[2][8]; unsigned ya[2][8], yb[2][8]; u32x2 yd[2][8]; float g0[2], g1[2]; int rr[2];
#pragma unroll
        for (int k = 0; k < 2; ++k) {
            rr[k] = (r + k * stride < T) ? r + k * stride : r;
            const u32x4 ra = *(const u32x4*)(ROUTE + (size_t)rr[k] * 8); const u32x2 rb = *(const u32x2*)(ROUTE + (size_t)rr[k] * 8 + 4);
            const int e0 = ra.x, p0 = ra.y, e1 = ra.w, p1 = rb.x; g0[k] = __uint_as_float(ra.z) * (1.0f / YSCALE_G); g1[k] = __uint_as_float(rb.y) * (1.0f / YSCALE_G);
            const unsigned char* y0 = YPAD + ((size_t)mt->tstart[e0] * 256 + p0) * DM + lane * 4; const unsigned char* y1 = YPAD + ((size_t)mt->tstart[e1] * 256 + p1) * DM + lane * 4;
            const bf16_t* dp = X1 + (size_t)rr[k] * DM + lane * 4;
#pragma unroll
            for (int j = 0; j < 8; ++j) { v[k][j] = (f32x4){0.f, 0.f, 0.f, 0.f};
                ya[k][j] = *(const unsigned*)(y0 + j * 256); yb[k][j] = *(const unsigned*)(y1 + j * 256); yd[k][j] = *(const u32x2*)(dp + j * 256); }
        }
        __builtin_amdgcn_sched_barrier(0);
#pragma unroll
        for (int k = 0; k < 2; ++k) {
            if (k == 0 || r + stride < T) {
#pragma unroll
                for (int j = 0; j < 8; ++j) {
                    typedef float f32x2_t __attribute__((ext_vector_type(2)));
                    const f32x2_t a01 = __builtin_amdgcn_cvt_pk_f32_fp8((int)ya[k][j], false), a23 = __builtin_amdgcn_cvt_pk_f32_fp8((int)ya[k][j], true);
                    const f32x2_t b01 = __builtin_amdgcn_cvt_pk_f32_fp8((int)yb[k][j], false), b23 = __builtin_amdgcn_cvt_pk_f32_fp8((int)yb[k][j], true);
                    v[k][j][0] += bflo(yd[k][j].x) + g0[k] * a01.x + g1[k] * b01.x; v[k][j][1] += bfhi(yd[k][j].x) + g0[k] * a01.y + g1[k] * b01.y;
                    v[k][j][2] += bflo(yd[k][j].y) + g0[k] * a23.x + g1[k] * b23.x; v[k][j][3] += bfhi(yd[k][j].y) + g0[k] * a23.y + g1[k] * b23.y;
                }
                if (l == DEPTH - 1) {
                    if (!DRY) {
#pragma unroll
                    for (int j = 0; j < 8; ++j) *(f32x4*)(c.out + (size_t)rr[k] * DM + j * 256 + lane * 4) = v[k][j]; }
                    else norm_store_row(v[k], c.in[1], c.HB() + (size_t)rr[k] * DM, lane);
                } else {
                    if (!DRY) {
#pragma unroll
                    for (int j = 0; j < 8; ++j) { u32x2 xw; xw.x = cvt_pk_bf16(v[k][j][0], v[k][j][1]); xw.y = cvt_pk_bf16(v[k][j][2], v[k][j][3]); *(u32x2*)(XB + (size_t)rr[k] * DM + j * 256 + lane * 4) = xw; } }
                    if (f8in(l + 1)) norm_store_row8(v[k], c.in[1] + (size_t)(l + 1) * DM, (unsigned char*)c.HB() + (size_t)rr[k] * pb_in(l + 1), lane);
                    else norm_store_row(v[k], c.in[1] + (size_t)(l + 1) * DM, (bf16_t*)((unsigned char*)c.HB() + (size_t)rr[k] * pb_in(l + 1)), lane);
                }
            }
        }
    }
}

__device__ __forceinline__ void phase_router_mfma(const Ctx& c, int l, float* lds) {
    float* LG = lds; float* SS = lds + 26624; float* RS = lds + 27136; int* LC = (int*)(lds + 27200); int* LB = (int*)(lds + 27232);
    const int tid = otid(), lane = tid & 63, wv = tid >> 6, rt = wv & 3, kh = wv >> 2, q = lane >> 4, l15 = lane & 15;
    const float* WR = c.WR(l);
    for (int tile = obid(); tile < T / 64; tile += gridDim.x) {
        const int r0 = tile * 64;
        f32x4 acc[4][3];
#pragma unroll
        for (int g = 0; g < 4; ++g)
#pragma unroll
            for (int ct = 0; ct < 3; ++ct) acc[g][ct] = (f32x4){0.f, 0.f, 0.f, 0.f};
        const bf16_t* xp = c.X1() + (size_t)(r0 + l15) * DM + wv * 256 + 8 * q;
        const bf16_t* wh = (const bf16_t*)WR + (size_t)l15 * DM + wv * 256 + 8 * q; const bf16_t* wl = wh + (size_t)48 * DM;
        float ssq[4] = {0.f, 0.f, 0.f, 0.f};
        bf16x8 xa[2][4], bh[2][3], bl[2][3];
#pragma unroll
        for (int st = 0; st < 2; ++st)
#pragma unroll
            for (int g = 0; g < 4; ++g) xa[st][g] = *(const bf16x8*)(xp + (size_t)(16 * g) * DM + 32 * st);
#pragma unroll
        for (int ct = 0; ct < 3; ++ct) { bh[0][ct] = *(const bf16x8*)(wh + (size_t)(16 * ct) * DM); bl[0][ct] = *(const bf16x8*)(wl + (size_t)(16 * ct) * DM); }
#define RT_STEP(st_, cur_, nxt_, ldb_, ldx_) do { \
            if (ldb_) { _Pragma("unroll") for (int ct = 0; ct < 3; ++ct) { bh[nxt_][ct] = *(const bf16x8*)(wh + (size_t)(16 * ct) * DM + 32 * ((st_) + 1)); bl[nxt_][ct] = *(const bf16x8*)(wl + (size_t)(16 * ct) * DM + 32 * ((st_) + 1)); } } \
            __builtin_amdgcn_sched_barrier(0); \
            _Pragma("unroll") for (int g = 0; g < 4; ++g) { \
                const bf16x8 xv = xa[cur_][g]; \
                _Pragma("unroll") for (int j = 0; j < 8; ++j) { const float xf = __uint_as_float(((unsigned)(unsigned short)xv[j]) << 16); ssq[g] += xf * xf; } \
                _Pragma("unroll") for (int ct = 0; ct < 3; ++ct) { acc[g][ct] = __builtin_amdgcn_mfma_f32_16x16x32_bf16(xv, bh[cur_][ct], acc[g][ct], 0, 0, 0); acc[g][ct] = __builtin_amdgcn_mfma_f32_16x16x32_bf16(xv, bl[cur_][ct], acc[g][ct], 0, 0, 0); } \
                if (ldx_) xa[cur_][g] = *(const bf16x8*)(xp + (size_t)(16 * g) * DM + 32 * ((st_) + 2)); } \
            __builtin_amdgcn_sched_barrier(0); } while (0)
#pragma unroll 1
        for (int sp = 0; sp < 4; ++sp) {
            RT_STEP(2 * sp, 0, 1, true, sp < 3);
            RT_STEP(2 * sp + 1, 1, 0, sp < 3, sp < 3);
        }
#undef RT_STEP
#pragma unroll
        for (int g = 0; g < 4; ++g) { float v = ssq[g]; v += __shfl_xor(v, 16); v += __shfl_xor(v, 32); if (q == 0) SS[wv * 64 + 16 * g + l15] = v; }
#pragma unroll
        for (int g = 0; g < 4; ++g)
#pragma unroll
            for (int ct = 0; ct < 3; ++ct)
#pragma unroll
                for (int i = 0; i < 4; ++i) LG[(wv * 64 + 16 * g + 4 * q + i) * 52 + 16 * ct + l15] = acc[g][ct][i];
        if (tid < NEXP) LC[tid] = 0;
        __syncthreads();
        int e0 = 0, e1 = 0, k0_ = 0, k1_ = 0; float rstd_ = 0.f, g0_ = 0.f, g1_ = 0.f;
        if (tid < 64) {
            float sst_ = 0.f;
#pragma unroll
            for (int w = 0; w < 8; ++w) sst_ += SS[w * 64 + tid];
            const float rstd = rsqrtf(sst_ * (1.0f / DM) + EPS);
            RS[tid] = rstd;
            float gl[4], el[8];
#pragma unroll
            for (int i = 0; i < 4; ++i) { float a_ = 0.f;
#pragma unroll
                for (int w = 0; w < 8; ++w) a_ += LG[(w * 64 + tid) * 52 + i];
                gl[i] = a_ * rstd + c.in[17][l * 4 + i]; }
            int gi = 0; float gm = gl[0];
#pragma unroll
            for (int i = 1; i < 4; ++i) if (gl[i] > gm) { gm = gl[i]; gi = i; }
            float gs = 0.f;
#pragma unroll
            for (int i = 0; i < 4; ++i) gs += __expf(gl[i] - gm);
            const float pg = 1.0f / gs;
#pragma unroll
            for (int i = 0; i < 8; ++i) { const int n = 4 + gi * 8 + i; float a_ = 0.f;
#pragma unroll
                for (int w = 0; w < 8; ++w) a_ += LG[(w * 64 + tid) * 52 + n];
                el[i] = a_ * rstd + c.in[19][l * 32 + gi * 8 + i]; }
            int i0 = 0; float m0 = el[0];
#pragma unroll
            for (int i = 1; i < 8; ++i) if (el[i] > m0) { m0 = el[i]; i0 = i; }
            int i1 = -1; float m1 = -3.0e38f;
#pragma unroll
            for (int i = 0; i < 8; ++i) if (i != i0 && el[i] > m1) { m1 = el[i]; i1 = i; }
            const float ex1 = __expf(m1 - m0), den = 1.0f + ex1;
            const float g0 = pg / den, g1 = pg * ex1 / den;
            e0 = gi * 8 + i0; e1 = gi * 8 + i1; rstd_ = rstd; g0_ = g0; g1_ = g1;
            k0_ = (int)__hip_atomic_fetch_add(&LC[e0], 1, __ATOMIC_RELAXED, __HIP_MEMORY_SCOPE_WORKGROUP);
            k1_ = (int)__hip_atomic_fetch_add(&LC[e1], 1, __ATOMIC_RELAXED, __HIP_MEMORY_SCOPE_WORKGROUP);
        }
        __syncthreads();
        if (tid < NEXP) { const int n = LC[tid]; LB[tid] = n > 0 ? (int)__hip_atomic_fetch_add(c.CNT(l) + tid * 64, (unsigned)n, __ATOMIC_RELAXED, __HIP_MEMORY_SCOPE_AGENT) : 0; }
        __syncthreads();
        if (tid < 64) {
            const int r = r0 + tid, p0 = LB[e0] + k0_, p1 = LB[e1] + k1_;
            c.LIST()[(size_t)e0 * T + p0] = r; c.LIST()[(size_t)e1 * T + p1] = r;
            c.LISTR()[(size_t)e0 * T + p0] = rstd_; c.LISTR()[(size_t)e1 * T + p1] = rstd_;
            unsigned* ro = c.ROUTE() + (size_t)r * 8;
            *(u32x4*)ro = (u32x4){(unsigned)e0, (unsigned)p0, __float_as_uint(g0_), (unsigned)e1};
            *(u32x2*)(ro + 4) = (u32x2){(unsigned)p1, __float_as_uint(g1_)};
        }
        __syncthreads();
    }
}

#define LAS __attribute__((address_space(3)))
typedef int i32x4_t __attribute__((ext_vector_type(4)));
typedef int i32x8_t __attribute__((ext_vector_type(8)));
__device__ __forceinline__ i32x8_t cat8(const bf16x8 a, const bf16x8 b) { const i32x4_t x = __builtin_bit_cast(i32x4_t, a), y = __builtin_bit_cast(i32x4_t, b); return __builtin_shufflevector(x, y, 0, 1, 2, 3, 4, 5, 6, 7); }
__device__ __forceinline__ void mfma_f8(f32x4& acc, const i32x8_t& a, const i32x8_t& b) { asm volatile("v_mfma_f32_16x16x128_f8f6f4 %0, %1, %2, %0" : "+v"(acc) : "v"(a), "v"(b)); }
__device__ __forceinline__ bf16x8 half8(const i32x8_t& v, int k) { const i32x4_t h = k ? __builtin_shufflevector(v, v, 4, 5, 6, 7) : __builtin_shufflevector(v, v, 0, 1, 2, 3); return __builtin_bit_cast(bf16x8, h); }
namespace g8 {
constexpr int BM = 256, BK = 64, HALF = 128, HTB = HALF * BK * 2, STAGE_BYTES = 8 * HTB, NXCD = 8, WGM = 8;
__device__ __forceinline__ int lds_byte(int r, int c) { const int st = (r >> 4) * 2 + (c >> 5), rr = r & 15, cc = c & 31, ob = rr * 64 + cc * 2; return st * 1024 + (ob ^ (((ob >> 9) & 1) << 5)); }
__device__ __forceinline__ void stage_rc(int b, int& R, int& C) { const int st = b / 1024, sb = b % 1024, swz = sb ^ (((sb >> 9) & 1) << 5); R = (st >> 1) * 16 + swz / 64; C = (st & 1) * 32 + (swz % 64) / 2; }
__device__ __forceinline__ int perm32(int rho) { const int n = rho >> 4, i = rho & 15; return 8 * (i >> 2) + 4 * n + (i & 3); }
struct Unit { int pm, pn; const char* B; };
typedef f32x4 Acc[2][2][4][2];

struct DenseOrder {
    static constexpr bool GATHER = false;
    int nM, nN, nwg, G, c; const char* Bt; size_t tstrideB; int rsh = 0, lim = 0x7fffffff;
    __device__ __forceinline__ void init(int M, int N, int G_, int c_, const bf16_t* Bt_, int ldb) { nM = M / BM; nN = N / BM; nwg = nM * nN; G = G_; c = c_; Bt = (const char*)Bt_; tstrideB = (size_t)BM * ldb * 2; }
    __device__ __forceinline__ bool next(int i, Unit& u) const {
        const long L = (long)(i >> rsh) * G + c; if (L >= nwg || L >= lim) return false;
        int wgid = (int)L; { const int q = nwg / NXCD, r = nwg % NXCD, xcd = wgid % NXCD, off = wgid / NXCD; wgid = (xcd < r ? xcd * (q + 1) : r * (q + 1) + (xcd - r) * q) + off; }
        const int nig = WGM * nN, gid = wgid / nig, fm = gid * WGM, gsz = (nM - fm) < WGM ? (nM - fm) : WGM;
        u.pm = fm + ((wgid % nig) % gsz); u.pn = (wgid % nig) / gsz; u.B = Bt + (size_t)u.pn * tstrideB; return true;
    }
    __device__ __forceinline__ unsigned arow_off(int) const { return 0u; }
};
struct SplitKOrder {
    static constexpr bool GATHER = false;
    int c; const char* Bt;
    __device__ __forceinline__ bool next(int i, Unit& u) const { if (i > 0) return false; u.pm = c >> 2; u.pn = c & 3; u.B = Bt; return true; }
    __device__ __forceinline__ unsigned arow_off(int) const { return 0u; }
};
template <bool GATHER_, int NCT, int LDA, size_t ESTRIDE, size_t TSTRIDE> struct MoeOrder {
    static constexpr bool GATHER = GATHER_;
    const MoeTab* mt; const int* LIST; int G, c; const char* W; int rsh = 0;
    __device__ __forceinline__ bool next(int i, Unit& u) const {
        const int L = (i >> rsh) * G + c; const int total = __builtin_amdgcn_readfirstlane(mt->tstart[NEXP]) * NCT; if (L >= total) return false;
        const int rt = L / NCT, ct = L % NCT; u.pm = rt; u.pn = ct; const int e = __builtin_amdgcn_readfirstlane(mt->texp[rt]); u.B = W + (size_t)e * ESTRIDE + (size_t)ct * TSTRIDE; return true;
    }
    __device__ __forceinline__ unsigned arow_off(int r) const {
        const int e = mt->texp[r >> 8]; const int pos = r - mt->tstart[e] * 256; const int tok = pos < mt->cnt[e] ? LIST[(size_t)e * T + pos] : 0; return (unsigned)tok * (unsigned)(LDA * 2);
    }
};

struct MoeOrder2 {
    static constexpr bool GATHER = false;
    const MoeTab* mt; int G, c, R, rtA; const char* W; int rsh = 0;
    __device__ __forceinline__ bool next(int i0, Unit& u) const {
        const int i = i0 >> rsh; int u2;
        if (c < R) { if (i >= 2) return false; u2 = rtA * 8 + 2 * c + i; }
        else { u2 = (c - R) + i * (G - R); if (u2 >= rtA * 8) return false; }
        const int rt = u2 >> 3, ct = u2 & 7; u.pm = rt; u.pn = ct; const int e = __builtin_amdgcn_readfirstlane(mt->texp[rt]);
        u.B = W + (size_t)e * ((size_t)DM * DEXP) + (size_t)ct * ((size_t)256 * DEXP); return true;
    }
    __device__ __forceinline__ unsigned arow_off(int) const { return 0u; }
};
__device__ __forceinline__ void moe_wait_dep(unsigned* rtc, int c, int G, int R, int rtA) {
    const int tid = otid();
    if (tid < 64) {
        int rt = -1;
        if (c < R) { if (tid < 2) rt = rtA + ((2 * c + tid) >> 3); } else if (tid < 32) { const int u2 = (c - R) + tid * (G - R); if (u2 < rtA * 8) rt = u2 >> 3; }
        unsigned spins = 0;
        for (;;) {
            const bool ok = rt < 0 || __hip_atomic_load(rtc + (rt < 0 ? 0 : rt) * 32, __ATOMIC_RELAXED, __HIP_MEMORY_SCOPE_AGENT) >= 32u;
            if (__all(ok)) break;
            __builtin_amdgcn_s_sleep(2); if (++spins > (1u << 22)) break;
        }
        __builtin_amdgcn_fence(__ATOMIC_ACQUIRE, "agent");
        asm volatile("s_waitcnt vmcnt(0)" ::: "memory");
    }
    __syncthreads();
}

template <class Epi, class Sched>
__device__ __forceinline__ void gemm_mfma(LAS unsigned char* lds, const bf16_t* A, int lda, int ldb, int K, const Sched& S, const Epi& E) {
    constexpr bool GATHER = Sched::GATHER;
    const int tid = otid(), wid = __builtin_amdgcn_readfirstlane(tid >> 6), lane = tid & 63, wr = wid >> 2, wc = wid & 3, fr = lane & 15, fq = lane >> 4;
    const int nt = K / BK;
    int Rst[2], Cst[2]; unsigned voffB[2], voA[2][2], voAn[2][2];
#pragma unroll
    for (int i = 0; i < 2; ++i) { stage_rc(tid * 16 + i * 8192, Rst[i], Cst[i]); const int Rb = Epi::PERM ? ((Rst[i] & ~31) + perm32(Rst[i] & 31)) : Rst[i];
        voffB[i] = (unsigned)(Rb * ldb + Cst[i]) * 2u;
#pragma unroll
        for (int h = 0; h < 2; ++h) { voA[h][i] = (unsigned)((h * HALF + Rst[i]) * lda + Cst[i]) * 2u; voAn[h][i] = voA[h][i]; } }
    const size_t kstep = (size_t)(BK * 2), hstepB = (size_t)HALF * ldb * 2, tstepA = (size_t)BM * lda * 2;
    const unsigned ldsw = (unsigned)wid * 1024u;
    const int aoff = lds_byte(wr * 64 + fr, fq * 8), boff = lds_byte(wc * 32 + fr, fq * 8);
#define G8_SA(b, h) (((b) * 2 + (h)) * HTB)
#define G8_SB(b, h) ((4 + (b) * 2 + (h)) * HTB)
#define G8_OPQ(x) ({ unsigned _o = (x); asm volatile("" : "+v"(_o)); _o; })
#define G8_STAGE_B(bufoff, gbase) do { _Pragma("unroll") for (int _i = 0; _i < 2; ++_i) \
        __builtin_amdgcn_global_load_lds((const unsigned*)((const char*)(gbase) + G8_OPQ(voffB[_i])), (LAS unsigned*)(lds + (bufoff) + ldsw + _i * 8192), 16, 0, 0); } while (0)
#define G8_STAGE_A(bufoff, gbase, o0, o1) do { \
        __builtin_amdgcn_global_load_lds((const unsigned*)((const char*)(gbase) + G8_OPQ(o0)), (LAS unsigned*)(lds + (bufoff) + ldsw), 16, 0, 0); \
        __builtin_amdgcn_global_load_lds((const unsigned*)((const char*)(gbase) + G8_OPQ(o1)), (LAS unsigned*)(lds + (bufoff) + ldsw + 8192), 16, 0, 0); } while (0)
#define G8_LDA(dst, b, h) do { _Pragma("unroll") for (int m = 0; m < 4; ++m) dst[m] = cat8(*(const LAS bf16x8*)(lds + G8_SA(b, h) + aoff + m * 2048), *(const LAS bf16x8*)(lds + G8_SA(b, h) + aoff + m * 2048 + 1024)); } while (0)
#define G8_LDB(dst, b, h) do { _Pragma("unroll") for (int n = 0; n < 2; ++n) dst[n] = cat8(*(const LAS bf16x8*)(lds + G8_SB(b, h) + boff + n * 2048), *(const LAS bf16x8*)(lds + G8_SB(b, h) + boff + n * 2048 + 1024)); } while (0)
#define G8_MMA(ai, bj, At, Bt) do { __builtin_amdgcn_s_setprio(1); \
        if constexpr (Epi::F8) { _Pragma("unroll") for (int m = 0; m < 4; ++m) _Pragma("unroll") for (int n = 0; n < 2; ++n) \
            mfma_f8(acc[ai][bj][m][n], Bt[n], At[m]); } \
        else { _Pragma("unroll") for (int m = 0; m < 4; ++m) _Pragma("unroll") for (int n = 0; n < 2; ++n) _Pragma("unroll") for (int k = 0; k < 2; ++k) \
            acc[ai][bj][m][n] = __builtin_amdgcn_mfma_f32_16x16x32_bf16(half8(Bt[n], k), half8(At[m], k), acc[ai][bj][m][n], 0, 0, 0); } \
        __builtin_amdgcn_s_setprio(0); } while (0)
#define G8_WAIT_V(n) asm volatile("s_waitcnt vmcnt(" #n ")" ::: "memory")
#define G8_WAIT_L(n) asm volatile("s_waitcnt lgkmcnt(" #n ")" ::: "memory")
#define G8_BAR __builtin_amdgcn_s_barrier()
#define G8_SCHED __builtin_amdgcn_sched_barrier(0)
    Unit cur, nxt; int ui = 0, prev_pm = -1;
    if (!S.next(0, cur)) return;
    Acc acc;
#pragma unroll
    for (int a = 0; a < 2; ++a)
#pragma unroll
        for (int b = 0; b < 2; ++b)
#pragma unroll
            for (int m = 0; m < 4; ++m)
#pragma unroll
                for (int n = 0; n < 2; ++n) acc[a][b][m][n] = (f32x4){0.f, 0.f, 0.f, 0.f};
    i32x8_t At[4], B0[2], B1[2];
    const char* cA; const char* cB = cur.B;
    if (GATHER) { cA = (const char*)A;
#pragma unroll
        for (int h = 0; h < 2; ++h)
#pragma unroll
            for (int i = 0; i < 2; ++i) voA[h][i] = S.arow_off(cur.pm * BM + h * HALF + Rst[i]) + (unsigned)Cst[i] * 2u;
    } else cA = (const char*)A + (size_t)cur.pm * tstepA;
    G8_STAGE_B(G8_SB(0, 0), cB); G8_STAGE_A(G8_SA(0, 0), cA, voA[0][0], voA[0][1]); G8_STAGE_B(G8_SB(0, 1), cB + hstepB); G8_STAGE_A(G8_SA(0, 1), cA, voA[1][0], voA[1][1]);
    if (wr == 1) G8_BAR;
    G8_WAIT_V(4); G8_BAR;
    G8_STAGE_B(G8_SB(1, 0), cB + kstep); G8_STAGE_A(G8_SA(1, 0), cA + kstep, voA[0][0], voA[0][1]); G8_STAGE_B(G8_SB(1, 1), cB + hstepB + kstep);
    G8_WAIT_V(6); G8_BAR;
    for (;;) {
        const bool has_next = S.next(ui + 1, nxt);
        const char* nA; const char* nB = has_next ? nxt.B : cB;
        if (GATHER) { nA = cA;
            if (has_next) {
#pragma unroll
                for (int h = 0; h < 2; ++h)
#pragma unroll
                    for (int i = 0; i < 2; ++i) voAn[h][i] = S.arow_off(nxt.pm * BM + h * HALF + Rst[i]) + (unsigned)Cst[i] * 2u;
            } else {
#pragma unroll
                for (int h = 0; h < 2; ++h)
#pragma unroll
                    for (int i = 0; i < 2; ++i) voAn[h][i] = voA[h][i];
            }
        } else nA = has_next ? (const char*)A + (size_t)nxt.pm * tstepA : cA;
        for (int t = 0; t < nt; t += 2) {
            const bool last = (t == nt - 2);
            const char* a1 = cA + (size_t)(t + 1) * kstep;
            const char* a2 = last ? nA : cA + (size_t)(t + 2) * kstep; const char* b2 = last ? nB : cB + (size_t)(t + 2) * kstep;
            const char* a3 = a2 + kstep; const char* b3 = b2 + kstep;
            unsigned o00 = voA[0][0], o01 = voA[0][1], o10 = voA[1][0], o11 = voA[1][1];
            if (GATHER) { if (last) { o00 = voAn[0][0]; o01 = voAn[0][1]; o10 = voAn[1][0]; o11 = voAn[1][1]; } }
            G8_LDB(B0, 0, 0); G8_SCHED; G8_LDA(At, 0, 0); G8_STAGE_A(G8_SA(1, 1), a1, voA[1][0], voA[1][1]);
            G8_WAIT_L(8); G8_BAR; G8_WAIT_L(0); G8_MMA(0, 0, At, B0); G8_BAR; G8_SCHED;
            G8_LDB(B1, 0, 1); G8_STAGE_B(G8_SB(0, 0), b2);
            G8_BAR; G8_WAIT_L(0); G8_MMA(0, 1, At, B1); G8_BAR;
            G8_LDA(At, 0, 1); G8_STAGE_A(G8_SA(0, 0), a2, o00, o01);
            G8_BAR; G8_WAIT_L(0); G8_MMA(1, 0, At, B0); G8_BAR; G8_SCHED;
            G8_STAGE_B(G8_SB(0, 1), b2 + hstepB);
            G8_WAIT_V(6);
            if constexpr (Epi::PUBLISH) { if (prev_pm >= 0) { E.publish(prev_pm); prev_pm = -1; } }
            G8_BAR; G8_MMA(1, 1, At, B1); G8_BAR;
            G8_LDB(B0, 1, 0); G8_SCHED; G8_LDA(At, 1, 0); G8_STAGE_A(G8_SA(0, 1), a2, o10, o11);
            G8_WAIT_L(8); G8_BAR; G8_WAIT_L(0); G8_MMA(0, 0, At, B0); G8_BAR; G8_SCHED;
            G8_LDB(B1, 1, 1); G8_STAGE_B(G8_SB(1, 0), b3);
            G8_BAR; G8_WAIT_L(0); G8_MMA(0, 1, At, B1); G8_BAR;
            G8_LDA(At, 1, 1); G8_STAGE_A(G8_SA(1, 0), a3, o00, o01);
            G8_BAR; G8_WAIT_L(0); G8_MMA(1, 0, At, B0); G8_BAR; G8_SCHED;
            G8_STAGE_B(G8_SB(1, 1), b3 + hstepB);
            G8_WAIT_V(6); G8_BAR; G8_MMA(1, 1, At, B1); G8_BAR;
        }
        if constexpr (Epi::F8) {
#define G8_TIE(a, b, txt) asm volatile(txt : "+v"(acc[a][b][0][0]), "+v"(acc[a][b][0][1]), "+v"(acc[a][b][1][0]), "+v"(acc[a][b][1][1]), "+v"(acc[a][b][2][0]), "+v"(acc[a][b][2][1]), "+v"(acc[a][b][3][0]), "+v"(acc[a][b][3][1]))
            G8_TIE(0, 0, ""); G8_TIE(0, 1, ""); G8_TIE(1, 0, "s_nop 7"); G8_TIE(1, 1, "s_nop 15\n\ts_nop 7");
#undef G8_TIE
        }
        if constexpr (Epi::ASCALE != 1.0f) {
#pragma unroll
            for (int a = 0; a < 2; ++a)
#pragma unroll
                for (int b = 0; b < 2; ++b)
#pragma unroll
                    for (int m = 0; m < 4; ++m)
#pragma unroll
                        for (int n = 0; n < 2; ++n) acc[a][b][m][n] *= Epi::ASCALE;
        }
        E(acc, cur, wr, wc, fr, fq);
        if constexpr (Epi::PUBLISH) prev_pm = cur.pm;
        if (!has_next) break;
#pragma unroll
        for (int a = 0; a < 2; ++a)
#pragma unroll
            for (int b = 0; b < 2; ++b)
#pragma unroll
                for (int m = 0; m < 4; ++m)
#pragma unroll
                    for (int n = 0; n < 2; ++n) acc[a][b][m][n] = (f32x4){0.f, 0.f, 0.f, 0.f};
        cur = nxt; cA = nA; cB = nB; ++ui;
        if (GATHER) {
#pragma unroll
            for (int h = 0; h < 2; ++h)
#pragma unroll
                for (int i = 0; i < 2; ++i) voA[h][i] = voAn[h][i];
        }
    }
    G8_WAIT_V(0);
    if constexpr (Epi::PUBLISH) { if (prev_pm >= 0) { E.publish(prev_pm); prev_pm = -1; } }
    if (wr == 0) G8_BAR;
    G8_BAR;
#undef G8_SA
#undef G8_SB
#undef G8_STAGE_A
#undef G8_STAGE_B
#undef G8_OPQ
#undef G8_LDA
#undef G8_LDB
#undef G8_MMA
#undef G8_WAIT_V
#undef G8_WAIT_L
#undef G8_BAR
#undef G8_SCHED
}

__device__ __forceinline__ u32x4 pack8(const f32x4& a, const f32x4& b) { u32x4 w; w.x = cvt_pk_bf16(a[0], a[1]); w.y = cvt_pk_bf16(a[2], a[3]); w.z = cvt_pk_bf16(b[0], b[1]); w.w = cvt_pk_bf16(b[2], b[3]); return w; }
__device__ __forceinline__ u32x4 subtile_T(LAS bf16_t* Tw, const f32x4& a, const f32x4& b, int fr, int fq, int lane) {
#pragma unroll
    for (int j = 0; j < 4; ++j) { Tw[(8 * fq + j) * 16 + fr] = f2bf(a[j]); Tw[(8 * fq + 4 + j) * 16 + fr] = f2bf(b[j]); }
    return *(const LAS u32x4*)(Tw + (lane >> 1) * 16 + (lane & 1) * 8);
}
template <bool F8_> struct MEpiProjT { static constexpr bool PERM = true, PUBLISH = false, F8 = F8_; static constexpr float ASCALE = F8_ ? 1.0f / (SHB * SWI) : 1.0f; bf16_t* PROJ; bf16_t* VT; LAS float* KX; const float* gq; const float* gk;
    __device__ __forceinline__ void operator()(const Acc& acc, const Unit& u, int wr, int wc, int fr, int fq) const {
        const int row0 = u.pm * BM + wr * 64 + fr;
        if (u.pn >= C_K / 256 && u.pn < DPROJ / 256) {
#pragma unroll
            for (int ai = 0; ai < 2; ++ai)
#pragma unroll
                for (int m = 0; m < 4; ++m)
#pragma unroll
                    for (int bj = 0; bj < 2; ++bj) {
                        const f32x4 a = acc[ai][bj][m][0], b = acc[ai][bj][m][1];
                        float ss = a[0] * a[0] + a[1] * a[1] + a[2] * a[2] + a[3] * a[3] + b[0] * b[0] + b[1] * b[1] + b[2] * b[2] + b[3] * b[3];
                        ss += __shfl_xor(ss, 16); ss += __shfl_xor(ss, 32);
                        if (fq == 0) KX[((ai * HALF + wr * 64 + m * 16 + fr) * 2 + bj) * 4 + wc] = ss;
                    }
            asm volatile("s_waitcnt lgkmcnt(0)" ::: "memory"); __builtin_amdgcn_s_barrier(); asm volatile("" ::: "memory");
            const int col0 = u.pn * BM + wc * 32 + 8 * fq;
            f32x4 g0[2], g1[2];
#pragma unroll
            for (int bj = 0; bj < 2; ++bj) { const int d0 = wc * 32 + 8 * fq; g0[bj] = *(const f32x4*)(gq + d0) * *(const f32x4*)(gk + d0); g1[bj] = *(const f32x4*)(gq + d0 + 4) * *(const f32x4*)(gk + d0 + 4); }
#pragma unroll
            for (int ai = 0; ai < 2; ++ai)
#pragma unroll
                for (int m = 0; m < 4; ++m) { bf16_t* rowp = PROJ + (size_t)(row0 + ai * HALF + m * 16) * DPROJ + col0;
#pragma unroll
                    for (int bj = 0; bj < 2; ++bj) { const f32x4 p4 = *(const LAS f32x4*)(KX + ((ai * HALF + wr * 64 + m * 16 + fr) * 2 + bj) * 4);
                        const float rs = rsqrtf(((p4[0] + p4[1]) + (p4[2] + p4[3])) * (1.0f / HD) + EPS);
                        *(u32x4*)(rowp + bj * HALF) = pack8(acc[ai][bj][m][0] * g0[bj] * rs, acc[ai][bj][m][1] * g1[bj] * rs); } }
            return;
        }
        if (u.pn < DPROJ / 256) {
            const int col0 = u.pn * BM + wc * 32 + 8 * fq;
#pragma unroll
            for (int ai = 0; ai < 2; ++ai)
#pragma unroll
                for (int m = 0; m < 4; ++m) { bf16_t* rowp = PROJ + (size_t)(row0 + ai * HALF + m * 16) * DPROJ + col0;
#pragma unroll
                    for (int bj = 0; bj < 2; ++bj) *(u32x4*)(rowp + bj * HALF) = pack8(acc[ai][bj][m][0], acc[ai][bj][m][1]); }
        } else {
            const int lane = fq * 16 + fr, cl = lane >> 1, hf = lane & 1; LAS bf16_t* Tw = (LAS bf16_t*)KX + (wr * 4 + wc) * 512;
            const int cc0 = (u.pn - DPROJ / 256) * BM + wc * 32 + cl;
#pragma unroll
            for (int ai = 0; ai < 2; ++ai)
#pragma unroll
                for (int m = 0; m < 4; ++m) { const int rowb = u.pm * BM + wr * 64 + ai * HALF + m * 16, b = rowb >> 12, s = (rowb & (SEQ - 1)) + hf * 8;
#pragma unroll
                    for (int bj = 0; bj < 2; ++bj) { const int cc = cc0 + bj * HALF;
                        const u32x4 w = subtile_T(Tw, acc[ai][bj][m][0], acc[ai][bj][m][1], fr, fq, lane);
                        *(u32x4*)(VT + ((size_t)(b * NHS + (cc >> 7)) * HD + (cc & 127)) * VTS + s) = w; } }
        }
    } };
template <bool F8_> struct MEpiPartT { static constexpr bool PERM = true, PUBLISH = false, F8 = F8_; static constexpr float ASCALE = F8_ ? 1.0f / (SHB * SWI) : 1.0f; bf16_t* PT; LAS float* KX;
    __device__ __forceinline__ void operator()(const Acc& acc, const Unit& u, int wr, int wc, int fr, int fq) const {
        const int lane = fq * 16 + fr, cl = lane >> 1, hf = lane & 1; LAS bf16_t* Tw = (LAS bf16_t*)KX + (wr * 4 + wc) * 512;
        bf16_t* base0 = PT + (size_t)(u.pm * 4 + u.pn) * 65536 + (size_t)(wc * 32 + cl) * 256 + wr * 64 + hf * 8;
#pragma unroll
        for (int ai = 0; ai < 2; ++ai)
#pragma unroll
            for (int m = 0; m < 4; ++m)
#pragma unroll
                for (int bj = 0; bj < 2; ++bj) {
                    const u32x4 w = subtile_T(Tw, acc[ai][bj][m][0], acc[ai][bj][m][1], fr, fq, lane);
                    *(u32x4*)(base0 + (size_t)(bj * HALF) * 256 + ai * HALF + m * 16) = w; }
    } };
__device__ __forceinline__ u32x4 pair16(unsigned a0, unsigned a1, unsigned b0, unsigned b1) {
    const auto s0 = __builtin_amdgcn_permlane16_swap(a0, b0, false, false); const auto s1 = __builtin_amdgcn_permlane16_swap(a1, b1, false, false);
    return (u32x4){s0[0], s1[0], s0[1], s1[1]};
}
__device__ __forceinline__ f32x4 silu_mul(const f32x4& g, const f32x4& u) { f32x4 r;
#pragma unroll
    for (int j = 0; j < 4; ++j) r[j] = g[j] / (1.0f + __expf(-g[j])) * u[j];
    return r; }
struct MEpiGU { static constexpr bool PERM = true, PUBLISH = true, F8 = true; static constexpr float ASCALE = 1.0f; unsigned char* HID; const float* LISTR; const MoeTab* mt; unsigned* rtc; int n1early;
    __device__ __forceinline__ void operator()(const Acc& acc, const Unit& u, int wr, int wc, int fr, int fq) const {
        const int row0 = u.pm * BM + wr * 64 + fr, col0 = u.pn * HALF + wc * 32 + 8 * fq;
        const int e = __builtin_amdgcn_readfirstlane(mt->texp[u.pm]), cnt = __builtin_amdgcn_readfirstlane(mt->cnt[e]), pb = __builtin_amdgcn_readfirstlane(mt->tstart[e]) * 256;
        const float* lr = LISTR + (size_t)e * T;
        const __amdgpu_buffer_rsrc_t rsrc = __builtin_amdgcn_make_buffer_rsrc(HID, 0, (int)((size_t)PADROWS * DEXP), 0x00020000);
#pragma unroll
        for (int ai = 0; ai < 2; ++ai)
#pragma unroll
            for (int mp = 0; mp < 2; ++mp) { int w[2][2];
#pragma unroll
                for (int mm = 0; mm < 2; ++mm) { const int m = 2 * mp + mm;
                    const int row = row0 + ai * HALF + m * 16, pos = row - pb;
                    const float rs = pos < cnt ? lr[pos] * (1.0f / (SX8 * SW1)) : 0.f;
                    const f32x4 h0 = silu_mul(acc[ai][0][m][0] * rs, acc[ai][1][m][0] * rs) * SH8, h1 = silu_mul(acc[ai][0][m][1] * rs, acc[ai][1][m][1] * rs) * SH8;
                    int w0 = 0, w1 = 0;
                    w0 = __builtin_amdgcn_cvt_pk_fp8_f32(__builtin_amdgcn_fmed3f(h0[0], -448.f, 448.f), __builtin_amdgcn_fmed3f(h0[1], -448.f, 448.f), w0, false); w0 = __builtin_amdgcn_cvt_pk_fp8_f32(__builtin_amdgcn_fmed3f(h0[2], -448.f, 448.f), __builtin_amdgcn_fmed3f(h0[3], -448.f, 448.f), w0, true);
                    w1 = __builtin_amdgcn_cvt_pk_fp8_f32(__builtin_amdgcn_fmed3f(h1[0], -448.f, 448.f), __builtin_amdgcn_fmed3f(h1[1], -448.f, 448.f), w1, false); w1 = __builtin_amdgcn_cvt_pk_fp8_f32(__builtin_amdgcn_fmed3f(h1[2], -448.f, 448.f), __builtin_amdgcn_fmed3f(h1[3], -448.f, 448.f), w1, true);
                    w[mm][0] = w0; w[mm][1] = w1; }
                __builtin_amdgcn_raw_buffer_store_b128(pair16((unsigned)w[0][0], (unsigned)w[0][1], (unsigned)w[1][0], (unsigned)w[1][1]), rsrc, (row0 + ai * HALF + mp * 32 + 16 * (fq & 1)) * DEXP + (u.pn * HALF + wc * 32 + 16 * (fq >> 1)), 0, 16);
            }
    }
    __device__ __forceinline__ void publish(int pm) const {
        if ((otid() & 63) == 0) __hip_atomic_fetch_add(rtc + pm * 32, 1u, __ATOMIC_RELAXED, __HIP_MEMORY_SCOPE_AGENT);
    } };
struct MEpiDown { static constexpr bool PERM = true, PUBLISH = false, F8 = false; static constexpr float ASCALE = 1.0f; bf16_t* YPAD;
    __device__ __forceinline__ void operator()(const Acc& acc, const Unit& u, int wr, int wc, int fr, int fq) const {
        const int row0 = u.pm * BM + wr * 64 + fr, col0 = u.pn * BM + wc * 32 + 8 * fq;
#pragma unroll
        for (int ai = 0; ai < 2; ++ai)
#pragma unroll
            for (int m = 0; m < 4; ++m) { bf16_t* rowp = YPAD + (size_t)(row0 + ai * HALF + m * 16) * DM + col0;
#pragma unroll
                for (int bj = 0; bj < 2; ++bj) *(u32x4*)(rowp + bj * HALF) = pack8(acc[ai][bj][m][0], acc[ai][bj][m][1]); }
    } };
template <bool XF32> struct MEpiOut { static constexpr bool STAMP = false, PERM = true, PUBLISH = false, F8 = false; static constexpr float ASCALE = 1.0f; const float* Xf; const bf16_t* Xb; bf16_t* X1; unsigned char* X18;
    __device__ __forceinline__ void operator()(const Acc& acc, const Unit& u, int wr, int wc, int fr, int fq) const {
        const int row0 = u.pm * BM + wr * 64 + fr, col0 = u.pn * BM + wc * 32 + 8 * fq;
        const int row8 = u.pm * BM + wr * 64 + fr + 16 * (fq & 1), col8 = u.pn * BM + wc * 32 + 16 * (fq >> 1);
#pragma unroll
        for (int ai = 0; ai < 2; ++ai) {
            f32x4 xa[4][2][2]; u32x4 xh[4][2];
#pragma unroll
            for (int m = 0; m < 4; ++m)
#pragma unroll
                for (int bj = 0; bj < 2; ++bj) { const size_t o = (size_t)(row0 + ai * HALF + m * 16) * DM + col0 + bj * HALF;
                    if (XF32) { xa[m][bj][0] = *(const f32x4*)(Xf + o); xa[m][bj][1] = *(const f32x4*)(Xf + o + 4); } else xh[m][bj] = *(const u32x4*)(Xb + o); }
            __builtin_amdgcn_sched_barrier(0);
#pragma unroll
            for (int mp = 0; mp < 2; ++mp)
#pragma unroll
                for (int bj = 0; bj < 2; ++bj) { int w8[2][2];
#pragma unroll
                    for (int mm = 0; mm < 2; ++mm) { const int m = 2 * mp + mm; const size_t o = (size_t)(row0 + ai * HALF + m * 16) * DM + col0 + bj * HALF;
                        f32x4 a = acc[ai][bj][m][0], b = acc[ai][bj][m][1];
                        if (XF32) { a += xa[m][bj][0]; b += xa[m][bj][1]; }
                        else { const u32x4 w = xh[m][bj]; a[0] += bflo(w.x); a[1] += bfhi(w.x); a[2] += bflo(w.y); a[3] += bfhi(w.y); b[0] += bflo(w.z); b[1] += bfhi(w.z); b[2] += bflo(w.w); b[3] += bfhi(w.w); }
                        *(u32x4*)(X1 + o) = pack8(a, b);
                        int w0 = 0, w1 = 0;
                        w0 = __builtin_amdgcn_cvt_pk_fp8_f32(a[0] * SX8, a[1] * SX8, w0, false); w0 = __builtin_amdgcn_cvt_pk_fp8_f32(a[2] * SX8, a[3] * SX8, w0, true);
                        w1 = __builtin_amdgcn_cvt_pk_fp8_f32(b[0] * SX8, b[1] * SX8, w1, false); w1 = __builtin_amdgcn_cvt_pk_fp8_f32(b[2] * SX8, b[3] * SX8, w1, true);
                        w8[mm][0] = w0; w8[mm][1] = w1; }
                    *(u32x4*)(X18 + (size_t)(row8 + ai * HALF + mp * 32) * DM + col8 + bj * HALF) = pair16((unsigned)w8[0][0], (unsigned)w8[0][1], (unsigned)w8[1][0], (unsigned)w8[1][1]); }
        }
    } };
constexpr float YSCALE = YSCALE_G;
struct MEpiDown8 { static constexpr bool PERM = true, PUBLISH = false, F8 = true; static constexpr float ASCALE = 1.0f; unsigned char* Y8;
    __device__ __forceinline__ void operator()(const Acc& acc, const Unit& u, int wr, int wc, int fr, int fq) const {
        const int row0 = u.pm * BM + wr * 64 + fr + 16 * (fq & 1), col0 = u.pn * BM + wc * 32 + 16 * (fq >> 1);
#pragma unroll
        for (int ai = 0; ai < 2; ++ai)
#pragma unroll
            for (int mp = 0; mp < 2; ++mp)
#pragma unroll
                for (int bj = 0; bj < 2; ++bj) { int w[2][2];
#pragma unroll
                    for (int mm = 0; mm < 2; ++mm) { const int m = 2 * mp + mm; const f32x4 a = acc[ai][bj][m][0] * (YSCALE / (SH8 * SW2)), b = acc[ai][bj][m][1] * (YSCALE / (SH8 * SW2)); int w0 = 0, w1 = 0;
                        w0 = __builtin_amdgcn_cvt_pk_fp8_f32(a[0], a[1], w0, false); w0 = __builtin_amdgcn_cvt_pk_fp8_f32(a[2], a[3], w0, true);
                        w1 = __builtin_amdgcn_cvt_pk_fp8_f32(b[0], b[1], w1, false); w1 = __builtin_amdgcn_cvt_pk_fp8_f32(b[2], b[3], w1, true); w[mm][0] = w0; w[mm][1] = w1; }
                    *(u32x4*)(Y8 + (size_t)(row0 + ai * HALF + mp * 32) * DM + col0 + bj * HALF) = pair16((unsigned)w[0][0], (unsigned)w[0][1], (unsigned)w[1][0], (unsigned)w[1][1]); }
    } };
}

__device__ __forceinline__ void phase_convb(const Ctx& c, int l) {
    const int gt = obid() * 512 + otid(), ng = gridDim.x * 512, sub = gt & 15;
    const float* cw = c.in[10] + (size_t)l * 3 * DCONV; const bf16_t* PROJ = c.PROJ();
#pragma unroll 2
    for (int item = gt >> 4; item < T * 4; item += ng >> 4) {
        const int t = item >> 2, hh = item & 3, ch = hh * HD + sub * 8, s = t & (SEQ - 1);
        u32x4 cg[3], xb[3];
#pragma unroll
        for (int tap = 0; tap < 3; ++tap) { const int ds = (s + tap - 2 >= 0) ? tap - 2 : 0; const bf16_t* row = PROJ + (size_t)(t + ds) * DPROJ; cg[tap] = *(const u32x4*)(row + C_CG + ch); xb[tap] = *(const u32x4*)(row + C_XB + ch); }
        const u32x4 bg = *(const u32x4*)(PROJ + (size_t)t * DPROJ + C_BG + ch);
        float acc[8] = {0, 0, 0, 0, 0, 0, 0, 0};
#pragma unroll
        for (int tap = 0; tap < 3; ++tap) {
            if (s + tap - 2 >= 0) {
                const f32x4 w0 = *(const f32x4*)(cw + tap * DCONV + ch), w1 = *(const f32x4*)(cw + tap * DCONV + ch + 4);
                acc[0] += w0[0] * bflo(cg[tap].x) * bflo(xb[tap].x); acc[1] += w0[1] * bfhi(cg[tap].x) * bfhi(xb[tap].x); acc[2] += w0[2] * bflo(cg[tap].y) * bflo(xb[tap].y); acc[3] += w0[3] * bfhi(cg[tap].y) * bfhi(xb[tap].y);
                acc[4] += w1[0] * bflo(cg[tap].z) * bflo(xb[tap].z); acc[5] += w1[1] * bfhi(cg[tap].z) * bfhi(xb[tap].z); acc[6] += w1[2] * bflo(cg[tap].w) * bflo(xb[tap].w); acc[7] += w1[3] * bfhi(cg[tap].w) * bfhi(xb[tap].w);
            }
        }
        acc[0] *= bflo(bg.x); acc[1] *= bfhi(bg.x); acc[2] *= bflo(bg.y); acc[3] *= bfhi(bg.y); acc[4] *= bflo(bg.z); acc[5] *= bfhi(bg.z); acc[6] *= bflo(bg.w); acc[7] *= bfhi(bg.w);
        float ss = 0.f;
#pragma unroll
        for (int i = 0; i < 8; ++i) ss += acc[i] * acc[i];
        ss += __shfl_xor(ss, 1); ss += __shfl_xor(ss, 2); ss += __shfl_xor(ss, 4); ss += __shfl_xor(ss, 8);
        const float rstd = rsqrtf(ss * (1.0f / HD) + EPS);
        const float* mg = c.in[13] + (size_t)l * DM + DLRU + ch;
        const f32x4 m0 = *(const f32x4*)mg, m1 = *(const f32x4*)(mg + 4);
        u32x4 o; o.x = cvt_pk_bf16(acc[0] * rstd * m0[0], acc[1] * rstd * m0[1]); o.y = cvt_pk_bf16(acc[2] * rstd * m0[2], acc[3] * rstd * m0[3]);
        o.z = cvt_pk_bf16(acc[4] * rstd * m1[0], acc[5] * rstd * m1[1]); o.w = cvt_pk_bf16(acc[6] * rstd * m1[2], acc[7] * rstd * m1[3]);
        *(u32x4*)(c.YMIX() + (size_t)t * DM + DLRU + ch) = o;
    }
}
typedef float f32x16 __attribute__((ext_vector_type(16)));
#define MFMA32(a, b, c) __builtin_amdgcn_mfma_f32_32x32x16_bf16((a), (b), (c), 0, 0, 0)
constexpr int XCS = 776;
__device__ __forceinline__ void phase_lruA(const Ctx& c, int l, unsigned char* ldsb) {
    constexpr bool PASS2 = false;
    bf16_t* XC = (bf16_t*)ldsb; bf16_t* PR = (bf16_t*)(ldsb + 99328); bf16_t* HL = c.HL(); bf16_t* PL = c.PL();
    const int tid = otid(), lane = tid & 63, wv = tid >> 6, hh = lane >> 5, l31 = lane & 31;
    const float* cw = c.in[3] + (size_t)l * 4 * DLRU; const float* cb = c.in[4] + (size_t)l * DLRU;
    const bf16_t* PROJ = c.PROJ(); float* AGG = c.AGG();
    typedef float f32x2_t __attribute__((ext_vector_type(2)));
    for (int tile = obid(); tile < T / 64; tile += gridDim.x) {
        const int t0 = tile * 64, s0 = t0 & (SEQ - 1), tb = tile & 63;
        if (tid < 480) {
            const int cg = tid % 48, tslot = tid / 48, ch = cg * 16;
            float w[4][16], bias[16];
#pragma unroll
            for (int i = 0; i < 16; i += 4) { *(f32x4*)&bias[i] = *(const f32x4*)(cb + ch + i);
#pragma unroll
                for (int tap = 0; tap < 4; ++tap) *(f32x4*)&w[tap][i] = *(const f32x4*)(cw + tap * DLRU + ch + i); }
#pragma unroll
            for (int it = 0; it < 7; ++it) {
                const int tokr = tslot + 10 * it, tok = tokr < 64 ? tokr : 63;
                u32x4 x0[4], x1[4]; float msk[4];
#pragma unroll
                for (int tap = 0; tap < 4; ++tap) {
                    const int ds = tap - 3; const bool ok = (s0 + tok + ds >= 0); msk[tap] = ok ? 1.0f : 0.0f;
                    const bf16_t* row = PROJ + (size_t)(t0 + tok + (ok ? ds : 0)) * DPROJ + C_XA + ch;
                    x0[tap] = *(const u32x4*)row; x1[tap] = *(const u32x4*)(row + 8);
                }
                float a[16];
#pragma unroll
                for (int i = 0; i < 16; ++i) a[i] = bias[i];
#pragma unroll
                for (int tap = 0; tap < 4; ++tap) {
                    const float m = msk[tap];
                    a[0] += m * w[tap][0] * bflo(x0[tap].x); a[1] += m * w[tap][1] * bfhi(x0[tap].x); a[2] += m * w[tap][2] * bflo(x0[tap].y); a[3] += m * w[tap][3] * bfhi(x0[tap].y);
                    a[4] += m * w[tap][4] * bflo(x0[tap].z); a[5] += m * w[tap][5] * bfhi(x0[tap].z); a[6] += m * w[tap][6] * bflo(x0[tap].w); a[7] += m * w[tap][7] * bfhi(x0[tap].w);
                    a[8] += m * w[tap][8] * bflo(x1[tap].x); a[9] += m * w[tap][9] * bfhi(x1[tap].x); a[10] += m * w[tap][10] * bflo(x1[tap].y); a[11] += m * w[tap][11] * bfhi(x1[tap].y);
                    a[12] += m * w[tap][12] * bflo(x1[tap].z); a[13] += m * w[tap][13] * bfhi(x1[tap].z); a[14] += m * w[tap][14] * bflo(x1[tap].w); a[15] += m * w[tap][15] * bfhi(x1[tap].w);
                }
                u32x4 o0, o1; o0.x = cvt_pk_bf16(a[0], a[1]); o0.y = cvt_pk_bf16(a[2], a[3]); o0.z = cvt_pk_bf16(a[4], a[5]); o0.w = cvt_pk_bf16(a[6], a[7]);
                o1.x = cvt_pk_bf16(a[8], a[9]); o1.y = cvt_pk_bf16(a[10], a[11]); o1.z = cvt_pk_bf16(a[12], a[13]); o1.w = cvt_pk_bf16(a[14], a[15]);
                if (tokr < 64) { *(u32x4*)(XC + tok * XCS + ch) = o0; *(u32x4*)(XC + tok * XCS + ch + 8) = o1; }
            }
        }
        __syncthreads();
#pragma unroll 1
        for (int i = 0; i < 3; ++i) {
            const int hd = 2 * i + (wv >> 2), ntw = wv & 3, chl = 32 * ntw + l31, ch = hd * HD + chl;
            const bf16_t* wa = c.WA(l) + ((size_t)hd * HD + chl) * HD + 8 * hh; const bf16_t* wx = c.WX(l) + ((size_t)hd * HD + chl) * HD + 8 * hh;
            const float ba = c.in[6][l * DLRU + ch], bx = c.in[8][l * DLRU + ch], c8 = -8.0f * softplusf_(-c.in[9][l * DLRU + ch]);
            float sst = 0.f, Pt = 1.f;
            float hreg[2][16], preg[2][16];
            bf16x8 bRf[8], bIf[8];
#pragma unroll
            for (int s = 0; s < 8; ++s) { bRf[s] = *(const bf16x8*)(wa + 16 * s); bIf[s] = *(const bf16x8*)(wx + 16 * s); }
            __builtin_amdgcn_sched_barrier(0);
#pragma unroll
            for (int half = 0; half < 2; ++half) {
                float av[16], uv[16];
                {
                    f32x16 accR, accI;
#pragma unroll
                    for (int r = 0; r < 16; ++r) { accR[r] = 0.f; accI[r] = 0.f; }
#pragma unroll
                    for (int s = 0; s < 8; ++s) {
                        const bf16x8 a = *(const bf16x8*)(XC + (32 * half + l31) * XCS + hd * HD + 16 * s + 8 * hh);
                        accR = MFMA32(a, bRf[s], accR); accI = MFMA32(a, bIf[s], accI);
                    }
#pragma unroll
                    for (int r = 0; r < 16; ++r) {
                        const int tok = 32 * half + (r & 3) + 8 * (r >> 2) + 4 * hh;
                        const float xc = bf2f(XC[tok * XCS + ch]);
                        const float rg = sigmoidf_(accR[r] + ba), ig = sigmoidf_(accI[r] + bx);
                        const float la = c8 * rg;
                        av[r] = fast_exp(la); uv[r] = __builtin_amdgcn_sqrtf(one_minus_exp(2.0f * la)) * (ig * xc);
                    }
                }
                float Pp[4], Hp[4];
#pragma unroll
                for (int g = 0; g < 4; ++g) { float P = 1.f, H = 0.f;
#pragma unroll
                    for (int r = 4 * g; r < 4 * g + 4; ++r) { H = av[r] * H + uv[r]; P *= av[r]; }
                    Pp[g] = __shfl_xor(P, 32); Hp[g] = __shfl_xor(H, 32); }
#pragma unroll
                for (int g = 0; g < 4; ++g) {
                    if (hh == 0) {
#pragma unroll
                        for (int r = 4 * g; r < 4 * g + 4; ++r) { sst = av[r] * sst + uv[r]; Pt *= av[r]; hreg[half][r] = sst; preg[half][r] = Pt; }
                        sst = Pp[g] * sst + Hp[g]; Pt *= Pp[g];
                    } else {
                        sst = Pp[g] * sst + Hp[g]; Pt *= Pp[g];
#pragma unroll
                        for (int r = 4 * g; r < 4 * g + 4; ++r) { sst = av[r] * sst + uv[r]; Pt *= av[r]; hreg[half][r] = sst; preg[half][r] = Pt; }
                    }
                }
            }
            if (hh == 0) { f32x2_t o; o.x = Pt; o.y = sst; ((f32x2_t*)AGG)[(size_t)tile * DLRU + ch] = o; }
            __syncthreads();
#pragma unroll
            for (int half = 0; half < 2; ++half)
#pragma unroll
                for (int r = 0; r < 16; ++r) { const int tok = 32 * half + (r & 3) + 8 * (r >> 2) + 4 * hh;
                    XC[tok * XCS + ch] = f2bf(hreg[half][r]); PR[tok * 264 + (wv >> 2) * HD + chl] = f2bf(preg[half][r]); }
            __syncthreads();
#pragma unroll
            for (int k = 0; k < 4; ++k) {
                const int item = tid + 512 * k, tok = item >> 5, g = item & 31, hs = g >> 4, sub = g & 15, cc = (2 * i + hs) * HD + sub * 8;
                *(u32x4*)(HL + (size_t)(t0 + tok) * DLRU + cc) = *(const u32x4*)(XC + tok * XCS + cc);
                *(u32x4*)(PL + (size_t)(t0 + tok) * DLRU + cc) = *(const u32x4*)(PR + tok * 264 + hs * HD + sub * 8);
            }
        }
        __syncthreads();
    }
}

__device__ __forceinline__ void phase_lruB(const Ctx& c, int l, unsigned char* ldsb) {
    float* HIN = (float*)ldsb;
    const int tid = otid();
    const bf16_t* PROJ = c.PROJ(); const float* AGG = c.AGG(); const bf16_t* HL = c.HL(); const bf16_t* PL = c.PL();
    typedef float f32x2_t __attribute__((ext_vector_type(2)));
    for (int tile = obid(); tile < T / 64; tile += gridDim.x) {
        const int t0 = tile * 64, tb = tile & 63;
        {
            const f32x2_t* ag = (const f32x2_t*)AGG + (size_t)(tile - tb) * DLRU;
            const int chb = 512 + (tid & 255);
            float ha = 0.f, hb = 0.f;
#pragma unroll 8
            for (int k = 0; k < tb; ++k) { const f32x2_t pa = ag[(size_t)k * DLRU + tid], pb_ = ag[(size_t)k * DLRU + chb]; ha = pa.x * ha + pa.y; hb = pb_.x * hb + pb_.y; }
            HIN[tid] = ha; if (tid < 256) HIN[chb] = hb;
        }
        __syncthreads();
        const int wv_ = tid >> 6, wit0 = wv_ < 4 ? 8 * wv_ : 32 + 16 * (wv_ - 4), wcnt = wv_ < 4 ? 8 : 16;
#define LB_ADDR(it_, tok_, cc_) const int item_##it_ = (wit0 + (it_)) * 64 + (tid & 63), tok_ = item_##it_ / 96, rem_##it_ = item_##it_ % 96, cc_ = (rem_##it_ >> 4) * HD + (rem_##it_ & 15) * 8
#define LB_LOAD(H_, P_, G_, tok_, cc_) do { H_ = *(const u32x4*)(HL + (size_t)(t0 + tok_) * DLRU + cc_); P_ = *(const u32x4*)(PL + (size_t)(t0 + tok_) * DLRU + cc_); G_ = *(const u32x4*)(PROJ + (size_t)(t0 + tok_) * DPROJ + C_GA + cc_); } while (0)
#define LB_BODY(hv, pv, ga, tok, cc) do { \
            const f32x4 i0 = *(const f32x4*)(HIN + cc), i1 = *(const f32x4*)(HIN + cc + 4); \
            float y[8] = {(bflo(hv.x) + bflo(pv.x) * i0[0]) * gelu_tanh(bflo(ga.x)), (bfhi(hv.x) + bfhi(pv.x) * i0[1]) * gelu_tanh(bfhi(ga.x)), \
                          (bflo(hv.y) + bflo(pv.y) * i0[2]) * gelu_tanh(bflo(ga.y)), (bfhi(hv.y) + bfhi(pv.y) * i0[3]) * gelu_tanh(bfhi(ga.y)), \
                          (bflo(hv.z) + bflo(pv.z) * i1[0]) * gelu_tanh(bflo(ga.z)), (bfhi(hv.z) + bfhi(pv.z) * i1[1]) * gelu_tanh(bfhi(ga.z)), \
                          (bflo(hv.w) + bflo(pv.w) * i1[2]) * gelu_tanh(bflo(ga.w)), (bfhi(hv.w) + bfhi(pv.w) * i1[3]) * gelu_tanh(bfhi(ga.w))}; \
            float ss = 0.f; \
            _Pragma("unroll") for (int k = 0; k < 8; ++k) ss += y[k] * y[k]; \
            ss += __shfl_xor(ss, 1); ss += __shfl_xor(ss, 2); ss += __shfl_xor(ss, 4); ss += __shfl_xor(ss, 8); \
            const float rstd = rsqrtf(ss * (1.0f / HD) + EPS); \
            const float* mg = c.in[13] + (size_t)l * DM + cc; \
            const f32x4 m0 = *(const f32x4*)mg, m1 = *(const f32x4*)(mg + 4); \
            u32x4 o; o.x = cvt_pk_bf16(y[0] * rstd * m0[0], y[1] * rstd * m0[1]); o.y = cvt_pk_bf16(y[2] * rstd * m0[2], y[3] * rstd * m0[3]); \
            o.z = cvt_pk_bf16(y[4] * rstd * m1[0], y[5] * rstd * m1[1]); o.w = cvt_pk_bf16(y[6] * rstd * m1[2], y[7] * rstd * m1[3]); \
            *(u32x4*)(c.YMIX() + (size_t)(t0 + tok) * DM + cc) = o; } while (0)
        {
            u32x4 hA, pA, gA, hB, pB, gB;
            { LB_ADDR(0, tk_, cc_); LB_LOAD(hA, pA, gA, tk_, cc_); }
#pragma unroll 1
            for (int it = 0; it < wcnt; it += 2) {
                LB_ADDR(it, tkA, ccA); const int itb = it + 1; LB_ADDR(itb, tkB, ccB);
                LB_LOAD(hB, pB, gB, tkB, ccB); __builtin_amdgcn_sched_barrier(0);
                LB_BODY(hA, pA, gA, tkA, ccA);
                if (it + 2 < wcnt) { const int itc = it + 2; LB_ADDR(itc, tkC, ccC); LB_LOAD(hA, pA, gA, tkC, ccC); } __builtin_amdgcn_sched_barrier(0);
                LB_BODY(hB, pB, gB, tkB, ccB);
            }
        }
#undef LB_ADDR
#undef LB_LOAD
#undef LB_BODY
        __syncthreads();
    }
}

__device__ __forceinline__ void phase_vreduce(const Ctx& c) {
    const bf16_t* PT = c.PT(); bf16_t* VT = c.VT();
    for (int item = obid() * 512 + otid(); item < 64 * 256 * 32; item += gridDim.x * 512) {
        const int ro = item & 31, col = (item >> 5) & 255, u = item >> 13;
        const bf16_t* p = PT + (size_t)(u * 4) * 65536 + col * 256 + ro * 8;
        float a[8] = {0, 0, 0, 0, 0, 0, 0, 0};
#pragma unroll
        for (int kq = 0; kq < 4; ++kq) { const u32x4 w = *(const u32x4*)(p + (size_t)kq * 65536);
            a[0] += bflo(w.x); a[1] += bfhi(w.x); a[2] += bflo(w.y); a[3] += bfhi(w.y); a[4] += bflo(w.z); a[5] += bfhi(w.z); a[6] += bflo(w.w); a[7] += bfhi(w.w); }
        const int b = u >> 4, s0 = (u & 15) * 256 + ro * 8, h = 4 + (col >> 7), d = col & 127;
        u32x4 o; o.x = cvt_pk_bf16(a[0], a[1]); o.y = cvt_pk_bf16(a[2], a[3]); o.z = cvt_pk_bf16(a[4], a[5]); o.w = cvt_pk_bf16(a[6], a[7]);
        *(u32x4*)(VT + ((size_t)(b * NHS + h) * HD + d) * VTS + s0) = o;
    }
}

__device__ __forceinline__ void phase_attn(const Ctx& c, int l, unsigned char* ldsb) {
    const int lane = otid() & 63, wv = otid() >> 6, hh = lane >> 5, l31 = lane & 31;
    const bf16_t* PROJ = c.PROJ(); const bf16_t* VT = c.VT();
    const int prow = (l31 & ~12) | ((l31 & 4) << 1) | ((l31 & 8) >> 1);
    unsigned char* wl = ldsb + wv * 16384;
    const int kwbase = (lane >> 4) * 256 + (((lane & 15) ^ (lane >> 4)) * 16);
    const int vwoff = (lane >> 2) * 64 + (((lane & 3) ^ (lane >> 4)) * 16);
    const int kroff = prow * 256;
    const int nwt = NB * NHS * (SEQ / 32);
    const int nper = (nwt + (int)gridDim.x - 1) / (int)gridDim.x, wt0 = obid() * nper, wt1 = (wt0 + nper < nwt) ? wt0 + nper : nwt;
    for (int wt = wt0 + wv; wt < wt1; wt += 8) {
        const int qt = wt % (SEQ / 32), bh = wt / (SEQ / 32), b = bh / NHS, h = bh % NHS, q0 = qt * 32;
        const bf16_t* qp = PROJ + (size_t)(b * SEQ + q0 + l31) * DPROJ + C_Q + h * HD + 8 * hh;
        bf16x8 bq[8];
#pragma unroll
        for (int s = 0; s < 8; ++s) bq[s] = *(const bf16x8*)(qp + 16 * s);
        {
            float qs = 0.f;
#pragma unroll
            for (int s = 0; s < 8; ++s) { const u32x4 w = __builtin_bit_cast(u32x4, bq[s]);
                qs += bflo(w.x) * bflo(w.x) + bfhi(w.x) * bfhi(w.x) + bflo(w.y) * bflo(w.y) + bfhi(w.y) * bfhi(w.y) + bflo(w.z) * bflo(w.z) + bfhi(w.z) * bfhi(w.z) + bflo(w.w) * bflo(w.w) + bfhi(w.w) * bfhi(w.w); }
            qs += __shfl_xor(qs, 32);
            const float sc = rsqrtf(qs * (1.0f / HD) + EPS) * (1.4426950408889634f * 0.08838834764831845f);
#pragma unroll
            for (int s = 0; s < 8; ++s) { const u32x4 w = __builtin_bit_cast(u32x4, bq[s]); u32x4 o;
                o.x = cvt_pk_bf16(bflo(w.x) * sc, bfhi(w.x) * sc); o.y = cvt_pk_bf16(bflo(w.y) * sc, bfhi(w.y) * sc); o.z = cvt_pk_bf16(bflo(w.z) * sc, bfhi(w.z) * sc); o.w = cvt_pk_bf16(bflo(w.w) * sc, bfhi(w.w) * sc);
                bq[s] = __builtin_bit_cast(bf16x8, o); }
        }
        f32x16 O[4];
#pragma unroll
        for (int m = 0; m < 4; ++m)
#pragma unroll
            for (int r = 0; r < 16; ++r) O[m][r] = 0.f;
        float carry = 0.f;
        const bf16_t* kgl = PROJ + (size_t)(b * SEQ + (lane >> 4)) * DPROJ + C_K + h * HD + (lane & 15) * 8;
        const bf16_t* vgl = VT + ((size_t)bh * HD + (lane >> 2)) * VTS + (lane & 3) * 8;
        u32x4 stK[8], stV[8];
#define ATT_LOAD(kk0) do { _Pragma("unroll") for (int j = 0; j < 8; ++j) { \
            stK[j] = *(const u32x4*)(kgl + (size_t)((kk0) + 4 * j) * DPROJ); stV[j] = *(const u32x4*)(vgl + (size_t)(16 * j) * VTS + (kk0)); } } while (0)
        ATT_LOAD(q0);
        for (int k0 = q0; k0 >= 0; k0 -= 32) {
#pragma unroll
            for (int j = 0; j < 8; ++j) { *(u32x4*)(wl + j * 1024 + (kwbase ^ (64 * (j & 3)))) = stK[j]; *(u32x4*)(wl + 8192 + vwoff + j * 1024) = stV[j]; }
            const int kn = k0 >= 32 ? k0 - 32 : k0;
            ATT_LOAD(kn);
            __builtin_amdgcn_sched_barrier(0);
            f32x16 S;
#pragma unroll
            for (int r = 0; r < 16; ++r) S[r] = 0.f;
#pragma unroll
            for (int s = 0; s < 8; ++s) { const bf16x8 ak = *(const bf16x8*)(wl + kroff + (((2 * s + hh) ^ (prow & 15)) * 16)); S = MFMA32(ak, bq[s], S); }
            const bool diag = (k0 == q0);
            float sp[16];
            float R0 = 0.f, R1 = 0.f;
#pragma unroll
            for (int r = 0; r < 16; ++r) {
                const int kk = 16 * (r >> 3) + 8 * hh + (r & 7);
                const float z = S[r];
                float v = fmaxf(z, 0.f) + __builtin_amdgcn_logf(1.0f + __builtin_amdgcn_exp2f(-fabsf(z)));
                if (diag && kk >= l31) v = 0.f;
                sp[r] = v;
                if (r < 8) R0 += v; else R1 += v;
            }
            const float R0p = __shfl_xor(R0, 32), R1p = __shfl_xor(R1, 32);
            float suf_hi = carry - (hh == 0 ? R1p : 0.f);
            float suf_lo = carry - R1 - R1p - (hh == 0 ? R0p : 0.f);
            float w[16];
#pragma unroll
            for (int r = 15; r >= 8; --r) { w[r] = __builtin_amdgcn_exp2f(S[r] - sp[r] + suf_hi); suf_hi -= sp[r]; }
#pragma unroll
            for (int r = 7; r >= 0; --r) { w[r] = __builtin_amdgcn_exp2f(S[r] - sp[r] + suf_lo); suf_lo -= sp[r]; }
            if (diag) {
#pragma unroll
                for (int r = 0; r < 16; ++r) { const int kk = 16 * (r >> 3) + 8 * hh + (r & 7); if (kk >= l31) w[r] = 0.f; }
            }
            carry -= (R0 + R1 + R0p + R1p);
            bf16x8 wb[2];
            __builtin_amdgcn_sched_barrier(0);
#pragma unroll
            for (int s = 0; s < 2; ++s) { u32x4 pk; pk.x = cvt_pk_bf16(w[8 * s + 0], w[8 * s + 1]); pk.y = cvt_pk_bf16(w[8 * s + 2], w[8 * s + 3]); pk.z = cvt_pk_bf16(w[8 * s + 4], w[8 * s + 5]); pk.w = cvt_pk_bf16(w[8 * s + 6], w[8 * s + 7]);
                wb[s] = __builtin_bit_cast(bf16x8, pk); }
#pragma unroll
            for (int m = 0; m < 4; ++m)
#pragma unroll
                for (int s = 0; s < 2; ++s) { const bf16x8 vtf = *(const bf16x8*)(wl + 8192 + (32 * m + l31) * 64 + (((2 * s + hh) ^ (((32 * m + l31) >> 2) & 3)) * 16)); O[m] = MFMA32(vtf, wb[s], O[m]); }
            if (!__any(carry >= -150.1f)) break;
        }
        float ss = 0.f;
#pragma unroll
        for (int m = 0; m < 4; ++m)
#pragma unroll
            for (int r = 0; r < 16; ++r) ss += O[m][r] * O[m][r];
        ss += __shfl_xor(ss, 32);
        const float rstd = rsqrtf(ss * (1.0f / HD) + EPS);
        const float* mg = c.in[13] + (size_t)l * DM + DLRU + DCONV + h * HD + 4 * hh;
        bf16_t* yp = c.YMIX() + (size_t)(b * SEQ + q0 + l31) * DM + DLRU + DCONV + h * HD + 8 * hh;
#pragma unroll
        for (int m = 0; m < 4; ++m)
#pragma unroll
            for (int gp = 0; gp < 2; ++gp) { u32x2 o[2];
#pragma unroll
                for (int gg_ = 0; gg_ < 2; ++gg_) { const int g = 2 * gp + gg_; const f32x4 gg = *(const f32x4*)(mg + 32 * m + 8 * g);
                    o[gg_].x = cvt_pk_bf16(O[m][4 * g] * rstd * gg[0], O[m][4 * g + 1] * rstd * gg[1]); o[gg_].y = cvt_pk_bf16(O[m][4 * g + 2] * rstd * gg[2], O[m][4 * g + 3] * rstd * gg[3]); }
                const auto sx = __builtin_amdgcn_permlane32_swap(o[0].x, o[1].x, false, false); const auto sy = __builtin_amdgcn_permlane32_swap(o[0].y, o[1].y, false, false);
                *(u32x4*)(yp + 32 * m + 16 * gp) = (u32x4){sx[0], sy[0], sx[1], sy[1]};
            }
    }
}

#define XB_TMO      128
#define XB_XCNT(j)  (256  + 64 * (j))
#define XB_XSUB(j)  (1280 + 64 * (j))
#define XB_XGEN(j)  (2304 + 64 * (j))
#define XB_TOP      3328
#define XB_TOPGEN   3392
#define XCD_BAR_WORDS 3456
#define XB_SPIN_CAP (1u << 18)
__device__ __forceinline__ unsigned xb_ld(unsigned* p)              { return __hip_atomic_load(p, __ATOMIC_RELAXED, __HIP_MEMORY_SCOPE_AGENT); }
__device__ __forceinline__ unsigned xb_add(unsigned* p, unsigned v) { return __hip_atomic_fetch_add(p, v, __ATOMIC_RELAXED, __HIP_MEMORY_SCOPE_AGENT); }
__device__ __forceinline__ unsigned xb_xcc_id() { return (unsigned)__builtin_amdgcn_s_getreg((3 << 11) | 20) & 0xFu; }
#define XB_SPIN(cond, bar) do { unsigned _sp = 0; while (cond) { __builtin_amdgcn_s_sleep(1); \
    if ((++_sp & 255u) == 0u) { if (xb_ld(&(bar)[XB_TMO])) break; if (_sp > XB_SPIN_CAP) { atomicAdd(&(bar)[XB_TMO], 1u); break; } } } } while (0)
struct XcdBarrier { unsigned* bar; unsigned x; volatile LAS unsigned* st; };
__device__ __forceinline__ XcdBarrier xcd_barrier_post(unsigned* bar, volatile LAS unsigned* st) {
    XcdBarrier b; b.bar = bar; b.x = xb_xcc_id(); b.st = st;
    if (threadIdx.x == 0) (void)xb_add(&bar[XB_XCNT(b.x)], 1u);
    return b;
}
__device__ __forceinline__ void xcd_barrier_complete(unsigned* bar, unsigned x, unsigned& nloc, unsigned& nx) {
    const unsigned G = gridDim.x * gridDim.y * gridDim.z;
    unsigned sum, cnt, mine, sp = 0u;
    for (;;) {
        sum = 0u; cnt = 0u; mine = 0u;
#pragma unroll
        for (unsigned j = 0; j < 16; ++j) { const unsigned c = xb_ld(&bar[XB_XCNT(j)]); sum += c; cnt += (c > 0u) ? 1u : 0u; mine = (j == x) ? c : mine; }
        if (sum == G) break;
        __builtin_amdgcn_s_sleep(1);
        if ((++sp & 255u) == 0u) { if (xb_ld(&bar[XB_TMO])) break; if (sp > XB_SPIN_CAP) { atomicAdd(&bar[XB_TMO], 1u); break; } }
    }
    nloc = mine > 0u ? mine : 1u; nx = cnt > 0u ? cnt : 1u;
}
__device__ __forceinline__ void xcd_barrier(const XcdBarrier& b) {
    asm volatile("s_waitcnt vmcnt(0)" ::: "memory");
    __syncthreads();
    if (threadIdx.x == 0) {
        unsigned* bar = b.bar;
        __builtin_amdgcn_s_waitcnt(0);
        unsigned nloc = b.st[0], nx = b.st[1];
        if (nloc == 0u) { xcd_barrier_complete(bar, b.x, nloc, nx); b.st[0] = nloc; b.st[1] = nx; }
        const unsigned old = xb_add(&bar[XB_XSUB(b.x)], 1u);
        const unsigned gen = old / nloc;
        if (old + 1u == (gen + 1u) * nloc) {
            __builtin_amdgcn_fence(__ATOMIC_RELEASE, "agent");
            asm volatile("s_waitcnt vmcnt(0)" ::: "memory");
            const unsigned og = xb_add(&bar[XB_TOP], 1u);
            const unsigned tg = og / nx;
            if (og + 1u == (tg + 1u) * nx) xb_add(&bar[XB_TOPGEN], 1u);
            else XB_SPIN(xb_ld(&bar[XB_TOPGEN]) == tg, bar);
            __builtin_amdgcn_fence(__ATOMIC_ACQUIRE, "agent");
            xb_add(&bar[XB_XGEN(b.x)], 1u);
            asm volatile("s_waitcnt vmcnt(0)" ::: "memory");
        } else {
            XB_SPIN(xb_ld(&bar[XB_XGEN(b.x)]) == gen, bar);
            __builtin_amdgcn_fence(__ATOMIC_ACQUIRE, "agent");
            asm volatile("s_waitcnt vmcnt(0)" ::: "memory");
        }
    }
    __syncthreads();
}

constexpr int NPH_LAYER = 7, NPH = 1 + DEPTH * NPH_LAYER;
constexpr int LDS_TAB = g8::STAGE_BYTES, LDS_BARW = g8::STAGE_BYTES + 2048, LDS_KX = g8::STAGE_BYTES + 4096, LDS_BYTES = g8::STAGE_BYTES + 4096 + 8192;
__global__ void __launch_bounds__(512, 2) mega(Params p) {
    extern __shared__ __attribute__((aligned(16))) unsigned char lds_raw[];
    float* lds = (float*)lds_raw;
    LAS unsigned char* ldsl = (LAS unsigned char*)lds_raw;
    MoeTab* mt = (MoeTab*)(lds_raw + LDS_TAB);
    Ctx c0; c0.in.p = p.in; c0.in.z = 0; c0.out = p.out; c0.ws = p.ws;
    const int lo = p.ph_lo, hi = p.ph_hi;
    if (threadIdx.x == 0) *(uint4*)(lds_raw + LDS_BARW) = make_uint4(0u, 0u, 0u, 0u);
    __syncthreads();
    XcdBarrier bar = xcd_barrier_post(c0.ctl(), (volatile LAS unsigned*)(ldsl + LDS_BARW));
#ifndef PH_MASK
#define PH_MASK 0x1ff
#endif
#define PHT(k) ((k) == 0 ? 0 : 1 + ((k) - 1) % NPH_LAYER)
#define IN(k) (((PH_MASK >> PHT(k)) & 1) && lo <= (k) && (k) < hi)
#define SEAM(k) do { if (IN(k) && IN((k) + 1)) xcd_barrier(bar); } while (0)
#ifndef PROBE_RSH
#define PROBE_RSH 0
#endif
#ifndef PROBE_DUP
#define PROBE_DUP 0x0
#endif
#define REP(k) for (int rep_ = 0; rep_ < (((PROBE_DUP >> PHT(k)) & 1) ? 2 : 1); ++rep_)
    REP(0) if (IN(0)) { if (rep_) xcd_barrier(bar); const Ctx c = octx(c0); phase_convert(c, lds); phase_norm_in(c, 0); }
    SEAM(0);
#define LAYER_BODY(l) { \
        const int pb = 1 + l * NPH_LAYER; \
        REP(pb + 0) if (IN(pb + 0)) { if (rep_) xcd_barrier(bar); const Ctx c = octx(c0); const bool split_ = (gridDim.x == 256); \
            constexpr bool f8_ = f8in(l); constexpr int ku_ = f8_ ? DM / 2 : DM, ld_ = pb_in(l) / 2;        \
            { g8::DenseOrder S; S.init(T, DIN, gridDim.x, obid(), c.WIN(l), ld_); if (split_) S.lim = 1280; g8::MEpiProjT<f8_> E{c.PROJ(), c.VT(), (LAS float*)(ldsl + LDS_KX), c.in[11] + l * HD, c.in[12] + l * HD}; g8::gemm_mfma(ldsl, c.HB(), ld_, ld_, ku_, S, E); } \
            if (split_) { const int cb_ = obid(), kq_ = cb_ & 3; int k4_ = ku_ / 4; asm volatile("" : "+s"(k4_)); g8::SplitKOrder S{cb_, (const char*)(c.WIN(l) + (size_t)(20 * 256) * ld_ + kq_ * (ku_ / 4))}; g8::MEpiPartT<f8_> E{c.PT(), (LAS float*)(ldsl + LDS_KX)}; g8::gemm_mfma(ldsl, c.HB() + kq_ * (ku_ / 4), ld_, ld_, k4_, S, E); } } \
        SEAM(pb + 0); \
        REP(pb + 1) if (IN(pb + 1)) { if (rep_) xcd_barrier(bar); const Ctx c = octx(c0); if (gridDim.x == 256) phase_vreduce(c); phase_convb(c, l); if (PROBE_SUB == 4) phase_convb(c, l); phase_lruA(c, l, lds_raw); if (PROBE_SUB == 3) phase_lruA(c, l, lds_raw); } \
        SEAM(pb + 1); \
        REP(pb + 2) if (IN(pb + 2)) { if (rep_) xcd_barrier(bar); const Ctx c = octx(c0); phase_lruB(c, l, lds_raw); if (PROBE_SUB == 2) phase_lruB(c, l, lds_raw); phase_attn(c, l, lds_raw); if (PROBE_SUB == 1) phase_attn(c, l, lds_raw); } \
        SEAM(pb + 2); \
        REP(pb + 3) if (IN(pb + 3)) { if (rep_) xcd_barrier(bar); const Ctx c = octx(c0); g8::DenseOrder S; S.init(T, DM, gridDim.x, obid(), c.WOUT(l), DM); if (PROBE_RSH == 3 && l == 0) S.rsh = 1; g8::MEpiOut<l == 0> E{c.in[0], c.XB(), c.X1(), c.X1F8()}; g8::gemm_mfma(ldsl, c.YMIX(), DM, DM, DM, S, E);       } \
        SEAM(pb + 3); \
        REP(pb + 4) if (IN(pb + 4)) { if (rep_) xcd_barrier(bar); const Ctx c = octx(c0); phase_router_mfma(c, l, lds); } \
        SEAM(pb + 4); \
        REP(pb + 5) if (IN(pb + 5)) { if (rep_) xcd_barrier(bar); const Ctx c = octx(c0); build_moe_tab(c, l, mt); \
            const int G_ = (int)gridDim.x, cb_ = obid(), n1_ = __builtin_amdgcn_readfirstlane(mt->tstart[NEXP]) * 4, R_ = n1_ % G_, n1e_ = n1_ - R_, rtA_ = n1e_ >> 2; \
            { g8::MoeOrder<true, 4, DM / 2, (size_t)1024 * DM, (size_t)256 * DM> S{mt, c.LIST(), G_, cb_, (const char*)c.WGU(l)}; g8::MEpiGU E{c.HID8(), c.LISTR(), mt, c.RTC(l), n1e_}; g8::gemm_mfma(ldsl, (const bf16_t*)c.X1F8(), DM / 2, DM / 2, DM / 2, S, E); }       \
            g8::moe_wait_dep(c.RTC(l), cb_, G_, R_, rtA_); \
            { g8::MoeOrder2 S{mt, G_, cb_, R_, rtA_, (const char*)c.WD(l)}; if (PROBE_RSH == 6) S.rsh = 1; g8::MEpiDown8 E{c.YPAD8()}; int k2_ = DEXP / 2; asm volatile("" : "+s"(k2_)); g8::gemm_mfma(ldsl, (const bf16_t*)c.HID8(), DEXP / 2, DEXP / 2, k2_, S, E); } }       \
        SEAM(pb + 5); \
        REP(pb + 6) if (IN(pb + 6)) { if (rep_) xcd_barrier(bar); const Ctx c = octx(c0); build_moe_tab(c, l, mt); if (PROBE_SUB == 6) { phase_combine<true>(c, l, mt); xcd_barrier(bar); } phase_combine<false>(c, l, mt); } \
        SEAM(pb + 6); \
    }
    LAYER_BODY(0)
    LAYER_BODY(1)
#undef LAYER_BODY
#undef IN
#undef SEAM
}

#ifndef N_LAUNCH_SPLIT
#define N_LAUNCH_SPLIT 0
#endif
extern "C" void kernel_launch(void* const* d_in, const int* in_sizes, int n_in, void* d_out, int out_size, void* d_ws, size_t ws_size, hipStream_t stream) {
    static int grid = 0;
    if (grid == 0) {
        if (n_in != 23 || out_size != T * DM || ws_size < WS_END) { fprintf(stderr, "kernel_launch: unexpected problem (n_in %d out %d ws %zu need %zu)\n", n_in, out_size, ws_size, (size_t)WS_END); grid = -1; return; }
        int dev = 0, cus = 0, per_cu = 0;
        if (hipGetDevice(&dev) != hipSuccess || hipDeviceGetAttribute(&cus, hipDeviceAttributeMultiprocessorCount, dev) != hipSuccess) { fprintf(stderr, "kernel_launch: device query failed\n"); grid = -1; return; }
        if (hipFuncSetAttribute((const void*)mega, hipFuncAttributeMaxDynamicSharedMemorySize, LDS_BYTES) != hipSuccess) { fprintf(stderr, "kernel_launch: hipFuncSetAttribute failed\n"); grid = -1; return; }
        if (hipOccupancyMaxActiveBlocksPerMultiprocessor(&per_cu, (const void*)mega, 512, LDS_BYTES) != hipSuccess || per_cu < 1) { fprintf(stderr, "kernel_launch: occupancy query says %d blocks per CU\n", per_cu); }
        (void)hipGetLastError();
        grid = cus;
    }
    if (grid < 0) return;
    (void)hipMemsetAsync((char*)d_ws + OFF_CTL, 0, SZ_CTL, stream);
    Params p{};
    for (int i = 0; i < 23; ++i) p.in[i] = (const float*)d_in[i];
    p.out = (float*)d_out; p.ws = (unsigned char*)d_ws;
    if (N_LAUNCH_SPLIT) { for (int ph = 0; ph < NPH; ++ph) { p.ph_lo = ph; p.ph_hi = ph + 1; hipLaunchKernelGGL(mega, dim3(grid), dim3(512), LDS_BYTES, stream, p); } }
    else { p.ph_lo = 0; p.ph_hi = NPH; hipLaunchKernelGGL(mega, dim3(grid), dim3(512), LDS_BYTES, stream, p); }
}
```

```cpp
#include <hip/hip_runtime.h>
#include <stdint.h>
#include <stdio.h>

typedef unsigned short bf16_t;
typedef float f32x4 __attribute__((ext_vector_type(4)));
typedef unsigned u32x4 __attribute__((ext_vector_type(4)));
typedef unsigned u32x2 __attribute__((ext_vector_type(2)));
typedef short bf16x8 __attribute__((ext_vector_type(8)));

constexpr int T = 16384, DM = 2048, DIN = 5376, DPROJ = 4608, SEQ = 4096, NB = 4, DEPTH = 2;
constexpr int DLRU = 768, DCONV = 512, DSB = 768, HD = 128, NHL = 6, NHS = 6;
constexpr int NEXP = 32, DEXP = 512, MAXTILES = 160, PADROWS = MAXTILES * 256;
constexpr float EPS = 1e-6f;
constexpr float YSCALE_G = 8.0f;
constexpr float SX8 = 8.0f, SW1 = 64.0f, SH8 = 8.0f, SW2 = 32.0f;
#ifndef F8_INPROJ_MASK
#define F8_INPROJ_MASK 2
#endif
constexpr bool f8in(int l) { return ((F8_INPROJ_MASK >> l) & 1) != 0; }
constexpr float SHB = 16.0f, SWI = 64.0f;
#ifndef PITCH_PAD
#define PITCH_PAD 128
#endif
constexpr int pb_in(int l) { return (f8in(l) ? DM : DM * 2) + PITCH_PAD; }
constexpr int VTS = SEQ + 64;
constexpr int C_XA = 0, C_GA = 768, C_BG = 1536, C_CG = 2048, C_XB = 2560, C_Q = 3072, C_K = 3840, C_V = 4608;

constexpr size_t AL(size_t x) { return (x + 255) & ~(size_t)255; }
constexpr size_t SZ_WIN = (size_t)DIN * (DM * 2 + 256), SZ_WOUT = (size_t)DM * DM * 2, SZ_WGU = (size_t)NEXP * 1024 * DM * 2, SZ_WD = (size_t)NEXP * DM * DEXP * 2;
constexpr size_t SZ_WA = (size_t)NHL * HD * HD * 2, SZ_WR = (size_t)48 * DM * 4;
constexpr size_t OFF_CTL = 0, SZ_CTL = 131072;
constexpr size_t OFF_WIN = OFF_CTL + SZ_CTL;
constexpr size_t OFF_WOUT = OFF_WIN + DEPTH * SZ_WIN;
constexpr size_t OFF_WGU = OFF_WOUT + DEPTH * SZ_WOUT;
constexpr size_t OFF_WD = OFF_WGU + DEPTH * SZ_WGU;
constexpr size_t OFF_WA = OFF_WD + DEPTH * SZ_WD;
constexpr size_t OFF_WX = OFF_WA + DEPTH * SZ_WA;
constexpr size_t OFF_WR = OFF_WX + DEPTH * SZ_WA;
constexpr size_t OFF_HB = OFF_WR + DEPTH * SZ_WR;
constexpr size_t OFF_PROJ = OFF_HB + (size_t)T * (DM * 2 + 256);
constexpr size_t OFF_VT = OFF_PROJ + (size_t)T * DPROJ * 2;
constexpr size_t OFF_YPAD = OFF_PROJ;
constexpr size_t OFF_YMIX = OFF_VT + (size_t)NB * NHS * HD * VTS * 2;
constexpr size_t OFF_X = OFF_YMIX + (size_t)T * DM * 2;
constexpr size_t OFF_HID = OFF_X + (size_t)T * DM * 4;
constexpr size_t OFF_AGG = OFF_HID + (size_t)PADROWS * DEXP * 2;
constexpr size_t OFF_ROUTE = OFF_AGG + (size_t)256 * DLRU * 8;
constexpr size_t OFF_LIST = OFF_ROUTE + (size_t)T * 8 * 4;
constexpr size_t OFF_LISTR = OFF_LIST + (size_t)NEXP * T * 4;
constexpr size_t OFF_DB = OFF_LISTR + (size_t)NEXP * T * 4;
constexpr size_t WS_END = OFF_DB + (size_t)T * DM * 2;
static_assert((size_t)PADROWS * DM * 2 <= (size_t)T * DPROJ * 2 + (size_t)NB * NHS * HD * VTS * 2, "YPAD alias");
constexpr int CW_RT = 16384;
constexpr int CW_CNT = 8192;

typedef __bf16 bf16v2_t __attribute__((ext_vector_type(2)));
typedef float f32v2_t __attribute__((ext_vector_type(2)));
__device__ __forceinline__ unsigned cvt_pk_bf16(float lo, float hi) { const f32v2_t f = {lo, hi}; const bf16v2_t b = __builtin_convertvector(f, bf16v2_t); return __builtin_bit_cast(unsigned, b); }
__device__ __forceinline__ bf16_t f2bf(float f) { return (bf16_t)(cvt_pk_bf16(f, 0.f) & 0xffffu); }
__device__ __forceinline__ float bf2f(bf16_t b) { return __uint_as_float(((unsigned)b) << 16); }
__device__ __forceinline__ float bflo(unsigned w) { return __uint_as_float(w << 16); }
__device__ __forceinline__ float bfhi(unsigned w) { return __uint_as_float(w & 0xffff0000u); }
__device__ __forceinline__ float sat8(float v) { return __builtin_amdgcn_fmed3f(v, -448.0f, 448.0f); }
__device__ __forceinline__ float wave_sum(float v) {
#pragma unroll
    for (int o = 32; o >= 1; o >>= 1) v += __shfl_xor(v, o);
    return v;
}
__device__ __forceinline__ float fast_exp(float x) { return __builtin_amdgcn_exp2f(x * 1.4426950408889634f); }
__device__ __forceinline__ float sigmoidf_(float x) { return __builtin_amdgcn_rcpf(1.0f + fast_exp(-x)); }
__device__ __forceinline__ float one_minus_exp(float x) { const float s = -x * (1.0f + x * (0.5f + x * 0.16666667f)); const float d = 1.0f - fast_exp(x); return x > -0.02f ? s : d; }
__device__ __forceinline__ float softplusf_(float x) { return fmaxf(x, 0.f) + log1pf(__expf(-fabsf(x))); }
__device__ __forceinline__ float gelu_tanh(float x) { const float u2 = 1.5957691216057308f * (x + 0.044715f * x * x * x); return x * sigmoidf_(u2); }

__device__ __forceinline__ int otid() { int t = (int)threadIdx.x; asm volatile("" : "+v"(t)); return t; }
__device__ __forceinline__ int obid() { int b = (int)blockIdx.x; asm volatile("" : "+s"(b)); return b; }
#ifndef PROBE_SUB
#define PROBE_SUB 0
#endif
struct Params { const float* in[23]; float* out; unsigned char* ws; int ph_lo, ph_hi; };

struct InProxy { const float* const* p; int z; __device__ __forceinline__ const float* operator[](int k) const { return p[k + z]; } };
struct Ctx {
    InProxy in; float* out; unsigned char* ws;
    __device__ __forceinline__ unsigned* ctl() const { return (unsigned*)(ws + OFF_CTL); }
    __device__ __forceinline__ bf16_t* WIN(int l) const { return (bf16_t*)(ws + OFF_WIN + l * SZ_WIN); }
    __device__ __forceinline__ bf16_t* WOUT(int l) const { return (bf16_t*)(ws + OFF_WOUT + l * SZ_WOUT); }
    __device__ __forceinline__ bf16_t* WGU(int l) const { return (bf16_t*)(ws + OFF_WGU + l * SZ_WGU); }
    __device__ __forceinline__ bf16_t* WD(int l) const { return (bf16_t*)(ws + OFF_WD + l * SZ_WD); }
    __device__ __forceinline__ bf16_t* WA(int l) const { return (bf16_t*)(ws + OFF_WA + l * SZ_WA); }
    __device__ __forceinline__ bf16_t* WX(int l) const { return (bf16_t*)(ws + OFF_WX + l * SZ_WA); }
    __device__ __forceinline__ float* WR(int l) const { return (float*)(ws + OFF_WR + l * SZ_WR); }
    __device__ __forceinline__ unsigned* RTC(int l) const { return ctl() + CW_RT + l * 8192; }
    __device__ __forceinline__ unsigned* CNT(int l) const { return ctl() + CW_CNT + l * 2048; }
#define WSP(name, type, off) __device__ __forceinline__ type* name() const { return (type*)(ws + (off)); }
    WSP(HB, bf16_t, OFF_HB) WSP(PROJ, bf16_t, OFF_PROJ) WSP(VT, bf16_t, OFF_VT) WSP(YPAD, bf16_t, OFF_YPAD) WSP(YPAD8, unsigned char, OFF_YPAD) WSP(YMIX, bf16_t, OFF_YMIX) WSP(HID, bf16_t, OFF_HID)
    WSP(X, float, OFF_X) WSP(XB, bf16_t, OFF_X) WSP(AGG, float, OFF_AGG) WSP(ROUTE, unsigned, OFF_ROUTE) WSP(LIST, int, OFF_LIST) WSP(LISTR, float, OFF_LISTR) WSP(PT, bf16_t, OFF_X + (size_t)T * DM * 2) WSP(X1, bf16_t, OFF_X + (size_t)T * DM * 2) WSP(X1F8, unsigned char, OFF_HB) WSP(HID8, unsigned char, OFF_HID) WSP(DB, bf16_t, OFF_DB) WSP(HL, bf16_t, OFF_DB) WSP(PL, bf16_t, OFF_DB + (size_t)T * DLRU * 2)
#undef WSP
};

__device__ __forceinline__ Ctx octx(const Ctx& c) { int z = 0; asm volatile("" : "+s"(z)); Ctx r; r.in.p = c.in.p; r.in.z = z; r.out = c.out + z; r.ws = c.ws + z; return r; }

__device__ __forceinline__ void cvt_tile_out(const float* tile, int st, int r0, bf16_t* dst, int ld_dst, int drow0, bool f8) {
    const int rr = (st & 7) * 8;
    if (f8) {
#pragma unroll
        for (int p = 0; p < 2; ++p) {
            const int c = (st >> 3) + 32 * p; int w0 = 0, w1 = 0;
            w0 = __builtin_amdgcn_cvt_pk_fp8_f32(tile[(rr + 0) * 65 + c], tile[(rr + 1) * 65 + c], w0, false); w0 = __builtin_amdgcn_cvt_pk_fp8_f32(tile[(rr + 2) * 65 + c], tile[(rr + 3) * 65 + c], w0, true);
            w1 = __builtin_amdgcn_cvt_pk_fp8_f32(tile[(rr + 4) * 65 + c], tile[(rr + 5) * 65 + c], w1, false); w1 = __builtin_amdgcn_cvt_pk_fp8_f32(tile[(rr + 6) * 65 + c], tile[(rr + 7) * 65 + c], w1, true);
            *(u32x2*)((unsigned char*)dst + (size_t)(drow0 + c) * ld_dst + r0 + rr) = (u32x2){(unsigned)w0, (unsigned)w1};
        }
        return;
    }
#pragma unroll
    for (int p = 0; p < 2; ++p) {
        const int c = (st >> 3) + 32 * p;
        u32x4 w;
        w.x = cvt_pk_bf16(tile[(rr + 0) * 65 + c], tile[(rr + 1) * 65 + c]); w.y = cvt_pk_bf16(tile[(rr + 2) * 65 + c], tile[(rr + 3) * 65 + c]);
        w.z = cvt_pk_bf16(tile[(rr + 4) * 65 + c], tile[(rr + 5) * 65 + c]); w.w = cvt_pk_bf16(tile[(rr + 6) * 65 + c], tile[(rr + 7) * 65 + c]);
        *(u32x4*)(dst + (size_t)(drow0 + c) * ld_dst + r0 + rr) = w;
    }
}
constexpr int CV_WIN = 32 * 84, CV_WOUT = 32 * 32, CV_EXP = 32 * 8  , CV_G = NEXP * CV_EXP, CV_LRU = NHL * 4;
constexpr int CV_PER_LAYER = CV_WIN + CV_WOUT + 3 * CV_G + 2 * CV_LRU;
struct CvtTile { const float* src; bf16_t* dst; const float* gk; int ld_src, ld_dst, r0, c0, drow0; float sc; };
__device__ __forceinline__ void cvt_decode(const Ctx& c, int id, CvtTile& t) {
    const int l = id / CV_PER_LAYER; int j = id % CV_PER_LAYER; t.gk = nullptr; t.sc = 1.0f;
    if (j < CV_WIN) { t.src = c.in[2] + (size_t)l * DM * DIN; t.ld_src = DIN; { const int g = j >> 3, kp = g / 21, nq = g % 21; t.r0 = (2 * kp + ((j >> 2) & 1)) * 64; t.c0 = (4 * nq + (j & 3)) * 64; } t.dst = c.WIN(l); t.ld_dst = f8in(l) ? pb_in(l) : pb_in(l) / 2; t.drow0 = t.c0; if (f8in(l)) t.sc = -SWI; }
    else if ((j -= CV_WIN) < CV_WOUT) { t.src = c.in[14] + (size_t)l * DM * DM; t.ld_src = DM; { const int g = j >> 3, kp = g / 8, nq = g % 8; t.r0 = (2 * kp + ((j >> 2) & 1)) * 64; t.c0 = (4 * nq + (j & 3)) * 64; } t.dst = c.WOUT(l); t.ld_dst = DM; t.drow0 = t.c0; }
    else if ((j -= CV_WOUT) < 2 * CV_G) {
        const int isup = j / CV_G; j %= CV_G; const int e = j / CV_EXP; j %= CV_EXP;
        t.src = c.in[isup ? 21 : 20] + ((size_t)l * NEXP + e) * DM * DEXP; t.ld_src = DEXP; { const int g = j >> 3, kp = g / 2, nq = g % 2; t.r0 = (2 * kp + ((j >> 2) & 1)) * 64; t.c0 = (4 * nq + (j & 3)) * 64; }
        t.dst = (bf16_t*)((unsigned char*)c.WGU(l) + (size_t)e * 1024 * DM); t.ld_dst = DM; t.drow0 = 256 * (t.c0 / 128) + 128 * isup + (t.c0 % 128); t.gk = c.in[15] + (size_t)l * DM; t.sc = -SW1;
    } else if ((j -= 2 * CV_G) < CV_G) {
        const int e = j / CV_EXP; j %= CV_EXP;
        t.src = c.in[22] + ((size_t)l * NEXP + e) * DEXP * DM; t.ld_src = DM; { const int g = j >> 3, kp = g / 8, nq = g % 8; t.r0 = (2 * kp + ((j >> 2) & 1)) * 64; t.c0 = (4 * nq + (j & 3)) * 64; }
        t.dst = (bf16_t*)((unsigned char*)c.WD(l) + (size_t)e * DM * DEXP); t.ld_dst = DEXP; t.drow0 = t.c0; t.sc = -SW2;
    } else { j -= CV_G; const int isx = j / CV_LRU; j %= CV_LRU; const int h = j / 4; j %= 4;
        t.src = c.in[isx ? 7 : 5] + ((size_t)l * NHL + h) * HD * HD; t.ld_src = HD; t.r0 = (j / 2) * 64; t.c0 = (j % 2) * 64;
        t.dst = (isx ? c.WX(l) : c.WA(l)) + (size_t)h * HD * HD; t.ld_dst = HD; t.drow0 = t.c0; }
}
constexpr int CVT_NT = 4;
__device__ __forceinline__ void phase_convert(const Ctx& c, float* lds) {
    const int tid = otid(), sb = tid >> 8, st = tid & 255;
    float* tile0 = lds + sb * (CVT_NT * 64 * 65);
    const int total = DEPTH * CV_PER_LAYER;
    const int nsub = gridDim.x * 2 * CVT_NT;
    const int idb = (obid() * 2 + sb) * CVT_NT;
    CvtTile tA[CVT_NT]; f32x4 vA[CVT_NT][4];
#define CVT_LOAD(T_, V_, base_) do { _Pragma("unroll") for (int k = 0; k < CVT_NT; ++k) { const int id_ = (base_) + idb + k; cvt_decode(c, id_ < total ? id_ : 0, T_[k]); \
        _Pragma("unroll") for (int i = 0; i < 4; ++i) V_[k][i] = __builtin_nontemporal_load((const f32x4*)(T_[k].src + (size_t)(T_[k].r0 + (st >> 4) + 16 * i) * T_[k].ld_src + T_[k].c0 + (st & 15) * 4)); } } while (0)
#define CVT_FLUSH(T_, V_, base_) do { _Pragma("unroll") for (int k = 0; k < CVT_NT; ++k) _Pragma("unroll") for (int i = 0; i < 4; ++i) { \
            float* p = tile0 + k * (64 * 65) + ((st >> 4) + 16 * i) * 65 + (st & 15) * 4; const float gs_ = (T_[k].gk ? T_[k].gk[T_[k].r0 + (st >> 4) + 16 * i] : 1.0f) * fabsf(T_[k].sc); \
            p[0] = V_[k][i][0] * gs_; p[1] = V_[k][i][1] * gs_; p[2] = V_[k][i][2] * gs_; p[3] = V_[k][i][3] * gs_; } \
        __syncthreads(); \
        _Pragma("unroll") for (int k = 0; k < CVT_NT; ++k) if ((base_) + idb + k < total) cvt_tile_out(tile0 + k * (64 * 65), st, T_[k].r0, T_[k].dst, T_[k].ld_dst, T_[k].drow0, T_[k].sc < 0.f); \
        __syncthreads(); } while (0)
    for (int base = 0; base < total; base += nsub) { CVT_LOAD(tA, vA, base); CVT_FLUSH(tA, vA, base); }
#undef CVT_LOAD
#undef CVT_FLUSH
    for (int i = obid() * blockDim.x + tid; i < DEPTH * 48 * DM; i += gridDim.x * blockDim.x) {
        const int l = i / (48 * DM), n = (i / DM) % 48, k = i % DM;
        float v = 0.f;
        if (n < 4) v = c.in[16][((size_t)l * DM + k) * 4 + n]; else if (n < 36) v = c.in[18][((size_t)l * DM + k) * 32 + (n - 4)];
        const float wg = v * c.in[15][(size_t)l * DM + k]; const bf16_t hi = f2bf(wg);
        bf16_t* wr = (bf16_t*)c.WR(l); wr[(size_t)n * DM + k] = hi; wr[(size_t)(48 + n) * DM + k] = f2bf(wg - bf2f(hi));
    }
}

__device__ __forceinline__ void norm_store_row(const f32x4 (&v)[8], const float* g, bf16_t* dst, int lane) {
    float s = 0.f;
#pragma unroll
    for (int j = 0; j < 8; ++j) s += v[j][0] * v[j][0] + v[j][1] * v[j][1] + v[j][2] * v[j][2] + v[j][3] * v[j][3];
    s = wave_sum(s);
    const float rstd = rsqrtf(s * (1.0f / DM) + EPS);
#pragma unroll
    for (int j = 0; j < 8; ++j) {
        const f32x4 gg = *(const f32x4*)(g + j * 256 + lane * 4);
        u32x2 w; w.x = cvt_pk_bf16(v[j][0] * rstd * gg[0], v[j][1] * rstd * gg[1]); w.y = cvt_pk_bf16(v[j][2] * rstd * gg[2], v[j][3] * rstd * gg[3]);
        *(u32x2*)(dst + j * 256 + lane * 4) = w;
    }
}
__device__ __forceinline__ void norm_store_row8(const f32x4 (&v)[8], const float* g, unsigned char* dst, int lane) {
    float s = 0.f;
#pragma unroll
    for (int j = 0; j < 8; ++j) s += v[j][0] * v[j][0] + v[j][1] * v[j][1] + v[j][2] * v[j][2] + v[j][3] * v[j][3];
    s = wave_sum(s);
    const float rstd = rsqrtf(s * (1.0f / DM) + EPS) * SHB;
#pragma unroll
    for (int j = 0; j < 8; ++j) {
        const f32x4 gg = *(const f32x4*)(g + j * 256 + lane * 4);
        int w = 0; w = __builtin_amdgcn_cvt_pk_fp8_f32(sat8(v[j][0] * rstd * gg[0]), sat8(v[j][1] * rstd * gg[1]), w, false); w = __builtin_amdgcn_cvt_pk_fp8_f32(sat8(v[j][2] * rstd * gg[2]), sat8(v[j][3] * rstd * gg[3]), w, true);
        *(int*)(dst + j * 256 + lane * 4) = w;
    }
}
__device__ __forceinline__ void phase_norm_in(const Ctx& c, int l) {
    const int tid = otid(), lane = tid & 63, wv = tid >> 6, stride = gridDim.x * 8;
    for (int r = obid() * 8 + wv; r < T; r += 4 * stride) {
        f32x4 v[4][8];
#pragma unroll
        for (int k = 0; k < 4; ++k) { const int rr = (r + k * stride < T) ? r + k * stride : r;
#pragma unroll
            for (int j = 0; j < 8; ++j) v[k][j] = *(const f32x4*)(c.in[0] + (size_t)rr * DM + j * 256 + lane * 4); }
#pragma unroll
        for (int k = 0; k < 4; ++k) if (k == 0 || r + k * stride < T) norm_store_row(v[k], c.in[1] + (size_t)l * DM, (bf16_t*)((unsigned char*)c.HB() + (size_t)(r + k * stride) * pb_in(0)), lane);
    }
}

struct MoeTab { int cnt[NEXP]; int tstart[NEXP + 1]; int texp[MAXTILES]; };
__device__ __forceinline__ void build_moe_tab(const Ctx& c, int l, MoeTab* mt) {
    __syncthreads();
    const int tid = otid();
    if (tid < 64) {
        const int n = tid < NEXP ? (int)__hip_atomic_load(c.CNT(l) + tid * 64, __ATOMIC_RELAXED, __HIP_MEMORY_SCOPE_AGENT) : 0;
        const int nt = (n + 255) >> 8;
        int incl = nt;
#pragma unroll
        for (int o = 1; o < 32; o <<= 1) { const int v = __shfl_up(incl, o); if (tid >= o) incl += v; }
        const int excl = incl - nt;
        if (tid < NEXP) { mt->cnt[tid] = n; mt->tstart[tid] = excl; for (int i = 0; i < nt; ++i) if (excl + i < MAXTILES) mt->texp[excl + i] = tid; }
        if (tid == NEXP - 1) mt->tstart[NEXP] = incl < MAXTILES ? incl : MAXTILES;
    }
    __syncthreads();
}

template <bool DRY> __device__ __forceinline__ void phase_combine(const Ctx& c, int l, const MoeTab* mt) {
    const int tid = otid(), lane = tid & 63, wv = tid >> 6, stride = gridDim.x * 8;
    bf16_t* XB = c.XB(); const bf16_t* X1 = c.X1(); const unsigned char* YPAD = c.YPAD8(); const unsigned* ROUTE = c.ROUTE();
    for (int r = obid() * 8 + wv; r < T; r += 2 * stride) {
        f32x4 v[2][8]; unsigned ya[2][8], yb[2][8]; u32x2 yd[2][8]; float g0[2], g1[2]; int rr[2];
#pragma unroll
        for (int k = 0; k < 2; ++k) {
            rr[k] = (r + k * stride < T) ? r + k * stride : r;
            const u32x4 ra = *(const u32x4*)(ROUTE + (size_t)rr[k] * 8); const u32x2 rb = *(const u32x2*)(ROUTE + (size_t)rr[k] * 8 + 4);
            const int e0 = ra.x, p0 = ra.y, e1 = ra.w, p1 = rb.x; g0[k] = __uint_as_float(ra.z) * (1.0f / YSCALE_G); g1[k] = __uint_as_float(rb.y) * (1.0f / YSCALE_G);
            const unsigned char* y0 = YPAD + ((size_t)mt->tstart[e0] * 256 + p0) * DM + lane * 4; const unsigned char* y1 = YPAD + ((size_t)mt->tstart[e1] * 256 + p1) * DM + lane * 4;
            const bf16_t* dp = X1 + (size_t)rr[k] * DM + lane * 4;
#pragma unroll
            for (int j = 0; j < 8; ++j) { v[k][j] = (f32x4){0.f, 0.f, 0.f, 0.f};
                ya[k][j] = *(const unsigned*)(y0 + j * 256); yb[k][j] = *(const unsigned*)(y1 + j * 256); yd[k][j] = *(const u32x2*)(dp + j * 256); }
        }
        __builtin_amdgcn_sched_barrier(0);
#pragma unroll
        for (int k = 0; k < 2; ++k) {
            if (k == 0 || r + stride < T) {
#pragma unroll
                for (int j = 0; j < 8; ++j) {
                    typedef float f32x2_t __attribute__((ext_vector_type(2)));
                    const f32x2_t a01 = __builtin_amdgcn_cvt_pk_f32_fp8((int)ya[k][j], false), a23 = __builtin_amdgcn_cvt_pk_f32_fp8((int)ya[k][j], true);
                    const f32x2_t b01 = __builtin_amdgcn_cvt_pk_f32_fp8((int)yb[k][j], false), b23 = __builtin_amdgcn_cvt_pk_f32_fp8((int)yb[k][j], true);
                    v[k][j][0] += bflo(yd[k][j].x) + g0[k] * a01.x + g1[k] * b01.x; v[k][j][1] += bfhi(yd[k][j].x) + g0[k] * a01.y + g1[k] * b01.y;
                    v[k][j][2] += bflo(yd[k][j].y) + g0[k] * a23.x + g1[k] * b23.x; v[k][j][3] += bfhi(yd[k][j].y) + g0[k] * a23.y + g1[k] * b23.y;
                }
                if (l == DEPTH - 1) {
                    if (!DRY) {
#pragma unroll
                    for (int j = 0; j < 8; ++j) *(f32x4*)(c.out + (size_t)rr[k] * DM + j * 256 + lane * 4) = v[k][j]; }
                    else norm_store_row(v[k], c.in[1], c.HB() + (size_t)rr[k] * DM, lane);
                } else {
                    if (!DRY) {
#pragma unroll
                    for (int j = 0; j < 8; ++j) { u32x2 xw; xw.x = cvt_pk_bf16(v[k][j][0], v[k][j][1]); xw.y = cvt_pk_bf16(v[k][j][2], v[k][j][3]); *(u32x2*)(XB + (size_t)rr[k] * DM + j * 256 + lane * 4) = xw; } }
                    if (f8in(l + 1)) norm_store_row8(v[k], c.in[1] + (size_t)(l + 1) * DM, (unsigned char*)c.HB() + (size_t)rr[k] * pb_in(l + 1), lane);
                    else norm_store_row(v[k], c.in[1] + (size_t)(l + 1) * DM, (bf16_t*)((unsigned char*)c.HB() + (size_t)rr[k] * pb_in(l + 1)), lane);
                }
            }
        }
    }
}

__device__ __forceinline__ void phase_router_mfma(const Ctx& c, int l, float* lds) {
    float* LG = lds; float* SS = lds + 26624; float* RS = lds + 27136; int* LC = (int*)(lds + 27200); int* LB = (int*)(lds + 27232);
    const int tid = otid(), lane = tid & 63, wv = tid >> 6, rt = wv & 3, kh = wv >> 2, q = lane >> 4, l15 = lane & 15;
    const float* WR = c.WR(l);
    for (int tile = obid(); tile < T / 64; tile += gridDim.x) {
        const int r0 = tile * 64;
        f32x4 acc[4][3];
#pragma unroll
        for (int g = 0; g < 4; ++g)
#pragma unroll
            for (int ct = 0; ct < 3; ++ct) acc[g][ct] = (f32x4){0.f, 0.f, 0.f, 0.f};
        const bf16_t* xp = c.X1() + (size_t)(r0 + l15) * DM + wv * 256 + 8 * q;
        const bf16_t* wh = (const bf16_t*)WR + (size_t)l15 * DM + wv * 256 + 8 * q; const bf16_t* wl = wh + (size_t)48 * DM;
        float ssq[4] = {0.f, 0.f, 0.f, 0.f};
        bf16x8 xa[2][4], bh[2][3], bl[2][3];
#pragma unroll
        for (int st = 0; st < 2; ++st)
#pragma unroll
            for (int g = 0; g < 4; ++g) xa[st][g] = *(const bf16x8*)(xp + (size_t)(16 * g) * DM + 32 * st);
#pragma unroll
        for (int ct = 0; ct < 3; ++ct) { bh[0][ct] = *(const bf16x8*)(wh + (size_t)(16 * ct) * DM); bl[0][ct] = *(const bf16x8*)(wl + (size_t)(16 * ct) * DM); }
#define RT_STEP(st_, cur_, nxt_, ldb_, ldx_) do { \
            if (ldb_) { _Pragma("unroll") for (int ct = 0; ct < 3; ++ct) { bh[nxt_][ct] = *(const bf16x8*)(wh + (size_t)(16 * ct) * DM + 32 * ((st_) + 1)); bl[nxt_][ct] = *(const bf16x8*)(wl + (size_t)(16 * ct) * DM + 32 * ((st_) + 1)); } } \
            __builtin_amdgcn_sched_barrier(0); \
            _Pragma("unroll") for (int g = 0; g < 4; ++g) { \
                const bf16x8 xv = xa[cur_][g]; \
                _Pragma("unroll") for (int j = 0; j < 8; ++j) { const float xf = __uint_as_float(((unsigned)(unsigned short)xv[j]) << 16); ssq[g] += xf * xf; } \
                _Pragma("unroll") for (int ct = 0; ct < 3; ++ct) { acc[g][ct] = __builtin_amdgcn_mfma_f32_16x16x32_bf16(xv, bh[cur_][ct], acc[g][ct], 0, 0, 0); acc[g][ct] = __builtin_amdgcn_mfma_f32_16x16x32_bf16(xv, bl[cur_][ct], acc[g][ct], 0, 0, 0); } \
                if (ldx_) xa[cur_][g] = *(const bf16x8*)(xp + (size_t)(16 * g) * DM + 32 * ((st_) + 2)); } \
            __builtin_amdgcn_sched_barrier(0); } while (0)
#pragma unroll 1
        for (int sp = 0; sp < 4; ++sp) {
            RT_STEP(2 * sp, 0, 1, true, sp < 3);
            RT_STEP(2 * sp + 1, 1, 0, sp < 3, sp < 3);
        }
#undef RT_STEP
#pragma unroll
        for (int g = 0; g < 4; ++g) { float v = ssq[g]; v += __shfl_xor(v, 16); v += __shfl_xor(v, 32); if (q == 0) SS[wv * 64 + 16 * g + l15] = v; }
#pragma unroll
        for (int g = 0; g < 4; ++g)
#pragma unroll
            for (int ct = 0; ct < 3; ++ct)
#pragma unroll
                for (int i = 0; i < 4; ++i) LG[(wv * 64 + 16 * g + 4 * q + i) * 52 + 16 * ct + l15] = acc[g][ct][i];
        if (tid < NEXP) LC[tid] = 0;
        __syncthreads();
        int e0 = 0, e1 = 0, k0_ = 0, k1_ = 0; float rstd_ = 0.f, g0_ = 0.f, g1_ = 0.f;
        if (tid < 64) {
            float sst_ = 0.f;
#pragma unroll
            for (int w = 0; w < 8; ++w) sst_ += SS[w * 64 + tid];
            const float rstd = rsqrtf(sst_ * (1.0f / DM) + EPS);
            RS[tid] = rstd;
            float gl[4], el[8];
#pragma unroll
            for (int i = 0; i < 4; ++i) { float a_ = 0.f;
#pragma unroll
                for (int w = 0; w < 8; ++w) a_ += LG[(w * 64 + tid) * 52 + i];
                gl[i] = a_ * rstd + c.in[17][l * 4 + i]; }
            int gi = 0; float gm = gl[0];
#pragma unroll
            for (int i = 1; i < 4; ++i) if (gl[i] > gm) { gm = gl[i]; gi = i; }
            float gs = 0.f;
#pragma unroll
            for (int i = 0; i < 4; ++i) gs += __expf(gl[i] - gm);
            const float pg = 1.0f / gs;
#pragma unroll
            for (int i = 0; i < 8; ++i) { const int n = 4 + gi * 8 + i; float a_ = 0.f;
#pragma unroll
                for (int w = 0; w < 8; ++w) a_ += LG[(w * 64 + tid) * 52 + n];
                el[i] = a_ * rstd + c.in[19][l * 32 + gi * 8 + i]; }
            int i0 = 0; float m0 = el[0];
#pragma unroll
            for (int i = 1; i < 8; ++i) if (el[i] > m0) { m0 = el[i]; i0 = i; }
            int i1 = -1; float m1 = -3.0e38f;
#pragma unroll
            for (int i = 0; i < 8; ++i) if (i != i0 && el[i] > m1) { m1 = el[i]; i1 = i; }
            const float ex1 = __expf(m1 - m0), den = 1.0f + ex1;
            const float g0 = pg / den, g1 = pg * ex1 / den;
            e0 = gi * 8 + i0; e1 = gi * 8 + i1; rstd_ = rstd; g0_ = g0; g1_ = g1;
            k0_ = (int)__hip_atomic_fetch_add(&LC[e0], 1, __ATOMIC_RELAXED, __HIP_MEMORY_SCOPE_WORKGROUP);
            k1_ = (int)__hip_atomic_fetch_add(&LC[e1], 1, __ATOMIC_RELAXED, __HIP_MEMORY_SCOPE_WORKGROUP);
        }
        __syncthreads();
        if (tid < NEXP) { const int n = LC[tid]; LB[tid] = n > 0 ? (int)__hip_atomic_fetch_add(c.CNT(l) + tid * 64, (unsigned)n, __ATOMIC_RELAXED, __HIP_MEMORY_SCOPE_AGENT) : 0; }
        __syncthreads();
        if (tid < 64) {
            const int r = r0 + tid, p0 = LB[e0] + k0_, p1 = LB[e1] + k1_;
            c.LIST()[(size_t)e0 * T + p0] = r; c.LIST()[(size_t)e1 * T + p1] = r;
            c.LISTR()[(size_t)e0 * T + p0] = rstd_; c.LISTR()[(size_t)e1 * T + p1] = rstd_;
            unsigned* ro = c.ROUTE() + (size_t)r * 8;
            *(u32x4*)ro = (u32x4){(unsigned)e0, (unsigned)p0, __float_as_uint(g0_), (unsigned)e1};
            *(u32x2*)(ro + 4) = (u32x2){(unsigned)p1, __float_as_uint(g1_)};
        }
        __syncthreads();
    }
}

#define LAS __attribute__((address_space(3)))
typedef int i32x4_t __attribute__((ext_vector_type(4)));
typedef int i32x8_t __attribute__((ext_vector_type(8)));
__device__ __forceinline__ i32x8_t cat8(const bf16x8 a, const bf16x8 b) { const i32x4_t x = __builtin_bit_cast(i32x4_t, a), y = __builtin_bit_cast(i32x4_t, b); return __builtin_shufflevector(x, y, 0, 1, 2, 3, 4, 5, 6, 7); }
__device__ __forceinline__ void mfma_f8(f32x4& acc, const i32x8_t& a, const i32x8_t& b) { asm volatile("v_mfma_f32_16x16x128_f8f6f4 %0, %1, %2, %0" : "+v"(acc) : "v"(a), "v"(b)); }
__device__ __forceinline__ bf16x8 half8(const i32x8_t& v, int k) { const i32x4_t h = k ? __builtin_shufflevector(v, v, 4, 5, 6, 7) : __builtin_shufflevector(v, v, 0, 1, 2, 3); return __builtin_bit_cast(bf16x8, h); }
namespace g8 {
constexpr int BM = 256, BK = 64, HALF = 128, HTB = HALF * BK * 2, STAGE_BYTES = 8 * HTB, NXCD = 8, WGM = 8;
__device__ __forceinline__ int lds_byte(int r, int c) { const int st = (r >> 4) * 2 + (c >> 5), rr = r & 15, cc = c & 31, ob = rr * 64 + cc * 2; return st * 1024 + (ob ^ (((ob >> 9) & 1) << 5)); }
__device__ __forceinline__ void stage_rc(int b, int& R, int& C) { const int st = b / 1024, sb = b % 1024, swz = sb ^ (((sb >> 9) & 1) << 5); R = (st >> 1) * 16 + swz / 64; C = (st & 1) * 32 + (swz % 64) / 2; }
__device__ __forceinline__ int perm32(int rho) { const int n = rho >> 4, i = rho & 15; return 8 * (i >> 2) + 4 * n + (i & 3); }
struct Unit { int pm, pn; const char* B; };
typedef f32x4 Acc[2][2][4][2];

struct DenseOrder {
    static constexpr bool GATHER = false;
    int nM, nN, nwg, G, c; const char* Bt; size_t tstrideB; int rsh = 0, lim = 0x7fffffff;
    __device__ __forceinline__ void init(int M, int N, int G_, int c_, const bf16_t* Bt_, int ldb) { nM = M / BM; nN = N / BM; nwg = nM * nN; G = G_; c = c_; Bt = (const char*)Bt_; tstrideB = (size_t)BM * ldb * 2; }
    __device__ __forceinline__ bool next(int i, Unit& u) const {
        const long L = (long)(i >> rsh) * G + c; if (L >= nwg || L >= lim) return false;
        int wgid = (int)L; { const int q = nwg / NXCD, r = nwg % NXCD, xcd = wgid % NXCD, off = wgid / NXCD; wgid = (xcd < r ? xcd * (q + 1) : r * (q + 1) + (xcd - r) * q) + off; }
        const int nig = WGM * nN, gid = wgid / nig, fm = gid * WGM, gsz = (nM - fm) < WGM ? (nM - fm) : WGM;
        u.pm = fm + ((wgid % nig) % gsz); u.pn = (wgid % nig) / gsz; u.B = Bt + (size_t)u.pn * tstrideB; return true;
    }
    __device__ __forceinline__ unsigned arow_off(int) const { return 0u; }
};
struct SplitKOrder {
    static constexpr bool GATHER = false;
    int c; const char* Bt;
    __device__ __forceinline__ bool next(int i, Unit& u) const { if (i > 0) return false; u.pm = c >> 2; u.pn = c & 3; u.B = Bt; return true; }
    __device__ __forceinline__ unsigned arow_off(int) const { return 0u; }
};
template <bool GATHER_, int NCT, int LDA, size_t ESTRIDE, size_t TSTRIDE> struct MoeOrder {
    static constexpr bool GATHER = GATHER_;
    const MoeTab* mt; const int* LIST; int G, c; const char* W; int rsh = 0;
    __device__ __forceinline__ bool next(int i, Unit& u) const {
        const int L = (i >> rsh) * G + c; const int total = __builtin_amdgcn_readfirstlane(mt->tstart[NEXP]) * NCT; if (L >= total) return false;
        const int rt = L / NCT, ct = L % NCT; u.pm = rt; u.pn = ct; const int e = __builtin_amdgcn_readfirstlane(mt->texp[rt]); u.B = W + (size_t)e * ESTRIDE + (size_t)ct * TSTRIDE; return true;
    }
    __device__ __forceinline__ unsigned arow_off(int r) const {
        const int e = mt->texp[r >> 8]; const int pos = r - mt->tstart[e] * 256; const int tok = pos < mt->cnt[e] ? LIST[(size_t)e * T + pos] : 0; return (unsigned)tok * (unsigned)(LDA * 2);
    }
};

struct MoeOrder2 {
    static constexpr bool GATHER = false;
    const MoeTab* mt; int G, c, R, rtA; const char* W; int rsh = 0;
    __device__ __forceinline__ bool next(int i0, Unit& u) const {
        const int i = i0 >> rsh; int u2;
        if (c < R) { if (i >= 2) return false; u2 = rtA * 8 + 2 * c + i; }
        else { u2 = (c - R) + i * (G - R); if (u2 >= rtA * 8) return false; }
        const int rt = u2 >> 3, ct = u2 & 7; u.pm = rt; u.pn = ct; const int e = __builtin_amdgcn_readfirstlane(mt->texp[rt]);
        u.B = W + (size_t)e * ((size_t)DM * DEXP) + (size_t)ct * ((size_t)256 * DEXP); return true;
    }
    __device__ __forceinline__ unsigned arow_off(int) const { return 0u; }
};
__device__ __forceinline__ void moe_wait_dep(unsigned* rtc, int c, int G, int R, int rtA) {
    const int tid = otid();
    if (tid < 64) {
        int rt = -1;
        if (c < R) { if (tid < 2) rt = rtA + ((2 * c + tid) >> 3); } else if (tid < 32) { const int u2 = (c - R) + tid * (G - R); if (u2 < rtA * 8) rt = u2 >> 3; }
        unsigned spins = 0;
        for (;;) {
            const bool ok = rt < 0 || __hip_atomic_load(rtc + (rt < 0 ? 0 : rt) * 32, __ATOMIC_RELAXED, __HIP_MEMORY_SCOPE_AGENT) >= 32u;
            if (__all(ok)) break;
            __builtin_amdgcn_s_sleep(2); if (++spins > (1u << 22)) break;
        }
        __builtin_amdgcn_fence(__ATOMIC_ACQUIRE, "agent");
        asm volatile("s_waitcnt vmcnt(0)" ::: "memory");
    }
    __syncthreads();
}

template <class Epi, class Sched>
__device__ __forceinline__ void gemm_mfma(LAS unsigned char* lds, const bf16_t* A, int lda, int ldb, int K, const Sched& S, const Epi& E) {
    constexpr bool GATHER = Sched::GATHER;
    const int tid = otid(), wid = __builtin_amdgcn_readfirstlane(tid >> 6), lane = tid & 63, wr = wid >> 2, wc = wid & 3, fr = lane & 15, fq = lane >> 4;
    const int nt = K / BK;
    int Rst[2], Cst[2]; unsigned voffB[2], voA[2][2], voAn[2][2];
#pragma unroll
    for (int i = 0; i < 2; ++i) { stage_rc(tid * 16 + i * 8192, Rst[i], Cst[i]); const int Rb = Epi::PERM ? ((Rst[i] & ~31) + perm32(Rst[i] & 31)) : Rst[i];
        voffB[i] = (unsigned)(Rb * ldb + Cst[i]) * 2u;
#pragma unroll
        for (int h = 0; h < 2; ++h) { voA[h][i] = (unsigned)((h * HALF + Rst[i]) * lda + Cst[i]) * 2u; voAn[h][i] = voA[h][i]; } }
    const size_t kstep = (size_t)(BK * 2), hstepB = (size_t)HALF * ldb * 2, tstepA = (size_t)BM * lda * 2;
    const unsigned ldsw = (unsigned)wid * 1024u;
    const int aoff = lds_byte(wr * 64 + fr, fq * 8), boff = lds_byte(wc * 32 + fr, fq * 8);
#define G8_SA(b, h) (((b) * 2 + (h)) * HTB)
#define G8_SB(b, h) ((4 + (b) * 2 + (h)) * HTB)
#define G8_OPQ(x) ({ unsigned _o = (x); asm volatile("" : "+v"(_o)); _o; })
#define G8_STAGE_B(bufoff, gbase) do { _Pragma("unroll") for (int _i = 0; _i < 2; ++_i) \
        __builtin_amdgcn_global_load_lds((const unsigned*)((const char*)(gbase) + G8_OPQ(voffB[_i])), (LAS unsigned*)(lds + (bufoff) + ldsw + _i * 8192), 16, 0, 0); } while (0)
#define G8_STAGE_A(bufoff, gbase, o0, o1) do { \
        __builtin_amdgcn_global_load_lds((const unsigned*)((const char*)(gbase) + G8_OPQ(o0)), (LAS unsigned*)(lds + (bufoff) + ldsw), 16, 0, 0); \
        __builtin_amdgcn_global_load_lds((const unsigned*)((const char*)(gbase) + G8_OPQ(o1)), (LAS unsigned*)(lds + (bufoff) + ldsw + 8192), 16, 0, 0); } while (0)
#define G8_LDA(dst, b, h) do { _Pragma("unroll") for (int m = 0; m < 4; ++m) dst[m] = cat8(*(const LAS bf16x8*)(lds + G8_SA(b, h) + aoff + m * 2048), *(const LAS bf16x8*)(lds + G8_SA(b, h) + aoff + m * 2048 + 1024)); } while (0)
#define G8_LDB(dst, b, h) do { _Pragma("unroll") for (int n = 0; n < 2; ++n) dst[n] = cat8(*(const LAS bf16x8*)(lds + G8_SB(b, h) + boff + n * 2048), *(const LAS bf16x8*)(lds + G8_SB(b, h) + boff + n * 2048 + 1024)); } while (0)
#define G8_MMA(ai, bj, At, Bt) do { __builtin_amdgcn_s_setprio(1); \
        if constexpr (Epi::F8) { _Pragma("unroll") for (int m = 0; m < 4; ++m) _Pragma("unroll") for (int n = 0; n < 2; ++n) \
            mfma_f8(acc[ai][bj][m][n], Bt[n], At[m]); } \
        else { _Pragma("unroll") for (int m = 0; m < 4; ++m) _Pragma("unroll") for (int n = 0; n < 2; ++n) _Pragma("unroll") for (int k = 0; k < 2; ++k) \
            acc[ai][bj][m][n] = __builtin_amdgcn_mfma_f32_16x16x32_bf16(half8(Bt[n], k), half8(At[m], k), acc[ai][bj][m][n], 0, 0, 0); } \
        __builtin_amdgcn_s_setprio(0); } while (0)
#define G8_WAIT_V(n) asm volatile("s_waitcnt vmcnt(" #n ")" ::: "memory")
#define G8_WAIT_L(n) asm volatile("s_waitcnt lgkmcnt(" #n ")" ::: "memory")
#define G8_BAR __builtin_amdgcn_s_barrier()
#define G8_SCHED __builtin_amdgcn_sched_barrier(0)
    Unit cur, nxt; int ui = 0, prev_pm = -1;
    if (!S.next(0, cur)) return;
    Acc acc;
#pragma unroll
    for (int a = 0; a < 2; ++a)
#pragma unroll
        for (int b = 0; b < 2; ++b)
#pragma unroll
            for (int m = 0; m < 4; ++m)
#pragma unroll
                for (int n = 0; n < 2; ++n) acc[a][b][m][n] = (f32x4){0.f, 0.f, 0.f, 0.f};
    i32x8_t At[4], B0[2], B1[2];
    const char* cA; const char* cB = cur.B;
    if (GATHER) { cA = (const char*)A;
#pragma unroll
        for (int h = 0; h < 2; ++h)
#pragma unroll
            for (int i = 0; i < 2; ++i) voA[h][i] = S.arow_off(cur.pm * BM + h * HALF + Rst[i]) + (unsigned)Cst[i] * 2u;
    } else cA = (const char*)A + (size_t)cur.pm * tstepA;
    G8_STAGE_B(G8_SB(0, 0), cB); G8_STAGE_A(G8_SA(0, 0), cA, voA[0][0], voA[0][1]); G8_STAGE_B(G8_SB(0, 1), cB + hstepB); G8_STAGE_A(G8_SA(0, 1), cA, voA[1][0], voA[1][1]);
    if (wr == 1) G8_BAR;
    G8_WAIT_V(4); G8_BAR;
    G8_STAGE_B(G8_SB(1, 0), cB + kstep); G8_STAGE_A(G8_SA(1, 0), cA + kstep, voA[0][0], voA[0][1]); G8_STAGE_B(G8_SB(1, 1), cB + hstepB + kstep);
    G8_WAIT_V(6); G8_BAR;
    for (;;) {
        const bool has_next = S.next(ui + 1, nxt);
        const char* nA; const char* nB = has_next ? nxt.B : cB;
        if (GATHER) { nA = cA;
            if (has_next) {
#pragma unroll
                for (int h = 0; h < 2; ++h)
#pragma unroll
                    for (int i = 0; i < 2; ++i) voAn[h][i] = S.arow_off(nxt.pm * BM + h * HALF + Rst[i]) + (unsigned)Cst[i] * 2u;
            } else {
#pragma unroll
                for (int h = 0; h < 2; ++h)
#pragma unroll
                    for (int i = 0; i < 2; ++i) voAn[h][i] = voA[h][i];
            }
        } else nA = has_next ? (const char*)A + (size_t)nxt.pm * tstepA : cA;
        for (int t = 0; t < nt; t += 2) {
            const bool last = (t == nt - 2);
            const char* a1 = cA + (size_t)(t + 1) * kstep;
            const char* a2 = last ? nA : cA + (size_t)(t + 2) * kstep; const char* b2 = last ? nB : cB + (size_t)(t + 2) * kstep;
            const char* a3 = a2 + kstep; const char* b3 = b2 + kstep;
            unsigned o00 = voA[0][0], o01 = voA[0][1], o10 = voA[1][0], o11 = voA[1][1];
            if (GATHER) { if (last) { o00 = voAn[0][0]; o01 = voAn[0][1]; o10 = voAn[1][0]; o11 = voAn[1][1]; } }
            G8_LDB(B0, 0, 0); G8_SCHED; G8_LDA(At, 0, 0); G8_STAGE_A(G8_SA(1, 1), a1, voA[1][0], voA[1][1]);
            G8_WAIT_L(8); G8_BAR; G8_WAIT_L(0); G8_MMA(0, 0, At, B0); G8_BAR; G8_SCHED;
            G8_LDB(B1, 0, 1); G8_STAGE_B(G8_SB(0, 0), b2);
            G8_BAR; G8_WAIT_L(0); G8_MMA(0, 1, At, B1); G8_BAR;
            G8_LDA(At, 0, 1); G8_STAGE_A(G8_SA(0, 0), a2, o00, o01);
            G8_BAR; G8_WAIT_L(0); G8_MMA(1, 0, At, B0); G8_BAR; G8_SCHED;
            G8_STAGE_B(G8_SB(0, 1), b2 + hstepB);
            G8_WAIT_V(6);
            if constexpr (Epi::PUBLISH) { if (prev_pm >= 0) { E.publish(prev_pm); prev_pm = -1; } }
            G8_BAR; G8_MMA(1, 1, At, B1); G8_BAR;
            G8_LDB(B0, 1, 0); G8_SCHED; G8_LDA(At, 1, 0); G8_STAGE_A(G8_SA(0, 1), a2, o10, o11);
            G8_WAIT_L(8); G8_BAR; G8_WAIT_L(0); G8_MMA(0, 0, At, B0); G8_BAR; G8_SCHED;
            G8_LDB(B1, 1, 1); G8_STAGE_B(G8_SB(1, 0), b3);
            G8_BAR; G8_WAIT_L(0); G8_MMA(0, 1, At, B1); G8_BAR;
            G8_LDA(At, 1, 1); G8_STAGE_A(G8_SA(1, 0), a3, o00, o01);
            G8_BAR; G8_WAIT_L(0); G8_MMA(1, 0, At, B0); G8_BAR; G8_SCHED;
            G8_STAGE_B(G8_SB(1, 1), b3 + hstepB);
            G8_WAIT_V(6); G8_BAR; G8_MMA(1, 1, At, B1); G8_BAR;
        }
        if constexpr (Epi::F8) {
#define G8_TIE(a, b, txt) asm volatile(txt : "+v"(acc[a][b][0][0]), "+v"(acc[a][b][0][1]), "+v"(acc[a][b][1][0]), "+v"(acc[a][b][1][1]), "+v"(acc[a][b][2][0]), "+v"(acc[a][b][2][1]), "+v"(acc[a][b][3][0]), "+v"(acc[a][b][3][1]))
            G8_TIE(0, 0, ""); G8_TIE(0, 1, ""); G8_TIE(1, 0, "s_nop 7"); G8_TIE(1, 1, "s_nop 15\n\ts_nop 7");
#undef G8_TIE
        }
        if constexpr (Epi::ASCALE != 1.0f) {
#pragma unroll
            for (int a = 0; a < 2; ++a)
#pragma unroll
                for (int b = 0; b < 2; ++b)
#pragma unroll
                    for (int m = 0; m < 4; ++m)
#pragma unroll
                        for (int n = 0; n < 2; ++n) acc[a][b][m][n] *= Epi::ASCALE;
        }
        E(acc, cur, wr, wc, fr, fq);
        if constexpr (Epi::PUBLISH) prev_pm = cur.pm;
        if (!has_next) break;
#pragma unroll
        for (int a = 0; a < 2; ++a)
#pragma unroll
            for (int b = 0; b < 2; ++b)
#pragma unroll
                for (int m = 0; m < 4; ++m)
#pragma unroll
                    for (int n = 0; n < 2; ++n) acc[a][b][m][n] = (f32x4){0.f, 0.f, 0.f, 0.f};
        cur = nxt; cA = nA; cB = nB; ++ui;
        if (GATHER) {
#pragma unroll
            for (int h = 0; h < 2; ++h)
#pragma unroll
                for (int i = 0; i < 2; ++i) voA[h][i] = voAn[h][i];
        }
    }
    G8_WAIT_V(0);
    if constexpr (Epi::PUBLISH) { if (prev_pm >= 0) { E.publish(prev_pm); prev_pm = -1; } }
    if (wr == 0) G8_BAR;
    G8_BAR;
#undef G8_SA
#undef G8_SB
#undef G8_STAGE_A
#undef G8_STAGE_B
#undef G8_OPQ
#undef G8_LDA
#undef G8_LDB
#undef G8_MMA
#undef G8_WAIT_V
#undef G8_WAIT_L
#undef G8_BAR
#undef G8_SCHED
}

__device__ __forceinline__ u32x4 pack8(const f32x4& a, const f32x4& b) { u32x4 w; w.x = cvt_pk_bf16(a[0], a[1]); w.y = cvt_pk_bf16(a[2], a[3]); w.z = cvt_pk_bf16(b[0], b[1]); w.w = cvt_pk_bf16(b[2], b[3]); return w; }
__device__ __forceinline__ u32x4 subtile_T(LAS bf16_t* Tw, const f32x4& a, const f32x4& b, int fr, int fq, int lane) {
#pragma unroll
    for (int j = 0; j < 4; ++j) { Tw[(8 * fq + j) * 16 + fr] = f2bf(a[j]); Tw[(8 * fq + 4 + j) * 16 + fr] = f2bf(b[j]); }
    return *(const LAS u32x4*)(Tw + (lane >> 1) * 16 + (lane & 1) * 8);
}
template <bool F8_> struct MEpiProjT { static constexpr bool PERM = true, PUBLISH = false, F8 = F8_; static constexpr float ASCALE = F8_ ? 1.0f / (SHB * SWI) : 1.0f; bf16_t* PROJ; bf16_t* VT; LAS float* KX; const float* gq; const float* gk;
    __device__ __forceinline__ void operator()(const Acc& acc, const Unit& u, int wr, int wc, int fr, int fq) const {
        const int row0 = u.pm * BM + wr * 64 + fr;
        if (u.pn >= C_K / 256 && u.pn < DPROJ / 256) {
#pragma unroll
            for (int ai = 0; ai < 2; ++ai)
#pragma unroll
                for (int m = 0; m < 4; ++m)
#pragma unroll
                    for (int bj = 0; bj < 2; ++bj) {
                        const f32x4 a = acc[ai][bj][m][0], b = acc[ai][bj][m][1];
                        float ss = a[0] * a[0] + a[1] * a[1] + a[2] * a[2] + a[3] * a[3] + b[0] * b[0] + b[1] * b[1] + b[2] * b[2] + b[3] * b[3];
                        ss += __shfl_xor(ss, 16); ss += __shfl_xor(ss, 32);
                        if (fq == 0) KX[((ai * HALF + wr * 64 + m * 16 + fr) * 2 + bj) * 4 + wc] = ss;
                    }
            asm volatile("s_waitcnt lgkmcnt(0)" ::: "memory"); __builtin_amdgcn_s_barrier(); asm volatile("" ::: "memory");
            const int col0 = u.pn * BM + wc * 32 + 8 * fq;
            f32x4 g0[2], g1[2];
#pragma unroll
            for (int bj = 0; bj < 2; ++bj) { const int d0 = wc * 32 + 8 * fq; g0[bj] = *(const f32x4*)(gq + d0) * *(const f32x4*)(gk + d0); g1[bj] = *(const f32x4*)(gq + d0 + 4) * *(const f32x4*)(gk + d0 + 4); }
#pragma unroll
            for (int ai = 0; ai < 2; ++ai)
#pragma unroll
                for (int m = 0; m < 4; ++m) { bf16_t* rowp = PROJ + (size_t)(row0 + ai * HALF + m * 16) * DPROJ + col0;
#pragma unroll
                    for (int bj = 0; bj < 2; ++bj) { const f32x4 p4 = *(const LAS f32x4*)(KX + ((ai * HALF + wr * 64 + m * 16 + fr) * 2 + bj) * 4);
                        const float rs = rsqrtf(((p4[0] + p4[1]) + (p4[2] + p4[3])) * (1.0f / HD) + EPS);
                        *(u32x4*)(rowp + bj * HALF) = pack8(acc[ai][bj][m][0] * g0[bj] * rs, acc[ai][bj][m][1] * g1[bj] * rs); } }
            return;
        }
        if (u.pn < DPROJ / 256) {
            const int col0 = u.pn * BM + wc * 32 + 8 * fq;
#pragma unroll
            for (int ai = 0; ai < 2; ++ai)
#pragma unroll
                for (int m = 0; m < 4; ++m) { bf16_t* rowp = PROJ + (size_t)(row0 + ai * HALF + m * 16) * DPROJ + col0;
#pragma unroll
                    for (int bj = 0; bj < 2; ++bj) *(u32x4*)(rowp + bj * HALF) = pack8(acc[ai][bj][m][0], acc[ai][bj][m][1]); }
        } else {
            const int lane = fq * 16 + fr, cl = lane >> 1, hf = lane & 1; LAS bf16_t* Tw = (LAS bf16_t*)KX + (wr * 4 + wc) * 512;
            const int cc0 = (u.pn - DPROJ / 256) * BM + wc * 32 + cl;
#pragma unroll
            for (int ai = 0; ai < 2; ++ai)
#pragma unroll
                for (int m = 0; m < 4; ++m) { const int rowb = u.pm * BM + wr * 64 + ai * HALF + m * 16, b = rowb >> 12, s = (rowb & (SEQ - 1)) + hf * 8;
#pragma unroll
                    for (int bj = 0; bj < 2; ++bj) { const int cc = cc0 + bj * HALF;
                        const u32x4 w = subtile_T(Tw, acc[ai][bj][m][0], acc[ai][bj][m][1], fr, fq, lane);
                        *(u32x4*)(VT + ((size_t)(b * NHS + (cc >> 7)) * HD + (cc & 127)) * VTS + s) = w; } }
        }
    } };
template <bool F8_> struct MEpiPartT { static constexpr bool PERM = true, PUBLISH = false, F8 = F8_; static constexpr float ASCALE = F8_ ? 1.0f / (SHB * SWI) : 1.0f; bf16_t* PT; LAS float* KX;
    __device__ __forceinline__ void operator()(const Acc& acc, const Unit& u, int wr, int wc, int fr, int fq) const {
        const int lane = fq * 16 + fr, cl = lane >> 1, hf = lane & 1; LAS bf16_t* Tw = (LAS bf16_t*)KX + (wr * 4 + wc) * 512;
        bf16_t* base0 = PT + (size_t)(u.pm * 4 + u.pn) * 65536 + (size_t)(wc * 32 + cl) * 256 + wr * 64 + hf * 8;
#pragma unroll
        for (int ai = 0; ai < 2; ++ai)
#pragma unroll
            for (int m = 0; m < 4; ++m)
#pragma unroll
                for (int bj = 0; bj < 2; ++bj) {
                    const u32x4 w = subtile_T(Tw, acc[ai][bj][m][0], acc[ai][bj][m][1], fr, fq, lane);
                    *(u32x4*)(base0 + (size_t)(bj * HALF) * 256 + ai * HALF + m * 16) = w; }
    } };
__device__ __forceinline__ u32x4 pair16(unsigned a0, unsigned a1, unsigned b0, unsigned b1) {
    const auto s0 = __builtin_amdgcn_permlane16_swap(a0, b0, false, false); const auto s1 = __builtin_amdgcn_permlane16_swap(a1, b1, false, false);
    return (u32x4){s0[0], s1[0], s0[1], s1[1]};
}
__device__ __forceinline__ f32x4 silu_mul(const f32x4& g, const f32x4& u) { f32x4 r;
#pragma unroll
    for (int j = 0; j < 4; ++j) r[j] = g[j] / (1.0f + __expf(-g[j])) * u[j];
    return r; }
struct MEpiGU { static constexpr bool PERM = true, PUBLISH = true, F8 = true; static constexpr float ASCALE = 1.0f; unsigned char* HID; const float* LISTR; const MoeTab* mt; unsigned* rtc; int n1early;
    __device__ __forceinline__ void operator()(const Acc& acc, const Unit& u, int wr, int wc, int fr, int fq) const {
        const int row0 = u.pm * BM + wr * 64 + fr, col0 = u.pn * HALF + wc * 32 + 8 * fq;
        const int e = __builtin_amdgcn_readfirstlane(mt->texp[u.pm]), cnt = __builtin_amdgcn_readfirstlane(mt->cnt[e]), pb = __builtin_amdgcn_readfirstlane(mt->tstart[e]) * 256;
        const float* lr = LISTR + (size_t)e * T;
        const __amdgpu_buffer_rsrc_t rsrc = __builtin_amdgcn_make_buffer_rsrc(HID, 0, (int)((size_t)PADROWS * DEXP), 0x00020000);
#pragma unroll
        for (int ai = 0; ai < 2; ++ai)
#pragma unroll
            for (int mp = 0; mp < 2; ++mp) { int w[2][2];
#pragma unroll
                for (int mm = 0; mm < 2; ++mm) { const int m = 2 * mp + mm;
                    const int row = row0 + ai * HALF + m * 16, pos = row - pb;
                    const float rs = pos < cnt ? lr[pos] * (1.0f / (SX8 * SW1)) : 0.f;
                    const f32x4 h0 = silu_mul(acc[ai][0][m][0] * rs, acc[ai][1][m][0] * rs) * SH8, h1 = silu_mul(acc[ai][0][m][1] * rs, acc[ai][1][m][1] * rs) * SH8;
                    int w0 = 0, w1 = 0;
                    w0 = __builtin_amdgcn_cvt_pk_fp8_f32(__builtin_amdgcn_fmed3f(h0[0], -448.f, 448.f), __builtin_amdgcn_fmed3f(h0[1], -448.f, 448.f), w0, false); w0 = __builtin_amdgcn_cvt_pk_fp8_f32(__builtin_amdgcn_fmed3f(h0[2], -448.f, 448.f), __builtin_amdgcn_fmed3f(h0[3], -448.f, 448.f), w0, true);
                    w1 = __builtin_amdgcn_cvt_pk_fp8_f32(__builtin_amdgcn_fmed3f(h1[0], -448.f, 448.f), __builtin_amdgcn_fmed3f(h1[1], -448.f, 448.f), w1, false); w1 = __builtin_amdgcn_cvt_pk_fp8_f32(__builtin_amdgcn_fmed3f(h1[2], -448.f, 448.f), __builtin_amdgcn_fmed3f(h1[3], -448.f, 448.f), w1, true);
                    w[mm][0] = w0; w[mm][1] = w1; }
                __builtin_amdgcn_raw_buffer_store_b128(pair16((unsigned)w[0][0], (unsigned)w[0][1], (unsigned)w[1][0], (unsigned)w[1][1]), rsrc, (row0 + ai * HALF + mp * 32 + 16 * (fq & 1)) * DEXP + (u.pn * HALF + wc * 32 + 16 * (fq >> 1)), 0, 16);
            }
    }
    __device__ __forceinline__ void publish(int pm) const {
        if ((otid() & 63) == 0) __hip_atomic_fetch_add(rtc + pm * 32, 1u, __ATOMIC_RELAXED, __HIP_MEMORY_SCOPE_AGENT);
    } };
struct MEpiDown { static constexpr bool PERM = true, PUBLISH = false, F8 = false; static constexpr float ASCALE = 1.0f; bf16_t* YPAD;
    __device__ __forceinline__ void operator()(const Acc& acc, const Unit& u, int wr, int wc, int fr, int fq) const {
        const int row0 = u.pm * BM + wr * 64 + fr, col0 = u.pn * BM + wc * 32 + 8 * fq;
#pragma unroll
        for (int ai = 0; ai < 2; ++ai)
#pragma unroll
            for (int m = 0; m < 4; ++m) { bf16_t* rowp = YPAD + (size_t)(row0 + ai * HALF + m * 16) * DM + col0;
#pragma unroll
                for (int bj = 0; bj < 2; ++bj) *(u32x4*)(rowp + bj * HALF) = pack8(acc[ai][bj][m][0], acc[ai][bj][m][1]); }
    } };
template <bool XF32> struct MEpiOut { static constexpr bool STAMP = false, PERM = true, PUBLISH = false, F8 = false; static constexpr float ASCALE = 1.0f; const float* Xf; const bf16_t* Xb; bf16_t* X1; unsigned char* X18;
    __device__ __forceinline__ void operator()(const Acc& acc, const Unit& u, int wr, int wc, int fr, int fq) const {
        const int row0 = u.pm * BM + wr * 64 + fr, col0 = u.pn * BM + wc * 32 + 8 * fq;
        const int row8 = u.pm * BM + wr * 64 + fr + 16 * (fq & 1), col8 = u.pn * BM + wc * 32 + 16 * (fq >> 1);
#pragma unroll
        for (int ai = 0; ai < 2; ++ai) {
            f32x4 xa[4][2][2]; u32x4 xh[4][2];
#pragma unroll
            for (int m = 0; m < 4; ++m)
#pragma unroll
                for (int bj = 0; bj < 2; ++bj) { const size_t o = (size_t)(row0 + ai * HALF + m * 16) * DM + col0 + bj * HALF;
                    if (XF32) { xa[m][bj][0] = *(const f32x4*)(Xf + o); xa[m][bj][1] = *(const f32x4*)(Xf + o + 4); } else xh[m][bj] = *(const u32x4*)(Xb + o); }
            __builtin_amdgcn_sched_barrier(0);
#pragma unroll
            for (int mp = 0; mp < 2; ++mp)
#pragma unroll
                for (int bj = 0; bj < 2; ++bj) { int w8[2][2];
#pragma unroll
                    for (int mm = 0; mm < 2; ++mm) { const int m = 2 * mp + mm; const size_t o = (size_t)(row0 + ai * HALF + m * 16) * DM + col0 + bj * HALF;
                        f32x4 a = acc[ai][bj][m][0], b = acc[ai][bj][m][1];
                        if (XF32) { a += xa[m][bj][0]; b += xa[m][bj][1]; }
                        else { const u32x4 w = xh[m][bj]; a[0] += bflo(w.x); a[1] += bfhi(w.x); a[2] += bflo(w.y); a[3] += bfhi(w.y); b[0] += bflo(w.z); b[1] += bfhi(w.z); b[2] += bflo(w.w); b[3] += bfhi(w.w); }
                        *(u32x4*)(X1 + o) = pack8(a, b);
                        int w0 = 0, w1 = 0;
                        w0 = __builtin_amdgcn_cvt_pk_fp8_f32(sat8(a[0] * SX8), sat8(a[1] * SX8), w0, false); w0 = __builtin_amdgcn_cvt_pk_fp8_f32(sat8(a[2] * SX8), sat8(a[3] * SX8), w0, true);
                        w1 = __builtin_amdgcn_cvt_pk_fp8_f32(sat8(b[0] * SX8), sat8(b[1] * SX8), w1, false); w1 = __builtin_amdgcn_cvt_pk_fp8_f32(sat8(b[2] * SX8), sat8(b[3] * SX8), w1, true);
                        w8[mm][0] = w0; w8[mm][1] = w1; }
                    *(u32x4*)(X18 + (size_t)(row8 + ai * HALF + mp * 32) * DM + col8 + bj * HALF) = pair16((unsigned)w8[0][0], (unsigned)w8[0][1], (unsigned)w8[1][0], (unsigned)w8[1][1]); }
        }
    } };
constexpr float YSCALE = YSCALE_G;
struct MEpiDown8 { static constexpr bool PERM = true, PUBLISH = false, F8 = true; static constexpr float ASCALE = 1.0f; unsigned char* Y8;
    __device__ __forceinline__ void operator()(const Acc& acc, const Unit& u, int wr, int wc, int fr, int fq) const {
        const int row0 = u.pm * BM + wr * 64 + fr + 16 * (fq & 1), col0 = u.pn * BM + wc * 32 + 16 * (fq >> 1);
#pragma unroll
        for (int ai = 0; ai < 2; ++ai)
#pragma unroll
            for (int mp = 0; mp < 2; ++mp)
#pragma unroll
                for (int bj = 0; bj < 2; ++bj) { int w[2][2];
#pragma unroll
                    for (int mm = 0; mm < 2; ++mm) { const int m = 2 * mp + mm; const f32x4 a = acc[ai][bj][m][0] * (YSCALE / (SH8 * SW2)), b = acc[ai][bj][m][1] * (YSCALE / (SH8 * SW2)); int w0 = 0, w1 = 0;
                        w0 = __builtin_amdgcn_cvt_pk_fp8_f32(sat8(a[0]), sat8(a[1]), w0, false); w0 = __builtin_amdgcn_cvt_pk_fp8_f32(sat8(a[2]), sat8(a[3]), w0, true);
                        w1 = __builtin_amdgcn_cvt_pk_fp8_f32(sat8(b[0]), sat8(b[1]), w1, false); w1 = __builtin_amdgcn_cvt_pk_fp8_f32(sat8(b[2]), sat8(b[3]), w1, true); w[mm][0] = w0; w[mm][1] = w1; }
                    *(u32x4*)(Y8 + (size_t)(row0 + ai * HALF + mp * 32) * DM + col0 + bj * HALF) = pair16((unsigned)w[0][0], (unsigned)w[0][1], (unsigned)w[1][0], (unsigned)w[1][1]); }
    } };
}

__device__ __forceinline__ void phase_convb(const Ctx& c, int l) {
    const int gt = obid() * 512 + otid(), ng = gridDim.x * 512, sub = gt & 15;
    const float* cw = c.in[10] + (size_t)l * 3 * DCONV; const bf16_t* PROJ = c.PROJ();
#pragma unroll 2
    for (int item = gt >> 4; item < T * 4; item += ng >> 4) {
        const int t = item >> 2, hh = item & 3, ch = hh * HD + sub * 8, s = t & (SEQ - 1);
        u32x4 cg[3], xb[3];
#pragma unroll
        for (int tap = 0; tap < 3; ++tap) { const int ds = (s + tap - 2 >= 0) ? tap - 2 : 0; const bf16_t* row = PROJ + (size_t)(t + ds) * DPROJ; cg[tap] = *(const u32x4*)(row + C_CG + ch); xb[tap] = *(const u32x4*)(row + C_XB + ch); }
        const u32x4 bg = *(const u32x4*)(PROJ + (size_t)t * DPROJ + C_BG + ch);
        float acc[8] = {0, 0, 0, 0, 0, 0, 0, 0};
#pragma unroll
        for (int tap = 0; tap < 3; ++tap) {
            if (s + tap - 2 >= 0) {
                const f32x4 w0 = *(const f32x4*)(cw + tap * DCONV + ch), w1 = *(const f32x4*)(cw + tap * DCONV + ch + 4);
                acc[0] += w0[0] * bflo(cg[tap].x) * bflo(xb[tap].x); acc[1] += w0[1] * bfhi(cg[tap].x) * bfhi(xb[tap].x); acc[2] += w0[2] * bflo(cg[tap].y) * bflo(xb[tap].y); acc[3] += w0[3] * bfhi(cg[tap].y) * bfhi(xb[tap].y);
                acc[4] += w1[0] * bflo(cg[tap].z) * bflo(xb[tap].z); acc[5] += w1[1] * bfhi(cg[tap].z) * bfhi(xb[tap].z); acc[6] += w1[2] * bflo(cg[tap].w) * bflo(xb[tap].w); acc[7] += w1[3] * bfhi(cg[tap].w) * bfhi(xb[tap].w);
            }
        }
        acc[0] *= bflo(bg.x); acc[1] *= bfhi(bg.x); acc[2] *= bflo(bg.y); acc[3] *= bfhi(bg.y); acc[4] *= bflo(bg.z); acc[5] *= bfhi(bg.z); acc[6] *= bflo(bg.w); acc[7] *= bfhi(bg.w);
        float ss = 0.f;
#pragma unroll
        for (int i = 0; i < 8; ++i) ss += acc[i] * acc[i];
        ss += __shfl_xor(ss, 1); ss += __shfl_xor(ss, 2); ss += __shfl_xor(ss, 4); ss += __shfl_xor(ss, 8);
        const float rstd = rsqrtf(ss * (1.0f / HD) + EPS);
        const float* mg = c.in[13] + (size_t)l * DM + DLRU + ch;
        const f32x4 m0 = *(const f32x4*)mg, m1 = *(const f32x4*)(mg + 4);
        u32x4 o; o.x = cvt_pk_bf16(acc[0] * rstd * m0[0], acc[1] * rstd * m0[1]); o.y = cvt_pk_bf16(acc[2] * rstd * m0[2], acc[3] * rstd * m0[3]);
        o.z = cvt_pk_bf16(acc[4] * rstd * m1[0], acc[5] * rstd * m1[1]); o.w = cvt_pk_bf16(acc[6] * rstd * m1[2], acc[7] * rstd * m1[3]);
        *(u32x4*)(c.YMIX() + (size_t)t * DM + DLRU + ch) = o;
    }
}
typedef float f32x16 __attribute__((ext_vector_type(16)));
#define MFMA32(a, b, c) __builtin_amdgcn_mfma_f32_32x32x16_bf16((a), (b), (c), 0, 0, 0)
constexpr int XCS = 776;
__device__ __forceinline__ void phase_lruA(const Ctx& c, int l, unsigned char* ldsb) {
    constexpr bool PASS2 = false;
    bf16_t* XC = (bf16_t*)ldsb; bf16_t* PR = (bf16_t*)(ldsb + 99328); bf16_t* HL = c.HL(); bf16_t* PL = c.PL();
    const int tid = otid(), lane = tid & 63, wv = tid >> 6, hh = lane >> 5, l31 = lane & 31;
    const float* cw = c.in[3] + (size_t)l * 4 * DLRU; const float* cb = c.in[4] + (size_t)l * DLRU;
    const bf16_t* PROJ = c.PROJ(); float* AGG = c.AGG();
    typedef float f32x2_t __attribute__((ext_vector_type(2)));
    for (int tile = obid(); tile < T / 64; tile += gridDim.x) {
        const int t0 = tile * 64, s0 = t0 & (SEQ - 1), tb = tile & 63;
        if (tid < 480) {
            const int cg = tid % 48, tslot = tid / 48, ch = cg * 16;
            float w[4][16], bias[16];
#pragma unroll
            for (int i = 0; i < 16; i += 4) { *(f32x4*)&bias[i] = *(const f32x4*)(cb + ch + i);
#pragma unroll
                for (int tap = 0; tap < 4; ++tap) *(f32x4*)&w[tap][i] = *(const f32x4*)(cw + tap * DLRU + ch + i); }
#pragma unroll
            for (int it = 0; it < 7; ++it) {
                const int tokr = tslot + 10 * it, tok = tokr < 64 ? tokr : 63;
                u32x4 x0[4], x1[4]; float msk[4];
#pragma unroll
                for (int tap = 0; tap < 4; ++tap) {
                    const int ds = tap - 3; const bool ok = (s0 + tok + ds >= 0); msk[tap] = ok ? 1.0f : 0.0f;
                    const bf16_t* row = PROJ + (size_t)(t0 + tok + (ok ? ds : 0)) * DPROJ + C_XA + ch;
                    x0[tap] = *(const u32x4*)row; x1[tap] = *(const u32x4*)(row + 8);
                }
                float a[16];
#pragma unroll
                for (int i = 0; i < 16; ++i) a[i] = bias[i];
#pragma unroll
                for (int tap = 0; tap < 4; ++tap) {
                    const float m = msk[tap];
                    a[0] += m * w[tap][0] * bflo(x0[tap].x); a[1] += m * w[tap][1] * bfhi(x0[tap].x); a[2] += m * w[tap][2] * bflo(x0[tap].y); a[3] += m * w[tap][3] * bfhi(x0[tap].y);
                    a[4] += m * w[tap][4] * bflo(x0[tap].z); a[5] += m * w[tap][5] * bfhi(x0[tap].z); a[6] += m * w[tap][6] * bflo(x0[tap].w); a[7] += m * w[tap][7] * bfhi(x0[tap].w);
                    a[8] += m * w[tap][8] * bflo(x1[tap].x); a[9] += m * w[tap][9] * bfhi(x1[tap].x); a[10] += m * w[tap][10] * bflo(x1[tap].y); a[11] += m * w[tap][11] * bfhi(x1[tap].y);
                    a[12] += m * w[tap][12] * bflo(x1[tap].z); a[13] += m * w[tap][13] * bfhi(x1[tap].z); a[14] += m * w[tap][14] * bflo(x1[tap].w); a[15] += m * w[tap][15] * bfhi(x1[tap].w);
                }
                u32x4 o0, o1; o0.x = cvt_pk_bf16(a[0], a[1]); o0.y = cvt_pk_bf16(a[2], a[3]); o0.z = cvt_pk_bf16(a[4], a[5]); o0.w = cvt_pk_bf16(a[6], a[7]);
                o1.x = cvt_pk_bf16(a[8], a[9]); o1.y = cvt_pk_bf16(a[10], a[11]); o1.z = cvt_pk_bf16(a[12], a[13]); o1.w = cvt_pk_bf16(a[14], a[15]);
                if (tokr < 64) { *(u32x4*)(XC + tok * XCS + ch) = o0; *(u32x4*)(XC + tok * XCS + ch + 8) = o1; }
            }
        }
        __syncthreads();
#pragma unroll 1
        for (int i = 0; i < 3; ++i) {
            const int hd = 2 * i + (wv >> 2), ntw = wv & 3, chl = 32 * ntw + l31, ch = hd * HD + chl;
            const bf16_t* wa = c.WA(l) + ((size_t)hd * HD + chl) * HD + 8 * hh; const bf16_t* wx = c.WX(l) + ((size_t)hd * HD + chl) * HD + 8 * hh;
            const float ba = c.in[6][l * DLRU + ch], bx = c.in[8][l * DLRU + ch], c8 = -8.0f * softplusf_(-c.in[9][l * DLRU + ch]);
            float sst = 0.f, Pt = 1.f;
            float hreg[2][16], preg[2][16];
            bf16x8 bRf[8], bIf[8];
#pragma unroll
            for (int s = 0; s < 8; ++s) { bRf[s] = *(const bf16x8*)(wa + 16 * s); bIf[s] = *(const bf16x8*)(wx + 16 * s); }
            __builtin_amdgcn_sched_barrier(0);
#pragma unroll
            for (int half = 0; half < 2; ++half) {
                float av[16], uv[16];
                {
                    f32x16 accR, accI;
#pragma unroll
                    for (int r = 0; r < 16; ++r) { accR[r] = 0.f; accI[r] = 0.f; }
#pragma unroll
                    for (int s = 0; s < 8; ++s) {
                        const bf16x8 a = *(const bf16x8*)(XC + (32 * half + l31) * XCS + hd * HD + 16 * s + 8 * hh);
                        accR = MFMA32(a, bRf[s], accR); accI = MFMA32(a, bIf[s], accI);
                    }
#pragma unroll
                    for (int r = 0; r < 16; ++r) {
                        const int tok = 32 * half + (r & 3) + 8 * (r >> 2) + 4 * hh;
                        const float xc = bf2f(XC[tok * XCS + ch]);
                        const float rg = sigmoidf_(accR[r] + ba), ig = sigmoidf_(accI[r] + bx);
                        const float la = c8 * rg;
                        av[r] = fast_exp(la); uv[r] = __builtin_amdgcn_sqrtf(one_minus_exp(2.0f * la)) * (ig * xc);
                    }
                }
                float Pp[4], Hp[4];
#pragma unroll
                for (int g = 0; g < 4; ++g) { float P = 1.f, H = 0.f;
#pragma unroll
                    for (int r = 4 * g; r < 4 * g + 4; ++r) { H = av[r] * H + uv[r]; P *= av[r]; }
                    Pp[g] = __shfl_xor(P, 32); Hp[g] = __shfl_xor(H, 32); }
#pragma unroll
                for (int g = 0; g < 4; ++g) {
                    if (hh == 0) {
#pragma unroll
                        for (int r = 4 * g; r < 4 * g + 4; ++r) { sst = av[r] * sst + uv[r]; Pt *= av[r]; hreg[half][r] = sst; preg[half][r] = Pt; }
                        sst = Pp[g] * sst + Hp[g]; Pt *= Pp[g];
                    } else {
                        sst = Pp[g] * sst + Hp[g]; Pt *= Pp[g];
#pragma unroll
                        for (int r = 4 * g; r < 4 * g + 4; ++r) { sst = av[r] * sst + uv[r]; Pt *= av[r]; hreg[half][r] = sst; preg[half][r] = Pt; }
                    }
                }
            }
            if (hh == 0) { f32x2_t o; o.x = Pt; o.y = sst; ((f32x2_t*)AGG)[(size_t)tile * DLRU + ch] = o; }
            __syncthreads();
#pragma unroll
            for (int half = 0; half < 2; ++half)
#pragma unroll
                for (int r = 0; r < 16; ++r) { const int tok = 32 * half + (r & 3) + 8 * (r >> 2) + 4 * hh;
                    XC[tok * XCS + ch] = f2bf(hreg[half][r]); PR[tok * 264 + (wv >> 2) * HD + chl] = f2bf(preg[half][r]); }
            __syncthreads();
#pragma unroll
            for (int k = 0; k < 4; ++k) {
                const int item = tid + 512 * k, tok = item >> 5, g = item & 31, hs = g >> 4, sub = g & 15, cc = (2 * i + hs) * HD + sub * 8;
                *(u32x4*)(HL + (size_t)(t0 + tok) * DLRU + cc) = *(const u32x4*)(XC + tok * XCS + cc);
                *(u32x4*)(PL + (size_t)(t0 + tok) * DLRU + cc) = *(const u32x4*)(PR + tok * 264 + hs * HD + sub * 8);
            }
        }
        __syncthreads();
    }
}

__device__ __forceinline__ void phase_lruB(const Ctx& c, int l, unsigned char* ldsb) {
    float* HIN = (float*)ldsb;
    const int tid = otid();
    const bf16_t* PROJ = c.PROJ(); const float* AGG = c.AGG(); const bf16_t* HL = c.HL(); const bf16_t* PL = c.PL();
    typedef float f32x2_t __attribute__((ext_vector_type(2)));
    for (int tile = obid(); tile < T / 64; tile += gridDim.x) {
        const int t0 = tile * 64, tb = tile & 63;
        {
            const f32x2_t* ag = (const f32x2_t*)AGG + (size_t)(tile - tb) * DLRU;
            const int chb = 512 + (tid & 255);
            float ha = 0.f, hb = 0.f;
#pragma unroll 8
            for (int k = 0; k < tb; ++k) { const f32x2_t pa = ag[(size_t)k * DLRU + tid], pb_ = ag[(size_t)k * DLRU + chb]; ha = pa.x * ha + pa.y; hb = pb_.x * hb + pb_.y; }
            HIN[tid] = ha; if (tid < 256) HIN[chb] = hb;
        }
        __syncthreads();
        const int wv_ = tid >> 6, wit0 = wv_ < 4 ? 8 * wv_ : 32 + 16 * (wv_ - 4), wcnt = wv_ < 4 ? 8 : 16;
#define LB_ADDR(it_, tok_, cc_) const int item_##it_ = (wit0 + (it_)) * 64 + (tid & 63), tok_ = item_##it_ / 96, rem_##it_ = item_##it_ % 96, cc_ = (rem_##it_ >> 4) * HD + (rem_##it_ & 15) * 8
#define LB_LOAD(H_, P_, G_, tok_, cc_) do { H_ = *(const u32x4*)(HL + (size_t)(t0 + tok_) * DLRU + cc_); P_ = *(const u32x4*)(PL + (size_t)(t0 + tok_) * DLRU + cc_); G_ = *(const u32x4*)(PROJ + (size_t)(t0 + tok_) * DPROJ + C_GA + cc_); } while (0)
#define LB_BODY(hv, pv, ga, tok, cc) do { \
            const f32x4 i0 = *(const f32x4*)(HIN + cc), i1 = *(const f32x4*)(HIN + cc + 4); \
            float y[8] = {(bflo(hv.x) + bflo(pv.x) * i0[0]) * gelu_tanh(bflo(ga.x)), (bfhi(hv.x) + bfhi(pv.x) * i0[1]) * gelu_tanh(bfhi(ga.x)), \
                          (bflo(hv.y) + bflo(pv.y) * i0[2]) * gelu_tanh(bflo(ga.y)), (bfhi(hv.y) + bfhi(pv.y) * i0[3]) * gelu_tanh(bfhi(ga.y)), \
                          (bflo(hv.z) + bflo(pv.z) * i1[0]) * gelu_tanh(bflo(ga.z)), (bfhi(hv.z) + bfhi(pv.z) * i1[1]) * gelu_tanh(bfhi(ga.z)), \
                          (bflo(hv.w) + bflo(pv.w) * i1[2]) * gelu_tanh(bflo(ga.w)), (bfhi(hv.w) + bfhi(pv.w) * i1[3]) * gelu_tanh(bfhi(ga.w))}; \
            float ss = 0.f; \
            _Pragma("unroll") for (int k = 0; k < 8; ++k) ss += y[k] * y[k]; \
            ss += __shfl_xor(ss, 1); ss += __shfl_xor(ss, 2); ss += __shfl_xor(ss, 4); ss += __shfl_xor(ss, 8); \
            const float rstd = rsqrtf(ss * (1.0f / HD) + EPS); \
            const float* mg = c.in[13] + (size_t)l * DM + cc; \
            const f32x4 m0 = *(const f32x4*)mg, m1 = *(const f32x4*)(mg + 4); \
            u32x4 o; o.x = cvt_pk_bf16(y[0] * rstd * m0[0], y[1] * rstd * m0[1]); o.y = cvt_pk_bf16(y[2] * rstd * m0[2], y[3] * rstd * m0[3]); \
            o.z = cvt_pk_bf16(y[4] * rstd * m1[0], y[5] * rstd * m1[1]); o.w = cvt_pk_bf16(y[6] * rstd * m1[2], y[7] * rstd * m1[3]); \
            *(u32x4*)(c.YMIX() + (size_t)(t0 + tok) * DM + cc) = o; } while (0)
        {
            u32x4 hA, pA, gA, hB, pB, gB;
            { LB_ADDR(0, tk_, cc_); LB_LOAD(hA, pA, gA, tk_, cc_); }
#pragma unroll 1
            for (int it = 0; it < wcnt; it += 2) {
                LB_ADDR(it, tkA, ccA); const int itb = it + 1; LB_ADDR(itb, tkB, ccB);
                LB_LOAD(hB, pB, gB, tkB, ccB); __builtin_amdgcn_sched_barrier(0);
                LB_BODY(hA, pA, gA, tkA, ccA);
                if (it + 2 < wcnt) { const int itc = it + 2; LB_ADDR(itc, tkC, ccC); LB_LOAD(hA, pA, gA, tkC, ccC); } __builtin_amdgcn_sched_barrier(0);
                LB_BODY(hB, pB, gB, tkB, ccB);
            }
        }
#undef LB_ADDR
#undef LB_LOAD
#undef LB_BODY
        __syncthreads();
    }
}

__device__ __forceinline__ void phase_vreduce(const Ctx& c) {
    const bf16_t* PT = c.PT(); bf16_t* VT = c.VT();
    for (int item = obid() * 512 + otid(); item < 64 * 256 * 32; item += gridDim.x * 512) {
        const int ro = item & 31, col = (item >> 5) & 255, u = item >> 13;
        const bf16_t* p = PT + (size_t)(u * 4) * 65536 + col * 256 + ro * 8;
        float a[8] = {0, 0, 0, 0, 0, 0, 0, 0};
#pragma unroll
        for (int kq = 0; kq < 4; ++kq) { const u32x4 w = *(const u32x4*)(p + (size_t)kq * 65536);
            a[0] += bflo(w.x); a[1] += bfhi(w.x); a[2] += bflo(w.y); a[3] += bfhi(w.y); a[4] += bflo(w.z); a[5] += bfhi(w.z); a[6] += bflo(w.w); a[7] += bfhi(w.w); }
        const int b = u >> 4, s0 = (u & 15) * 256 + ro * 8, h = 4 + (col >> 7), d = col & 127;
        u32x4 o; o.x = cvt_pk_bf16(a[0], a[1]); o.y = cvt_pk_bf16(a[2], a[3]); o.z = cvt_pk_bf16(a[4], a[5]); o.w = cvt_pk_bf16(a[6], a[7]);
        *(u32x4*)(VT + ((size_t)(b * NHS + h) * HD + d) * VTS + s0) = o;
    }
}

__device__ __forceinline__ void phase_attn(const Ctx& c, int l, unsigned char* ldsb) {
    const int lane = otid() & 63, wv = otid() >> 6, hh = lane >> 5, l31 = lane & 31;
    const bf16_t* PROJ = c.PROJ(); const bf16_t* VT = c.VT();
    const int prow = (l31 & ~12) | ((l31 & 4) << 1) | ((l31 & 8) >> 1);
    unsigned char* wl = ldsb + wv * 16384;
    const int kwbase = (lane >> 4) * 256 + (((lane & 15) ^ (lane >> 4)) * 16);
    const int vwoff = (lane >> 2) * 64 + (((lane & 3) ^ (lane >> 4)) * 16);
    const int kroff = prow * 256;
    const int nwt = NB * NHS * (SEQ / 32);
    const int nper = (nwt + (int)gridDim.x - 1) / (int)gridDim.x, wt0 = obid() * nper, wt1 = (wt0 + nper < nwt) ? wt0 + nper : nwt;
    for (int wt = wt0 + wv; wt < wt1; wt += 8) {
        const int qt = wt % (SEQ / 32), bh = wt / (SEQ / 32), b = bh / NHS, h = bh % NHS, q0 = qt * 32;
        const bf16_t* qp = PROJ + (size_t)(b * SEQ + q0 + l31) * DPROJ + C_Q + h * HD + 8 * hh;
        bf16x8 bq[8];
#pragma unroll
        for (int s = 0; s < 8; ++s) bq[s] = *(const bf16x8*)(qp + 16 * s);
        {
            float qs = 0.f;
#pragma unroll
            for (int s = 0; s < 8; ++s) { const u32x4 w = __builtin_bit_cast(u32x4, bq[s]);
                qs += bflo(w.x) * bflo(w.x) + bfhi(w.x) * bfhi(w.x) + bflo(w.y) * bflo(w.y) + bfhi(w.y) * bfhi(w.y) + bflo(w.z) * bflo(w.z) + bfhi(w.z) * bfhi(w.z) + bflo(w.w) * bflo(w.w) + bfhi(w.w) * bfhi(w.w); }
            qs += __shfl_xor(qs, 32);
            const float sc = rsqrtf(qs * (1.0f / HD) + EPS) * (1.4426950408889634f * 0.08838834764831845f);
#pragma unroll
            for (int s = 0; s < 8; ++s) { const u32x4 w = __builtin_bit_cast(u32x4, bq[s]); u32x4 o;
                o.x = cvt_pk_bf16(bflo(w.x) * sc, bfhi(w.x) * sc); o.y = cvt_pk_bf16(bflo(w.y) * sc, bfhi(w.y) * sc); o.z = cvt_pk_bf16(bflo(w.z) * sc, bfhi(w.z) * sc); o.w = cvt_pk_bf16(bflo(w.w) * sc, bfhi(w.w) * sc);
                bq[s] = __builtin_bit_cast(bf16x8, o); }
        }
        f32x16 O[4];
#pragma unroll
        for (int m = 0; m < 4; ++m)
#pragma unroll
            for (int r = 0; r < 16; ++r) O[m][r] = 0.f;
        float carry = 0.f;
        const bf16_t* kgl = PROJ + (size_t)(b * SEQ + (lane >> 4)) * DPROJ + C_K + h * HD + (lane & 15) * 8;
        const bf16_t* vgl = VT + ((size_t)bh * HD + (lane >> 2)) * VTS + (lane & 3) * 8;
        u32x4 stK[8], stV[8];
#define ATT_LOAD(kk0) do { _Pragma("unroll") for (int j = 0; j < 8; ++j) { \
            stK[j] = *(const u32x4*)(kgl + (size_t)((kk0) + 4 * j) * DPROJ); stV[j] = *(const u32x4*)(vgl + (size_t)(16 * j) * VTS + (kk0)); } } while (0)
        ATT_LOAD(q0);
        for (int k0 = q0; k0 >= 0; k0 -= 32) {
#pragma unroll
            for (int j = 0; j < 8; ++j) { *(u32x4*)(wl + j * 1024 + (kwbase ^ (64 * (j & 3)))) = stK[j]; *(u32x4*)(wl + 8192 + vwoff + j * 1024) = stV[j]; }
            const int kn = k0 >= 32 ? k0 - 32 : k0;
            ATT_LOAD(kn);
            __builtin_amdgcn_sched_barrier(0);
            f32x16 S;
#pragma unroll
            for (int r = 0; r < 16; ++r) S[r] = 0.f;
#pragma unroll
            for (int s = 0; s < 8; ++s) { const bf16x8 ak = *(const bf16x8*)(wl + kroff + (((2 * s + hh) ^ (prow & 15)) * 16)); S = MFMA32(ak, bq[s], S); }
            const bool diag = (k0 == q0);
            float sp[16];
            float R0 = 0.f, R1 = 0.f;
#pragma unroll
            for (int r = 0; r < 16; ++r) {
                const int kk = 16 * (r >> 3) + 8 * hh + (r & 7);
                const float z = S[r];
                float v = fmaxf(z, 0.f) + __builtin_amdgcn_logf(1.0f + __builtin_amdgcn_exp2f(-fabsf(z)));
                if (diag && kk >= l31) v = 0.f;
                sp[r] = v;
                if (r < 8) R0 += v; else R1 += v;
            }
            const float R0p = __shfl_xor(R0, 32), R1p = __shfl_xor(R1, 32);
            float suf_hi = carry - (hh == 0 ? R1p : 0.f);
            float suf_lo = carry - R1 - R1p - (hh == 0 ? R0p : 0.f);
            float w[16];
#pragma unroll
            for (int r = 15; r >= 8; --r) { w[r] = __builtin_amdgcn_exp2f(S[r] - sp[r] + suf_hi); suf_hi -= sp[r]; }
#pragma unroll
            for (int r = 7; r >= 0; --r) { w[r] = __builtin_amdgcn_exp2f(S[r] - sp[r] + suf_lo); suf_lo -= sp[r]; }
            if (diag) {
#pragma unroll
                for (int r = 0; r < 16; ++r) { const int kk = 16 * (r >> 3) + 8 * hh + (r & 7); if (kk >= l31) w[r] = 0.f; }
            }
            carry -= (R0 + R1 + R0p + R1p);
            bf16x8 wb[2];
            __builtin_amdgcn_sched_barrier(0);
#pragma unroll
            for (int s = 0; s < 2; ++s) { u32x4 pk; pk.x = cvt_pk_bf16(w[8 * s + 0], w[8 * s + 1]); pk.y = cvt_pk_bf16(w[8 * s + 2], w[8 * s + 3]); pk.z = cvt_pk_bf16(w[8 * s + 4], w[8 * s + 5]); pk.w = cvt_pk_bf16(w[8 * s + 6], w[8 * s + 7]);
                wb[s] = __builtin_bit_cast(bf16x8, pk); }
#pragma unroll
            for (int m = 0; m < 4; ++m)
#pragma unroll
                for (int s = 0; s < 2; ++s) { const bf16x8 vtf = *(const bf16x8*)(wl + 8192 + (32 * m + l31) * 64 + (((2 * s + hh) ^ (((32 * m + l31) >> 2) & 3)) * 16)); O[m] = MFMA32(vtf, wb[s], O[m]); }
            if (!__any(carry >= -150.1f)) break;
        }
        float ss = 0.f;
#pragma unroll
        for (int m = 0; m < 4; ++m)
#pragma unroll
            for (int r = 0; r < 16; ++r) ss += O[m][r] * O[m][r];
        ss += __shfl_xor(ss, 32);
        const float rstd = rsqrtf(ss * (1.0f / HD) + EPS);
        const float* mg = c.in[13] + (size_t)l * DM + DLRU + DCONV + h * HD + 4 * hh;
        bf16_t* yp = c.YMIX() + (size_t)(b * SEQ + q0 + l31) * DM + DLRU + DCONV + h * HD + 8 * hh;
#pragma unroll
        for (int m = 0; m < 4; ++m)
#pragma unroll
            for (int gp = 0; gp < 2; ++gp) { u32x2 o[2];
#pragma unroll
                for (int gg_ = 0; gg_ < 2; ++gg_) { const int g = 2 * gp + gg_; const f32x4 gg = *(const f32x4*)(mg + 32 * m + 8 * g);
                    o[gg_].x = cvt_pk_bf16(O[m][4 * g] * rstd * gg[0], O[m][4 * g + 1] * rstd * gg[1]); o[gg_].y = cvt_pk_bf16(O[m][4 * g + 2] * rstd * gg[2], O[m][4 * g + 3] * rstd * gg[3]); }
                const auto sx = __builtin_amdgcn_permlane32_swap(o[0].x, o[1].x, false, false); const auto sy = __builtin_amdgcn_permlane32_swap(o[0].y, o[1].y, false, false);
                *(u32x4*)(yp + 32 * m + 16 * gp) = (u32x4){sx[0], sy[0], sx[1], sy[1]};
            }
    }
}

#define XB_TMO      128
#define XB_XCNT(j)  (256  + 64 * (j))
#define XB_XSUB(j)  (1280 + 64 * (j))
#define XB_XGEN(j)  (2304 + 64 * (j))
#define XB_TOP      3328
#define XB_TOPGEN   3392
#define XCD_BAR_WORDS 3456
#define XB_SPIN_CAP (1u << 18)
__device__ __forceinline__ unsigned xb_ld(unsigned* p)              { return __hip_atomic_load(p, __ATOMIC_RELAXED, __HIP_MEMORY_SCOPE_AGENT); }
__device__ __forceinline__ unsigned xb_add(unsigned* p, unsigned v) { return __hip_atomic_fetch_add(p, v, __ATOMIC_RELAXED, __HIP_MEMORY_SCOPE_AGENT); }
__device__ __forceinline__ unsigned xb_xcc_id() { return (unsigned)__builtin_amdgcn_s_getreg((3 << 11) | 20) & 0xFu; }
#define XB_SPIN(cond, bar) do { unsigned _sp = 0; while (cond) { __builtin_amdgcn_s_sleep(1); \
    if ((++_sp & 255u) == 0u) { if (xb_ld(&(bar)[XB_TMO])) break; if (_sp > XB_SPIN_CAP) { atomicAdd(&(bar)[XB_TMO], 1u); break; } } } } while (0)
struct XcdBarrier { unsigned* bar; unsigned x; volatile LAS unsigned* st; };
__device__ __forceinline__ XcdBarrier xcd_barrier_post(unsigned* bar, volatile LAS unsigned* st) {
    XcdBarrier b; b.bar = bar; b.x = xb_xcc_id(); b.st = st;
    if (threadIdx.x == 0) (void)xb_add(&bar[XB_XCNT(b.x)], 1u);
    return b;
}
__device__ __forceinline__ void xcd_barrier_complete(unsigned* bar, unsigned x, unsigned& nloc, unsigned& nx) {
    const unsigned G = gridDim.x * gridDim.y * gridDim.z;
    unsigned sum, cnt, mine, sp = 0u;
    for (;;) {
        sum = 0u; cnt = 0u; mine = 0u;
#pragma unroll
        for (unsigned j = 0; j < 16; ++j) { const unsigned c = xb_ld(&bar[XB_XCNT(j)]); sum += c; cnt += (c > 0u) ? 1u : 0u; mine = (j == x) ? c : mine; }
        if (sum == G) break;
        __builtin_amdgcn_s_sleep(1);
        if ((++sp & 255u) == 0u) { if (xb_ld(&bar[XB_TMO])) break; if (sp > XB_SPIN_CAP) { atomicAdd(&bar[XB_TMO], 1u); break; } }
    }
    nloc = mine > 0u ? mine : 1u; nx = cnt > 0u ? cnt : 1u;
}
__device__ __forceinline__ void xcd_barrier(const XcdBarrier& b) {
    asm volatile("s_waitcnt vmcnt(0)" ::: "memory");
    __syncthreads();
    if (threadIdx.x == 0) {
        unsigned* bar = b.bar;
        __builtin_amdgcn_s_waitcnt(0);
        unsigned nloc = b.st[0], nx = b.st[1];
        if (nloc == 0u) { xcd_barrier_complete(bar, b.x, nloc, nx); b.st[0] = nloc; b.st[1] = nx; }
        const unsigned old = xb_add(&bar[XB_XSUB(b.x)], 1u);
        const unsigned gen = old / nloc;
        if (old + 1u == (gen + 1u) * nloc) {
            __builtin_amdgcn_fence(__ATOMIC_RELEASE, "agent");
            asm volatile("s_waitcnt vmcnt(0)" ::: "memory");
            const unsigned og = xb_add(&bar[XB_TOP], 1u);
            const unsigned tg = og / nx;
            if (og + 1u == (tg + 1u) * nx) xb_add(&bar[XB_TOPGEN], 1u);
            else XB_SPIN(xb_ld(&bar[XB_TOPGEN]) == tg, bar);
            __builtin_amdgcn_fence(__ATOMIC_ACQUIRE, "agent");
            xb_add(&bar[XB_XGEN(b.x)], 1u);
            asm volatile("s_waitcnt vmcnt(0)" ::: "memory");
        } else {
            XB_SPIN(xb_ld(&bar[XB_XGEN(b.x)]) == gen, bar);
            __builtin_amdgcn_fence(__ATOMIC_ACQUIRE, "agent");
            asm volatile("s_waitcnt vmcnt(0)" ::: "memory");
        }
    }
    __syncthreads();
}

constexpr int NPH_LAYER = 7, NPH = 1 + DEPTH * NPH_LAYER;
constexpr int LDS_TAB = g8::STAGE_BYTES, LDS_BARW = g8::STAGE_BYTES + 2048, LDS_KX = g8::STAGE_BYTES + 4096, LDS_BYTES = g8::STAGE_BYTES + 4096 + 8192;
__global__ void __launch_bounds__(512, 2) mega(Params p) {
    extern __shared__ __attribute__((aligned(16))) unsigned char lds_raw[];
    float* lds = (float*)lds_raw;
    LAS unsigned char* ldsl = (LAS unsigned char*)lds_raw;
    MoeTab* mt = (MoeTab*)(lds_raw + LDS_TAB);
    Ctx c0; c0.in.p = p.in; c0.in.z = 0; c0.out = p.out; c0.ws = p.ws;
    const int lo = p.ph_lo, hi = p.ph_hi;
    if (threadIdx.x == 0) *(uint4*)(lds_raw + LDS_BARW) = make_uint4(0u, 0u, 0u, 0u);
    __syncthreads();
    XcdBarrier bar = xcd_barrier_post(c0.ctl(), (volatile LAS unsigned*)(ldsl + LDS_BARW));
#ifndef PH_MASK
#define PH_MASK 0x1ff
#endif
#define PHT(k) ((k) == 0 ? 0 : 1 + ((k) - 1) % NPH_LAYER)
#define IN(k) (((PH_MASK >> PHT(k)) & 1) && lo <= (k) && (k) < hi)
#define SEAM(k) do { if (IN(k) && IN((k) + 1)) xcd_barrier(bar); } while (0)
#ifndef PROBE_RSH
#define PROBE_RSH 0
#endif
#ifndef PROBE_DUP
#define PROBE_DUP 0x0
#endif
#define REP(k) for (int rep_ = 0; rep_ < (((PROBE_DUP >> PHT(k)) & 1) ? 2 : 1); ++rep_)
    REP(0) if (IN(0)) { if (rep_) xcd_barrier(bar); const Ctx c = octx(c0); phase_convert(c, lds); phase_norm_in(c, 0); }
    SEAM(0);
#define LAYER_BODY(l) { \
        const int pb = 1 + l * NPH_LAYER; \
        REP(pb + 0) if (IN(pb + 0)) { if (rep_) xcd_barrier(bar); const Ctx c = octx(c0); const bool split_ = (gridDim.x == 256); \
            constexpr bool f8_ = f8in(l); constexpr int ku_ = f8_ ? DM / 2 : DM, ld_ = pb_in(l) / 2;        \
            { g8::DenseOrder S; S.init(T, DIN, gridDim.x, obid(), c.WIN(l), ld_); if (split_) S.lim = 1280; g8::MEpiProjT<f8_> E{c.PROJ(), c.VT(), (LAS float*)(ldsl + LDS_KX), c.in[11] + l * HD, c.in[12] + l * HD}; g8::gemm_mfma(ldsl, c.HB(), ld_, ld_, ku_, S, E); } \
            if (split_) { const int cb_ = obid(), kq_ = cb_ & 3; int k4_ = ku_ / 4; asm volatile("" : "+s"(k4_)); g8::SplitKOrder S{cb_, (const char*)(c.WIN(l) + (size_t)(20 * 256) * ld_ + kq_ * (ku_ / 4))}; g8::MEpiPartT<f8_> E{c.PT(), (LAS float*)(ldsl + LDS_KX)}; g8::gemm_mfma(ldsl, c.HB() + kq_ * (ku_ / 4), ld_, ld_, k4_, S, E); } } \
        SEAM(pb + 0); \
        REP(pb + 1) if (IN(pb + 1)) { if (rep_) xcd_barrier(bar); const Ctx c = octx(c0); if (gridDim.x == 256) phase_vreduce(c); phase_convb(c, l); if (PROBE_SUB == 4) phase_convb(c, l); phase_lruA(c, l, lds_raw); if (PROBE_SUB == 3) phase_lruA(c, l, lds_raw); } \
        SEAM(pb + 1); \
        REP(pb + 2) if (IN(pb + 2)) { if (rep_) xcd_barrier(bar); const Ctx c = octx(c0); phase_lruB(c, l, lds_raw); if (PROBE_SUB == 2) phase_lruB(c, l, lds_raw); phase_attn(c, l, lds_raw); if (PROBE_SUB == 1) phase_attn(c, l, lds_raw); } \
        SEAM(pb + 2); \
        REP(pb + 3) if (IN(pb + 3)) { if (rep_) xcd_barrier(bar); const Ctx c = octx(c0); g8::DenseOrder S; S.init(T, DM, gridDim.x, obid(), c.WOUT(l), DM); if (PROBE_RSH == 3 && l == 0) S.rsh = 1; g8::MEpiOut<l == 0> E{c.in[0], c.XB(), c.X1(), c.X1F8()}; g8::gemm_mfma(ldsl, c.YMIX(), DM, DM, DM, S, E);       } \
        SEAM(pb + 3); \
        REP(pb + 4) if (IN(pb + 4)) { if (rep_) xcd_barrier(bar); const Ctx c = octx(c0); phase_router_mfma(c, l, lds); } \
        SEAM(pb + 4); \
        REP(pb + 5) if (IN(pb + 5)) { if (rep_) xcd_barrier(bar); const Ctx c = octx(c0); build_moe_tab(c, l, mt); \
            const int G_ = (int)gridDim.x, cb_ = obid(), n1_ = __builtin_amdgcn_readfirstlane(mt->tstart[NEXP]) * 4, R_ = n1_ % G_, n1e_ = n1_ - R_, rtA_ = n1e_ >> 2; \
            { g8::MoeOrder<true, 4, DM / 2, (size_t)1024 * DM, (size_t)256 * DM> S{mt, c.LIST(), G_, cb_, (const char*)c.WGU(l)}; g8::MEpiGU E{c.HID8(), c.LISTR(), mt, c.RTC(l), n1e_}; g8::gemm_mfma(ldsl, (const bf16_t*)c.X1F8(), DM / 2, DM / 2, DM / 2, S, E); }       \
            g8::moe_wait_dep(c.RTC(l), cb_, G_, R_, rtA_); \
            { g8::MoeOrder2 S{mt, G_, cb_, R_, rtA_, (const char*)c.WD(l)}; if (PROBE_RSH == 6) S.rsh = 1; g8::MEpiDown8 E{c.YPAD8()}; int k2_ = DEXP / 2; asm volatile("" : "+s"(k2_)); g8::gemm_mfma(ldsl, (const bf16_t*)c.HID8(), DEXP / 2, DEXP / 2, k2_, S, E); } }       \
        SEAM(pb + 5); \
        REP(pb + 6) if (IN(pb + 6)) { if (rep_) xcd_barrier(bar); const Ctx c = octx(c0); build_moe_tab(c, l, mt); if (PROBE_SUB == 6) { phase_combine<true>(c, l, mt); xcd_barrier(bar); } phase_combine<false>(c, l, mt); } \
        SEAM(pb + 6); \
    }
    LAYER_BODY(0)
    LAYER_BODY(1)
#undef LAYER_BODY
#undef IN
#undef SEAM
}

#ifndef N_LAUNCH_SPLIT
#define N_LAUNCH_SPLIT 0
#endif
extern "C" void kernel_launch(void* const* d_in, const int* in_sizes, int n_in, void* d_out, int out_size, void* d_ws, size_t ws_size, hipStream_t stream) {
    static int grid = 0;
    if (grid == 0) {
        if (n_in != 23 || out_size != T * DM || ws_size < WS_END) { fprintf(stderr, "kernel_launch: unexpected problem (n_in %d out %d ws %zu need %zu)\n", n_in, out_size, ws_size, (size_t)WS_END); grid = -1; return; }
        int dev = 0, cus = 0, per_cu = 0;
        if (hipGetDevice(&dev) != hipSuccess || hipDeviceGetAttribute(&cus, hipDeviceAttributeMultiprocessorCount, dev) != hipSuccess) { fprintf(stderr, "kernel_launch: device query failed\n"); grid = -1; return; }
        if (hipFuncSetAttribute((const void*)mega, hipFuncAttributeMaxDynamicSharedMemorySize, LDS_BYTES) != hipSuccess) { fprintf(stderr, "kernel_launch: hipFuncSetAttribute failed\n"); grid = -1; return; }
        if (hipOccupancyMaxActiveBlocksPerMultiprocessor(&per_cu, (const void*)mega, 512, LDS_BYTES) != hipSuccess || per_cu < 1) { fprintf(stderr, "kernel_launch: occupancy query says %d blocks per CU\n", per_cu); }
        (void)hipGetLastError();
        grid = cus;
    }
    if (grid < 0) return;
    (void)hipMemsetAsync((char*)d_ws + OFF_CTL, 0, SZ_CTL, stream);
    Params p{};
    for (int i = 0; i < 23; ++i) p.in[i] = (const float*)d_in[i];
    p.out = (float*)d_out; p.ws = (unsigned char*)d_ws;
    if (N_LAUNCH_SPLIT) { for (int ph = 0; ph < NPH; ++ph) { p.ph_lo = ph; p.ph_hi = ph + 1; hipLaunchKernelGGL(mega, dim3(grid), dim3(512), LDS_BYTES, stream, p); } }
    else { p.ph_lo = 0; p.ph_hi = NPH; hipLaunchKernelGGL(mega, dim3(grid), dim3(512), LDS_BYTES, stream, p); }
}
```

```cpp
#include <hip/hip_runtime.h>
#include <stdint.h>
#include <stdio.h>

typedef unsigned short bf16_t;
typedef float f32x4 __attribute__((ext_vector_type(4)));
typedef unsigned u32x4 __attribute__((ext_vector_type(4)));
typedef unsigned u32x2 __attribute__((ext_vector_type(2)));
typedef short bf16x8 __attribute__((ext_vector_type(8)));

constexpr int T = 16384, DM = 2048, DIN = 5376, DPROJ = 4608, SEQ = 4096, NB = 4, DEPTH = 2;
constexpr int DLRU = 768, DCONV = 512, DSB = 768, HD = 128, NHL = 6, NHS = 6;
constexpr int NEXP = 32, DEXP = 512, MAXTILES = 160, PADROWS = MAXTILES * 256;
constexpr float EPS = 1e-6f;
constexpr float YSCALE_G = 8.0f;
constexpr float SX8 = 8.0f, SW1 = 64.0f, SH8 = 8.0f, SW2 = 32.0f;
#ifndef F8_INPROJ_MASK
#define F8_INPROJ_MASK 2
#endif
constexpr bool f8in(int l) { return ((F8_INPROJ_MASK >> l) & 1) != 0; }
constexpr float SHB = 16.0f, SWI = 64.0f;
#ifndef PITCH_PAD
#define PITCH_PAD 128
#endif
constexpr int pb_in(int l) { return (f8in(l) ? DM : DM * 2) + PITCH_PAD; }
constexpr int VTS = SEQ + 64;
constexpr int C_XA = 0, C_GA = 768, C_BG = 1536, C_CG = 2048, C_XB = 2560, C_Q = 3072, C_K = 3840, C_V = 4608;

constexpr size_t AL(size_t x) { return (x + 255) & ~(size_t)255; }
constexpr size_t SZ_WIN = (size_t)DIN * (DM * 2 + 256), SZ_WOUT = (size_t)DM * DM * 2, SZ_WGU = (size_t)NEXP * 1024 * DM * 2, SZ_WD = (size_t)NEXP * DM * DEXP * 2;
constexpr size_t SZ_WA = (size_t)NHL * HD * HD * 2, SZ_WR = (size_t)48 * DM * 4;
constexpr size_t OFF_CTL = 0, SZ_CTL = 131072;
constexpr size_t OFF_WIN = OFF_CTL + SZ_CTL;
constexpr size_t OFF_WOUT = OFF_WIN + DEPTH * SZ_WIN;
constexpr size_t OFF_WGU = OFF_WOUT + DEPTH * SZ_WOUT;
constexpr size_t OFF_WD = OFF_WGU + DEPTH * SZ_WGU;
constexpr size_t OFF_WA = OFF_WD + DEPTH * SZ_WD;
constexpr size_t OFF_WX = OFF_WA + DEPTH * SZ_WA;
constexpr size_t OFF_WR = OFF_WX + DEPTH * SZ_WA;
constexpr size_t OFF_HB = OFF_WR + DEPTH * SZ_WR;
constexpr size_t OFF_PROJ = OFF_HB + (size_t)T * (DM * 2 + 256);
constexpr size_t OFF_VT = OFF_PROJ + (size_t)T * DPROJ * 2;
constexpr size_t OFF_YPAD = OFF_PROJ;
constexpr size_t OFF_YMIX = OFF_VT + (size_t)NB * NHS * HD * VTS * 2;
constexpr size_t OFF_X = OFF_YMIX + (size_t)T * DM * 2;
constexpr size_t OFF_HID = OFF_X + (size_t)T * DM * 4;
constexpr size_t OFF_AGG = OFF_HID + (size_t)PADROWS * DEXP * 2;
constexpr size_t OFF_ROUTE = OFF_AGG + (size_t)256 * DLRU * 8;
constexpr size_t OFF_LIST = OFF_ROUTE + (size_t)T * 8 * 4;
constexpr size_t OFF_LISTR = OFF_LIST + (size_t)NEXP * T * 4;
constexpr size_t OFF_DB = OFF_LISTR + (size_t)NEXP * T * 4;
constexpr size_t WS_END = OFF_DB + (size_t)T * DM * 2;
static_assert((size_t)PADROWS * DM * 2 <= (size_t)T * DPROJ * 2 + (size_t)NB * NHS * HD * VTS * 2, "YPAD alias");
constexpr int CW_RT = 16384;
constexpr int CW_CNT = 8192;

typedef __bf16 bf16v2_t __attribute__((ext_vector_type(2)));
typedef float f32v2_t __attribute__((ext_vector_type(2)));
__device__ __forceinline__ unsigned cvt_pk_bf16(float lo, float hi) { const f32v2_t f = {lo, hi}; const bf16v2_t b = __builtin_convertvector(f, bf16v2_t); return __builtin_bit_cast(unsigned, b); }
__device__ __forceinline__ bf16_t f2bf(float f) { return (bf16_t)(cvt_pk_bf16(f, 0.f) & 0xffffu); }
__device__ __forceinline__ float bf2f(bf16_t b) { return __uint_as_float(((unsigned)b) << 16); }
__device__ __forceinline__ float bflo(unsigned w) { return __uint_as_float(w << 16); }
__device__ __forceinline__ float bfhi(unsigned w) { return __uint_as_float(w & 0xffff0000u); }
__device__ __forceinline__ float sat8(float v) { return __builtin_amdgcn_fmed3f(v, -448.0f, 448.0f); }
__device__ __forceinline__ float wave_sum(float v) {
#pragma unroll
    for (int o = 32; o >= 1; o >>= 1) v += __shfl_xor(v, o);
    return v;
}
__device__ __forceinline__ float fast_exp(float x) { return __builtin_amdgcn_exp2f(x * 1.4426950408889634f); }
__device__ __forceinline__ float sigmoidf_(float x) { return __builtin_amdgcn_rcpf(1.0f + fast_exp(-x)); }
__device__ __forceinline__ float one_minus_exp(float x) { const float s = -x * (1.0f + x * (0.5f + x * 0.16666667f)); const float d = 1.0f - fast_exp(x); return x > -0.02f ? s : d; }
__device__ __forceinline__ float softplusf_(float x) { return fmaxf(x, 0.f) + log1pf(__expf(-fabsf(x))); }
__device__ __forceinline__ float gelu_tanh(float x) { const float u2 = 1.5957691216057308f * (x + 0.044715f * x * x * x); return x * sigmoidf_(u2); }

__device__ __forceinline__ int otid() { int t = (int)threadIdx.x; asm volatile("" : "+v"(t)); return t; }
__device__ __forceinline__ int obid() { int b = (int)blockIdx.x; asm volatile("" : "+s"(b)); return b; }
#ifndef PROBE_SUB
#define PROBE_SUB 0
#endif
struct Params { const float* in[23]; float* out; unsigned char* ws; int ph_lo, ph_hi; };

struct InProxy { const float* const* p; int z; __device__ __forceinline__ const float* operator[](int k) const { return p[k + z]; } };
struct Ctx {
    InProxy in; float* out; unsigned char* ws;
    __device__ __forceinline__ unsigned* ctl() const { return (unsigned*)(ws + OFF_CTL); }
    __device__ __forceinline__ bf16_t* WIN(int l) const { return (bf16_t*)(ws + OFF_WIN + l * SZ_WIN); }
    __device__ __forceinline__ bf16_t* WOUT(int l) const { return (bf16_t*)(ws + OFF_WOUT + l * SZ_WOUT); }
    __device__ __forceinline__ bf16_t* WGU(int l) const { return (bf16_t*)(ws + OFF_WGU + l * SZ_WGU); }
    __device__ __forceinline__ bf16_t* WD(int l) const { return (bf16_t*)(ws + OFF_WD + l * SZ_WD); }
    __device__ __forceinline__ bf16_t* WA(int l) const { return (bf16_t*)(ws + OFF_WA + l * SZ_WA); }
    __device__ __forceinline__ bf16_t* WX(int l) const { return (bf16_t*)(ws + OFF_WX + l * SZ_WA); }
    __device__ __forceinline__ float* WR(int l) const { return (float*)(ws + OFF_WR + l * SZ_WR); }
    __device__ __forceinline__ unsigned* RTC(int l) const { return ctl() + CW_RT + l * 8192; }
    __device__ __forceinline__ unsigned* CNT(int l) const { return ctl() + CW_CNT + l * 2048; }
#define WSP(name, type, off) __device__ __forceinline__ type* name() const { return (type*)(ws + (off)); }
    WSP(HB, bf16_t, OFF_HB) WSP(PROJ, bf16_t, OFF_PROJ) WSP(VT, bf16_t, OFF_VT) WSP(YPAD, bf16_t, OFF_YPAD) WSP(YPAD8, unsigned char, OFF_YPAD) WSP(YMIX, bf16_t, OFF_YMIX) WSP(HID, bf16_t, OFF_HID)
    WSP(X, float, OFF_X) WSP(XB, bf16_t, OFF_X) WSP(AGG, float, OFF_AGG) WSP(ROUTE, unsigned, OFF_ROUTE) WSP(LIST, int, OFF_LIST) WSP(LISTR, float, OFF_LISTR) WSP(PT, bf16_t, OFF_X + (size_t)T * DM * 2) WSP(X1, bf16_t, OFF_X + (size_t)T * DM * 2) WSP(X1F8, unsigned char, OFF_HB) WSP(HID8, unsigned char, OFF_HID) WSP(DB, bf16_t, OFF_DB) WSP(HL, bf16_t, OFF_DB) WSP(PL, bf16_t, OFF_DB + (size_t)T * DLRU * 2)
#undef WSP
};

__device__ __forceinline__ Ctx octx(const Ctx& c) { int z = 0; asm volatile("" : "+s"(z)); Ctx r; r.in.p = c.in.p; r.in.z = z; r.out = c.out + z; r.ws = c.ws + z; return r; }

__device__ __forceinline__ void cvt_tile_out(const float* tile, int st, int r0, bf16_t* dst, int ld_dst, int drow0, bool f8) {
    const int rr = (st & 7) * 8;
    if (f8) {
#pragma unroll
        for (int p = 0; p < 2; ++p) {
            const int c = (st >> 3) + 32 * p; int w0 = 0, w1 = 0;
            w0 = __builtin_amdgcn_cvt_pk_fp8_f32(tile[(rr + 0) * 65 + c], tile[(rr + 1) * 65 + c], w0, false); w0 = __builtin_amdgcn_cvt_pk_fp8_f32(tile[(rr + 2) * 65 + c], tile[(rr + 3) * 65 + c], w0, true);
            w1 = __builtin_amdgcn_cvt_pk_fp8_f32(tile[(rr + 4) * 65 + c], tile[(rr + 5) * 65 + c], w1, false); w1 = __builtin_amdgcn_cvt_pk_fp8_f32(tile[(rr + 6) * 65 + c], tile[(rr + 7) * 65 + c], w1, true);
            *(u32x2*)((unsigned char*)dst + (size_t)(drow0 + c) * ld_dst + r0 + rr) = (u32x2){(unsigned)w0, (unsigned)w1};
        }
        return;
    }
#pragma unroll
    for (int p = 0; p < 2; ++p) {
        const int c = (st >> 3) + 32 * p;
        u32x4 w;
        w.x = cvt_pk_bf16(tile[(rr + 0) * 65 + c], tile[(rr + 1) * 65 + c]); w.y = cvt_pk_bf16(tile[(rr + 2) * 65 + c], tile[(rr + 3) * 65 + c]);
        w.z = cvt_pk_bf16(tile[(rr + 4) * 65 + c], tile[(rr + 5) * 65 + c]); w.w = cvt_pk_bf16(tile[(rr + 6) * 65 + c], tile[(rr + 7) * 65 + c]);
        *(u32x4*)(dst + (size_t)(drow0 + c) * ld_dst + r0 + rr) = w;
    }
}
constexpr int CV_WIN = 32 * 84, CV_WOUT = 32 * 32, CV_EXP = 32 * 8  , CV_G = NEXP * CV_EXP, CV_LRU = NHL * 4;
constexpr int CV_PER_LAYER = CV_WIN + CV_WOUT + 3 * CV_G + 2 * CV_LRU;
struct CvtTile { const float* src; bf16_t* dst; const float* gk; int ld_src, ld_dst, r0, c0, drow0; float sc; };
__device__ __forceinline__ void cvt_decode(const Ctx& c, int id, CvtTile& t) {
    const int l = id / CV_PER_LAYER; int j = id % CV_PER_LAYER; t.gk = nullptr; t.sc = 1.0f;
    if (j < CV_WIN) { t.src = c.in[2] + (size_t)l * DM * DIN; t.ld_src = DIN; { const int g = j >> 3, kp = g / 21, nq = g % 21; t.r0 = (2 * kp + ((j >> 2) & 1)) * 64; t.c0 = (4 * nq + (j & 3)) * 64; } t.dst = c.WIN(l); t.ld_dst = f8in(l) ? pb_in(l) : pb_in(l) / 2; t.drow0 = t.c0; if (f8in(l)) t.sc = -SWI; }
    else if ((j -= CV_WIN) < CV_WOUT) { t.src = c.in[14] + (size_t)l * DM * DM; t.ld_src = DM; { const int g = j >> 3, kp = g / 8, nq = g % 8; t.r0 = (2 * kp + ((j >> 2) & 1)) * 64; t.c0 = (4 * nq + (j & 3)) * 64; } t.dst = c.WOUT(l); t.ld_dst = DM; t.drow0 = t.c0; }
    else if ((j -= CV_WOUT) < 2 * CV_G) {
        const int isup = j / CV_G; j %= CV_G; const int e = j / CV_EXP; j %= CV_EXP;
        t.src = c.in[isup ? 21 : 20] + ((size_t)l * NEXP + e) * DM * DEXP; t.ld_src = DEXP; { const int g = j >> 3, kp = g / 2, nq = g % 2; t.r0 = (2 * kp + ((j >> 2) & 1)) * 64; t.c0 = (4 * nq + (j & 3)) * 64; }
        t.dst = (bf16_t*)((unsigned char*)c.WGU(l) + (size_t)e * 1024 * DM); t.ld_dst = DM; t.drow0 = 256 * (t.c0 / 128) + 128 * isup + (t.c0 % 128); t.gk = c.in[15] + (size_t)l * DM; t.sc = -SW1;
    } else if ((j -= 2 * CV_G) < CV_G) {
        const int e = j / CV_EXP; j %= CV_EXP;
        t.src = c.in[22] + ((size_t)l * NEXP + e) * DEXP * DM; t.ld_src = DM; { const int g = j >> 3, kp = g / 8, nq = g % 8; t.r0 = (2 * kp + ((j >> 2) & 1)) * 64; t.c0 = (4 * nq + (j & 3)) * 64; }
        t.dst = (bf16_t*)((unsigned char*)c.WD(l) + (size_t)e * DM * DEXP); t.ld_dst = DEXP; t.drow0 = t.c0; t.sc = -SW2;
    } else { j -= CV_G; const int isx = j / CV_LRU; j %= CV_LRU; const int h = j / 4; j %= 4;
        t.src = c.in[isx ? 7 : 5] + ((size_t)l * NHL + h) * HD * HD; t.ld_src = HD; t.r0 = (j / 2) * 64; t.c0 = (j % 2) * 64;
        t.dst = (isx ? c.WX(l) : c.WA(l)) + (size_t)h * HD * HD; t.ld_dst = HD; t.drow0 = t.c0; }
}
constexpr int CVT_NT = 4;
__device__ __forceinline__ void phase_convert(const Ctx& c, float* lds) {
    const int tid = otid(), sb = tid >> 8, st = tid & 255;
    float* tile0 = lds + sb * (CVT_NT * 64 * 65);
    const int total = DEPTH * CV_PER_LAYER;
    const int nsub = gridDim.x * 2 * CVT_NT;
    const int idb = (obid() * 2 + sb) * CVT_NT;
    CvtTile tA[CVT_NT]; f32x4 vA[CVT_NT][4];
#define CVT_LOAD(T_, V_, base_) do { _Pragma("unroll") for (int k = 0; k < CVT_NT; ++k) { const int id_ = (base_) + idb + k; cvt_decode(c, id_ < total ? id_ : 0, T_[k]); \
        _Pragma("unroll") for (int i = 0; i < 4; ++i) V_[k][i] = __builtin_nontemporal_load((const f32x4*)(T_[k].src + (size_t)(T_[k].r0 + (st >> 4) + 16 * i) * T_[k].ld_src + T_[k].c0 + (st & 15) * 4)); } } while (0)
#define CVT_FLUSH(T_, V_, base_) do { _Pragma("unroll") for (int k = 0; k < CVT_NT; ++k) _Pragma("unroll") for (int i = 0; i < 4; ++i) { \
            float* p = tile0 + k * (64 * 65) + ((st >> 4) + 16 * i) * 65 + (st & 15) * 4; const float gs_ = (T_[k].gk ? T_[k].gk[T_[k].r0 + (st >> 4) + 16 * i] : 1.0f) * fabsf(T_[k].sc); \
            p[0] = V_[k][i][0] * gs_; p[1] = V_[k][i][1] * gs_; p[2] = V_[k][i][2] * gs_; p[3] = V_[k][i][3] * gs_; } \
        __syncthreads(); \
        _Pragma("unroll") for (int k = 0; k < CVT_NT; ++k) if ((base_) + idb + k < total) cvt_tile_out(tile0 + k * (64 * 65), st, T_[k].r0, T_[k].dst, T_[k].ld_dst, T_[k].drow0, T_[k].sc < 0.f); \
        __syncthreads(); } while (0)
    for (int base = 0; base < total; base += nsub) { CVT_LOAD(tA, vA, base); CVT_FLUSH(tA, vA, base); }
#undef CVT_LOAD
#undef CVT_FLUSH
    for (int i = obid() * blockDim.x + tid; i < DEPTH * 48 * DM; i += gridDim.x * blockDim.x) {
        const int l = i / (48 * DM), n = (i / DM) % 48, k = i % DM;
        float v = 0.f;
        if (n < 4) v = c.in[16][((size_t)l * DM + k) * 4 + n]; else if (n < 36) v = c.in[18][((size_t)l * DM + k) * 32 + (n - 4)];
        const float wg = v * c.in[15][(size_t)l * DM + k]; const bf16_t hi = f2bf(wg);
        bf16_t* wr = (bf16_t*)c.WR(l); wr[(size_t)n * DM + k] = hi; wr[(size_t)(48 + n) * DM + k] = f2bf(wg - bf2f(hi));
    }
}

__device__ __forceinline__ void norm_store_row(const f32x4 (&v)[8], const float* g, bf16_t* dst, int lane) {
    float s = 0.f;
#pragma unroll
    for (int j = 0; j < 8; ++j) s += v[j][0] * v[j][0] + v[j][1] * v[j][1] + v[j][2] * v[j][2] + v[j][3] * v[j][3];
    s = wave_sum(s);
    const float rstd = rsqrtf(s * (1.0f / DM) + EPS);
#pragma unroll
    for (int j = 0; j < 8; ++j) {
        const f32x4 gg = *(const f32x4*)(g + j * 256 + lane * 4);
        u32x2 w; w.x = cvt_pk_bf16(v[j][0] * rstd * gg[0], v[j][1] * rstd * gg[1]); w.y = cvt_pk_bf16(v[j][2] * rstd * gg[2], v[j][3] * rstd * gg[3]);
        *(u32x2*)(dst + j * 256 + lane * 4) = w;
    }
}
__device__ __forceinline__ void norm_store_row8(const f32x4 (&v)[8], const float* g, unsigned char* dst, int lane) {
    float s = 0.f;
#pragma unroll
    for (int j = 0; j < 8; ++j) s += v[j][0] * v[j][0] + v[j][1] * v[j][1] + v[j][2] * v[j][2] + v[j][3] * v[j][3];
    s = wave_sum(s);
    const float rstd = rsqrtf(s * (1.0f / DM) + EPS) * SHB;
#pragma unroll
    for (int j = 0; j < 8; ++j) {
        const f32x4 gg = *(const f32x4*)(g + j * 256 + lane * 4);
        int w = 0; w = __builtin_amdgcn_cvt_pk_fp8_f32(sat8(v[j][0] * rstd * gg[0]), sat8(v[j][1] * rstd * gg[1]), w, false); w = __builtin_amdgcn_cvt_pk_fp8_f32(sat8(v[j][2] * rstd * gg[2]), sat8(v[j][3] * rstd * gg[3]), w, true);
        *(int*)(dst + j * 256 + lane * 4) = w;
    }
}
__device__ __forceinline__ void phase_norm_in(const Ctx& c, int l) {
    const int tid = otid(), lane = tid & 63, wv = tid >> 6, stride = gridDim.x * 8;
    for (int r = obid() * 8 + wv; r < T; r += 4 * stride) {
        f32x4 v[4][8];
#pragma unroll
        for (int k = 0; k < 4; ++k) { const int rr = (r + k * stride < T) ? r + k * stride : r;
#pragma unroll
            for (int j = 0; j < 8; ++j) v[k][j] = *(const f32x4*)(c.in[0] + (size_t)rr * DM + j * 256 + lane * 4); }
#pragma unroll
        for (int k = 0; k < 4; ++k) if (k == 0 || r + k * stride < T) norm_store_row(v[k], c.in[1] + (size_t)l * DM, (bf16_t*)((unsigned char*)c.HB() + (size_t)(r + k * stride) * pb_in(0)), lane);
    }
}

struct MoeTab { int cnt[NEXP]; int tstart[NEXP + 1]; int texp[MAXTILES]; };
__device__ __forceinline__ void build_moe_tab(const Ctx& c, int l, MoeTab* mt) {
    __syncthreads();
    const int tid = otid();
    if (tid < 64) {
        const int n = tid < NEXP ? (int)__hip_atomic_load(c.CNT(l) + tid * 64, __ATOMIC_RELAXED, __HIP_MEMORY_SCOPE_AGENT) : 0;
        const int nt = (n + 255) >> 8;
        int incl = nt;
#pragma unroll
        for (int o = 1; o < 32; o <<= 1) { const int v = __shfl_up(incl, o); if (tid >= o) incl += v; }
        const int excl = incl - nt;
        if (tid < NEXP) { mt->cnt[tid] = n; mt->tstart[tid] = excl; for (int i = 0; i < nt; ++i) if (excl + i < MAXTILES) mt->texp[excl + i] = tid; }
        if (tid == NEXP - 1) mt->tstart[NEXP] = incl < MAXTILES ? incl : MAXTILES;
    }
    __syncthreads();
}

template <bool DRY> __device__ __forceinline__ void phase_combine(const Ctx& c, int l, const MoeTab* mt) {
    const int tid = otid(), lane = tid & 63, wv = tid >> 6, stride = gridDim.x * 8;
    bf16_t* XB = c.XB(); const bf16_t* X1 = c.X1(); const unsigned char* YPAD = c.YPAD8(); const unsigned* ROUTE = c.ROUTE();
    for (int r = obid() * 8 + wv; r < T; r += 2 * stride) {
        f32x4 v[2][8]; unsigned ya[2][8], yb[2][8]; u32x2 yd[2][8]; float g0[2], g1[2]; int rr[2];
#pragma unroll
        for (int k = 0; k < 2; ++k) {
            rr[k] = (r + k * stride < T) ? r + k * stride : r;
            const u32x4 ra = *(const u32x4*)(ROUTE + (size_t)rr[k] * 8); const u32x2 rb = *(const u32x2*)(ROUTE + (size_t)rr[k] * 8 + 4);
            const int e0 = ra.x, p0 = ra.y, e1 = ra.w, p1 = rb.x; g0[k] = __uint_as_float(ra.z) * (1.0f / YSCALE_G); g1[k] = __uint_as_float(rb.y) * (1.0f / YSCALE_G);
            const unsigned char* y0 = YPAD + ((size_t)mt->tstart[e0] * 256 + p0) * DM + lane * 4; const unsigned char* y1 = YPAD + ((size_t)mt->tstart[e1] * 256 + p1) * DM + lane * 4;
            const bf16_t* dp = X1 + (size_t)rr[k] * DM + lane * 4;
#pragma unroll
            for (int j = 0; j < 8; ++j) { v[k][j] = (f32x4){0.f, 0.f, 0.f, 0.f};
                ya[k][j] = *(const unsigned*)(y0 + j * 256); yb[k][j] = *(const unsigned*)(y1 + j * 256); yd[k][j] = *(const u32x2*)(dp + j * 256); }
        }
        __builtin_amdgcn_sched_barrier(0);
#pragma unroll
        for (int k = 0; k < 2; ++k) {
            if (k == 0 || r + stride < T) {
#pragma unroll
                for (int j = 0; j < 8; ++j) {
                    typedef float f32x2_t __attribute__((ext_vector_type(2)));
                    const f32x2_t a01 = __builtin_amdgcn_cvt_pk_f32_fp8((int)ya[k][j], false), a23 = __builtin_amdgcn_cvt_pk_f32_fp8((int)ya[k][j], true);
                    const f32x2_t b01 = __builtin_amdgcn_cvt_pk_f32_fp8((int)yb[k][j], false), b23 = __builtin_amdgcn_cvt_pk_f32_fp8((int)yb[k][j], true);
                    v[k][j][0] += bflo(yd[k][j].x) + g0[k] * a01.x + g1[k] * b01.x; v[k][j][1] += bfhi(yd[k][j].x) + g0[k] * a01.y + g1[k] * b01.y;
                    v[k][j][2] += bflo(yd[k][j].y) + g0[k] * a23.x + g1[k] * b23.x; v[k][j][3] += bfhi(yd[k][j].y) + g0[k] * a23.y + g1[k] * b23.y;
                }
                if (l == DEPTH - 1) {
                    if (!DRY) {
#pragma unroll
                    for (int j = 0; j < 8; ++j) *(f32x4*)(c.out + (size_t)rr[k] * DM + j * 256 + lane * 4) = v[k][j]; }
                    else norm_store_row(v[k], c.in[1], c.HB() + (size_t)rr[k] * DM, lane);
                } else {
                    if (!DRY) {
#pragma unroll
                    for (int j = 0; j < 8; ++j) { u32x2 xw; xw.x = cvt_pk_bf16(v[k][j][0], v[k][j][1]); xw.y = cvt_pk_bf16(v[k][j][2], v[k][j][3]); *(u32x2*)(XB + (size_t)rr[k] * DM + j * 256 + lane * 4) = xw; } }
                    if (f8in(l + 1)) norm_store_row8(v[k], c.in[1] + (size_t)(l + 1) * DM, (unsigned char*)c.HB() + (size_t)rr[k] * pb_in(l + 1), lane);
                    else norm_store_row(v[k], c.in[1] + (size_t)(l + 1) * DM, (bf16_t*)((unsigned char*)c.HB() + (size_t)rr[k] * pb_in(l + 1)), lane);
                }
            }
        }
    }
}

__device__ __forceinline__ void phase_router_mfma(const Ctx& c, int l, float* lds) {
    float* LG = lds; float* SS = lds + 26624; float* RS = lds + 27136; int* LC = (int*)(lds + 27200); int* LB = (int*)(lds + 27232);
    const int tid = otid(), lane = tid & 63, wv = tid >> 6, rt = wv & 3, kh = wv >> 2, q = lane >> 4, l15 = lane & 15;
    const float* WR = c.WR(l);
    for (int tile = obid(); tile < T / 64; tile += gridDim.x) {
        const int r0 = tile * 64;
        f32x4 acc[4][3];
#pragma unroll
        for (int g = 0; g < 4; ++g)
#pragma unroll
            for (int ct = 0; ct < 3; ++ct) acc[g][ct] = (f32x4){0.f, 0.f, 0.f, 0.f};
        const bf16_t* xp = c.X1() + (size_t)(r0 + l15) * DM + wv * 256 + 8 * q;
        const bf16_t* wh = (const bf16_t*)WR + (size_t)l15 * DM + wv * 256 + 8 * q; const bf16_t* wl = wh + (size_t)48 * DM;
        float ssq[4] = {0.f, 0.f, 0.f, 0.f};
        bf16x8 xa[2][4], bh[2][3], bl[2][3];
#pragma unroll
        for (int st = 0; st < 2; ++st)
#pragma unroll
            for (int g = 0; g < 4; ++g) xa[st][g] = *(const bf16x8*)(xp + (size_t)(16 * g) * DM + 32 * st);
#pragma unroll
        for (int ct = 0; ct < 3; ++ct) { bh[0][ct] = *(const bf16x8*)(wh + (size_t)(16 * ct) * DM); bl[0][ct] = *(const bf16x8*)(wl + (size_t)(16 * ct) * DM); }
#define RT_STEP(st_, cur_, nxt_, ldb_, ldx_) do { \
            if (ldb_) { _Pragma("unroll") for (int ct = 0; ct < 3; ++ct) { bh[nxt_][ct] = *(const bf16x8*)(wh + (size_t)(16 * ct) * DM + 32 * ((st_) + 1)); bl[nxt_][ct] = *(const bf16x8*)(wl + (size_t)(16 * ct) * DM + 32 * ((st_) + 1)); } } \
            __builtin_amdgcn_sched_barrier(0); \
            _Pragma("unroll") for (int g = 0; g < 4; ++g) { \
                const bf16x8 xv = xa[cur_][g]; \
                _Pragma("unroll") for (int j = 0; j < 8; ++j) { const float xf = __uint_as_float(((unsigned)(unsigned short)xv[j]) << 16); ssq[g] += xf * xf; } \
                _Pragma("unroll") for (int ct = 0; ct < 3; ++ct) { acc[g][ct] = __builtin_amdgcn_mfma_f32_16x16x32_bf16(xv, bh[cur_][ct], acc[g][ct], 0, 0, 0); acc[g][ct] = __builtin_amdgcn_mfma_f32_16x16x32_bf16(xv, bl[cur_][ct], acc[g][ct], 0, 0, 0); } \
                if (ldx_) xa[cur_][g] = *(const bf16x8*)(xp + (size_t)(16 * g) * DM + 32 * ((st_) + 2)); } \
            __builtin_amdgcn_sched_barrier(0); } while (0)
#pragma unroll 1
        for (int sp = 0; sp < 4; ++sp) {
            RT_STEP(2 * sp, 0, 1, true, sp < 3);
            RT_STEP(2 * sp + 1, 1, 0, sp < 3, sp < 3);
        }
#undef RT_STEP
#pragma unroll
        for (int g = 0; g < 4; ++g) { float v = ssq[g]; v += __shfl_xor(v, 16); v += __shfl_xor(v, 32); if (q == 0) SS[wv * 64 + 16 * g + l15] = v; }
#pragma unroll
        for (int g = 0; g < 4; ++g)
#pragma unroll
            for (int ct = 0; ct < 3; ++ct)
#pragma unroll
                for (int i = 0; i < 4; ++i) LG[(wv * 64 + 16 * g + 4 * q + i) * 52 + 16 * ct + l15] = acc[g][ct][i];
        if (tid < NEXP) LC[tid] = 0;
        __syncthreads();
        int e0 = 0, e1 = 0, k0_ = 0, k1_ = 0; float rstd_ = 0.f, g0_ = 0.f, g1_ = 0.f;
        if (tid < 64) {
            float sst_ = 0.f;
#pragma unroll
            for (int w = 0; w < 8; ++w) sst_ += SS[w * 64 + tid];
            const float rstd = rsqrtf(sst_ * (1.0f / DM) + EPS);
            RS[tid] = rstd;
            float gl[4], el[8];
#pragma unroll
            for (int i = 0; i < 4; ++i) { float a_ = 0.f;
#pragma unroll
                for (int w = 0; w < 8; ++w) a_ += LG[(w * 64 + tid) * 52 + i];
                gl[i] = a_ * rstd + c.in[17][l * 4 + i]; }
            int gi = 0; float gm = gl[0];
#pragma unroll
            for (int i = 1; i < 4; ++i) if (gl[i] > gm) { gm = gl[i]; gi = i; }
            float gs = 0.f;
#pragma unroll
            for (int i = 0; i < 4; ++i) gs += __expf(gl[i] - gm);
            const float pg = 1.0f / gs;
#pragma unroll
            for (int i = 0; i < 8; ++i) { const int n = 4 + gi * 8 + i; float a_ = 0.f;
#pragma unroll
                for (int w = 0; w < 8; ++w) a_ += LG[(w * 64 + tid) * 52 + n];
                el[i] = a_ * rstd + c.in[19][l * 32 + gi * 8 + i]; }
            int i0 = 0; float m0 = el[0];
#pragma unroll
            for (int i = 1; i < 8; ++i) if (el[i] > m0) { m0 = el[i]; i0 = i; }
            int i1 = -1; float m1 = -3.0e38f;
#pragma unroll
            for (int i = 0; i < 8; ++i) if (i != i0 && el[i] > m1) { m1 = el[i]; i1 = i; }
            const float ex1 = __expf(m1 - m0), den = 1.0f + ex1;
            const float g0 = pg / den, g1 = pg * ex1 / den;
            e0 = gi * 8 + i0; e1 = gi * 8 + i1; rstd_ = rstd; g0_ = g0; g1_ = g1;
            k0_ = (int)__hip_atomic_fetch_add(&LC[e0], 1, __ATOMIC_RELAXED, __HIP_MEMORY_SCOPE_WORKGROUP);
            k1_ = (int)__hip_atomic_fetch_add(&LC[e1], 1, __ATOMIC_RELAXED, __HIP_MEMORY_SCOPE_WORKGROUP);
        }
        __syncthreads();
        if (tid < NEXP) { const int n = LC[tid]; LB[tid] = n > 0 ? (int)__hip_atomic_fetch_add(c.CNT(l) + tid * 64, (unsigned)n, __ATOMIC_RELAXED, __HIP_MEMORY_SCOPE_AGENT) : 0; }
        __syncthreads();
        if (tid < 64) {
            const int r = r0 + tid, p0 = LB[e0] + k0_, p1 = LB[e1] + k1_;
            c.LIST()[(size_t)e0 * T + p0] = r; c.LIST()[(size_t)e1 * T + p1] = r;
            c.LISTR()[(size_t)e0 * T + p0] = rstd_; c.LISTR()[(size_t)e1 * T + p1] = rstd_;
            unsigned* ro = c.ROUTE() + (size_t)r * 8;
            *(u32x4*)ro = (u32x4){(unsigned)e0, (unsigned)p0, __float_as_uint(g0_), (unsigned)e1};
            *(u32x2*)(ro + 4) = (u32x2){(unsigned)p1, __float_as_uint(g1_)};
        }
        __syncthreads();
    }
}

#define LAS __attribute__((address_space(3)))
typedef int i32x4_t __attribute__((ext_vector_type(4)));
typedef int i32x8_t __attribute__((ext_vector_type(8)));
__device__ __forceinline__ i32x8_t cat8(const bf16x8 a, const bf16x8 b) { const i32x4_t x = __builtin_bit_cast(i32x4_t, a), y = __builtin_bit_cast(i32x4_t, b); return __builtin_shufflevector(x, y, 0, 1, 2, 3, 4, 5, 6, 7); }
__device__ __forceinline__ void mfma_f8(f32x4& acc, const i32x8_t& a, const i32x8_t& b) { asm volatile("v_mfma_f32_16x16x128_f8f6f4 %0, %1, %2, %0" : "+v"(acc) : "v"(a), "v"(b)); }
__device__ __forceinline__ bf16x8 half8(const i32x8_t& v, int k) { const i32x4_t h = k ? __builtin_shufflevector(v, v, 4, 5, 6, 7) : __builtin_shufflevector(v, v, 0, 1, 2, 3); return __builtin_bit_cast(bf16x8, h); }
namespace g8 {
constexpr int BM = 256, BK = 64, HALF = 128, HTB = HALF * BK * 2, STAGE_BYTES = 8 * HTB, NXCD = 8, WGM = 8;
__device__ __forceinline__ int lds_byte(int r, int c) { const int st = (r >> 4) * 2 + (c >> 5), rr = r & 15, cc = c & 31, ob = rr * 64 + cc * 2; return st * 1024 + (ob ^ (((ob >> 9) & 1) << 5)); }
__device__ __forceinline__ void stage_rc(int b, int& R, int& C) { const int st = b / 1024, sb = b % 1024, swz = sb ^ (((sb >> 9) & 1) << 5); R = (st >> 1) * 16 + swz / 64; C = (st & 1) * 32 + (swz % 64) / 2; }
__device__ __forceinline__ int perm32(int rho) { const int n = rho >> 4, i = rho & 15; return 8 * (i >> 2) + 4 * n + (i & 3); }
struct Unit { int pm, pn; const char* B; };
typedef f32x4 Acc[2][2][4][2];

struct DenseOrder {
    static constexpr bool GATHER = false;
    int nM, nN, nwg, G, c; const char* Bt; size_t tstrideB; int rsh = 0, lim = 0x7fffffff;
    __device__ __forceinline__ void init(int M, int N, int G_, int c_, const bf16_t* Bt_, int ldb) { nM = M / BM; nN = N / BM; nwg = nM * nN; G = G_; c = c_; Bt = (const char*)Bt_; tstrideB = (size_t)BM * ldb * 2; }
    __device__ __forceinline__ bool next(int i, Unit& u) const {
        const long L = (long)(i >> rsh) * G + c; if (L >= nwg || L >= lim) return false;
        int wgid = (int)L; { const int q = nwg / NXCD, r = nwg % NXCD, xcd = wgid % NXCD, off = wgid / NXCD; wgid = (xcd < r ? xcd * (q + 1) : r * (q + 1) + (xcd - r) * q) + off; }
        const int nig = WGM * nN, gid = wgid / nig, fm = gid * WGM, gsz = (nM - fm) < WGM ? (nM - fm) : WGM;
        u.pm = fm + ((wgid % nig) % gsz); u.pn = (wgid % nig) / gsz; u.B = Bt + (size_t)u.pn * tstrideB; return true;
    }
    __device__ __forceinline__ unsigned arow_off(int) const { return 0u; }
};
struct SplitKOrder {
    static constexpr bool GATHER = false;
    int c; const char* Bt;
    __device__ __forceinline__ bool next(int i, Unit& u) const { if (i > 0) return false; u.pm = c >> 2; u.pn = c & 3; u.B = Bt; return true; }
    __device__ __forceinline__ unsigned arow_off(int) const { return 0u; }
};
template <bool GATHER_, int NCT, int LDA, size_t ESTRIDE, size_t TSTRIDE> struct MoeOrder {
    static constexpr bool GATHER = GATHER_;
    const MoeTab* mt; const int* LIST; int G, c; const char* W; int rsh = 0;
    __device__ __forceinline__ bool next(int i, Unit& u) const {
        const int L = (i >> rsh) * G + c; const int total = __builtin_amdgcn_readfirstlane(mt->tstart[NEXP]) * NCT; if (L >= total) return false;
        const int rt = L / NCT, ct = L % NCT; u.pm = rt; u.pn = ct; const int e = __builtin_amdgcn_readfirstlane(mt->texp[rt]); u.B = W + (size_t)e * ESTRIDE + (size_t)ct * TSTRIDE; return true;
    }
    __device__ __forceinline__ unsigned arow_off(int r) const {
        const int e = mt->texp[r >> 8]; const int pos = r - mt->tstart[e] * 256; const int tok = pos < mt->cnt[e] ? LIST[(size_t)e * T + pos] : 0; return (unsigned)tok * (unsigned)(LDA * 2);
    }
};

struct MoeOrder2 {
    static constexpr bool GATHER = false;
    const MoeTab* mt; int G, c, R, rtA; const char* W; int rsh = 0;
    __device__ __forceinline__ bool next(int i0, Unit& u) const {
        const int i = i0 >> rsh; int u2;
        if (c < R) { if (i >= 2) return false; u2 = rtA * 8 + 2 * c + i; }
        else { u2 = (c - R) + i * (G - R); if (u2 >= rtA * 8) return false; }
        const int rt = u2 >> 3, ct = u2 & 7; u.pm = rt; u.pn = ct; const int e = __builtin_amdgcn_readfirstlane(mt->texp[rt]);
        u.B = W + (size_t)e * ((size_t)DM * DEXP) + (size_t)ct * ((size_t)256 * DEXP); return true;
    }
    __device__ __forceinline__ unsigned arow_off(int) const { return 0u; }
};
__device__ __forceinline__ void moe_wait_dep(unsigned* rtc, int c, int G, int R, int rtA) {
    const int tid = otid();
    if (tid < 64) {
        int rt = -1;
        if (c < R) { if (tid < 2) rt = rtA + ((2 * c + tid) >> 3); } else if (tid < 32) { const int u2 = (c - R) + tid * (G - R); if (u2 < rtA * 8) rt = u2 >> 3; }
        unsigned spins = 0;
        for (;;) {
            const bool ok = rt < 0 || __hip_atomic_load(rtc + (rt < 0 ? 0 : rt) * 32, __ATOMIC_RELAXED, __HIP_MEMORY_SCOPE_AGENT) >= 32u;
            if (__all(ok)) break;
            __builtin_amdgcn_s_sleep(2); if (++spins > (1u << 22)) break;
        }
        __builtin_amdgcn_fence(__ATOMIC_ACQUIRE, "agent");
        asm volatile("s_waitcnt vmcnt(0)" ::: "memory");
    }
    __syncthreads();
}

template <class Epi, class Sched>
__device__ __forceinline__ void gemm_mfma(LAS unsigned char* lds, const bf16_t* A, int lda, int ldb, int K, const Sched& S, const Epi& E) {
    constexpr bool GATHER = Sched::GATHER;
    const int tid = otid(), wid = __builtin_amdgcn_readfirstlane(tid >> 6), lane = tid & 63, wr = wid >> 2, wc = wid & 3, fr = lane & 15, fq = lane >> 4;
    const int nt = K / BK;
    int Rst[2], Cst[2]; unsigned voffB[2], voA[2][2], voAn[2][2];
#pragma unroll
    for (int i = 0; i < 2; ++i) { stage_rc(tid * 16 + i * 8192, Rst[i], Cst[i]); const int Rb = Epi::PERM ? ((Rst[i] & ~31) + perm32(Rst[i] & 31)) : Rst[i];
        voffB[i] = (unsigned)(Rb * ldb + Cst[i]) * 2u;
#pragma unroll
        for (int h = 0; h < 2; ++h) { voA[h][i] = (unsigned)((h * HALF + Rst[i]) * lda + Cst[i]) * 2u; voAn[h][i] = voA[h][i]; } }
    const size_t kstep = (size_t)(BK * 2), hstepB = (size_t)HALF * ldb * 2, tstepA = (size_t)BM * lda * 2;
    const unsigned ldsw = (unsigned)wid * 1024u;
    const int aoff = lds_byte(wr * 64 + fr, fq * 8), boff = lds_byte(wc * 32 + fr, fq * 8);
#define G8_SA(b, h) (((b) * 2 + (h)) * HTB)
#define G8_SB(b, h) ((4 + (b) * 2 + (h)) * HTB)
#define G8_OPQ(x) ({ unsigned _o = (x); asm volatile("" : "+v"(_o)); _o; })
#define G8_STAGE_B(bufoff, gbase) do { _Pragma("unroll") for (int _i = 0; _i < 2; ++_i) \
        __builtin_amdgcn_global_load_lds((const unsigned*)((const char*)(gbase) + G8_OPQ(voffB[_i])), (LAS unsigned*)(lds + (bufoff) + ldsw + _i * 8192), 16, 0, 0); } while (0)
#define G8_STAGE_A(bufoff, gbase, o0, o1) do { \
        __builtin_amdgcn_global_load_lds((const unsigned*)((const char*)(gbase) + G8_OPQ(o0)), (LAS unsigned*)(lds + (bufoff) + ldsw), 16, 0, 0); \
        __builtin_amdgcn_global_load_lds((const unsigned*)((const char*)(gbase) + G8_OPQ(o1)), (LAS unsigned*)(lds + (bufoff) + ldsw + 8192), 16, 0, 0); } while (0)
#define G8_LDA(dst, b, h) do { _Pragma("unroll") for (int m = 0; m < 4; ++m) dst[m] = cat8(*(const LAS bf16x8*)(lds + G8_SA(b, h) + aoff + m * 2048), *(const LAS bf16x8*)(lds + G8_SA(b, h) + aoff + m * 2048 + 1024)); } while (0)
#define G8_LDB(dst, b, h) do { _Pragma("unroll") for (int n = 0; n < 2; ++n) dst[n] = cat8(*(const LAS bf16x8*)(lds + G8_SB(b, h) + boff + n * 2048), *(const LAS bf16x8*)(lds + G8_SB(b, h) + boff + n * 2048 + 1024)); } while (0)
#define G8_MMA(ai, bj, At, Bt) do { __builtin_amdgcn_s_setprio(1); \
        if constexpr (Epi::F8) { _Pragma("unroll") for (int m = 0; m < 4; ++m) _Pragma("unroll") for (int n = 0; n < 2; ++n) \
            mfma_f8(acc[ai][bj][m][n], Bt[n], At[m]); } \
        else { _Pragma("unroll") for (int m = 0; m < 4; ++m) _Pragma("unroll") for (int n = 0; n < 2; ++n) _Pragma("unroll") for (int k = 0; k < 2; ++k) \
            acc[ai][bj][m][n] = __builtin_amdgcn_mfma_f32_16x16x32_bf16(half8(Bt[n], k), half8(At[m], k), acc[ai][bj][m][n], 0, 0, 0); } \
        __builtin_amdgcn_s_setprio(0); } while (0)
#define G8_WAIT_V(n) asm volatile("s_waitcnt vmcnt(" #n ")" ::: "memory")
#define G8_WAIT_L(n) asm volatile("s_waitcnt lgkmcnt(" #n ")" ::: "memory")
#define G8_BAR __builtin_amdgcn_s_barrier()
#define G8_SCHED __builtin_amdgcn_sched_barrier(0)
    Unit cur, nxt; int ui = 0, prev_pm = -1;
    if (!S.next(0, cur)) return;
    Acc acc;
#pragma unroll
    for (int a = 0; a < 2; ++a)
#pragma unroll
        for (int b = 0; b < 2; ++b)
#pragma unroll
            for (int m = 0; m < 4; ++m)
#pragma unroll
                for (int n = 0; n < 2; ++n) acc[a][b][m][n] = (f32x4){0.f, 0.f, 0.f, 0.f};
    i32x8_t At[4], B0[2], B1[2];
    const char* cA; const char* cB = cur.B;
    if (GATHER) { cA = (const char*)A;
#pragma unroll
        for (int h = 0; h < 2; ++h)
#pragma unroll
            for (int i = 0; i < 2; ++i) voA[h][i] = S.arow_off(cur.pm * BM + h * HALF + Rst[i]) + (unsigned)Cst[i] * 2u;
    } else cA = (const char*)A + (size_t)cur.pm * tstepA;
    G8_STAGE_B(G8_SB(0, 0), cB); G8_STAGE_A(G8_SA(0, 0), cA, voA[0][0], voA[0][1]); G8_STAGE_B(G8_SB(0, 1), cB + hstepB); G8_STAGE_A(G8_SA(0, 1), cA, voA[1][0], voA[1][1]);
    if (wr == 1) G8_BAR;
    G8_WAIT_V(4); G8_BAR;
    G8_STAGE_B(G8_SB(1, 0), cB + kstep); G8_STAGE_A(G8_SA(1, 0), cA + kstep, voA[0][0], voA[0][1]); G8_STAGE_B(G8_SB(1, 1), cB + hstepB + kstep);
    G8_WAIT_V(6); G8_BAR;
    for (;;) {
        const bool has_next = S.next(ui + 1, nxt);
        const char* nA; const char* nB = has_next ? nxt.B : cB;
        if (GATHER) { nA = cA;
            if (has_next) {
#pragma unroll
                for (int h = 0; h < 2; ++h)
#pragma unroll
                    for (int i = 0; i < 2; ++i) voAn[h][i] = S.arow_off(nxt.pm * BM + h * HALF + Rst[i]) + (unsigned)Cst[i] * 2u;
            } else {
#pragma unroll
                for (int h = 0; h < 2; ++h)
#pragma unroll
                    for (int i = 0; i < 2; ++i) voAn[h][i] = voA[h][i];
            }
        } else nA = has_next ? (const char*)A + (size_t)nxt.pm * tstepA : cA;
        for (int t = 0; t < nt; t += 2) {
            const bool last = (t == nt - 2);
            const char* a1 = cA + (size_t)(t + 1) * kstep;
            const char* a2 = last ? nA : cA + (size_t)(t + 2) * kstep; const char* b2 = last ? nB : cB + (size_t)(t + 2) * kstep;
            const char* a3 = a2 + kstep; const char* b3 = b2 + kstep;
            unsigned o00 = voA[0][0], o01 = voA[0][1], o10 = voA[1][0], o11 = voA[1][1];
            if (GATHER) { if (last) { o00 = voAn[0][0]; o01 = voAn[0][1]; o10 = voAn[1][0]; o11 = voAn[1][1]; } }
            G8_LDB(B0, 0, 0); G8_SCHED; G8_LDA(At, 0, 0); G8_STAGE_A(G8_SA(1, 1), a1, voA[1][0], voA[1][1]);
            G8_WAIT_L(8); G8_BAR; G8_WAIT_L(0); G8_MMA(0, 0, At, B0); G8_BAR; G8_SCHED;
            G8_LDB(B1, 0, 1); G8_STAGE_B(G8_SB(0, 0), b2);
            G8_BAR; G8_WAIT_L(0); G8_MMA(0, 1, At, B1); G8_BAR;
            G8_LDA(At, 0, 1); G8_STAGE_A(G8_SA(0, 0), a2, o00, o01);
            G8_BAR; G8_WAIT_L(0); G8_MMA(1, 0, At, B0); G8_BAR; G8_SCHED;
            G8_STAGE_B(G8_SB(0, 1), b2 + hstepB);
            G8_WAIT_V(6);
            if constexpr (Epi::PUBLISH) { if (prev_pm >= 0) { E.publish(prev_pm); prev_pm = -1; } }
            G8_BAR; G8_MMA(1, 1, At, B1); G8_BAR;
            G8_LDB(B0, 1, 0); G8_SCHED; G8_LDA(At, 1, 0); G8_STAGE_A(G8_SA(0, 1), a2, o10, o11);
            G8_WAIT_L(8); G8_BAR; G8_WAIT_L(0); G8_MMA(0, 0, At, B0); G8_BAR; G8_SCHED;
            G8_LDB(B1, 1, 1); G8_STAGE_B(G8_SB(1, 0), b3);
            G8_BAR; G8_WAIT_L(0); G8_MMA(0, 1, At, B1); G8_BAR;
            G8_LDA(At, 1, 1); G8_STAGE_A(G8_SA(1, 0), a3, o00, o01);
            G8_BAR; G8_WAIT_L(0); G8_MMA(1, 0, At, B0); G8_BAR; G8_SCHED;
            G8_STAGE_B(G8_SB(1, 1), b3 + hstepB);
            G8_WAIT_V(6); G8_BAR; G8_MMA(1, 1, At, B1); G8_BAR;
        }
        if constexpr (Epi::F8) {
#define G8_TIE(a, b, txt) asm volatile(txt : "+v"(acc[a][b][0][0]), "+v"(acc[a][b][0][1]), "+v"(acc[a][b][1][0]), "+v"(acc[a][b][1][1]), "+v"(acc[a][b][2][0]), "+v"(acc[a][b][2][1]), "+v"(acc[a][b][3][0]), "+v"(acc[a][b][3][1]))
            G8_TIE(0, 0, ""); G8_TIE(0, 1, ""); G8_TIE(1, 0, "s_nop 7"); G8_TIE(1, 1, "s_nop 15\n\ts_nop 7");
#undef G8_TIE
        }
        if constexpr (Epi::ASCALE != 1.0f) {
#pragma unroll
            for (int a = 0; a < 2; ++a)
#pragma unroll
                for (int b = 0; b < 2; ++b)
#pragma unroll
                    for (int m = 0; m < 4; ++m)
#pragma unroll
                        for (int n = 0; n < 2; ++n) acc[a][b][m][n] *= Epi::ASCALE;
        }
        E(acc, cur, wr, wc, fr, fq);
        if constexpr (Epi::PUBLISH) prev_pm = cur.pm;
        if (!has_next) break;
#pragma unroll
        for (int a = 0; a < 2; ++a)
#pragma unroll
            for (int b = 0; b < 2; ++b)
#pragma unroll
                for (int m = 0; m < 4; ++m)
#pragma unroll
                    for (int n = 0; n < 2; ++n) acc[a][b][m][n] = (f32x4){0.f, 0.f, 0.f, 0.f};
        cur = nxt; cA = nA; cB = nB; ++ui;
        if (GATHER) {
#pragma unroll
            for (int h = 0; h < 2; ++h)
#pragma unroll
                for (int i = 0; i < 2; ++i) voA[h][i] = voAn[h][i];
        }
    }
    G8_WAIT_V(0);
    if constexpr (Epi::PUBLISH) { if (prev_pm >= 0) { E.publish(prev_pm); prev_pm = -1; } }
    if (wr == 0) G8_BAR;
    G8_BAR;
#undef G8_SA
#undef G8_SB
#undef G8_STAGE_A
#undef G8_STAGE_B
#undef G8_OPQ
#undef G8_LDA
#undef G8_LDB
#undef G8_MMA
#undef G8_WAIT_V
#undef G8_WAIT_L
#undef G8_BAR
#undef G8_SCHED
}

__device__ __forceinline__ u32x4 pack8(const f32x4& a, const f32x4& b) { u32x4 w; w.x = cvt_pk_bf16(a[0], a[1]); w.y = cvt_pk_bf16(a[2], a[3]); w.z = cvt_pk_bf16(b[0], b[1]); w.w = cvt_pk_bf16(b[2], b[3]); return w; }
__device__ __forceinline__ u32x4 subtile_T(LAS bf16_t* Tw, const f32x4& a, const f32x4& b, int fr, int fq, int lane) {
#pragma unroll
    for (int j = 0; j < 4; ++j) { Tw[(8 * fq + j) * 16 + fr] = f2bf(a[j]); Tw[(8 * fq + 4 + j) * 16 + fr] = f2bf(b[j]); }
    return *(const LAS u32x4*)(Tw + (lane >> 1) * 16 + (lane & 1) * 8);
}
template <bool F8_> struct MEpiProjT { static constexpr bool PERM = true, PUBLISH = false, F8 = F8_; static constexpr float ASCALE = F8_ ? 1.0f / (SHB * SWI) : 1.0f; bf16_t* PROJ; bf16_t* VT; LAS float* KX; const float* gq; const float* gk;
    __device__ __forceinline__ void operator()(const Acc& acc, const Unit& u, int wr, int wc, int fr, int fq) const {
        const int row0 = u.pm * BM + wr * 64 + fr;
        if (u.pn >= C_K / 256 && u.pn < DPROJ / 256) {
#pragma unroll
            for (int ai = 0; ai < 2; ++ai)
#pragma unroll
                for (int m = 0; m < 4; ++m)
#pragma unroll
                    for (int bj = 0; bj < 2; ++bj) {
                        const f32x4 a = acc[ai][bj][m][0], b = acc[ai][bj][m][1];
                        float ss = a[0] * a[0] + a[1] * a[1] + a[2] * a[2] + a[3] * a[3] + b[0] * b[0] + b[1] * b[1] + b[2] * b[2] + b[3] * b[3];
                        ss += __shfl_xor(ss, 16); ss += __shfl_xor(ss, 32);
                        if (fq == 0) KX[((ai * HALF + wr * 64 + m * 16 + fr) * 2 + bj) * 4 + wc] = ss;
                    }
            asm volatile("s_waitcnt lgkmcnt(0)" ::: "memory"); __builtin_amdgcn_s_barrier(); asm volatile("" ::: "memory");
            const int col0 = u.pn * BM + wc * 32 + 8 * fq;
            f32x4 g0[2], g1[2];
#pragma unroll
            for (int bj = 0; bj < 2; ++bj) { const int d0 = wc * 32 + 8 * fq; g0[bj] = *(const f32x4*)(gq + d0) * *(const f32x4*)(gk + d0); g1[bj] = *(const f32x4*)(gq + d0 + 4) * *(const f32x4*)(gk + d0 + 4); }
#pragma unroll
            for (int ai = 0; ai < 2; ++ai)
#pragma unroll
                for (int m = 0; m < 4; ++m) { bf16_t* rowp = PROJ + (size_t)(row0 + ai * HALF + m * 16) * DPROJ + col0;
#pragma unroll
                    for (int bj = 0; bj < 2; ++bj) { const f32x4 p4 = *(const LAS f32x4*)(KX + ((ai * HALF + wr * 64 + m * 16 + fr) * 2 + bj) * 4);
                        const float rs = rsqrtf(((p4[0] + p4[1]) + (p4[2] + p4[3])) * (1.0f / HD) + EPS);
                        *(u32x4*)(rowp + bj * HALF) = pack8(acc[ai][bj][m][0] * g0[bj] * rs, acc[ai][bj][m][1] * g1[bj] * rs); } }
            return;
        }
        if (u.pn < DPROJ / 256) {
            const int col0 = u.pn * BM + wc * 32 + 8 * fq;
#pragma unroll
            for (int ai = 0; ai < 2; ++ai)
#pragma unroll
                for (int m = 0; m < 4; ++m) { bf16_t* rowp = PROJ + (size_t)(row0 + ai * HALF + m * 16) * DPROJ + col0;
#pragma unroll
                    for (int bj = 0; bj < 2; ++bj) *(u32x4*)(rowp + bj * HALF) = pack8(acc[ai][bj][m][0], acc[ai][bj][m][1]); }
        } else {
            const int lane = fq * 16 + fr, cl = lane >> 1, hf = lane & 1; LAS bf16_t* Tw = (LAS bf16_t*)KX + (wr * 4 + wc) * 512;
            const int cc0 = (u.pn - DPROJ / 256) * BM + wc * 32 + cl;
#pragma unroll
            for (int ai = 0; ai < 2; ++ai)
#pragma unroll
                for (int m = 0; m < 4; ++m) { const int rowb = u.pm * BM + wr * 64 + ai * HALF + m * 16, b = rowb >> 12, s = (rowb & (SEQ - 1)) + hf * 8;
#pragma unroll
                    for (int bj = 0; bj < 2; ++bj) { const int cc = cc0 + bj * HALF;
                        const u32x4 w = subtile_T(Tw, acc[ai][bj][m][0], acc[ai][bj][m][1], fr, fq, lane);
                        *(u32x4*)(VT + ((size_t)(b * NHS + (cc >> 7)) * HD + (cc & 127)) * VTS + s) = w; } }
        }
    } };
template <bool F8_> struct MEpiPartT { static constexpr bool PERM = true, PUBLISH = false, F8 = F8_; static constexpr float ASCALE = F8_ ? 1.0f / (SHB * SWI) : 1.0f; bf16_t* PT; LAS float* KX;
    __device__ __forceinline__ void operator()(const Acc& acc, const Unit& u, int wr, int wc, int fr, int fq) const {
        const int lane = fq * 16 + fr, cl = lane >> 1, hf = lane & 1; LAS bf16_t* Tw = (LAS bf16_t*)KX + (wr * 4 + wc) * 512;
        bf16_t* base0 = PT + (size_t)(u.pm * 4 + u.pn) * 65536 + (size_t)(wc * 32 + cl) * 256 + wr * 64 + hf * 8;
#pragma unroll
        for (int ai = 0; ai < 2; ++ai)
#pragma unroll
            for (int m = 0; m < 4; ++m)
#pragma unroll
                for (int bj = 0; bj < 2; ++bj) {
                    const u32x4 w = subtile_T(Tw, acc[ai][bj][m][0], acc[ai][bj][m][1], fr, fq, lane);
                    *(u32x4*)(base0 + (size_t)(bj * HALF) * 256 + ai * HALF + m * 16) = w; }
    } };
__device__ __forceinline__ u32x4 pair16(unsigned a0, unsigned a1, unsigned b0, unsigned b1) {
    const auto s0 = __builtin_amdgcn_permlane16_swap(a0, b0, false, false); const auto s1 = __builtin_amdgcn_permlane16_swap(a1, b1, false, false);
    return (u32x4){s0[0], s1[0], s0[1], s1[1]};
}
__device__ __forceinline__ f32x4 silu_mul(const f32x4& g, const f32x4& u) { f32x4 r;
#pragma unroll
    for (int j = 0; j < 4; ++j) r[j] = g[j] * sigmoidf_(g[j]) * u[j];
    return r; }
struct MEpiGU { static constexpr bool PERM = true, PUBLISH = true, F8 = true; static constexpr float ASCALE = 1.0f; unsigned char* HID; const float* LISTR; const MoeTab* mt; unsigned* rtc; int n1early;
    __device__ __forceinline__ void operator()(const Acc& acc, const Unit& u, int wr, int wc, int fr, int fq) const {
        const int row0 = u.pm * BM + wr * 64 + fr, col0 = u.pn * HALF + wc * 32 + 8 * fq;
        const int e = __builtin_amdgcn_readfirstlane(mt->texp[u.pm]), cnt = __builtin_amdgcn_readfirstlane(mt->cnt[e]), pb = __builtin_amdgcn_readfirstlane(mt->tstart[e]) * 256;
        const float* lr = LISTR + (size_t)e * T;
        const __amdgpu_buffer_rsrc_t rsrc = __builtin_amdgcn_make_buffer_rsrc(HID, 0, (int)((size_t)PADROWS * DEXP), 0x00020000);
#pragma unroll
        for (int ai = 0; ai < 2; ++ai)
#pragma unroll
            for (int mp = 0; mp < 2; ++mp) { int w[2][2];
#pragma unroll
                for (int mm = 0; mm < 2; ++mm) { const int m = 2 * mp + mm;
                    const int row = row0 + ai * HALF + m * 16, pos = row - pb;
                    const float rs = pos < cnt ? lr[pos] * (1.0f / (SX8 * SW1)) : 0.f;
                    const f32x4 h0 = silu_mul(acc[ai][0][m][0] * rs, acc[ai][1][m][0] * rs) * SH8, h1 = silu_mul(acc[ai][0][m][1] * rs, acc[ai][1][m][1] * rs) * SH8;
                    int w0 = 0, w1 = 0;
                    w0 = __builtin_amdgcn_cvt_pk_fp8_f32(__builtin_amdgcn_fmed3f(h0[0], -448.f, 448.f), __builtin_amdgcn_fmed3f(h0[1], -448.f, 448.f), w0, false); w0 = __builtin_amdgcn_cvt_pk_fp8_f32(__builtin_amdgcn_fmed3f(h0[2], -448.f, 448.f), __builtin_amdgcn_fmed3f(h0[3], -448.f, 448.f), w0, true);
                    w1 = __builtin_amdgcn_cvt_pk_fp8_f32(__builtin_amdgcn_fmed3f(h1[0], -448.f, 448.f), __builtin_amdgcn_fmed3f(h1[1], -448.f, 448.f), w1, false); w1 = __builtin_amdgcn_cvt_pk_fp8_f32(__builtin_amdgcn_fmed3f(h1[2], -448.f, 448.f), __builtin_amdgcn_fmed3f(h1[3], -448.f, 448.f), w1, true);
                    w[mm][0] = w0; w[mm][1] = w1; }
                __builtin_amdgcn_raw_buffer_store_b128(pair16((unsigned)w[0][0], (unsigned)w[0][1], (unsigned)w[1][0], (unsigned)w[1][1]), rsrc, (row0 + ai * HALF + mp * 32 + 16 * (fq & 1)) * DEXP + (u.pn * HALF + wc * 32 + 16 * (fq >> 1)), 0, 16);
            }
    }
    __device__ __forceinline__ void publish(int pm) const {
        if ((otid() & 63) == 0) __hip_atomic_fetch_add(rtc + pm * 32, 1u, __ATOMIC_RELAXED, __HIP_MEMORY_SCOPE_AGENT);
    } };
struct MEpiDown { static constexpr bool PERM = true, PUBLISH = false, F8 = false; static constexpr float ASCALE = 1.0f; bf16_t* YPAD;
    __device__ __forceinline__ void operator()(const Acc& acc, const Unit& u, int wr, int wc, int fr, int fq) const {
        const int row0 = u.pm * BM + wr * 64 + fr, col0 = u.pn * BM + wc * 32 + 8 * fq;
#pragma unroll
        for (int ai = 0; ai < 2; ++ai)
#pragma unroll
            for (int m = 0; m < 4; ++m) { bf16_t* rowp = YPAD + (size_t)(row0 + ai * HALF + m * 16) * DM + col0;
#pragma unroll
                for (int bj = 0; bj < 2; ++bj) *(u32x4*)(rowp + bj * HALF) = pack8(acc[ai][bj][m][0], acc[ai][bj][m][1]); }
    } };
template <bool XF32> struct MEpiOut { static constexpr bool STAMP = false, PERM = true, PUBLISH = false, F8 = false; static constexpr float ASCALE = 1.0f; const float* Xf; const bf16_t* Xb; bf16_t* X1; unsigned char* X18;
    __device__ __forceinline__ void operator()(const Acc& acc, const Unit& u, int wr, int wc, int fr, int fq) const {
        const int row0 = u.pm * BM + wr * 64 + fr, col0 = u.pn * BM + wc * 32 + 8 * fq;
        const int row8 = u.pm * BM + wr * 64 + fr + 16 * (fq & 1), col8 = u.pn * BM + wc * 32 + 16 * (fq >> 1);
#pragma unroll
        for (int ai = 0; ai < 2; ++ai) {
            f32x4 xa[4][2][2]; u32x4 xh[4][2];
#pragma unroll
            for (int m = 0; m < 4; ++m)
#pragma unroll
                for (int bj = 0; bj < 2; ++bj) { const size_t o = (size_t)(row0 + ai * HALF + m * 16) * DM + col0 + bj * HALF;
                    if (XF32) { xa[m][bj][0] = *(const f32x4*)(Xf + o); xa[m][bj][1] = *(const f32x4*)(Xf + o + 4); } else xh[m][bj] = *(const u32x4*)(Xb + o); }
            __builtin_amdgcn_sched_barrier(0);
#pragma unroll
            for (int mp = 0; mp < 2; ++mp)
#pragma unroll
                for (int bj = 0; bj < 2; ++bj) { int w8[2][2];
#pragma unroll
                    for (int mm = 0; mm < 2; ++mm) { const int m = 2 * mp + mm; const size_t o = (size_t)(row0 + ai * HALF + m * 16) * DM + col0 + bj * HALF;
                        f32x4 a = acc[ai][bj][m][0], b = acc[ai][bj][m][1];
                        if (XF32) { a += xa[m][bj][0]; b += xa[m][bj][1]; }
                        else { const u32x4 w = xh[m][bj]; a[0] += bflo(w.x); a[1] += bfhi(w.x); a[2] += bflo(w.y); a[3] += bfhi(w.y); b[0] += bflo(w.z); b[1] += bfhi(w.z); b[2] += bflo(w.w); b[3] += bfhi(w.w); }
                        *(u32x4*)(X1 + o) = pack8(a, b);
                        int w0 = 0, w1 = 0;
                        w0 = __builtin_amdgcn_cvt_pk_fp8_f32(sat8(a[0] * SX8), sat8(a[1] * SX8), w0, false); w0 = __builtin_amdgcn_cvt_pk_fp8_f32(sat8(a[2] * SX8), sat8(a[3] * SX8), w0, true);
                        w1 = __builtin_amdgcn_cvt_pk_fp8_f32(sat8(b[0] * SX8), sat8(b[1] * SX8), w1, false); w1 = __builtin_amdgcn_cvt_pk_fp8_f32(sat8(b[2] * SX8), sat8(b[3] * SX8), w1, true);
                        w8[mm][0] = w0; w8[mm][1] = w1; }
                    *(u32x4*)(X18 + (size_t)(row8 + ai * HALF + mp * 32) * DM + col8 + bj * HALF) = pair16((unsigned)w8[0][0], (unsigned)w8[0][1], (unsigned)w8[1][0], (unsigned)w8[1][1]); }
        }
    } };
constexpr float YSCALE = YSCALE_G;
struct MEpiDown8 { static constexpr bool PERM = true, PUBLISH = false, F8 = true; static constexpr float ASCALE = 1.0f; unsigned char* Y8;
    __device__ __forceinline__ void operator()(const Acc& acc, const Unit& u, int wr, int wc, int fr, int fq) const {
        const int row0 = u.pm * BM + wr * 64 + fr + 16 * (fq & 1), col0 = u.pn * BM + wc * 32 + 16 * (fq >> 1);
#pragma unroll
        for (int ai = 0; ai < 2; ++ai)
#pragma unroll
            for (int mp = 0; mp < 2; ++mp)
#pragma unroll
                for (int bj = 0; bj < 2; ++bj) { int w[2][2];
#pragma unroll
                    for (int mm = 0; mm < 2; ++mm) { const int m = 2 * mp + mm; const f32x4 a = acc[ai][bj][m][0] * (YSCALE / (SH8 * SW2)), b = acc[ai][bj][m][1] * (YSCALE / (SH8 * SW2)); int w0 = 0, w1 = 0;
                        w0 = __builtin_amdgcn_cvt_pk_fp8_f32(sat8(a[0]), sat8(a[1]), w0, false); w0 = __builtin_amdgcn_cvt_pk_fp8_f32(sat8(a[2]), sat8(a[3]), w0, true);
                        w1 = __builtin_amdgcn_cvt_pk_fp8_f32(sat8(b[0]), sat8(b[1]), w1, false); w1 = __builtin_amdgcn_cvt_pk_fp8_f32(sat8(b[2]), sat8(b[3]), w1, true); w[mm][0] = w0; w[mm][1] = w1; }
                    *(u32x4*)(Y8 + (size_t)(row0 + ai * HALF + mp * 32) * DM + col0 + bj * HALF) = pair16((unsigned)w[0][0], (unsigned)w[0][1], (unsigned)w[1][0], (unsigned)w[1][1]); }
    } };
}

__device__ __forceinline__ void phase_convb(const Ctx& c, int l) {
    const int gt = obid() * 512 + otid(), ng = gridDim.x * 512, sub = gt & 15;
    const float* cw = c.in[10] + (size_t)l * 3 * DCONV; const bf16_t* PROJ = c.PROJ();
#pragma unroll 2
    for (int item = gt >> 4; item < T * 4; item += ng >> 4) {
        const int t = item >> 2, hh = item & 3, ch = hh * HD + sub * 8, s = t & (SEQ - 1);
        u32x4 cg[3], xb[3];
#pragma unroll
        for (int tap = 0; tap < 3; ++tap) { const int ds = (s + tap - 2 >= 0) ? tap - 2 : 0; const bf16_t* row = PROJ + (size_t)(t + ds) * DPROJ; cg[tap] = *(const u32x4*)(row + C_CG + ch); xb[tap] = *(const u32x4*)(row + C_XB + ch); }
        const u32x4 bg = *(const u32x4*)(PROJ + (size_t)t * DPROJ + C_BG + ch);
        float acc[8] = {0, 0, 0, 0, 0, 0, 0, 0};
#pragma unroll
        for (int tap = 0; tap < 3; ++tap) {
            if (s + tap - 2 >= 0) {
                const f32x4 w0 = *(const f32x4*)(cw + tap * DCONV + ch), w1 = *(const f32x4*)(cw + tap * DCONV + ch + 4);
                acc[0] += w0[0] * bflo(cg[tap].x) * bflo(xb[tap].x); acc[1] += w0[1] * bfhi(cg[tap].x) * bfhi(xb[tap].x); acc[2] += w0[2] * bflo(cg[tap].y) * bflo(xb[tap].y); acc[3] += w0[3] * bfhi(cg[tap].y) * bfhi(xb[tap].y);
                acc[4] += w1[0] * bflo(cg[tap].z) * bflo(xb[tap].z); acc[5] += w1[1] * bfhi(cg[tap].z) * bfhi(xb[tap].z); acc[6] += w1[2] * bflo(cg[tap].w) * bflo(xb[tap].w); acc[7] += w1[3] * bfhi(cg[tap].w) * bfhi(xb[tap].w);
            }
        }
        acc[0] *= bflo(bg.x); acc[1] *= bfhi(bg.x); acc[2] *= bflo(bg.y); acc[3] *= bfhi(bg.y); acc[4] *= bflo(bg.z); acc[5] *= bfhi(bg.z); acc[6] *= bflo(bg.w); acc[7] *= bfhi(bg.w);
        float ss = 0.f;
#pragma unroll
        for (int i = 0; i < 8; ++i) ss += acc[i] * acc[i];
        ss += __shfl_xor(ss, 1); ss += __shfl_xor(ss, 2); ss += __shfl_xor(ss, 4); ss += __shfl_xor(ss, 8);
        const float rstd = rsqrtf(ss * (1.0f / HD) + EPS);
        const float* mg = c.in[13] + (size_t)l * DM + DLRU + ch;
        const f32x4 m0 = *(const f32x4*)mg, m1 = *(const f32x4*)(mg + 4);
        u32x4 o; o.x = cvt_pk_bf16(acc[0] * rstd * m0[0], acc[1] * rstd * m0[1]); o.y = cvt_pk_bf16(acc[2] * rstd * m0[2], acc[3] * rstd * m0[3]);
        o.z = cvt_pk_bf16(acc[4] * rstd * m1[0], acc[5] * rstd * m1[1]); o.w = cvt_pk_bf16(acc[6] * rstd * m1[2], acc[7] * rstd * m1[3]);
        *(u32x4*)(c.YMIX() + (size_t)t * DM + DLRU + ch) = o;
    }
}
typedef float f32x16 __attribute__((ext_vector_type(16)));
#define MFMA32(a, b, c) __builtin_amdgcn_mfma_f32_32x32x16_bf16((a), (b), (c), 0, 0, 0)
constexpr int XCS = 776;
__device__ __forceinline__ void phase_lruA(const Ctx& c, int l, unsigned char* ldsb) {
    constexpr bool PASS2 = false;
    bf16_t* XC = (bf16_t*)ldsb; bf16_t* PR = (bf16_t*)(ldsb + 99328); bf16_t* HL = c.HL(); bf16_t* PL = c.PL();
    const int tid = otid(), lane = tid & 63, wv = tid >> 6, hh = lane >> 5, l31 = lane & 31;
    const float* cw = c.in[3] + (size_t)l * 4 * DLRU; const float* cb = c.in[4] + (size_t)l * DLRU;
    const bf16_t* PROJ = c.PROJ(); float* AGG = c.AGG();
    typedef float f32x2_t __attribute__((ext_vector_type(2)));
    for (int tile = obid(); tile < T / 64; tile += gridDim.x) {
        const int t0 = tile * 64, s0 = t0 & (SEQ - 1), tb = tile & 63;
        if (tid < 480) {
            const int cg = tid % 48, tslot = tid / 48, ch = cg * 16;
            float w[4][16], bias[16];
#pragma unroll
            for (int i = 0; i < 16; i += 4) { *(f32x4*)&bias[i] = *(const f32x4*)(cb + ch + i);
#pragma unroll
                for (int tap = 0; tap < 4; ++tap) *(f32x4*)&w[tap][i] = *(const f32x4*)(cw + tap * DLRU + ch + i); }
#pragma unroll
            for (int it = 0; it < 7; ++it) {
                const int tokr = tslot + 10 * it, tok = tokr < 64 ? tokr : 63;
                u32x4 x0[4], x1[4]; float msk[4];
#pragma unroll
                for (int tap = 0; tap < 4; ++tap) {
                    const int ds = tap - 3; const bool ok = (s0 + tok + ds >= 0); msk[tap] = ok ? 1.0f : 0.0f;
                    const bf16_t* row = PROJ + (size_t)(t0 + tok + (ok ? ds : 0)) * DPROJ + C_XA + ch;
                    x0[tap] = *(const u32x4*)row; x1[tap] = *(const u32x4*)(row + 8);
                }
                float a[16];
#pragma unroll
                for (int i = 0; i < 16; ++i) a[i] = bias[i];
#pragma unroll
                for (int tap = 0; tap < 4; ++tap) {
                    const float m = msk[tap];
                    a[0] += m * w[tap][0] * bflo(x0[tap].x); a[1] += m * w[tap][1] * bfhi(x0[tap].x); a[2] += m * w[tap][2] * bflo(x0[tap].y); a[3] += m * w[tap][3] * bfhi(x0[tap].y);
                    a[4] += m * w[tap][4] * bflo(x0[tap].z); a[5] += m * w[tap][5] * bfhi(x0[tap].z); a[6] += m * w[tap][6] * bflo(x0[tap].w); a[7] += m * w[tap][7] * bfhi(x0[tap].w);
                    a[8] += m * w[tap][8] * bflo(x1[tap].x); a[9] += m * w[tap][9] * bfhi(x1[tap].x); a[10] += m * w[tap][10] * bflo(x1[tap].y); a[11] += m * w[tap][11] * bfhi(x1[tap].y);
                    a[12] += m * w[tap][12] * bflo(x1[tap].z); a[13] += m * w[tap][13] * bfhi(x1[tap].z); a[14] += m * w[tap][14] * bflo(x1[tap].w); a[15] += m * w[tap][15] * bfhi(x1[tap].w);
                }
                u32x4 o0, o1; o0.x = cvt_pk_bf16(a[0], a[1]); o0.y = cvt_pk_bf16(a[2], a[3]); o0.z = cvt_pk_bf16(a[4], a[5]); o0.w = cvt_pk_bf16(a[6], a[7]);
                o1.x = cvt_pk_bf16(a[8], a[9]); o1.y = cvt_pk_bf16(a[10], a[11]); o1.z = cvt_pk_bf16(a[12], a[13]); o1.w = cvt_pk_bf16(a[14], a[15]);
                if (tokr < 64) { *(u32x4*)(XC + tok * XCS + ch) = o0; *(u32x4*)(XC + tok * XCS + ch + 8) = o1; }
            }
        }
        __syncthreads();
#pragma unroll 1
        for (int i = 0; i < 3; ++i) {
            const int hd = 2 * i + (wv >> 2), ntw = wv & 3, chl = 32 * ntw + l31, ch = hd * HD + chl;
            const bf16_t* wa = c.WA(l) + ((size_t)hd * HD + chl) * HD + 8 * hh; const bf16_t* wx = c.WX(l) + ((size_t)hd * HD + chl) * HD + 8 * hh;
            const float ba = c.in[6][l * DLRU + ch], bx = c.in[8][l * DLRU + ch], c8 = -8.0f * softplusf_(-c.in[9][l * DLRU + ch]);
            float sst = 0.f, Pt = 1.f;
            float hreg[2][16], preg[2][16];
            bf16x8 bRf[8], bIf[8];
#pragma unroll
            for (int s = 0; s < 8; ++s) { bRf[s] = *(const bf16x8*)(wa + 16 * s); bIf[s] = *(const bf16x8*)(wx + 16 * s); }
            __builtin_amdgcn_sched_barrier(0);
#pragma unroll
            for (int half = 0; half < 2; ++half) {
                float av[16], uv[16];
                {
                    f32x16 accR, accI;
#pragma unroll
                    for (int r = 0; r < 16; ++r) { accR[r] = 0.f; accI[r] = 0.f; }
#pragma unroll
                    for (int s = 0; s < 8; ++s) {
                        const bf16x8 a = *(const bf16x8*)(XC + (32 * half + l31) * XCS + hd * HD + 16 * s + 8 * hh);
                        accR = MFMA32(a, bRf[s], accR); accI = MFMA32(a, bIf[s], accI);
                    }
#pragma unroll
                    for (int r = 0; r < 16; ++r) {
                        const int tok = 32 * half + (r & 3) + 8 * (r >> 2) + 4 * hh;
                        const float xc = bf2f(XC[tok * XCS + ch]);
                        const float rg = sigmoidf_(accR[r] + ba), ig = sigmoidf_(accI[r] + bx);
                        const float la = c8 * rg;
                        av[r] = fast_exp(la); uv[r] = __builtin_amdgcn_sqrtf(one_minus_exp(2.0f * la)) * (ig * xc);
                    }
                }
                float Pp[4], Hp[4];
#pragma unroll
                for (int g = 0; g < 4; ++g) { float P = 1.f, H = 0.f;
#pragma unroll
                    for (int r = 4 * g; r < 4 * g + 4; ++r) { H = av[r] * H + uv[r]; P *= av[r]; }
                    Pp[g] = __shfl_xor(P, 32); Hp[g] = __shfl_xor(H, 32); }
#pragma unroll
                for (int g = 0; g < 4; ++g) {
                    if (hh == 0) {
#pragma unroll
                        for (int r = 4 * g; r < 4 * g + 4; ++r) { sst = av[r] * sst + uv[r]; Pt *= av[r]; hreg[half][r] = sst; preg[half][r] = Pt; }
                        sst = Pp[g] * sst + Hp[g]; Pt *= Pp[g];
                    } else {
                        sst = Pp[g] * sst + Hp[g]; Pt *= Pp[g];
#pragma unroll
                        for (int r = 4 * g; r < 4 * g + 4; ++r) { sst = av[r] * sst + uv[r]; Pt *= av[r]; hreg[half][r] = sst; preg[half][r] = Pt; }
                    }
                }
            }
            if (hh == 0) { f32x2_t o; o.x = Pt; o.y = sst; ((f32x2_t*)AGG)[(size_t)tile * DLRU + ch] = o; }
            __syncthreads();
#pragma unroll
            for (int half = 0; half < 2; ++half)
#pragma unroll
                for (int r = 0; r < 16; ++r) { const int tok = 32 * half + (r & 3) + 8 * (r >> 2) + 4 * hh;
                    XC[tok * XCS + ch] = f2bf(hreg[half][r]); PR[tok * 264 + (wv >> 2) * HD + chl] = f2bf(preg[half][r]); }
            __syncthreads();
#pragma unroll
            for (int k = 0; k < 4; ++k) {
                const int item = tid + 512 * k, tok = item >> 5, g = item & 31, hs = g >> 4, sub = g & 15, cc = (2 * i + hs) * HD + sub * 8;
                *(u32x4*)(HL + (size_t)(t0 + tok) * DLRU + cc) = *(const u32x4*)(XC + tok * XCS + cc);
                *(u32x4*)(PL + (size_t)(t0 + tok) * DLRU + cc) = *(const u32x4*)(PR + tok * 264 + hs * HD + sub * 8);
            }
        }
        __syncthreads();
    }
}

__device__ __forceinline__ void phase_lruB(const Ctx& c, int l, unsigned char* ldsb) {
    float* HIN = (float*)ldsb;
    const int tid = otid();
    const bf16_t* PROJ = c.PROJ(); const float* AGG = c.AGG(); const bf16_t* HL = c.HL(); const bf16_t* PL = c.PL();
    typedef float f32x2_t __attribute__((ext_vector_type(2)));
    for (int tile = obid(); tile < T / 64; tile += gridDim.x) {
        const int t0 = tile * 64, tb = tile & 63;
        {
            const f32x2_t* ag = (const f32x2_t*)AGG + (size_t)(tile - tb) * DLRU;
            const int chb = 512 + (tid & 255);
            float ha = 0.f, hb = 0.f;
#pragma unroll 8
            for (int k = 0; k < tb; ++k) { const f32x2_t pa = ag[(size_t)k * DLRU + tid], pb_ = ag[(size_t)k * DLRU + chb]; ha = pa.x * ha + pa.y; hb = pb_.x * hb + pb_.y; }
            HIN[tid] = ha; if (tid < 256) HIN[chb] = hb;
        }
        __syncthreads();
        const int wv_ = tid >> 6, wit0 = wv_ < 4 ? 8 * wv_ : 32 + 16 * (wv_ - 4), wcnt = wv_ < 4 ? 8 : 16;
#define LB_ADDR(it_, tok_, cc_) const int item_##it_ = (wit0 + (it_)) * 64 + (tid & 63), tok_ = item_##it_ / 96, rem_##it_ = item_##it_ % 96, cc_ = (rem_##it_ >> 4) * HD + (rem_##it_ & 15) * 8
#define LB_LOAD(H_, P_, G_, tok_, cc_) do { H_ = *(const u32x4*)(HL + (size_t)(t0 + tok_) * DLRU + cc_); P_ = *(const u32x4*)(PL + (size_t)(t0 + tok_) * DLRU + cc_); G_ = *(const u32x4*)(PROJ + (size_t)(t0 + tok_) * DPROJ + C_GA + cc_); } while (0)
#define LB_BODY(hv, pv, ga, tok, cc) do { \
            const f32x4 i0 = *(const f32x4*)(HIN + cc), i1 = *(const f32x4*)(HIN + cc + 4); \
            float y[8] = {(bflo(hv.x) + bflo(pv.x) * i0[0]) * gelu_tanh(bflo(ga.x)), (bfhi(hv.x) + bfhi(pv.x) * i0[1]) * gelu_tanh(bfhi(ga.x)), \
                          (bflo(hv.y) + bflo(pv.y) * i0[2]) * gelu_tanh(bflo(ga.y)), (bfhi(hv.y) + bfhi(pv.y) * i0[3]) * gelu_tanh(bfhi(ga.y)), \
                          (bflo(hv.z) + bflo(pv.z) * i1[0]) * gelu_tanh(bflo(ga.z)), (bfhi(hv.z) + bfhi(pv.z) * i1[1]) * gelu_tanh(bfhi(ga.z)), \
                          (bflo(hv.w) + bflo(pv.w) * i1[2]) * gelu_tanh(bflo(ga.w)), (bfhi(hv.w) + bfhi(pv.w) * i1[3]) * gelu_tanh(bfhi(ga.w))}; \
            float ss = 0.f; \
            _Pragma("unroll") for (int k = 0; k < 8; ++k) ss += y[k] * y[k]; \
            ss += __shfl_xor(ss, 1); ss += __shfl_xor(ss, 2); ss += __shfl_xor(ss, 4); ss += __shfl_xor(ss, 8); \
            const float rstd = rsqrtf(ss * (1.0f / HD) + EPS); \
            const float* mg = c.in[13] + (size_t)l * DM + cc; \
            const f32x4 m0 = *(const f32x4*)mg, m1 = *(const f32x4*)(mg + 4); \
            u32x4 o; o.x = cvt_pk_bf16(y[0] * rstd * m0[0], y[1] * rstd * m0[1]); o.y = cvt_pk_bf16(y[2] * rstd * m0[2], y[3] * rstd * m0[3]); \
            o.z = cvt_pk_bf16(y[4] * rstd * m1[0], y[5] * rstd * m1[1]); o.w = cvt_pk_bf16(y[6] * rstd * m1[2], y[7] * rstd * m1[3]); \
            *(u32x4*)(c.YMIX() + (size_t)(t0 + tok) * DM + cc) = o; } while (0)
        {
            u32x4 hA, pA, gA, hB, pB, gB;
            { LB_ADDR(0, tk_, cc_); LB_LOAD(hA, pA, gA, tk_, cc_); }
#pragma unroll 1
            for (int it = 0; it < wcnt; it += 2) {
                LB_ADDR(it, tkA, ccA); const int itb = it + 1; LB_ADDR(itb, tkB, ccB);
                LB_LOAD(hB, pB, gB, tkB, ccB); __builtin_amdgcn_sched_barrier(0);
                LB_BODY(hA, pA, gA, tkA, ccA);
                if (it + 2 < wcnt) { const int itc = it + 2; LB_ADDR(itc, tkC, ccC); LB_LOAD(hA, pA, gA, tkC, ccC); } __builtin_amdgcn_sched_barrier(0);
                LB_BODY(hB, pB, gB, tkB, ccB);
            }
        }
#undef LB_ADDR
#undef LB_LOAD
#undef LB_BODY
        __syncthreads();
    }
}

__device__ __forceinline__ void phase_vreduce(const Ctx& c) {
    const bf16_t* PT = c.PT(); bf16_t* VT = c.VT();
    for (int item = obid() * 512 + otid(); item < 64 * 256 * 32; item += gridDim.x * 512) {
        const int ro = item & 31, col = (item >> 5) & 255, u = item >> 13;
        const bf16_t* p = PT + (size_t)(u * 4) * 65536 + col * 256 + ro * 8;
        float a[8] = {0, 0, 0, 0, 0, 0, 0, 0};
#pragma unroll
        for (int kq = 0; kq < 4; ++kq) { const u32x4 w = *(const u32x4*)(p + (size_t)kq * 65536);
            a[0] += bflo(w.x); a[1] += bfhi(w.x); a[2] += bflo(w.y); a[3] += bfhi(w.y); a[4] += bflo(w.z); a[5] += bfhi(w.z); a[6] += bflo(w.w); a[7] += bfhi(w.w); }
        const int b = u >> 4, s0 = (u & 15) * 256 + ro * 8, h = 4 + (col >> 7), d = col & 127;
        u32x4 o; o.x = cvt_pk_bf16(a[0], a[1]); o.y = cvt_pk_bf16(a[2], a[3]); o.z = cvt_pk_bf16(a[4], a[5]); o.w = cvt_pk_bf16(a[6], a[7]);
        *(u32x4*)(VT + ((size_t)(b * NHS + h) * HD + d) * VTS + s0) = o;
    }
}

__device__ __forceinline__ void phase_attn(const Ctx& c, int l, unsigned char* ldsb) {
    const int lane = otid() & 63, wv = otid() >> 6, hh = lane >> 5, l31 = lane & 31;
    const bf16_t* PROJ = c.PROJ(); const bf16_t* VT = c.VT();
    const int prow = (l31 & ~12) | ((l31 & 4) << 1) | ((l31 & 8) >> 1);
    unsigned char* wl = ldsb + wv * 16384;
    const int kwbase = (lane >> 4) * 256 + (((lane & 15) ^ (lane >> 4)) * 16);
    const int vwoff = (lane >> 2) * 64 + (((lane & 3) ^ (lane >> 4)) * 16);
    const int kroff = prow * 256;
    const int nwt = NB * NHS * (SEQ / 32);
    const int nper = (nwt + (int)gridDim.x - 1) / (int)gridDim.x, wt0 = obid() * nper, wt1 = (wt0 + nper < nwt) ? wt0 + nper : nwt;
    for (int wt = wt0 + wv; wt < wt1; wt += 8) {
        const int qt = wt % (SEQ / 32), bh = wt / (SEQ / 32), b = bh / NHS, h = bh % NHS, q0 = qt * 32;
        const bf16_t* qp = PROJ + (size_t)(b * SEQ + q0 + l31) * DPROJ + C_Q + h * HD + 8 * hh;
        bf16x8 bq[8];
#pragma unroll
        for (int s = 0; s < 8; ++s) bq[s] = *(const bf16x8*)(qp + 16 * s);
        {
            float qs = 0.f;
#pragma unroll
            for (int s = 0; s < 8; ++s) { const u32x4 w = __builtin_bit_cast(u32x4, bq[s]);
                qs += bflo(w.x) * bflo(w.x) + bfhi(w.x) * bfhi(w.x) + bflo(w.y) * bflo(w.y) + bfhi(w.y) * bfhi(w.y) + bflo(w.z) * bflo(w.z) + bfhi(w.z) * bfhi(w.z) + bflo(w.w) * bflo(w.w) + bfhi(w.w) * bfhi(w.w); }
            qs += __shfl_xor(qs, 32);
            const float sc = rsqrtf(qs * (1.0f / HD) + EPS) * (1.4426950408889634f * 0.08838834764831845f);
#pragma unroll
            for (int s = 0; s < 8; ++s) { const u32x4 w = __builtin_bit_cast(u32x4, bq[s]); u32x4 o;
                o.x = cvt_pk_bf16(bflo(w.x) * sc, bfhi(w.x) * sc); o.y = cvt_pk_bf16(bflo(w.y) * sc, bfhi(w.y) * sc); o.z = cvt_pk_bf16(bflo(w.z) * sc, bfhi(w.z) * sc); o.w = cvt_pk_bf16(bflo(w.w) * sc, bfhi(w.w) * sc);
                bq[s] = __builtin_bit_cast(bf16x8, o); }
        }
        f32x16 O[4];
#pragma unroll
        for (int m = 0; m < 4; ++m)
#pragma unroll
            for (int r = 0; r < 16; ++r) O[m][r] = 0.f;
        float carry = 0.f;
        const bf16_t* kgl = PROJ + (size_t)(b * SEQ + (lane >> 4)) * DPROJ + C_K + h * HD + (lane & 15) * 8;
        const bf16_t* vgl = VT + ((size_t)bh * HD + (lane >> 2)) * VTS + (lane & 3) * 8;
        u32x4 stK[8], stV[8];
#define ATT_LOAD(kk0) do { _Pragma("unroll") for (int j = 0; j < 8; ++j) { \
            stK[j] = *(const u32x4*)(kgl + (size_t)((kk0) + 4 * j) * DPROJ); stV[j] = *(const u32x4*)(vgl + (size_t)(16 * j) * VTS + (kk0)); } } while (0)
        ATT_LOAD(q0);
        for (int k0 = q0; k0 >= 0; k0 -= 32) {
#pragma unroll
            for (int j = 0; j < 8; ++j) { *(u32x4*)(wl + j * 1024 + (kwbase ^ (64 * (j & 3)))) = stK[j]; *(u32x4*)(wl + 8192 + vwoff + j * 1024) = stV[j]; }
            const int kn = k0 >= 32 ? k0 - 32 : k0;
            ATT_LOAD(kn);
            __builtin_amdgcn_sched_barrier(0);
            f32x16 S;
#pragma unroll
            for (int r = 0; r < 16; ++r) S[r] = 0.f;
#pragma unroll
            for (int s = 0; s < 8; ++s) { const bf16x8 ak = *(const bf16x8*)(wl + kroff + (((2 * s + hh) ^ (prow & 15)) * 16)); S = MFMA32(ak, bq[s], S); }
            const bool diag = (k0 == q0);
            float sp[16];
            float R0 = 0.f, R1 = 0.f;
#pragma unroll
            for (int r = 0; r < 16; ++r) {
                const int kk = 16 * (r >> 3) + 8 * hh + (r & 7);
                const float z = S[r];
                float v = fmaxf(z, 0.f) + __builtin_amdgcn_logf(1.0f + __builtin_amdgcn_exp2f(-fabsf(z)));
                if (diag && kk >= l31) v = 0.f;
                sp[r] = v;
                if (r < 8) R0 += v; else R1 += v;
            }
            const float R0p = __shfl_xor(R0, 32), R1p = __shfl_xor(R1, 32);
            float suf_hi = carry - (hh == 0 ? R1p : 0.f);
            float suf_lo = carry - R1 - R1p - (hh == 0 ? R0p : 0.f);
            float w[16];
#pragma unroll
            for (int r = 15; r >= 8; --r) { w[r] = __builtin_amdgcn_exp2f(S[r] - sp[r] + suf_hi); suf_hi -= sp[r]; }
#pragma unroll
            for (int r = 7; r >= 0; --r) { w[r] = __builtin_amdgcn_exp2f(S[r] - sp[r] + suf_lo); suf_lo -= sp[r]; }
            if (diag) {
#pragma unroll
                for (int r = 0; r < 16; ++r) { const int kk = 16 * (r >> 3) + 8 * hh + (r & 7); if (kk >= l31) w[r] = 0.f; }
            }
            carry -= (R0 + R1 + R0p + R1p);
            bf16x8 wb[2];
            __builtin_amdgcn_sched_barrier(0);
#pragma unroll
            for (int s = 0; s < 2; ++s) { u32x4 pk; pk.x = cvt_pk_bf16(w[8 * s + 0], w[8 * s + 1]); pk.y = cvt_pk_bf16(w[8 * s + 2], w[8 * s + 3]); pk.z = cvt_pk_bf16(w[8 * s + 4], w[8 * s + 5]); pk.w = cvt_pk_bf16(w[8 * s + 6], w[8 * s + 7]);
                wb[s] = __builtin_bit_cast(bf16x8, pk); }
#pragma unroll
            for (int m = 0; m < 4; ++m)
#pragma unroll
                for (int s = 0; s < 2; ++s) { const bf16x8 vtf = *(const bf16x8*)(wl + 8192 + (32 * m + l31) * 64 + (((2 * s + hh) ^ (((32 * m + l31) >> 2) & 3)) * 16)); O[m] = MFMA32(vtf, wb[s], O[m]); }
            if (!__any(carry >= -150.1f)) break;
        }
        float ss = 0.f;
#pragma unroll
        for (int m = 0; m < 4; ++m)
#pragma unroll
            for (int r = 0; r < 16; ++r) ss += O[m][r] * O[m][r];
        ss += __shfl_xor(ss, 32);
        const float rstd = rsqrtf(ss * (1.0f / HD) + EPS);
        const float* mg = c.in[13] + (size_t)l * DM + DLRU + DCONV + h * HD + 4 * hh;
        bf16_t* yp = c.YMIX() + (size_t)(b * SEQ + q0 + l31) * DM + DLRU + DCONV + h * HD + 8 * hh;
#pragma unroll
        for (int m = 0; m < 4; ++m)
#pragma unroll
            for (int gp = 0; gp < 2; ++gp) { u32x2 o[2];
#pragma unroll
                for (int gg_ = 0; gg_ < 2; ++gg_) { const int g = 2 * gp + gg_; const f32x4 gg = *(const f32x4*)(mg + 32 * m + 8 * g);
                    o[gg_].x = cvt_pk_bf16(O[m][4 * g] * rstd * gg[0], O[m][4 * g + 1] * rstd * gg[1]); o[gg_].y = cvt_pk_bf16(O[m][4 * g + 2] * rstd * gg[2], O[m][4 * g + 3] * rstd * gg[3]); }
                const auto sx = __builtin_amdgcn_permlane32_swap(o[0].x, o[1].x, false, false); const auto sy = __builtin_amdgcn_permlane32_swap(o[0].y, o[1].y, false, false);
                *(u32x4*)(yp + 32 * m + 16 * gp) = (u32x4){sx[0], sy[0], sx[1], sy[1]};
            }
    }
}

#define XB_TMO      128
#define XB_XCNT(j)  (256  + 64 * (j))
#define XB_XSUB(j)  (1280 + 64 * (j))
#define XB_XGEN(j)  (2304 + 64 * (j))
#define XB_TOP      3328
#define XB_TOPGEN   3392
#define XCD_BAR_WORDS 3456
#define XB_SPIN_CAP (1u << 18)
__device__ __forceinline__ unsigned xb_ld(unsigned* p)              { return __hip_atomic_load(p, __ATOMIC_RELAXED, __HIP_MEMORY_SCOPE_AGENT); }
__device__ __forceinline__ unsigned xb_add(unsigned* p, unsigned v) { return __hip_atomic_fetch_add(p, v, __ATOMIC_RELAXED, __HIP_MEMORY_SCOPE_AGENT); }
__device__ __forceinline__ unsigned xb_xcc_id() { return (unsigned)__builtin_amdgcn_s_getreg((3 << 11) | 20) & 0xFu; }
#define XB_SPIN(cond, bar) do { unsigned _sp = 0; while (cond) { __builtin_amdgcn_s_sleep(1); \
    if ((++_sp & 255u) == 0u) { if (xb_ld(&(bar)[XB_TMO])) break; if (_sp > XB_SPIN_CAP) { atomicAdd(&(bar)[XB_TMO], 1u); break; } } } } while (0)
struct XcdBarrier { unsigned* bar; unsigned x; volatile LAS unsigned* st; };
__device__ __forceinline__ XcdBarrier xcd_barrier_post(unsigned* bar, volatile LAS unsigned* st) {
    XcdBarrier b; b.bar = bar; b.x = xb_xcc_id(); b.st = st;
    if (threadIdx.x == 0) (void)xb_add(&bar[XB_XCNT(b.x)], 1u);
    return b;
}
__device__ __forceinline__ void xcd_barrier_complete(unsigned* bar, unsigned x, unsigned& nloc, unsigned& nx) {
    const unsigned G = gridDim.x * gridDim.y * gridDim.z;
    unsigned sum, cnt, mine, sp = 0u;
    for (;;) {
        sum = 0u; cnt = 0u; mine = 0u;
#pragma unroll
        for (unsigned j = 0; j < 16; ++j) { const unsigned c = xb_ld(&bar[XB_XCNT(j)]); sum += c; cnt += (c > 0u) ? 1u : 0u; mine = (j == x) ? c : mine; }
        if (sum == G) break;
        __builtin_amdgcn_s_sleep(1);
        if ((++sp & 255u) == 0u) { if (xb_ld(&bar[XB_TMO])) break; if (sp > XB_SPIN_CAP) { atomicAdd(&bar[XB_TMO], 1u); break; } }
    }
    nloc = mine > 0u ? mine : 1u; nx = cnt > 0u ? cnt : 1u;
}
__device__ __forceinline__ void xcd_barrier(const XcdBarrier& b) {
    asm volatile("s_waitcnt vmcnt(0)" ::: "memory");
    __syncthreads();
    if (threadIdx.x == 0) {
        unsigned* bar = b.bar;
        __builtin_amdgcn_s_waitcnt(0);
        unsigned nloc = b.st[0], nx = b.st[1];
        if (nloc == 0u) { xcd_barrier_complete(bar, b.x, nloc, nx); b.st[0] = nloc; b.st[1] = nx; }
        const unsigned old = xb_add(&bar[XB_XSUB(b.x)], 1u);
        const unsigned gen = old / nloc;
        if (old + 1u == (gen + 1u) * nloc) {
            __builtin_amdgcn_fence(__ATOMIC_RELEASE, "agent");
            asm volatile("s_waitcnt vmcnt(0)" ::: "memory");
            const unsigned og = xb_add(&bar[XB_TOP], 1u);
            const unsigned tg = og / nx;
            if (og + 1u == (tg + 1u) * nx) xb_add(&bar[XB_TOPGEN], 1u);
            else XB_SPIN(xb_ld(&bar[XB_TOPGEN]) == tg, bar);
            __builtin_amdgcn_fence(__ATOMIC_ACQUIRE, "agent");
            xb_add(&bar[XB_XGEN(b.x)], 1u);
            asm volatile("s_waitcnt vmcnt(0)" ::: "memory");
        } else {
            XB_SPIN(xb_ld(&bar[XB_XGEN(b.x)]) == gen, bar);
            __builtin_amdgcn_fence(__ATOMIC_ACQUIRE, "agent");
            asm volatile("s_waitcnt vmcnt(0)" ::: "memory");
        }
    }
    __syncthreads();
}

constexpr int NPH_LAYER = 7, NPH = 1 + DEPTH * NPH_LAYER;
constexpr int LDS_TAB = g8::STAGE_BYTES, LDS_BARW = g8::STAGE_BYTES + 2048, LDS_KX = g8::STAGE_BYTES + 4096, LDS_BYTES = g8::STAGE_BYTES + 4096 + 8192;
__global__ void __launch_bounds__(512, 2) mega(Params p) {
    extern __shared__ __attribute__((aligned(16))) unsigned char lds_raw[];
    float* lds = (float*)lds_raw;
    LAS unsigned char* ldsl = (LAS unsigned char*)lds_raw;
    MoeTab* mt = (MoeTab*)(lds_raw + LDS_TAB);
    Ctx c0; c0.in.p = p.in; c0.in.z = 0; c0.out = p.out; c0.ws = p.ws;
    const int lo = p.ph_lo, hi = p.ph_hi;
    if (threadIdx.x == 0) *(uint4*)(lds_raw + LDS_BARW) = make_uint4(0u, 0u, 0u, 0u);
    __syncthreads();
    XcdBarrier bar = xcd_barrier_post(c0.ctl(), (volatile LAS unsigned*)(ldsl + LDS_BARW));
#ifndef PH_MASK
#define PH_MASK 0x1ff
#endif
#define PHT(k) ((k) == 0 ? 0 : 1 + ((k) - 1) % NPH_LAYER)
#define IN(k) (((PH_MASK >> PHT(k)) & 1) && lo <= (k) && (k) < hi)
#define SEAM(k) do { if (IN(k) && IN((k) + 1)) xcd_barrier(bar); } while (0)
#ifndef PROBE_RSH
#define PROBE_RSH 0
#endif
#ifndef PROBE_DUP
#define PROBE_DUP 0x0
#endif
#define REP(k) for (int rep_ = 0; rep_ < (((PROBE_DUP >> PHT(k)) & 1) ? 2 : 1); ++rep_)
    REP(0) if (IN(0)) { if (rep_) xcd_barrier(bar); const Ctx c = octx(c0); phase_convert(c, lds); phase_norm_in(c, 0); }
    SEAM(0);
#define LAYER_BODY(l) { \
        const int pb = 1 + l * NPH_LAYER; \
        REP(pb + 0) if (IN(pb + 0)) { if (rep_) xcd_barrier(bar); const Ctx c = octx(c0); const bool split_ = (gridDim.x == 256); \
            constexpr bool f8_ = f8in(l); constexpr int ku_ = f8_ ? DM / 2 : DM, ld_ = pb_in(l) / 2;        \
            { g8::DenseOrder S; S.init(T, DIN, gridDim.x, obid(), c.WIN(l), ld_); if (split_) S.lim = 1280; g8::MEpiProjT<f8_> E{c.PROJ(), c.VT(), (LAS float*)(ldsl + LDS_KX), c.in[11] + l * HD, c.in[12] + l * HD}; g8::gemm_mfma(ldsl, c.HB(), ld_, ld_, ku_, S, E); } \
            if (split_) { const int cb_ = obid(), kq_ = cb_ & 3; int k4_ = ku_ / 4; asm volatile("" : "+s"(k4_)); g8::SplitKOrder S{cb_, (const char*)(c.WIN(l) + (size_t)(20 * 256) * ld_ + kq_ * (ku_ / 4))}; g8::MEpiPartT<f8_> E{c.PT(), (LAS float*)(ldsl + LDS_KX)}; g8::gemm_mfma(ldsl, c.HB() + kq_ * (ku_ / 4), ld_, ld_, k4_, S, E); } } \
        SEAM(pb + 0); \
        REP(pb + 1) if (IN(pb + 1)) { if (rep_) xcd_barrier(bar); const Ctx c = octx(c0); if (gridDim.x == 256) phase_vreduce(c); phase_convb(c, l); if (PROBE_SUB == 4) phase_convb(c, l); phase_lruA(c, l, lds_raw); if (PROBE_SUB == 3) phase_lruA(c, l, lds_raw); } \
        SEAM(pb + 1); \
        REP(pb + 2) if (IN(pb + 2)) { if (rep_) xcd_barrier(bar); const Ctx c = octx(c0); phase_lruB(c, l, lds_raw); if (PROBE_SUB == 2) phase_lruB(c, l, lds_raw); phase_attn(c, l, lds_raw); if (PROBE_SUB == 1) phase_attn(c, l, lds_raw); } \
        SEAM(pb + 2); \
        REP(pb + 3) if (IN(pb + 3)) { if (rep_) xcd_barrier(bar); const Ctx c = octx(c0); g8::DenseOrder S; S.init(T, DM, gridDim.x, obid(), c.WOUT(l), DM); if (PROBE_RSH == 3 && l == 0) S.rsh = 1; g8::MEpiOut<l == 0> E{c.in[0], c.XB(), c.X1(), c.X1F8()}; g8::gemm_mfma(ldsl, c.YMIX(), DM, DM, DM, S, E);       } \
        SEAM(pb + 3); \
        REP(pb + 4) if (IN(pb + 4)) { if (rep_) xcd_barrier(bar); const Ctx c = octx(c0); phase_router_mfma(c, l, lds); } \
        SEAM(pb + 4); \
        REP(pb + 5) if (IN(pb + 5)) { if (rep_) xcd_barrier(bar); const Ctx c = octx(c0); build_moe_tab(c, l, mt); \
            const int G_ = (int)gridDim.x, cb_ = obid(), n1_ = __builtin_amdgcn_readfirstlane(mt->tstart[NEXP]) * 4, R_ = n1_ % G_, n1e_ = n1_ - R_, rtA_ = n1e_ >> 2; \
            { g8::MoeOrder<true, 4, DM / 2, (size_t)1024 * DM, (size_t)256 * DM> S{mt, c.LIST(), G_, cb_, (const char*)c.WGU(l)}; g8::MEpiGU E{c.HID8(), c.LISTR(), mt, c.RTC(l), n1e_}; g8::gemm_mfma(ldsl, (const bf16_t*)c.X1F8(), DM / 2, DM / 2, DM / 2, S, E); }       \
            g8::moe_wait_dep(c.RTC(l), cb_, G_, R_, rtA_); \
            { g8::MoeOrder2 S{mt, G_, cb_, R_, rtA_, (const char*)c.WD(l)}; if (PROBE_RSH == 6) S.rsh = 1; g8::MEpiDown8 E{c.YPAD8()}; int k2_ = DEXP / 2; asm volatile("" : "+s"(k2_)); g8::gemm_mfma(ldsl, (const bf16_t*)c.HID8(), DEXP / 2, DEXP / 2, k2_, S, E); } }       \
        SEAM(pb + 5); \
        REP(pb + 6) if (IN(pb + 6)) { if (rep_) xcd_barrier(bar); const Ctx c = octx(c0); build_moe_tab(c, l, mt); if (PROBE_SUB == 6) { phase_combine<true>(c, l, mt); xcd_barrier(bar); } phase_combine<false>(c, l, mt); } \
        SEAM(pb + 6); \
    }
    LAYER_BODY(0)
    LAYER_BODY(1)
#undef LAYER_BODY
#undef IN
#undef SEAM
}

#ifndef N_LAUNCH_SPLIT
#define N_LAUNCH_SPLIT 0
#endif
extern "C" void kernel_launch(void* const* d_in, const int* in_sizes, int n_in, void* d_out, int out_size, void* d_ws, size_t ws_size, hipStream_t stream) {
    static int grid = 0;
    if (grid == 0) {
        if (n_in != 23 || out_size != T * DM || ws_size < WS_END) { fprintf(stderr, "kernel_launch: unexpected problem (n_in %d out %d ws %zu need %zu)\n", n_in, out_size, ws_size, (size_t)WS_END); grid = -1; return; }
        int dev = 0, cus = 0, per_cu = 0;
        if (hipGetDevice(&dev) != hipSuccess || hipDeviceGetAttribute(&cus, hipDeviceAttributeMultiprocessorCount, dev) != hipSuccess) { fprintf(stderr, "kernel_launch: device query failed\n"); grid = -1; return; }
        if (hipFuncSetAttribute((const void*)mega, hipFuncAttributeMaxDynamicSharedMemorySize, LDS_BYTES) != hipSuccess) { fprintf(stderr, "kernel_launch: hipFuncSetAttribute failed\n"); grid = -1; return; }
        if (hipOccupancyMaxActiveBlocksPerMultiprocessor(&per_cu, (const void*)mega, 512, LDS_BYTES) != hipSuccess || per_cu < 1) { fprintf(stderr, "kernel_launch: occupancy query says %d blocks per CU\n", per_cu); }
        (void)hipGetLastError();
        grid = cus;
    }
    if (grid < 0) return;
    (void)hipMemsetAsync((char*)d_ws + OFF_CTL, 0, SZ_CTL, stream);
    Params p{};
    for (int i = 0; i < 23; ++i) p.in[i] = (const float*)d_in[i];
    p.out = (float*)d_out; p.ws = (unsigned char*)d_ws;
    if (N_LAUNCH_SPLIT) { for (int ph = 0; ph < NPH; ++ph) { p.ph_lo = ph; p.ph_hi = ph + 1; hipLaunchKernelGGL(mega, dim3(grid), dim3(512), LDS_BYTES, stream, p); } }
    else { p.ph_lo = 0; p.ph_hi = NPH; hipLaunchKernelGGL(mega, dim3(grid), dim3(512), LDS_BYTES, stream, p); }
}
```

```cpp
#include <hip/hip_runtime.h>
#include <stdint.h>
#include <stdio.h>

typedef unsigned short bf16_t;
typedef float f32x4 __attribute__((ext_vector_type(4)));
typedef unsigned u32x4 __attribute__((ext_vector_type(4)));
typedef unsigned u32x2 __attribute__((ext_vector_type(2)));
typedef short bf16x8 __attribute__((ext_vector_type(8)));

constexpr int T = 16384, DM = 2048, DIN = 5376, DPROJ = 4608, SEQ = 4096, NB = 4, DEPTH = 2;
constexpr int DLRU = 768, DCONV = 512, DSB = 768, HD = 128, NHL = 6, NHS = 6;
constexpr int NEXP = 32, DEXP = 512, MAXTILES = 160, PADROWS = MAXTILES * 256;
constexpr float EPS = 1e-6f;
constexpr float YSCALE_G = 8.0f;
constexpr float SX8 = 8.0f, SW1 = 64.0f, SH8 = 8.0f, SW2 = 32.0f;
#ifndef F8_INPROJ_MASK
#define F8_INPROJ_MASK 2
#endif
constexpr bool f8in(int l) { return ((F8_INPROJ_MASK >> l) & 1) != 0; }
constexpr float SHB = 16.0f, SWI = 64.0f;
#ifndef PITCH_PAD
#define PITCH_PAD 128
#endif
constexpr int pb_in(int l) { return (f8in(l) ? DM : DM * 2) + PITCH_PAD; }
constexpr int VTS = SEQ + 64;
constexpr int C_XA = 0, C_GA = 768, C_BG = 1536, C_CG = 2048, C_XB = 2560, C_Q = 3072, C_K = 3840, C_V = 4608;

constexpr size_t AL(size_t x) { return (x + 255) & ~(size_t)255; }
constexpr size_t SZ_WIN = (size_t)DIN * (DM * 2 + 256), SZ_WOUT = (size_t)DM * DM * 2, SZ_WGU = (size_t)NEXP * 1024 * DM * 2, SZ_WD = (size_t)NEXP * DM * DEXP * 2;
constexpr size_t SZ_WA = (size_t)NHL * HD * HD * 2, SZ_WR = (size_t)48 * DM * 4;
constexpr size_t OFF_CTL = 0, SZ_CTL = 131072;
constexpr size_t OFF_WIN = OFF_CTL + SZ_CTL;
constexpr size_t OFF_WOUT = OFF_WIN + DEPTH * SZ_WIN;
constexpr size_t OFF_WGU = OFF_WOUT + DEPTH * SZ_WOUT;
constexpr size_t OFF_WD = OFF_WGU + DEPTH * SZ_WGU;
constexpr size_t OFF_WA = OFF_WD + DEPTH * SZ_WD;
constexpr size_t OFF_WX = OFF_WA + DEPTH * SZ_WA;
constexpr size_t OFF_WR = OFF_WX + DEPTH * SZ_WA;
constexpr size_t OFF_HB = OFF_WR + DEPTH * SZ_WR;
constexpr size_t OFF_PROJ = OFF_HB + (size_t)T * (DM * 2 + 256);
constexpr size_t OFF_VT = OFF_PROJ + (size_t)T * DPROJ * 2;
constexpr size_t OFF_YPAD = OFF_PROJ;
constexpr size_t OFF_YMIX = OFF_VT + (size_t)NB * NHS * HD * VTS * 2;
constexpr size_t OFF_X = OFF_YMIX + (size_t)T * DM * 2;
constexpr size_t OFF_HID = OFF_X + (size_t)T * DM * 4;
constexpr size_t OFF_AGG = OFF_HID + (size_t)PADROWS * DEXP * 2;
constexpr size_t OFF_ROUTE = OFF_AGG + (size_t)256 * DLRU * 8;
constexpr size_t OFF_LIST = OFF_ROUTE + (size_t)T * 8 * 4;
constexpr size_t OFF_LISTR = OFF_LIST + (size_t)NEXP * T * 4;
constexpr size_t OFF_DB = OFF_LISTR + (size_t)NEXP * T * 4;
constexpr size_t WS_END = OFF_DB + (size_t)T * DM * 2;
static_assert((size_t)PADROWS * DM * 2 <= (size_t)T * DPROJ * 2 + (size_t)NB * NHS * HD * VTS * 2, "YPAD alias");
constexpr int CW_RT = 16384;
constexpr int CW_CNT = 8192;

typedef __bf16 bf16v2_t __attribute__((ext_vector_type(2)));
typedef float f32v2_t __attribute__((ext_vector_type(2)));
__device__ __forceinline__ unsigned cvt_pk_bf16(float lo, float hi) { const f32v2_t f = {lo, hi}; const bf16v2_t b = __builtin_convertvector(f, bf16v2_t); return __builtin_bit_cast(unsigned, b); }
__device__ __forceinline__ bf16_t f2bf(float f) { return (bf16_t)(cvt_pk_bf16(f, 0.f) & 0xffffu); }
__device__ __forceinline__ float bf2f(bf16_t b) { return __uint_as_float(((unsigned)b) << 16); }
__device__ __forceinline__ float bflo(unsigned w) { return __uint_as_float(w << 16); }
__device__ __forceinline__ float bfhi(unsigned w) { return __uint_as_float(w & 0xffff0000u); }
__device__ __forceinline__ float sat8(float v) { return __builtin_amdgcn_fmed3f(v, -448.0f, 448.0f); }
__device__ __forceinline__ float wave_sum(float v) {
#pragma unroll
    for (int o = 32; o >= 1; o >>= 1) v += __shfl_xor(v, o);
    return v;
}
__device__ __forceinline__ float fast_exp(float x) { return __builtin_amdgcn_exp2f(x * 1.4426950408889634f); }
__device__ __forceinline__ float sigmoidf_(float x) { return __builtin_amdgcn_rcpf(1.0f + fast_exp(-x)); }
__device__ __forceinline__ float one_minus_exp(float x) { const float s = -x * (1.0f + x * (0.5f + x * 0.16666667f)); const float d = 1.0f - fast_exp(x); return x > -0.02f ? s : d; }
__device__ __forceinline__ float softplusf_(float x) { return fmaxf(x, 0.f) + log1pf(__expf(-fabsf(x))); }
__device__ __forceinline__ float gelu_tanh(float x) { const float u2 = 1.5957691216057308f * (x + 0.044715f * x * x * x); return x * sigmoidf_(u2); }

__device__ __forceinline__ int otid() { int t = (int)threadIdx.x; asm volatile("" : "+v"(t)); return t; }
__device__ __forceinline__ int obid() { int b = (int)blockIdx.x; asm volatile("" : "+s"(b)); return b; }
#ifndef PROBE_SUB
#define PROBE_SUB 0
#endif
struct Params { const float* in[23]; float* out; unsigned char* ws; int ph_lo, ph_hi; };

struct InProxy { const float* const* p; int z; __device__ __forceinline__ const float* operator[](int k) const { return p[k + z]; } };
struct Ctx {
    InProxy in; float* out; unsigned char* ws;
    __device__ __forceinline__ unsigned* ctl() const { return (unsigned*)(ws + OFF_CTL); }
    __device__ __forceinline__ bf16_t* WIN(int l) const { return (bf16_t*)(ws + OFF_WIN + l * SZ_WIN); }
    __device__ __forceinline__ bf16_t* WOUT(int l) const { return (bf16_t*)(ws + OFF_WOUT + l * SZ_WOUT); }
    __device__ __forceinline__ bf16_t* WGU(int l) const { return (bf16_t*)(ws + OFF_WGU + l * SZ_WGU); }
    __device__ __forceinline__ bf16_t* WD(int l) const { return (bf16_t*)(ws + OFF_WD + l * SZ_WD); }
    __device__ __forceinline__ bf16_t* WA(int l) const { return (bf16_t*)(ws + OFF_WA + l * SZ_WA); }
    __device__ __forceinline__ bf16_t* WX(int l) const { return (bf16_t*)(ws + OFF_WX + l * SZ_WA); }
    __device__ __forceinline__ float* WR(int l) const { return (float*)(ws + OFF_WR + l * SZ_WR); }
    __device__ __forceinline__ unsigned* RTC(int l) const { return ctl() + CW_RT + l * 8192; }
    __device__ __forceinline__ unsigned* CNT(int l) const { return ctl() + CW_CNT + l * 2048; }
#define WSP(name, type, off) __device__ __forceinline__ type* name() const { return (type*)(ws + (off)); }
    WSP(HB, bf16_t, OFF_HB) WSP(PROJ, bf16_t, OFF_PROJ) WSP(VT, bf16_t, OFF_VT) WSP(YPAD, bf16_t, OFF_YPAD) WSP(YPAD8, unsigned char, OFF_YPAD) WSP(YMIX, bf16_t, OFF_YMIX) WSP(HID, bf16_t, OFF_HID)
    WSP(X, float, OFF_X) WSP(XB, bf16_t, OFF_X) WSP(AGG, float, OFF_AGG) WSP(ROUTE, unsigned, OFF_ROUTE) WSP(LIST, int, OFF_LIST) WSP(LISTR, float, OFF_LISTR) WSP(PT, bf16_t, OFF_X + (size_t)T * DM * 2) WSP(X1, bf16_t, OFF_X + (size_t)T * DM * 2) WSP(X1F8, unsigned char, OFF_HB) WSP(HID8, unsigned char, OFF_HID) WSP(DB, bf16_t, OFF_DB) WSP(HL, bf16_t, OFF_DB) WSP(PL, bf16_t, OFF_DB + (size_t)T * DLRU * 2)
#undef WSP
};

__device__ __forceinline__ Ctx octx(const Ctx& c) { int z = 0; asm volatile("" : "+s"(z)); Ctx r; r.in.p = c.in.p; r.in.z = z; r.out = c.out + z; r.ws = c.ws + z; return r; }

__device__ __forceinline__ void cvt_tile_out(const float* tile, int st, int r0, bf16_t* dst, int ld_dst, int drow0, bool f8) {
    const int rr = (st & 7) * 8;
    if (f8) {
#pragma unroll
        for (int p = 0; p < 2; ++p) {
            const int c = (st >> 3) + 32 * p; int w0 = 0, w1 = 0;
            w0 = __builtin_amdgcn_cvt_pk_fp8_f32(tile[(rr + 0) * 65 + c], tile[(rr + 1) * 65 + c], w0, false); w0 = __builtin_amdgcn_cvt_pk_fp8_f32(tile[(rr + 2) * 65 + c], tile[(rr + 3) * 65 + c], w0, true);
            w1 = __builtin_amdgcn_cvt_pk_fp8_f32(tile[(rr + 4) * 65 + c], tile[(rr + 5) * 65 + c], w1, false); w1 = __builtin_amdgcn_cvt_pk_fp8_f32(tile[(rr + 6) * 65 + c], tile[(rr + 7) * 65 + c], w1, true);
            *(u32x2*)((unsigned char*)dst + (size_t)(drow0 + c) * ld_dst + r0 + rr) = (u32x2){(unsigned)w0, (unsigned)w1};
        }
        return;
    }
#pragma unroll
    for (int p = 0; p < 2; ++p) {
        const int c = (st >> 3) + 32 * p;
        u32x4 w;
        w.x = cvt_pk_bf16(tile[(rr + 0) * 65 + c], tile[(rr + 1) * 65 + c]); w.y = cvt_pk_bf16(tile[(rr + 2) * 65 + c], tile[(rr + 3) * 65 + c]);
        w.z = cvt_pk_bf16(tile[(rr + 4) * 65 + c], tile[(rr + 5) * 65 + c]); w.w = cvt_pk_bf16(tile[(rr + 6) * 65 + c], tile[(rr + 7) * 65 + c]);
        *(u32x4*)(dst + (size_t)(drow0 + c) * ld_dst + r0 + rr) = w;
    }
}
constexpr int CV_WIN = 32 * 84, CV_WOUT = 32 * 32, CV_EXP = 32 * 8  , CV_G = NEXP * CV_EXP, CV_LRU = NHL * 4;
constexpr int CV_PER_LAYER = CV_WIN + CV_WOUT + 3 * CV_G + 2 * CV_LRU;
struct CvtTile { const float* src; bf16_t* dst; const float* gk; int ld_src, ld_dst, r0, c0, drow0; float sc; };
__device__ __forceinline__ void cvt_decode(const Ctx& c, int id, CvtTile& t) {
    const int l = id / CV_PER_LAYER; int j = id % CV_PER_LAYER; t.gk = nullptr; t.sc = 1.0f;
    if (j < CV_WIN) { t.src = c.in[2] + (size_t)l * DM * DIN; t.ld_src = DIN; { const int g = j >> 3, kp = g / 21, nq = g % 21; t.r0 = (2 * kp + ((j >> 2) & 1)) * 64; t.c0 = (4 * nq + (j & 3)) * 64; } t.dst = c.WIN(l); t.ld_dst = f8in(l) ? pb_in(l) : pb_in(l) / 2; t.drow0 = t.c0; if (f8in(l)) t.sc = -SWI; }
    else if ((j -= CV_WIN) < CV_WOUT) { t.src = c.in[14] + (size_t)l * DM * DM; t.ld_src = DM; { const int g = j >> 3, kp = g / 8, nq = g % 8; t.r0 = (2 * kp + ((j >> 2) & 1)) * 64; t.c0 = (4 * nq + (j & 3)) * 64; } t.dst = c.WOUT(l); t.ld_dst = DM; t.drow0 = t.c0; }
    else if ((j -= CV_WOUT) < 2 * CV_G) {
        const int isup = j / CV_G; j %= CV_G; const int e = j / CV_EXP; j %= CV_EXP;
        t.src = c.in[isup ? 21 : 20] + ((size_t)l * NEXP + e) * DM * DEXP; t.ld_src = DEXP; { const int g = j >> 3, kp = g / 2, nq = g % 2; t.r0 = (2 * kp + ((j >> 2) & 1)) * 64; t.c0 = (4 * nq + (j & 3)) * 64; }
        t.dst = (bf16_t*)((unsigned char*)c.WGU(l) + (size_t)e * 1024 * DM); t.ld_dst = DM; t.drow0 = 256 * (t.c0 / 128) + 128 * isup + (t.c0 % 128); t.gk = c.in[15] + (size_t)l * DM; t.sc = -SW1;
    } else if ((j -= 2 * CV_G) < CV_G) {
        const int e = j / CV_EXP; j %= CV_EXP;
        t.src = c.in[22] + ((size_t)l * NEXP + e) * DEXP * DM; t.ld_src = DM; { const int g = j >> 3, kp = g / 8, nq = g % 8; t.r0 = (2 * kp + ((j >> 2) & 1)) * 64; t.c0 = (4 * nq + (j & 3)) * 64; }
        t.dst = (bf16_t*)((unsigned char*)c.WD(l) + (size_t)e * DM * DEXP); t.ld_dst = DEXP; t.drow0 = t.c0; t.sc = -SW2;
    } else { j -= CV_G; const int isx = j / CV_LRU; j %= CV_LRU; const int h = j / 4; j %= 4;
        t.src = c.in[isx ? 7 : 5] + ((size_t)l * NHL + h) * HD * HD; t.ld_src = HD; t.r0 = (j / 2) * 64; t.c0 = (j % 2) * 64;
        t.dst = (isx ? c.WX(l) : c.WA(l)) + (size_t)h * HD * HD; t.ld_dst = HD; t.drow0 = t.c0; }
}
constexpr int CVT_NT = 4;
__device__ __forceinline__ void phase_convert(const Ctx& c, float* lds) {
    const int tid = otid(), sb = tid >> 8, st = tid & 255;
    float* tile0 = lds + sb * (CVT_NT * 64 * 65);
    const int total = DEPTH * CV_PER_LAYER;
    const int nsub = gridDim.x * 2 * CVT_NT;
    const int idb = (obid() * 2 + sb) * CVT_NT;
    CvtTile tA[CVT_NT]; f32x4 vA[CVT_NT][4];
#define CVT_LOAD(T_, V_, base_) do { _Pragma("unroll") for (int k = 0; k < CVT_NT; ++k) { const int id_ = (base_) + idb + k; cvt_decode(c, id_ < total ? id_ : 0, T_[k]); \
        _Pragma("unroll") for (int i = 0; i < 4; ++i) V_[k][i] = __builtin_nontemporal_load((const f32x4*)(T_[k].src + (size_t)(T_[k].r0 + (st >> 4) + 16 * i) * T_[k].ld_src + T_[k].c0 + (st & 15) * 4)); } } while (0)
#define CVT_FLUSH(T_, V_, base_) do { _Pragma("unroll") for (int k = 0; k < CVT_NT; ++k) _Pragma("unroll") for (int i = 0; i < 4; ++i) { \
            float* p = tile0 + k * (64 * 65) + ((st >> 4) + 16 * i) * 65 + (st & 15) * 4; const float gs_ = (T_[k].gk ? T_[k].gk[T_[k].r0 + (st >> 4) + 16 * i] : 1.0f) * fabsf(T_[k].sc); \
            p[0] = V_[k][i][0] * gs_; p[1] = V_[k][i][1] * gs_; p[2] = V_[k][i][2] * gs_; p[3] = V_[k][i][3] * gs_; } \
        __syncthreads(); \
        _Pragma("unroll") for (int k = 0; k < CVT_NT; ++k) if ((base_) + idb + k < total) cvt_tile_out(tile0 + k * (64 * 65), st, T_[k].r0, T_[k].dst, T_[k].ld_dst, T_[k].drow0, T_[k].sc < 0.f); \
        __syncthreads(); } while (0)
    for (int base = 0; base < total; base += nsub) { CVT_LOAD(tA, vA, base); CVT_FLUSH(tA, vA, base); }
#undef CVT_LOAD
#undef CVT_FLUSH
    for (int i = obid() * blockDim.x + tid; i < DEPTH * 48 * DM; i += gridDim.x * blockDim.x) {
        const int l = i / (48 * DM), n = (i / DM) % 48, k = i % DM;
        float v = 0.f;
        if (n < 4) v = c.in[16][((size_t)l * DM + k) * 4 + n]; else if (n < 36) v = c.in[18][((size_t)l * DM + k) * 32 + (n - 4)];
        const float wg = v * c.in[15][(size_t)l * DM + k]; const bf16_t hi = f2bf(wg);
        bf16_t* wr = (bf16_t*)c.WR(l); wr[(size_t)n * DM + k] = hi; wr[(size_t)(48 + n) * DM + k] = f2bf(wg - bf2f(hi));
    }
}

__device__ __forceinline__ void norm_store_row(const f32x4 (&v)[8], const float* g, bf16_t* dst, int lane) {
    float s = 0.f;
#pragma unroll
    for (int j = 0; j < 8; ++j) s += v[j][0] * v[j][0] + v[j][1] * v[j][1] + v[j][2] * v[j][2] + v[j][3] * v[j][3];
    s = wave_sum(s);
    const float rstd = rsqrtf(s * (1.0f / DM) + EPS);
#pragma unroll
    for (int j = 0; j < 8; ++j) {
        const f32x4 gg = *(const f32x4*)(g + j * 256 + lane * 4);
        u32x2 w; w.x = cvt_pk_bf16(v[j][0] * rstd * gg[0], v[j][1] * rstd * gg[1]); w.y = cvt_pk_bf16(v[j][2] * rstd * gg[2], v[j][3] * rstd * gg[3]);
        *(u32x2*)(dst + j * 256 + lane * 4) = w;
    }
}
__device__ __forceinline__ void norm_store_row8(const f32x4 (&v)[8], const float* g, unsigned char* dst, int lane) {
    float s = 0.f;
#pragma unroll
    for (int j = 0; j < 8; ++j) s += v[j][0] * v[j][0] + v[j][1] * v[j][1] + v[j][2] * v[j][2] + v[j][3] * v[j][3];
    s = wave_sum(s);
    const float rstd = rsqrtf(s * (1.0f / DM) + EPS) * SHB;
#pragma unroll
    for (int j = 0; j < 8; ++j) {
        const f32x4 gg = *(const f32x4*)(g + j * 256 + lane * 4);
        int w = 0; w = __builtin_amdgcn_cvt_pk_fp8_f32(sat8(v[j][0] * rstd * gg[0]), sat8(v[j][1] * rstd * gg[1]), w, false); w = __builtin_amdgcn_cvt_pk_fp8_f32(sat8(v[j][2] * rstd * gg[2]), sat8(v[j][3] * rstd * gg[3]), w, true);
        *(int*)(dst + j * 256 + lane * 4) = w;
    }
}
__device__ __forceinline__ void phase_norm_in(const Ctx& c, int l) {
    const int tid = otid(), lane = tid & 63, wv = tid >> 6, stride = gridDim.x * 8;
    for (int r = obid() * 8 + wv; r < T; r += 4 * stride) {
        f32x4 v[4][8];
#pragma unroll
        for (int k = 0; k < 4; ++k) { const int rr = (r + k * stride < T) ? r + k * stride : r;
#pragma unroll
            for (int j = 0; j < 8; ++j) v[k][j] = *(const f32x4*)(c.in[0] + (size_t)rr * DM + j * 256 + lane * 4); }
#pragma unroll
        for (int k = 0; k < 4; ++k) if (k == 0 || r + k * stride < T) norm_store_row(v[k], c.in[1] + (size_t)l * DM, (bf16_t*)((unsigned char*)c.HB() + (size_t)(r + k * stride) * pb_in(0)), lane);
    }
}

struct MoeTab { int cnt[NEXP]; int tstart[NEXP + 1]; int texp[MAXTILES]; };
__device__ __forceinline__ void build_moe_tab(const Ctx& c, int l, MoeTab* mt) {
    __syncthreads();
    const int tid = otid();
    if (tid < 64) {
        const int n = tid < NEXP ? (int)__hip_atomic_load(c.CNT(l) + tid * 64, __ATOMIC_RELAXED, __HIP_MEMORY_SCOPE_AGENT) : 0;
        const int nt = (n + 255) >> 8;
        int incl = nt;
#pragma unroll
        for (int o = 1; o < 32; o <<= 1) { const int v = __shfl_up(incl, o); if (tid >= o) incl += v; }
        const int excl = incl - nt;
        if (tid < NEXP) { mt->cnt[tid] = n; mt->tstart[tid] = excl; for (int i = 0; i < nt; ++i) if (excl + i < MAXTILES) mt->texp[excl + i] = tid; }
        if (tid == NEXP - 1) mt->tstart[NEXP] = incl < MAXTILES ? incl : MAXTILES;
    }
    __syncthreads();
}

template <bool DRY> __device__ __forceinline__ void phase_combine(const Ctx& c, int l, const MoeTab* mt) {
    const int tid = otid(), lane = tid & 63, wv = tid >> 6, stride = gridDim.x * 8;
    bf16_t* XB = c.XB(); const bf16_t* X1 = c.X1(); const unsigned char* YPAD = c.YPAD8(); const unsigned* ROUTE = c.ROUTE();
    for (int r = obid() * 8 + wv; r < T; r += 2 * stride) {
        f32x4 v[2][8]; unsigned ya[2][8], yb[2][8]; u32x2 yd[2][8]; float g0[2], g1[2]; int rr[2];
#pragma unroll
        for (int k = 0; k < 2; ++k) {
            rr[k] = (r + k * stride < T) ? r + k * stride : r;
            const u32x4 ra = *(const u32x4*)(ROUTE + (size_t)rr[k] * 8); const u32x2 rb = *(const u32x2*)(ROUTE + (size_t)rr[k] * 8 + 4);
            const int e0 = ra.x, p0 = ra.y, e1 = ra.w, p1 = rb.x; g0[k] = __uint_as_float(ra.z) * (1.0f / YSCALE_G); g1[k] = __uint_as_float(rb.y) * (1.0f / YSCALE_G);
            const unsigned char* y0 = YPAD + ((size_t)mt->tstart[e0] * 256 + p0) * DM + lane * 4; const unsigned char* y1 = YPAD + ((size_t)mt->tstart[e1] * 256 + p1) * DM + lane * 4;
            const bf16_t* dp = X1 + (size_t)rr[k] * DM + lane * 4;
#pragma unroll
            for (int j = 0; j < 8; ++j) { v[k][j] = (f32x4){0.f, 0.f, 0.f, 0.f};
                ya[k][j] = *(const unsigned*)(y0 + j * 256); yb[k][j] = *(const unsigned*)(y1 + j * 256); yd[k][j] = *(const u32x2*)(dp + j * 256); }
        }
        __builtin_amdgcn_sched_barrier(0);
#pragma unroll
        for (int k = 0; k < 2; ++k) {
            if (k == 0 || r + stride < T) {
#pragma unroll
                for (int j = 0; j < 8; ++j) {
                    typedef float f32x2_t __attribute__((ext_vector_type(2)));
                    const f32x2_t a01 = __builtin_amdgcn_cvt_pk_f32_fp8((int)ya[k][j], false), a23 = __builtin_amdgcn_cvt_pk_f32_fp8((int)ya[k][j], true);
                    const f32x2_t b01 = __builtin_amdgcn_cvt_pk_f32_fp8((int)yb[k][j], false), b23 = __builtin_amdgcn_cvt_pk_f32_fp8((int)yb[k][j], true);
                    v[k][j][0] += bflo(yd[k][j].x) + g0[k] * a01.x + g1[k] * b01.x; v[k][j][1] += bfhi(yd[k][j].x) + g0[k] * a01.y + g1[k] * b01.y;
                    v[k][j][2] += bflo(yd[k][j].y) + g0[k] * a23.x + g1[k] * b23.x; v[k][j][3] += bfhi(yd[k][j].y) + g0[k] * a23.y + g1[k] * b23.y;
                }
                if (l == DEPTH - 1) {
                    if (!DRY) {
#pragma unroll
                    for (int j = 0; j < 8; ++j) *(f32x4*)(c.out + (size_t)rr[k] * DM + j * 256 + lane * 4) = v[k][j]; }
                    else norm_store_row(v[k], c.in[1], c.HB() + (size_t)rr[k] * DM, lane);
                } else {
                    if (!DRY) {
#pragma unroll
                    for (int j = 0; j < 8; ++j) { u32x2 xw; xw.x = cvt_pk_bf16(v[k][j][0], v[k][j][1]); xw.y = cvt_pk_bf16(v[k][j][2], v[k][j][3]); *(u32x2*)(XB + (size_t)rr[k] * DM + j * 256 + lane * 4) = xw; } }
                    if (f8in(l + 1)) norm_store_row8(v[k], c.in[1] + (size_t)(l + 1) * DM, (unsigned char*)c.HB() + (size_t)rr[k] * pb_in(l + 1), lane);
                    else norm_store_row(v[k], c.in[1] + (size_t)(l + 1) * DM, (bf16_t*)((unsigned char*)c.HB() + (size_t)rr[k] * pb_in(l + 1)), lane);
                }
            }
        }
    }
}

__device__ __forceinline__ void phase_router_mfma(const Ctx& c, int l, float* lds) {
    float* LG = lds; float* SS = lds + 26624; float* RS = lds + 27136; int* LC = (int*)(lds + 27200); int* LB = (int*)(lds + 27232);
    const int tid = otid(), lane = tid & 63, wv = tid >> 6, rt = wv & 3, kh = wv >> 2, q = lane >> 4, l15 = lane & 15;
    const float* WR = c.WR(l);
    for (int tile = obid(); tile < T / 64; tile += gridDim.x) {
        const int r0 = tile * 64;
        f32x4 acc[4][3];
#pragma unroll
        for (int g = 0; g < 4; ++g)
#pragma unroll
            for (int ct = 0; ct < 3; ++ct) acc[g][ct] = (f32x4){0.f, 0.f, 0.f, 0.f};
        const bf16_t* xp = c.X1() + (size_t)(r0 + l15) * DM + wv * 256 + 8 * q;
        const bf16_t* wh = (const bf16_t*)WR + (size_t)l15 * DM + wv * 256 + 8 * q; const bf16_t* wl = wh + (size_t)48 * DM;
        float ssq[4] = {0.f, 0.f, 0.f, 0.f};
        bf16x8 xa[2][4], bh[2][3], bl[2][3];
#pragma unroll
        for (int st = 0; st < 2; ++st)
#pragma unroll
            for (int g = 0; g < 4; ++g) xa[st][g] = *(const bf16x8*)(xp + (size_t)(16 * g) * DM + 32 * st);
#pragma unroll
        for (int ct = 0; ct < 3; ++ct) { bh[0][ct] = *(const bf16x8*)(wh + (size_t)(16 * ct) * DM); bl[0][ct] = *(const bf16x8*)(wl + (size_t)(16 * ct) * DM); }
#define RT_STEP(st_, cur_, nxt_, ldb_, ldx_) do { \
            if (ldb_) { _Pragma("unroll") for (int ct = 0; ct < 3; ++ct) { bh[nxt_][ct] = *(const bf16x8*)(wh + (size_t)(16 * ct) * DM + 32 * ((st_) + 1)); bl[nxt_][ct] = *(const bf16x8*)(wl + (size_t)(16 * ct) * DM + 32 * ((st_) + 1)); } } \
            __builtin_amdgcn_sched_barrier(0); \
            _Pragma("unroll") for (int g = 0; g < 4; ++g) { \
                const bf16x8 xv = xa[cur_][g]; \
                _Pragma("unroll") for (int j = 0; j < 8; ++j) { const float xf = __uint_as_float(((unsigned)(unsigned short)xv[j]) << 16); ssq[g] += xf * xf; } \
                _Pragma("unroll") for (int ct = 0; ct < 3; ++ct) { acc[g][ct] = __builtin_amdgcn_mfma_f32_16x16x32_bf16(xv, bh[cur_][ct], acc[g][ct], 0, 0, 0); acc[g][ct] = __builtin_amdgcn_mfma_f32_16x16x32_bf16(xv, bl[cur_][ct], acc[g][ct], 0, 0, 0); } \
                if (ldx_) xa[cur_][g] = *(const bf16x8*)(xp + (size_t)(16 * g) * DM + 32 * ((st_) + 2)); } \
            __builtin_amdgcn_sched_barrier(0); } while (0)
#pragma unroll 1
        for (int sp = 0; sp < 4; ++sp) {
            RT_STEP(2 * sp, 0, 1, true, sp < 3);
            RT_STEP(2 * sp + 1, 1, 0, sp < 3, sp < 3);
        }
#undef RT_STEP
#pragma unroll
        for (int g = 0; g < 4; ++g) { float v = ssq[g]; v += __shfl_xor(v, 16); v += __shfl_xor(v, 32); if (q == 0) SS[wv * 64 + 16 * g + l15] = v; }
#pragma unroll
        for (int g = 0; g < 4; ++g)
#pragma unroll
            for (int ct = 0; ct < 3; ++ct)
#pragma unroll
                for (int i = 0; i < 4; ++i) LG[(wv * 64 + 16 * g + 4 * q + i) * 52 + 16 * ct + l15] = acc[g][ct][i];
        if (tid < NEXP) LC[tid] = 0;
        __syncthreads();
        int e0 = 0, e1 = 0, k0_ = 0, k1_ = 0; float rstd_ = 0.f, g0_ = 0.f, g1_ = 0.f;
        if (tid < 64) {
            float sst_ = 0.f;
#pragma unroll
            for (int w = 0; w < 8; ++w) sst_ += SS[w * 64 + tid];
            const float rstd = rsqrtf(sst_ * (1.0f / DM) + EPS);
            RS[tid] = rstd;
            float gl[4], el[8];
#pragma unroll
            for (int i = 0; i < 4; ++i) { float a_ = 0.f;
#pragma unroll
                for (int w = 0; w < 8; ++w) a_ += LG[(w * 64 + tid) * 52 + i];
                gl[i] = a_ * rstd + c.in[17][l * 4 + i]; }
            int gi = 0; float gm = gl[0];
#pragma unroll
            for (int i = 1; i < 4; ++i) if (gl[i] > gm) { gm = gl[i]; gi = i; }
            float gs = 0.f;
#pragma unroll
            for (int i = 0; i < 4; ++i) gs += __expf(gl[i] - gm);
            const float pg = 1.0f / gs;
#pragma unroll
            for (int i = 0; i < 8; ++i) { const int n = 4 + gi * 8 + i; float a_ = 0.f;
#pragma unroll
                for (int w = 0; w < 8; ++w) a_ += LG[(w * 64 + tid) * 52 + n];
                el[i] = a_ * rstd + c.in[19][l * 32 + gi * 8 + i]; }
            int i0 = 0; float m0 = el[0];
#pragma unroll
            for (int i = 1; i < 8; ++i) if (el[i] > m0) { m0 = el[i]; i0 = i; }
            int i1 = -1; float m1 = -3.0e38f;
#pragma unroll
            for (int i = 0; i < 8; ++i) if (i != i0 && el[i] > m1) { m1 = el[i]; i1 = i; }
            const float ex1 = __expf(m1 - m0), den = 1.0f + ex1;
            const float g0 = pg / den, g1 = pg * ex1 / den;
            e0 = gi * 8 + i0; e1 = gi * 8 + i1; rstd_ = rstd; g0_ = g0; g1_ = g1;
            k0_ = (int)__hip_atomic_fetch_add(&LC[e0], 1, __ATOMIC_RELAXED, __HIP_MEMORY_SCOPE_WORKGROUP);
            k1_ = (int)__hip_atomic_fetch_add(&LC[e1], 1, __ATOMIC_RELAXED, __HIP_MEMORY_SCOPE_WORKGROUP);
        }
        __syncthreads();
        if (tid < NEXP) { const int n = LC[tid]; LB[tid] = n > 0 ? (int)__hip_atomic_fetch_add(c.CNT(l) + tid * 64, (unsigned)n, __ATOMIC_RELAXED, __HIP_MEMORY_SCOPE_AGENT) : 0; }
        __syncthreads();
        if (tid < 64) {
            const int r = r0 + tid, p0 = LB[e0] + k0_, p1 = LB[e1] + k1_;
            c.LIST()[(size_t)e0 * T + p0] = r; c.LIST()[(size_t)e1 * T + p1] = r;
            c.LISTR()[(size_t)e0 * T + p0] = rstd_; c.LISTR()[(size_t)e1 * T + p1] = rstd_;
            unsigned* ro = c.ROUTE() + (size_t)r * 8;
            *(u32x4*)ro = (u32x4){(unsigned)e0, (unsigned)p0, __float_as_uint(g0_), (unsigned)e1};
            *(u32x2*)(ro + 4) = (u32x2){(unsigned)p1, __float_as_uint(g1_)};
        }
        __syncthreads();
    }
}

#define LAS __attribute__((address_space(3)))
typedef int i32x4_t __attribute__((ext_vector_type(4)));
typedef int i32x8_t __attribute__((ext_vector_type(8)));
__device__ __forceinline__ i32x8_t cat8(const bf16x8 a, const bf16x8 b) { const i32x4_t x = __builtin_bit_cast(i32x4_t, a), y = __builtin_bit_cast(i32x4_t, b); return __builtin_shufflevector(x, y, 0, 1, 2, 3, 4, 5, 6, 7); }
__device__ __forceinline__ void mfma_f8(f32x4& acc, const i32x8_t& a, const i32x8_t& b) { asm volatile("v_mfma_f32_16x16x128_f8f6f4 %0, %1, %2, %0" : "+v"(acc) : "v"(a), "v"(b)); }
__device__ __forceinline__ bf16x8 half8(const i32x8_t& v, int k) { const i32x4_t h = k ? __builtin_shufflevector(v, v, 4, 5, 6, 7) : __builtin_shufflevector(v, v, 0, 1, 2, 3); return __builtin_bit_cast(bf16x8, h); }
namespace g8 {
constexpr int BM = 256, BK = 64, HALF = 128, HTB = HALF * BK * 2, STAGE_BYTES = 8 * HTB, NXCD = 8, WGM = 8;
__device__ __forceinline__ int lds_byte(int r, int c) { const int st = (r >> 4) * 2 + (c >> 5), rr = r & 15, cc = c & 31, ob = rr * 64 + cc * 2; return st * 1024 + (ob ^ (((ob >> 9) & 1) << 5)); }
__device__ __forceinline__ void stage_rc(int b, int& R, int& C) { const int st = b / 1024, sb = b % 1024, swz = sb ^ (((sb >> 9) & 1) << 5); R = (st >> 1) * 16 + swz / 64; C = (st & 1) * 32 + (swz % 64) / 2; }
__device__ __forceinline__ int perm32(int rho) { const int n = rho >> 4, i = rho & 15; return 8 * (i >> 2) + 4 * n + (i & 3); }
struct Unit { int pm, pn; const char* B; };
typedef f32x4 Acc[2][2][4][2];

struct DenseOrder {
    static constexpr bool GATHER = false;
    int nM, nN, nwg, G, c; const char* Bt; size_t tstrideB; int rsh = 0, lim = 0x7fffffff;
    __device__ __forceinline__ void init(int M, int N, int G_, int c_, const bf16_t* Bt_, int ldb) { nM = M / BM; nN = N / BM; nwg = nM * nN; G = G_; c = c_; Bt = (const char*)Bt_; tstrideB = (size_t)BM * ldb * 2; }
    __device__ __forceinline__ bool next(int i, Unit& u) const {
        const long L = (long)(i >> rsh) * G + c; if (L >= nwg || L >= lim) return false;
        int wgid = (int)L; { const int q = nwg / NXCD, r = nwg % NXCD, xcd = wgid % NXCD, off = wgid / NXCD; wgid = (xcd < r ? xcd * (q + 1) : r * (q + 1) + (xcd - r) * q) + off; }
        const int nig = WGM * nN, gid = wgid / nig, fm = gid * WGM, gsz = (nM - fm) < WGM ? (nM - fm) : WGM;
        u.pm = fm + ((wgid % nig) % gsz); u.pn = (wgid % nig) / gsz; u.B = Bt + (size_t)u.pn * tstrideB; return true;
    }
    __device__ __forceinline__ unsigned arow_off(int) const { return 0u; }
};
struct SplitKOrder {
    static constexpr bool GATHER = false;
    int c; const char* Bt;
    __device__ __forceinline__ bool next(int i, Unit& u) const { if (i > 0) return false; u.pm = c >> 2; u.pn = c & 3; u.B = Bt; return true; }
    __device__ __forceinline__ unsigned arow_off(int) const { return 0u; }
};
template <bool GATHER_, int NCT, int LDA, size_t ESTRIDE, size_t TSTRIDE> struct MoeOrder {
    static constexpr bool GATHER = GATHER_;
    const MoeTab* mt; const int* LIST; int G, c; const char* W; int rsh = 0;
    __device__ __forceinline__ bool next(int i, Unit& u) const {
        const int L = (i >> rsh) * G + c; const int total = __builtin_amdgcn_readfirstlane(mt->tstart[NEXP]) * NCT; if (L >= total) return false;
        const int rt = L / NCT, ct = L % NCT; u.pm = rt; u.pn = ct; const int e = __builtin_amdgcn_readfirstlane(mt->texp[rt]); u.B = W + (size_t)e * ESTRIDE + (size_t)ct * TSTRIDE; return true;
    }
    __device__ __forceinline__ unsigned arow_off(int r) const {
        const int e = mt->texp[r >> 8]; const int pos = r - mt->tstart[e] * 256; const int tok = pos < mt->cnt[e] ? LIST[(size_t)e * T + pos] : 0; return (unsigned)tok * (unsigned)(LDA * 2);
    }
};

struct MoeOrder2 {
    static constexpr bool GATHER = false;
    const MoeTab* mt; int G, c, R, rtA; const char* W; int rsh = 0;
    __device__ __forceinline__ bool next(int i0, Unit& u) const {
        const int i = i0 >> rsh; int u2;
        if (c < R) { if (i >= 2) return false; u2 = rtA * 8 + 2 * c + i; }
        else { u2 = (c - R) + i * (G - R); if (u2 >= rtA * 8) return false; }
        const int rt = u2 >> 3, ct = u2 & 7; u.pm = rt; u.pn = ct; const int e = __builtin_amdgcn_readfirstlane(mt->texp[rt]);
        u.B = W + (size_t)e * ((size_t)DM * DEXP) + (size_t)ct * ((size_t)256 * DEXP); return true;
    }
    __device__ __forceinline__ unsigned arow_off(int) const { return 0u; }
};
__device__ __forceinline__ void moe_wait_dep(unsigned* rtc, int c, int G, int R, int rtA) {
    const int tid = otid();
    if (tid < 64) {
        int rt = -1;
        if (c < R) { if (tid < 2) rt = rtA + ((2 * c + tid) >> 3); } else if (tid < 32) { const int u2 = (c - R) + tid * (G - R); if (u2 < rtA * 8) rt = u2 >> 3; }
        unsigned spins = 0;
        for (;;) {
            const bool ok = rt < 0 || __hip_atomic_load(rtc + (rt < 0 ? 0 : rt) * 32, __ATOMIC_RELAXED, __HIP_MEMORY_SCOPE_AGENT) >= 32u;
            if (__all(ok)) break;
            __builtin_amdgcn_s_sleep(2); if (++spins > (1u << 22)) break;
        }
        __builtin_amdgcn_fence(__ATOMIC_ACQUIRE, "agent");
        asm volatile("s_waitcnt vmcnt(0)" ::: "memory");
    }
    __syncthreads();
}

template <class Epi, class Sched>
__device__ __forceinline__ void gemm_mfma(LAS unsigned char* lds, const bf16_t* A, int lda, int ldb, int K, const Sched& S, const Epi& E) {
    constexpr bool GATHER = Sched::GATHER;
    const int tid = otid(), wid = __builtin_amdgcn_readfirstlane(tid >> 6), lane = tid & 63, wr = wid >> 2, wc = wid & 3, fr = lane & 15, fq = lane >> 4;
    const int nt = K / BK;
    int Rst[2], Cst[2]; unsigned voffB[2], voA[2][2], voAn[2][2];
#pragma unroll
    for (int i = 0; i < 2; ++i) { stage_rc(tid * 16 + i * 8192, Rst[i], Cst[i]); const int Rb = Epi::PERM ? ((Rst[i] & ~31) + perm32(Rst[i] & 31)) : Rst[i];
        voffB[i] = (unsigned)(Rb * ldb + Cst[i]) * 2u;
#pragma unroll
        for (int h = 0; h < 2; ++h) { voA[h][i] = (unsigned)((h * HALF + Rst[i]) * lda + Cst[i]) * 2u; voAn[h][i] = voA[h][i]; } }
    const size_t kstep = (size_t)(BK * 2), hstepB = (size_t)HALF * ldb * 2, tstepA = (size_t)BM * lda * 2;
    const unsigned ldsw = (unsigned)wid * 1024u;
    const int aoff = lds_byte(wr * 64 + fr, fq * 8), boff = lds_byte(wc * 32 + fr, fq * 8);
#define G8_SA(b, h) (((b) * 2 + (h)) * HTB)
#define G8_SB(b, h) ((4 + (b) * 2 + (h)) * HTB)
#define G8_OPQ(x) ({ unsigned _o = (x); asm volatile("" : "+v"(_o)); _o; })
#define G8_STAGE_B(bufoff, gbase) do { _Pragma("unroll") for (int _i = 0; _i < 2; ++_i) \
        __builtin_amdgcn_global_load_lds((const unsigned*)((const char*)(gbase) + G8_OPQ(voffB[_i])), (LAS unsigned*)(lds + (bufoff) + ldsw + _i * 8192), 16, 0, 0); } while (0)
#define G8_STAGE_A(bufoff, gbase, o0, o1) do { \
        __builtin_amdgcn_global_load_lds((const unsigned*)((const char*)(gbase) + G8_OPQ(o0)), (LAS unsigned*)(lds + (bufoff) + ldsw), 16, 0, 0); \
        __builtin_amdgcn_global_load_lds((const unsigned*)((const char*)(gbase) + G8_OPQ(o1)), (LAS unsigned*)(lds + (bufoff) + ldsw + 8192), 16, 0, 0); } while (0)
#define G8_LDA(dst, b, h) do { _Pragma("unroll") for (int m = 0; m < 4; ++m) dst[m] = cat8(*(const LAS bf16x8*)(lds + G8_SA(b, h) + aoff + m * 2048), *(const LAS bf16x8*)(lds + G8_SA(b, h) + aoff + m * 2048 + 1024)); } while (0)
#define G8_LDB(dst, b, h) do { _Pragma("unroll") for (int n = 0; n < 2; ++n) dst[n] = cat8(*(const LAS bf16x8*)(lds + G8_SB(b, h) + boff + n * 2048), *(const LAS bf16x8*)(lds + G8_SB(b, h) + boff + n * 2048 + 1024)); } while (0)
#define G8_MMA(ai, bj, At, Bt) do { __builtin_amdgcn_s_setprio(1); \
        if constexpr (Epi::F8) { _Pragma("unroll") for (int m = 0; m < 4; ++m) _Pragma("unroll") for (int n = 0; n < 2; ++n) \
            mfma_f8(acc[ai][bj][m][n], Bt[n], At[m]); } \
        else { _Pragma("unroll") for (int m = 0; m < 4; ++m) _Pragma("unroll") for (int n = 0; n < 2; ++n) _Pragma("unroll") for (int k = 0; k < 2; ++k) \
            acc[ai][bj][m][n] = __builtin_amdgcn_mfma_f32_16x16x32_bf16(half8(Bt[n], k), half8(At[m], k), acc[ai][bj][m][n], 0, 0, 0); } \
        __builtin_amdgcn_s_setprio(0); } while (0)
#define G8_WAIT_V(n) asm volatile("s_waitcnt vmcnt(" #n ")" ::: "memory")
#define G8_WAIT_L(n) asm volatile("s_waitcnt lgkmcnt(" #n ")" ::: "memory")
#define G8_BAR __builtin_amdgcn_s_barrier()
#define G8_SCHED __builtin_amdgcn_sched_barrier(0)
    Unit cur, nxt; int ui = 0, prev_pm = -1;
    if (!S.next(0, cur)) return;
    Acc acc;
#pragma unroll
    for (int a = 0; a < 2; ++a)
#pragma unroll
        for (int b = 0; b < 2; ++b)
#pragma unroll
            for (int m = 0; m < 4; ++m)
#pragma unroll
                for (int n = 0; n < 2; ++n) acc[a][b][m][n] = (f32x4){0.f, 0.f, 0.f, 0.f};
    i32x8_t At[4], B0[2], B1[2];
    const char* cA; const char* cB = cur.B;
    if (GATHER) { cA = (const char*)A;
#pragma unroll
        for (int h = 0; h < 2; ++h)
#pragma unroll
            for (int i = 0; i < 2; ++i) voA[h][i] = S.arow_off(cur.pm * BM + h * HALF + Rst[i]) + (unsigned)Cst[i] * 2u;
    } else cA = (const char*)A + (size_t)cur.pm * tstepA;
    G8_STAGE_B(G8_SB(0, 0), cB); G8_STAGE_A(G8_SA(0, 0), cA, voA[0][0], voA[0][1]); G8_STAGE_B(G8_SB(0, 1), cB + hstepB); G8_STAGE_A(G8_SA(0, 1), cA, voA[1][0], voA[1][1]);
    if (wr == 1) G8_BAR;
    G8_WAIT_V(4); G8_BAR;
    G8_STAGE_B(G8_SB(1, 0), cB + kstep); G8_STAGE_A(G8_SA(1, 0), cA + kstep, voA[0][0], voA[0][1]); G8_STAGE_B(G8_SB(1, 1), cB + hstepB + kstep);
    G8_WAIT_V(6); G8_BAR;
    for (;;) {
        const bool has_next = S.next(ui + 1, nxt);
        const char* nA; const char* nB = has_next ? nxt.B : cB;
        if (GATHER) { nA = cA;
            if (has_next) {
#pragma unroll
                for (int h = 0; h < 2; ++h)
#pragma unroll
                    for (int i = 0; i < 2; ++i) voAn[h][i] = S.arow_off(nxt.pm * BM + h * HALF + Rst[i]) + (unsigned)Cst[i] * 2u;
            } else {
#pragma unroll
                for (int h = 0; h < 2; ++h)
#pragma unroll
                    for (int i = 0; i < 2; ++i) voAn[h][i] = voA[h][i];
            }
        } else nA = has_next ? (const char*)A + (size_t)nxt.pm * tstepA : cA;
        for (int t = 0; t < nt; t += 2) {
            const bool last = (t == nt - 2);
            const char* a1 = cA + (size_t)(t + 1) * kstep;
            const char* a2 = last ? nA : cA + (size_t)(t + 2) * kstep; const char* b2 = last ? nB : cB + (size_t)(t + 2) * kstep;
            const char* a3 = a2 + kstep; const char* b3 = b2 + kstep;
            unsigned o00 = voA[0][0], o01 = voA[0][1], o10 = voA[1][0], o11 = voA[1][1];
            if (GATHER) { if (last) { o00 = voAn[0][0]; o01 = voAn[0][1]; o10 = voAn[1][0]; o11 = voAn[1][1]; } }
            G8_LDB(B0, 0, 0); G8_SCHED; G8_LDA(At, 0, 0); G8_STAGE_A(G8_SA(1, 1), a1, voA[1][0], voA[1][1]);
            G8_WAIT_L(8); G8_BAR; G8_WAIT_L(0); G8_MMA(0, 0, At, B0); G8_BAR; G8_SCHED;
            G8_LDB(B1, 0, 1); G8_STAGE_B(G8_SB(0, 0), b2);
            G8_BAR; G8_WAIT_L(0); G8_MMA(0, 1, At, B1); G8_BAR;
            G8_LDA(At, 0, 1); G8_STAGE_A(G8_SA(0, 0), a2, o00, o01);
            G8_BAR; G8_WAIT_L(0); G8_MMA(1, 0, At, B0); G8_BAR; G8_SCHED;
            G8_STAGE_B(G8_SB(0, 1), b2 + hstepB);
            G8_WAIT_V(6);
            if constexpr (Epi::PUBLISH) { if (prev_pm >= 0) { E.publish(prev_pm); prev_pm = -1; } }
            G8_BAR; G8_MMA(1, 1, At, B1); G8_BAR;
            G8_LDB(B0, 1, 0); G8_SCHED; G8_LDA(At, 1, 0); G8_STAGE_A(G8_SA(0, 1), a2, o10, o11);
            G8_WAIT_L(8); G8_BAR; G8_WAIT_L(0); G8_MMA(0, 0, At, B0); G8_BAR; G8_SCHED;
            G8_LDB(B1, 1, 1); G8_STAGE_B(G8_SB(1, 0), b3);
            G8_BAR; G8_WAIT_L(0); G8_MMA(0, 1, At, B1); G8_BAR;
            G8_LDA(At, 1, 1); G8_STAGE_A(G8_SA(1, 0), a3, o00, o01);
            G8_BAR; G8_WAIT_L(0); G8_MMA(1, 0, At, B0); G8_BAR; G8_SCHED;
            G8_STAGE_B(G8_SB(1, 1), b3 + hstepB);
            G8_WAIT_V(6); G8_BAR; G8_MMA(1, 1, At, B1); G8_BAR;
        }
        if constexpr (Epi::F8) {
#define G8_TIE(a, b, txt) asm volatile(txt : "+v"(acc[a][b][0][0]), "+v"(acc[a][b][0][1]), "+v"(acc[a][b][1][0]), "+v"(acc[a][b][1][1]), "+v"(acc[a][b][2][0]), "+v"(acc[a][b][2][1]), "+v"(acc[a][b][3][0]), "+v"(acc[a][b][3][1]))
            G8_TIE(0, 0, ""); G8_TIE(0, 1, ""); G8_TIE(1, 0, "s_nop 7"); G8_TIE(1, 1, "s_nop 15\n\ts_nop 7");
#undef G8_TIE
        }
        if constexpr (Epi::ASCALE != 1.0f) {
#pragma unroll
            for (int a = 0; a < 2; ++a)
#pragma unroll
                for (int b = 0; b < 2; ++b)
#pragma unroll
                    for (int m = 0; m < 4; ++m)
#pragma unroll
                        for (int n = 0; n < 2; ++n) acc[a][b][m][n] *= Epi::ASCALE;
        }
        E(acc, cur, wr, wc, fr, fq);
        if constexpr (Epi::PUBLISH) prev_pm = cur.pm;
        if (!has_next) break;
#pragma unroll
        for (int a = 0; a < 2; ++a)
#pragma unroll
            for (int b = 0; b < 2; ++b)
#pragma unroll
                for (int m = 0; m < 4; ++m)
#pragma unroll
                    for (int n = 0; n < 2; ++n) acc[a][b][m][n] = (f32x4){0.f, 0.f, 0.f, 0.f};
        cur = nxt; cA = nA; cB = nB; ++ui;
        if (GATHER) {
#pragma unroll
            for (int h = 0; h < 2; ++h)
#pragma unroll
                for (int i = 0; i < 2; ++i) voA[h][i] = voAn[h][i];
        }
    }
    G8_WAIT_V(0);
    if constexpr (Epi::PUBLISH) { if (prev_pm >= 0) { E.publish(prev_pm); prev_pm = -1; } }
    if (wr == 0) G8_BAR;
    G8_BAR;
#undef G8_SA
#undef G8_SB
#undef G8_STAGE_A
#undef G8_STAGE_B
#undef G8_OPQ
#undef G8_LDA
#undef G8_LDB
#undef G8_MMA
#undef G8_WAIT_V
#undef G8_WAIT_L
#undef G8_BAR
#undef G8_SCHED
}

__device__ __forceinline__ u32x4 pack8(const f32x4& a, const f32x4& b) { u32x4 w; w.x = cvt_pk_bf16(a[0], a[1]); w.y = cvt_pk_bf16(a[2], a[3]); w.z = cvt_pk_bf16(b[0], b[1]); w.w = cvt_pk_bf16(b[2], b[3]); return w; }
__device__ __forceinline__ u32x4 subtile_T(LAS bf16_t* Tw, const f32x4& a, const f32x4& b, int fr, int fq, int lane) {
#pragma unroll
    for (int j = 0; j < 4; ++j) { Tw[(8 * fq + j) * 16 + fr] = f2bf(a[j]); Tw[(8 * fq + 4 + j) * 16 + fr] = f2bf(b[j]); }
    asm volatile("" ::: "memory");
    const u32x4 r = *(const LAS u32x4*)(Tw + (lane >> 1) * 16 + (lane & 1) * 8);
    asm volatile("" ::: "memory");
    return r;
}
template <bool F8_> struct MEpiProjT { static constexpr bool PERM = true, PUBLISH = false, F8 = F8_; static constexpr float ASCALE = F8_ ? 1.0f / (SHB * SWI) : 1.0f; bf16_t* PROJ; bf16_t* VT; LAS float* KX; const float* gq; const float* gk;
    __device__ __forceinline__ void operator()(const Acc& acc, const Unit& u, int wr, int wc, int fr, int fq) const {
        const int row0 = u.pm * BM + wr * 64 + fr;
        if (u.pn >= C_K / 256 && u.pn < DPROJ / 256) {
#pragma unroll
            for (int ai = 0; ai < 2; ++ai)
#pragma unroll
                for (int m = 0; m < 4; ++m)
#pragma unroll
                    for (int bj = 0; bj < 2; ++bj) {
                        const f32x4 a = acc[ai][bj][m][0], b = acc[ai][bj][m][1];
                        float ss = a[0] * a[0] + a[1] * a[1] + a[2] * a[2] + a[3] * a[3] + b[0] * b[0] + b[1] * b[1] + b[2] * b[2] + b[3] * b[3];
                        ss += __shfl_xor(ss, 16); ss += __shfl_xor(ss, 32);
                        if (fq == 0) KX[((ai * HALF + wr * 64 + m * 16 + fr) * 2 + bj) * 4 + wc] = ss;
                    }
            asm volatile("s_waitcnt lgkmcnt(0)" ::: "memory"); __builtin_amdgcn_s_barrier(); asm volatile("" ::: "memory");
            const int col0 = u.pn * BM + wc * 32 + 8 * fq;
            f32x4 g0[2], g1[2];
#pragma unroll
            for (int bj = 0; bj < 2; ++bj) { const int d0 = wc * 32 + 8 * fq; g0[bj] = *(const f32x4*)(gq + d0) * *(const f32x4*)(gk + d0); g1[bj] = *(const f32x4*)(gq + d0 + 4) * *(const f32x4*)(gk + d0 + 4); }
#pragma unroll
            for (int ai = 0; ai < 2; ++ai)
#pragma unroll
                for (int m = 0; m < 4; ++m) { bf16_t* rowp = PROJ + (size_t)(row0 + ai * HALF + m * 16) * DPROJ + col0;
#pragma unroll
                    for (int bj = 0; bj < 2; ++bj) { const f32x4 p4 = *(const LAS f32x4*)(KX + ((ai * HALF + wr * 64 + m * 16 + fr) * 2 + bj) * 4);
                        const float rs = rsqrtf(((p4[0] + p4[1]) + (p4[2] + p4[3])) * (1.0f / HD) + EPS);
                        *(u32x4*)(rowp + bj * HALF) = pack8(acc[ai][bj][m][0] * g0[bj] * rs, acc[ai][bj][m][1] * g1[bj] * rs); } }
            return;
        }
        if (u.pn < DPROJ / 256) {
            const int col0 = u.pn * BM + wc * 32 + 8 * fq;
#pragma unroll
            for (int ai = 0; ai < 2; ++ai)
#pragma unroll
                for (int m = 0; m < 4; ++m) { bf16_t* rowp = PROJ + (size_t)(row0 + ai * HALF + m * 16) * DPROJ + col0;
#pragma unroll
                    for (int bj = 0; bj < 2; ++bj) *(u32x4*)(rowp + bj * HALF) = pack8(acc[ai][bj][m][0], acc[ai][bj][m][1]); }
        } else {
            const int lane = fq * 16 + fr, cl = lane >> 1, hf = lane & 1; LAS bf16_t* Tw = (LAS bf16_t*)KX + (wr * 4 + wc) * 512;
            const int cc0 = (u.pn - DPROJ / 256) * BM + wc * 32 + cl;
#pragma unroll
            for (int ai = 0; ai < 2; ++ai)
#pragma unroll
                for (int m = 0; m < 4; ++m) { const int rowb = u.pm * BM + wr * 64 + ai * HALF + m * 16, b = rowb >> 12, s = (rowb & (SEQ - 1)) + hf * 8;
#pragma unroll
                    for (int bj = 0; bj < 2; ++bj) { const int cc = cc0 + bj * HALF;
                        const u32x4 w = subtile_T(Tw, acc[ai][bj][m][0], acc[ai][bj][m][1], fr, fq, lane);
                        *(u32x4*)(VT + ((size_t)(b * NHS + (cc >> 7)) * HD + (cc & 127)) * VTS + s) = w; } }
        }
    } };
template <bool F8_> struct MEpiPartT { static constexpr bool PERM = true, PUBLISH = false, F8 = F8_; static constexpr float ASCALE = F8_ ? 1.0f / (SHB * SWI) : 1.0f; bf16_t* PT; LAS float* KX;
    __device__ __forceinline__ void operator()(const Acc& acc, const Unit& u, int wr, int wc, int fr, int fq) const {
        const int lane = fq * 16 + fr, cl = lane >> 1, hf = lane & 1; LAS bf16_t* Tw = (LAS bf16_t*)KX + (wr * 4 + wc) * 512;
        bf16_t* base0 = PT + (size_t)(u.pm * 4 + u.pn) * 65536 + (size_t)(wc * 32 + cl) * 256 + wr * 64 + hf * 8;
#pragma unroll
        for (int ai = 0; ai < 2; ++ai)
#pragma unroll
            for (int m = 0; m < 4; ++m)
#pragma unroll
                for (int bj = 0; bj < 2; ++bj) {
                    const u32x4 w = subtile_T(Tw, acc[ai][bj][m][0], acc[ai][bj][m][1], fr, fq, lane);
                    *(u32x4*)(base0 + (size_t)(bj * HALF) * 256 + ai * HALF + m * 16) = w; }
    } };
__device__ __forceinline__ u32x4 pair16(unsigned a0, unsigned a1, unsigned b0, unsigned b1) {
    const auto s0 = __builtin_amdgcn_permlane16_swap(a0, b0, false, false); const auto s1 = __builtin_amdgcn_permlane16_swap(a1, b1, false, false);
    return (u32x4){s0[0], s1[0], s0[1], s1[1]};
}
__device__ __forceinline__ f32x4 silu_mul(const f32x4& g, const f32x4& u) { f32x4 r;
#pragma unroll
    for (int j = 0; j < 4; ++j) r[j] = g[j] * sigmoidf_(g[j]) * u[j];
    return r; }
struct MEpiGU { static constexpr bool PERM = true, PUBLISH = true, F8 = true; static constexpr float ASCALE = 1.0f; unsigned char* HID; const float* LISTR; const MoeTab* mt; unsigned* rtc; int n1early;
    __device__ __forceinline__ void operator()(const Acc& acc, const Unit& u, int wr, int wc, int fr, int fq) const {
        const int row0 = u.pm * BM + wr * 64 + fr, col0 = u.pn * HALF + wc * 32 + 8 * fq;
        const int e = __builtin_amdgcn_readfirstlane(mt->texp[u.pm]), cnt = __builtin_amdgcn_readfirstlane(mt->cnt[e]), pb = __builtin_amdgcn_readfirstlane(mt->tstart[e]) * 256;
        const float* lr = LISTR + (size_t)e * T;
        const __amdgpu_buffer_rsrc_t rsrc = __builtin_amdgcn_make_buffer_rsrc(HID, 0, (int)((size_t)PADROWS * DEXP), 0x00020000);
#pragma unroll
        for (int ai = 0; ai < 2; ++ai)
#pragma unroll
            for (int mp = 0; mp < 2; ++mp) { int w[2][2];
#pragma unroll
                for (int mm = 0; mm < 2; ++mm) { const int m = 2 * mp + mm;
                    const int row = row0 + ai * HALF + m * 16, pos = row - pb;
                    const float rs = pos < cnt ? lr[pos] * (1.0f / (SX8 * SW1)) : 0.f;
                    const f32x4 h0 = silu_mul(acc[ai][0][m][0] * rs, acc[ai][1][m][0] * rs) * SH8, h1 = silu_mul(acc[ai][0][m][1] * rs, acc[ai][1][m][1] * rs) * SH8;
                    int w0 = 0, w1 = 0;
                    w0 = __builtin_amdgcn_cvt_pk_fp8_f32(__builtin_amdgcn_fmed3f(h0[0], -448.f, 448.f), __builtin_amdgcn_fmed3f(h0[1], -448.f, 448.f), w0, false); w0 = __builtin_amdgcn_cvt_pk_fp8_f32(__builtin_amdgcn_fmed3f(h0[2], -448.f, 448.f), __builtin_amdgcn_fmed3f(h0[3], -448.f, 448.f), w0, true);
                    w1 = __builtin_amdgcn_cvt_pk_fp8_f32(__builtin_amdgcn_fmed3f(h1[0], -448.f, 448.f), __builtin_amdgcn_fmed3f(h1[1], -448.f, 448.f), w1, false); w1 = __builtin_amdgcn_cvt_pk_fp8_f32(__builtin_amdgcn_fmed3f(h1[2], -448.f, 448.f), __builtin_amdgcn_fmed3f(h1[3], -448.f, 448.f), w1, true);
                    w[mm][0] = w0; w[mm][1] = w1; }
                __builtin_amdgcn_raw_buffer_store_b128(pair16((unsigned)w[0][0], (unsigned)w[0][1], (unsigned)w[1][0], (unsigned)w[1][1]), rsrc, (row0 + ai * HALF + mp * 32 + 16 * (fq & 1)) * DEXP + (u.pn * HALF + wc * 32 + 16 * (fq >> 1)), 0, 16);
            }
    }
    __device__ __forceinline__ void publish(int pm) const {
        if ((otid() & 63) == 0) __hip_atomic_fetch_add(rtc + pm * 32, 1u, __ATOMIC_RELAXED, __HIP_MEMORY_SCOPE_AGENT);
    } };
struct MEpiDown { static constexpr bool PERM = true, PUBLISH = false, F8 = false; static constexpr float ASCALE = 1.0f; bf16_t* YPAD;
    __device__ __forceinline__ void operator()(const Acc& acc, const Unit& u, int wr, int wc, int fr, int fq) const {
        const int row0 = u.pm * BM + wr * 64 + fr, col0 = u.pn * BM + wc * 32 + 8 * fq;
#pragma unroll
        for (int ai = 0; ai < 2; ++ai)
#pragma unroll
            for (int m = 0; m < 4; ++m) { bf16_t* rowp = YPAD + (size_t)(row0 + ai * HALF + m * 16) * DM + col0;
#pragma unroll
                for (int bj = 0; bj < 2; ++bj) *(u32x4*)(rowp + bj * HALF) = pack8(acc[ai][bj][m][0], acc[ai][bj][m][1]); }
    } };
template <bool XF32> struct MEpiOut { static constexpr bool STAMP = false, PERM = true, PUBLISH = false, F8 = false; static constexpr float ASCALE = 1.0f; const float* Xf; const bf16_t* Xb; bf16_t* X1; unsigned char* X18;
    __device__ __forceinline__ void operator()(const Acc& acc, const Unit& u, int wr, int wc, int fr, int fq) const {
        const int row0 = u.pm * BM + wr * 64 + fr, col0 = u.pn * BM + wc * 32 + 8 * fq;
        const int row8 = u.pm * BM + wr * 64 + fr + 16 * (fq & 1), col8 = u.pn * BM + wc * 32 + 16 * (fq >> 1);
#pragma unroll
        for (int ai = 0; ai < 2; ++ai) {
            f32x4 xa[4][2][2]; u32x4 xh[4][2];
#pragma unroll
            for (int m = 0; m < 4; ++m)
#pragma unroll
                for (int bj = 0; bj < 2; ++bj) { const size_t o = (size_t)(row0 + ai * HALF + m * 16) * DM + col0 + bj * HALF;
                    if (XF32) { xa[m][bj][0] = *(const f32x4*)(Xf + o); xa[m][bj][1] = *(const f32x4*)(Xf + o + 4); } else xh[m][bj] = *(const u32x4*)(Xb + o); }
            __builtin_amdgcn_sched_barrier(0);
#pragma unroll
            for (int mp = 0; mp < 2; ++mp)
#pragma unroll
                for (int bj = 0; bj < 2; ++bj) { int w8[2][2];
#pragma unroll
                    for (int mm = 0; mm < 2; ++mm) { const int m = 2 * mp + mm; const size_t o = (size_t)(row0 + ai * HALF + m * 16) * DM + col0 + bj * HALF;
                        f32x4 a = acc[ai][bj][m][0], b = acc[ai][bj][m][1];
                        if (XF32) { a += xa[m][bj][0]; b += xa[m][bj][1]; }
                        else { const u32x4 w = xh[m][bj]; a[0] += bflo(w.x); a[1] += bfhi(w.x); a[2] += bflo(w.y); a[3] += bfhi(w.y); b[0] += bflo(w.z); b[1] += bfhi(w.z); b[2] += bflo(w.w); b[3] += bfhi(w.w); }
                        *(u32x4*)(X1 + o) = pack8(a, b);
                        int w0 = 0, w1 = 0;
                        w0 = __builtin_amdgcn_cvt_pk_fp8_f32(sat8(a[0] * SX8), sat8(a[1] * SX8), w0, false); w0 = __builtin_amdgcn_cvt_pk_fp8_f32(sat8(a[2] * SX8), sat8(a[3] * SX8), w0, true);
                        w1 = __builtin_amdgcn_cvt_pk_fp8_f32(sat8(b[0] * SX8), sat8(b[1] * SX8), w1, false); w1 = __builtin_amdgcn_cvt_pk_fp8_f32(sat8(b[2] * SX8), sat8(b[3] * SX8), w1, true);
                        w8[mm][0] = w0; w8[mm][1] = w1; }
                    *(u32x4*)(X18 + (size_t)(row8 + ai * HALF + mp * 32) * DM + col8 + bj * HALF) = pair16((unsigned)w8[0][0], (unsigned)w8[0][1], (unsigned)w8[1][0], (unsigned)w8[1][1]); }
        }
    } };
constexpr float YSCALE = YSCALE_G;
struct MEpiDown8 { static constexpr bool PERM = true, PUBLISH = false, F8 = true; static constexpr float ASCALE = 1.0f; unsigned char* Y8;
    __device__ __forceinline__ void operator()(const Acc& acc, const Unit& u, int wr, int wc, int fr, int fq) const {
        const int row0 = u.pm * BM + wr * 64 + fr + 16 * (fq & 1), col0 = u.pn * BM + wc * 32 + 16 * (fq >> 1);
#pragma unroll
        for (int ai = 0; ai < 2; ++ai)
#pragma unroll
            for (int mp = 0; mp < 2; ++mp)
#pragma unroll
                for (int bj = 0; bj < 2; ++bj) { int w[2][2];
#pragma unroll
                    for (int mm = 0; mm < 2; ++mm) { const int m = 2 * mp + mm; const f32x4 a = acc[ai][bj][m][0] * (YSCALE / (SH8 * SW2)), b = acc[ai][bj][m][1] * (YSCALE / (SH8 * SW2)); int w0 = 0, w1 = 0;
                        w0 = __builtin_amdgcn_cvt_pk_fp8_f32(sat8(a[0]), sat8(a[1]), w0, false); w0 = __builtin_amdgcn_cvt_pk_fp8_f32(sat8(a[2]), sat8(a[3]), w0, true);
                        w1 = __builtin_amdgcn_cvt_pk_fp8_f32(sat8(b[0]), sat8(b[1]), w1, false); w1 = __builtin_amdgcn_cvt_pk_fp8_f32(sat8(b[2]), sat8(b[3]), w1, true); w[mm][0] = w0; w[mm][1] = w1; }
                    *(u32x4*)(Y8 + (size_t)(row0 + ai * HALF + mp * 32) * DM + col0 + bj * HALF) = pair16((unsigned)w[0][0], (unsigned)w[0][1], (unsigned)w[1][0], (unsigned)w[1][1]); }
    } };
}

__device__ __forceinline__ void phase_convb(const Ctx& c, int l) {
    const int gt = obid() * 512 + otid(), ng = gridDim.x * 512, sub = gt & 15;
    const float* cw = c.in[10] + (size_t)l * 3 * DCONV; const bf16_t* PROJ = c.PROJ();
#pragma unroll 2
    for (int item = gt >> 4; item < T * 4; item += ng >> 4) {
        const int t = item >> 2, hh = item & 3, ch = hh * HD + sub * 8, s = t & (SEQ - 1);
        u32x4 cg[3], xb[3];
#pragma unroll
        for (int tap = 0; tap < 3; ++tap) { const int ds = (s + tap - 2 >= 0) ? tap - 2 : 0; const bf16_t* row = PROJ + (size_t)(t + ds) * DPROJ; cg[tap] = *(const u32x4*)(row + C_CG + ch); xb[tap] = *(const u32x4*)(row + C_XB + ch); }
        const u32x4 bg = *(const u32x4*)(PROJ + (size_t)t * DPROJ + C_BG + ch);
        float acc[8] = {0, 0, 0, 0, 0, 0, 0, 0};
#pragma unroll
        for (int tap = 0; tap < 3; ++tap) {
            if (s + tap - 2 >= 0) {
                const f32x4 w0 = *(const f32x4*)(cw + tap * DCONV + ch), w1 = *(const f32x4*)(cw + tap * DCONV + ch + 4);
                acc[0] += w0[0] * bflo(cg[tap].x) * bflo(xb[tap].x); acc[1] += w0[1] * bfhi(cg[tap].x) * bfhi(xb[tap].x); acc[2] += w0[2] * bflo(cg[tap].y) * bflo(xb[tap].y); acc[3] += w0[3] * bfhi(cg[tap].y) * bfhi(xb[tap].y);
                acc[4] += w1[0] * bflo(cg[tap].z) * bflo(xb[tap].z); acc[5] += w1[1] * bfhi(cg[tap].z) * bfhi(xb[tap].z); acc[6] += w1[2] * bflo(cg[tap].w) * bflo(xb[tap].w); acc[7] += w1[3] * bfhi(cg[tap].w) * bfhi(xb[tap].w);
            }
        }
        acc[0] *= bflo(bg.x); acc[1] *= bfhi(bg.x); acc[2] *= bflo(bg.y); acc[3] *= bfhi(bg.y); acc[4] *= bflo(bg.z); acc[5] *= bfhi(bg.z); acc[6] *= bflo(bg.w); acc[7] *= bfhi(bg.w);
        float ss = 0.f;
#pragma unroll
        for (int i = 0; i < 8; ++i) ss += acc[i] * acc[i];
        ss += __shfl_xor(ss, 1); ss += __shfl_xor(ss, 2); ss += __shfl_xor(ss, 4); ss += __shfl_xor(ss, 8);
        const float rstd = rsqrtf(ss * (1.0f / HD) + EPS);
        const float* mg = c.in[13] + (size_t)l * DM + DLRU + ch;
        const f32x4 m0 = *(const f32x4*)mg, m1 = *(const f32x4*)(mg + 4);
        u32x4 o; o.x = cvt_pk_bf16(acc[0] * rstd * m0[0], acc[1] * rstd * m0[1]); o.y = cvt_pk_bf16(acc[2] * rstd * m0[2], acc[3] * rstd * m0[3]);
        o.z = cvt_pk_bf16(acc[4] * rstd * m1[0], acc[5] * rstd * m1[1]); o.w = cvt_pk_bf16(acc[6] * rstd * m1[2], acc[7] * rstd * m1[3]);
        *(u32x4*)(c.YMIX() + (size_t)t * DM + DLRU + ch) = o;
    }
}
typedef float f32x16 __attribute__((ext_vector_type(16)));
#define MFMA32(a, b, c) __builtin_amdgcn_mfma_f32_32x32x16_bf16((a), (b), (c), 0, 0, 0)
constexpr int XCS = 776;
__device__ __forceinline__ void phase_lruA(const Ctx& c, int l, unsigned char* ldsb) {
    constexpr bool PASS2 = false;
    bf16_t* XC = (bf16_t*)ldsb; bf16_t* PR = (bf16_t*)(ldsb + 99328); bf16_t* HL = c.HL(); bf16_t* PL = c.PL();
    const int tid = otid(), lane = tid & 63, wv = tid >> 6, hh = lane >> 5, l31 = lane & 31;
    const float* cw = c.in[3] + (size_t)l * 4 * DLRU; const float* cb = c.in[4] + (size_t)l * DLRU;
    const bf16_t* PROJ = c.PROJ(); float* AGG = c.AGG();
    typedef float f32x2_t __attribute__((ext_vector_type(2)));
    for (int tile = obid(); tile < T / 64; tile += gridDim.x) {
        const int t0 = tile * 64, s0 = t0 & (SEQ - 1), tb = tile & 63;
        if (tid < 480) {
            const int cg = tid % 48, tslot = tid / 48, ch = cg * 16;
            float w[4][16], bias[16];
#pragma unroll
            for (int i = 0; i < 16; i += 4) { *(f32x4*)&bias[i] = *(const f32x4*)(cb + ch + i);
#pragma unroll
                for (int tap = 0; tap < 4; ++tap) *(f32x4*)&w[tap][i] = *(const f32x4*)(cw + tap * DLRU + ch + i); }
#pragma unroll
            for (int it = 0; it < 7; ++it) {
                const int tokr = tslot + 10 * it, tok = tokr < 64 ? tokr : 63;
                u32x4 x0[4], x1[4]; float msk[4];
#pragma unroll
                for (int tap = 0; tap < 4; ++tap) {
                    const int ds = tap - 3; const bool ok = (s0 + tok + ds >= 0); msk[tap] = ok ? 1.0f : 0.0f;
                    const bf16_t* row = PROJ + (size_t)(t0 + tok + (ok ? ds : 0)) * DPROJ + C_XA + ch;
                    x0[tap] = *(const u32x4*)row; x1[tap] = *(const u32x4*)(row + 8);
                }
                float a[16];
#pragma unroll
                for (int i = 0; i < 16; ++i) a[i] = bias[i];
#pragma unroll
                for (int tap = 0; tap < 4; ++tap) {
                    const float m = msk[tap];
                    a[0] += m * w[tap][0] * bflo(x0[tap].x); a[1] += m * w[tap][1] * bfhi(x0[tap].x); a[2] += m * w[tap][2] * bflo(x0[tap].y); a[3] += m * w[tap][3] * bfhi(x0[tap].y);
                    a[4] += m * w[tap][4] * bflo(x0[tap].z); a[5] += m * w[tap][5] * bfhi(x0[tap].z); a[6] += m * w[tap][6] * bflo(x0[tap].w); a[7] += m * w[tap][7] * bfhi(x0[tap].w);
                    a[8] += m * w[tap][8] * bflo(x1[tap].x); a[9] += m * w[tap][9] * bfhi(x1[tap].x); a[10] += m * w[tap][10] * bflo(x1[tap].y); a[11] += m * w[tap][11] * bfhi(x1[tap].y);
                    a[12] += m * w[tap][12] * bflo(x1[tap].z); a[13] += m * w[tap][13] * bfhi(x1[tap].z); a[14] += m * w[tap][14] * bflo(x1[tap].w); a[15] += m * w[tap][15] * bfhi(x1[tap].w);
                }
                u32x4 o0, o1; o0.x = cvt_pk_bf16(a[0], a[1]); o0.y = cvt_pk_bf16(a[2], a[3]); o0.z = cvt_pk_bf16(a[4], a[5]); o0.w = cvt_pk_bf16(a[6], a[7]);
                o1.x = cvt_pk_bf16(a[8], a[9]); o1.y = cvt_pk_bf16(a[10], a[11]); o1.z = cvt_pk_bf16(a[12], a[13]); o1.w = cvt_pk_bf16(a[14], a[15]);
                if (tokr < 64) { *(u32x4*)(XC + tok * XCS + ch) = o0; *(u32x4*)(XC + tok * XCS + ch + 8) = o1; }
            }
        }
        __syncthreads();
#pragma unroll 1
        for (int i = 0; i < 3; ++i) {
            const int hd = 2 * i + (wv >> 2), ntw = wv & 3, chl = 32 * ntw + l31, ch = hd * HD + chl;
            const bf16_t* wa = c.WA(l) + ((size_t)hd * HD + chl) * HD + 8 * hh; const bf16_t* wx = c.WX(l) + ((size_t)hd * HD + chl) * HD + 8 * hh;
            const float ba = c.in[6][l * DLRU + ch], bx = c.in[8][l * DLRU + ch], c8 = -8.0f * softplusf_(-c.in[9][l * DLRU + ch]);
            float sst = 0.f, Pt = 1.f;
            float hreg[2][16], preg[2][16];
            bf16x8 bRf[8], bIf[8];
#pragma unroll
            for (int s = 0; s < 8; ++s) { bRf[s] = *(const bf16x8*)(wa + 16 * s); bIf[s] = *(const bf16x8*)(wx + 16 * s); }
            __builtin_amdgcn_sched_barrier(0);
#pragma unroll
            for (int half = 0; half < 2; ++half) {
                float av[16], uv[16];
                {
                    f32x16 accR, accI;
#pragma unroll
                    for (int r = 0; r < 16; ++r) { accR[r] = 0.f; accI[r] = 0.f; }
#pragma unroll
                    for (int s = 0; s < 8; ++s) {
                        const bf16x8 a = *(const bf16x8*)(XC + (32 * half + l31) * XCS + hd * HD + 16 * s + 8 * hh);
                        accR = MFMA32(a, bRf[s], accR); accI = MFMA32(a, bIf[s], accI);
                    }
#pragma unroll
                    for (int r = 0; r < 16; ++r) {
                        const int tok = 32 * half + (r & 3) + 8 * (r >> 2) + 4 * hh;
                        const float xc = bf2f(XC[tok * XCS + ch]);
                        const float rg = sigmoidf_(accR[r] + ba), ig = sigmoidf_(accI[r] + bx);
                        const float la = c8 * rg;
                        av[r] = fast_exp(la); uv[r] = __builtin_amdgcn_sqrtf(one_minus_exp(2.0f * la)) * (ig * xc);
                    }
                }
                float Pp[4], Hp[4];
#pragma unroll
                for (int g = 0; g < 4; ++g) { float P = 1.f, H = 0.f;
#pragma unroll
                    for (int r = 4 * g; r < 4 * g + 4; ++r) { H = av[r] * H + uv[r]; P *= av[r]; }
                    Pp[g] = __shfl_xor(P, 32); Hp[g] = __shfl_xor(H, 32); }
#pragma unroll
                for (int g = 0; g < 4; ++g) {
                    if (hh == 0) {
#pragma unroll
                        for (int r = 4 * g; r < 4 * g + 4; ++r) { sst = av[r] * sst + uv[r]; Pt *= av[r]; hreg[half][r] = sst; preg[half][r] = Pt; }
                        sst = Pp[g] * sst + Hp[g]; Pt *= Pp[g];
                    } else {
                        sst = Pp[g] * sst + Hp[g]; Pt *= Pp[g];
#pragma unroll
                        for (int r = 4 * g; r < 4 * g + 4; ++r) { sst = av[r] * sst + uv[r]; Pt *= av[r]; hreg[half][r] = sst; preg[half][r] = Pt; }
                    }
                }
            }
            if (hh == 0) { f32x2_t o; o.x = Pt; o.y = sst; ((f32x2_t*)AGG)[(size_t)tile * DLRU + ch] = o; }
            __syncthreads();
#pragma unroll
            for (int half = 0; half < 2; ++half)
#pragma unroll
                for (int r = 0; r < 16; ++r) { const int tok = 32 * half + (r & 3) + 8 * (r >> 2) + 4 * hh;
                    XC[tok * XCS + ch] = f2bf(hreg[half][r]); PR[tok * 264 + (wv >> 2) * HD + chl] = f2bf(preg[half][r]); }
            __syncthreads();
#pragma unroll
            for (int k = 0; k < 4; ++k) {
                const int item = tid + 512 * k, tok = item >> 5, g = item & 31, hs = g >> 4, sub = g & 15, cc = (2 * i + hs) * HD + sub * 8;
                *(u32x4*)(HL + (size_t)(t0 + tok) * DLRU + cc) = *(const u32x4*)(XC + tok * XCS + cc);
                *(u32x4*)(PL + (size_t)(t0 + tok) * DLRU + cc) = *(const u32x4*)(PR + tok * 264 + hs * HD + sub * 8);
            }
        }
        __syncthreads();
    }
}

__device__ __forceinline__ void phase_lruB(const Ctx& c, int l, unsigned char* ldsb) {
    float* HIN = (float*)ldsb;
    const int tid = otid();
    const bf16_t* PROJ = c.PROJ(); const float* AGG = c.AGG(); const bf16_t* HL = c.HL(); const bf16_t* PL = c.PL();
    typedef float f32x2_t __attribute__((ext_vector_type(2)));
    for (int tile = obid(); tile < T / 64; tile += gridDim.x) {
        const int t0 = tile * 64, tb = tile & 63;
        {
            const f32x2_t* ag = (const f32x2_t*)AGG + (size_t)(tile - tb) * DLRU;
            const int chb = 512 + (tid & 255);
            float ha = 0.f, hb = 0.f;
#pragma unroll 8
            for (int k = 0; k < tb; ++k) { const f32x2_t pa = ag[(size_t)k * DLRU + tid], pb_ = ag[(size_t)k * DLRU + chb]; ha = pa.x * ha + pa.y; hb = pb_.x * hb + pb_.y; }
            HIN[tid] = ha; if (tid < 256) HIN[chb] = hb;
        }
        __syncthreads();
        const int wv_ = tid >> 6, wit0 = wv_ < 4 ? 8 * wv_ : 32 + 16 * (wv_ - 4), wcnt = wv_ < 4 ? 8 : 16;
#define LB_ADDR(it_, tok_, cc_) const int item_##it_ = (wit0 + (it_)) * 64 + (tid & 63), tok_ = item_##it_ / 96, rem_##it_ = item_##it_ % 96, cc_ = (rem_##it_ >> 4) * HD + (rem_##it_ & 15) * 8
#define LB_LOAD(H_, P_, G_, tok_, cc_) do { H_ = *(const u32x4*)(HL + (size_t)(t0 + tok_) * DLRU + cc_); P_ = *(const u32x4*)(PL + (size_t)(t0 + tok_) * DLRU + cc_); G_ = *(const u32x4*)(PROJ + (size_t)(t0 + tok_) * DPROJ + C_GA + cc_); } while (0)
#define LB_BODY(hv, pv, ga, tok, cc) do { \
            const f32x4 i0 = *(const f32x4*)(HIN + cc), i1 = *(const f32x4*)(HIN + cc + 4); \
            float y[8] = {(bflo(hv.x) + bflo(pv.x) * i0[0]) * gelu_tanh(bflo(ga.x)), (bfhi(hv.x) + bfhi(pv.x) * i0[1]) * gelu_tanh(bfhi(ga.x)), \
                          (bflo(hv.y) + bflo(pv.y) * i0[2]) * gelu_tanh(bflo(ga.y)), (bfhi(hv.y) + bfhi(pv.y) * i0[3]) * gelu_tanh(bfhi(ga.y)), \
                          (bflo(hv.z) + bflo(pv.z) * i1[0]) * gelu_tanh(bflo(ga.z)), (bfhi(hv.z) + bfhi(pv.z) * i1[1]) * gelu_tanh(bfhi(ga.z)), \
                          (bflo(hv.w) + bflo(pv.w) * i1[2]) * gelu_tanh(bflo(ga.w)), (bfhi(hv.w) + bfhi(pv.w) * i1[3]) * gelu_tanh(bfhi(ga.w))}; \
            float ss = 0.f; \
            _Pragma("unroll") for (int k = 0; k < 8; ++k) ss += y[k] * y[k]; \
            ss += __shfl_xor(ss, 1); ss += __shfl_xor(ss, 2); ss += __shfl_xor(ss, 4); ss += __shfl_xor(ss, 8); \
            const float rstd = rsqrtf(ss * (1.0f / HD) + EPS); \
            const float* mg = c.in[13] + (size_t)l * DM + cc; \
            const f32x4 m0 = *(const f32x4*)mg, m1 = *(const f32x4*)(mg + 4); \
            u32x4 o; o.x = cvt_pk_bf16(y[0] * rstd * m0[0], y[1] * rstd * m0[1]); o.y = cvt_pk_bf16(y[2] * rstd * m0[2], y[3] * rstd * m0[3]); \
            o.z = cvt_pk_bf16(y[4] * rstd * m1[0], y[5] * rstd * m1[1]); o.w = cvt_pk_bf16(y[6] * rstd * m1[2], y[7] * rstd * m1[3]); \
            *(u32x4*)(c.YMIX() + (size_t)(t0 + tok) * DM + cc) = o; } while (0)
        {
            u32x4 hA, pA, gA, hB, pB, gB;
            { LB_ADDR(0, tk_, cc_); LB_LOAD(hA, pA, gA, tk_, cc_); }
#pragma unroll 1
            for (int it = 0; it < wcnt; it += 2) {
                LB_ADDR(it, tkA, ccA); const int itb = it + 1; LB_ADDR(itb, tkB, ccB);
                LB_LOAD(hB, pB, gB, tkB, ccB); __builtin_amdgcn_sched_barrier(0);
                LB_BODY(hA, pA, gA, tkA, ccA);
                if (it + 2 < wcnt) { const int itc = it + 2; LB_ADDR(itc, tkC, ccC); LB_LOAD(hA, pA, gA, tkC, ccC); } __builtin_amdgcn_sched_barrier(0);
                LB_BODY(hB, pB, gB, tkB, ccB);
            }
        }
#undef LB_ADDR
#undef LB_LOAD
#undef LB_BODY
        __syncthreads();
    }
}

__device__ __forceinline__ void phase_vreduce(const Ctx& c) {
    const bf16_t* PT = c.PT(); bf16_t* VT = c.VT();
    for (int item = obid() * 512 + otid(); item < 64 * 256 * 32; item += gridDim.x * 512) {
        const int ro = item & 31, col = (item >> 5) & 255, u = item >> 13;
        const bf16_t* p = PT + (size_t)(u * 4) * 65536 + col * 256 + ro * 8;
        float a[8] = {0, 0, 0, 0, 0, 0, 0, 0};
#pragma unroll
        for (int kq = 0; kq < 4; ++kq) { const u32x4 w = *(const u32x4*)(p + (size_t)kq * 65536);
            a[0] += bflo(w.x); a[1] += bfhi(w.x); a[2] += bflo(w.y); a[3] += bfhi(w.y); a[4] += bflo(w.z); a[5] += bfhi(w.z); a[6] += bflo(w.w); a[7] += bfhi(w.w); }
        const int b = u >> 4, s0 = (u & 15) * 256 + ro * 8, h = 4 + (col >> 7), d = col & 127;
        u32x4 o; o.x = cvt_pk_bf16(a[0], a[1]); o.y = cvt_pk_bf16(a[2], a[3]); o.z = cvt_pk_bf16(a[4], a[5]); o.w = cvt_pk_bf16(a[6], a[7]);
        *(u32x4*)(VT + ((size_t)(b * NHS + h) * HD + d) * VTS + s0) = o;
    }
}

__device__ __forceinline__ void phase_attn(const Ctx& c, int l, unsigned char* ldsb) {
    const int lane = otid() & 63, wv = otid() >> 6, hh = lane >> 5, l31 = lane & 31;
    const bf16_t* PROJ = c.PROJ(); const bf16_t* VT = c.VT();
    const int prow = (l31 & ~12) | ((l31 & 4) << 1) | ((l31 & 8) >> 1);
    unsigned char* wl = ldsb + wv * 16384;
    const int kwbase = (lane >> 4) * 256 + (((lane & 15) ^ (lane >> 4)) * 16);
    const int vwoff = (lane >> 2) * 64 + (((lane & 3) ^ (lane >> 4)) * 16);
    const int kroff = prow * 256;
    const int nwt = NB * NHS * (SEQ / 32);
    const int nper = (nwt + (int)gridDim.x - 1) / (int)gridDim.x, wt0 = obid() * nper, wt1 = (wt0 + nper < nwt) ? wt0 + nper : nwt;
    for (int wt = wt0 + wv; wt < wt1; wt += 8) {
        const int qt = wt % (SEQ / 32), bh = wt / (SEQ / 32), b = bh / NHS, h = bh % NHS, q0 = qt * 32;
        const bf16_t* qp = PROJ + (size_t)(b * SEQ + q0 + l31) * DPROJ + C_Q + h * HD + 8 * hh;
        bf16x8 bq[8];
#pragma unroll
        for (int s = 0; s < 8; ++s) bq[s] = *(const bf16x8*)(qp + 16 * s);
        {
            float qs = 0.f;
#pragma unroll
            for (int s = 0; s < 8; ++s) { const u32x4 w = __builtin_bit_cast(u32x4, bq[s]);
                qs += bflo(w.x) * bflo(w.x) + bfhi(w.x) * bfhi(w.x) + bflo(w.y) * bflo(w.y) + bfhi(w.y) * bfhi(w.y) + bflo(w.z) * bflo(w.z) + bfhi(w.z) * bfhi(w.z) + bflo(w.w) * bflo(w.w) + bfhi(w.w) * bfhi(w.w); }
            qs += __shfl_xor(qs, 32);
            const float sc = rsqrtf(qs * (1.0f / HD) + EPS) * (1.4426950408889634f * 0.08838834764831845f);
#pragma unroll
            for (int s = 0; s < 8; ++s) { const u32x4 w = __builtin_bit_cast(u32x4, bq[s]); u32x4 o;
                o.x = cvt_pk_bf16(bflo(w.x) * sc, bfhi(w.x) * sc); o.y = cvt_pk_bf16(bflo(w.y) * sc, bfhi(w.y) * sc); o.z = cvt_pk_bf16(bflo(w.z) * sc, bfhi(w.z) * sc); o.w = cvt_pk_bf16(bflo(w.w) * sc, bfhi(w.w) * sc);
                bq[s] = __builtin_bit_cast(bf16x8, o); }
        }
        f32x16 O[4];
#pragma unroll
        for (int m = 0; m < 4; ++m)
#pragma unroll
            for (int r = 0; r < 16; ++r) O[m][r] = 0.f;
        float carry = 0.f;
        const bf16_t* kgl = PROJ + (size_t)(b * SEQ + (lane >> 4)) * DPROJ + C_K + h * HD + (lane & 15) * 8;
        const bf16_t* vgl = VT + ((size_t)bh * HD + (lane >> 2)) * VTS + (lane & 3) * 8;
        u32x4 stK[8], stV[8];
#define ATT_LOAD(kk0) do { _Pragma("unroll") for (int j = 0; j < 8; ++j) { \
            stK[j] = *(const u32x4*)(kgl + (size_t)((kk0) + 4 * j) * DPROJ); stV[j] = *(const u32x4*)(vgl + (size_t)(16 * j) * VTS + (kk0)); } } while (0)
        ATT_LOAD(q0);
        for (int k0 = q0; k0 >= 0; k0 -= 32) {
#pragma unroll
            for (int j = 0; j < 8; ++j) { *(u32x4*)(wl + j * 1024 + (kwbase ^ (64 * (j & 3)))) = stK[j]; *(u32x4*)(wl + 8192 + vwoff + j * 1024) = stV[j]; }
            const int kn = k0 >= 32 ? k0 - 32 : k0;
            ATT_LOAD(kn);
            __builtin_amdgcn_sched_barrier(0);
            f32x16 S;
#pragma unroll
            for (int r = 0; r < 16; ++r) S[r] = 0.f;
#pragma unroll
            for (int s = 0; s < 8; ++s) { const bf16x8 ak = *(const bf16x8*)(wl + kroff + (((2 * s + hh) ^ (prow & 15)) * 16)); S = MFMA32(ak, bq[s], S); }
            const bool diag = (k0 == q0);
            float sp[16];
            float R0 = 0.f, R1 = 0.f;
#pragma unroll
            for (int r = 0; r < 16; ++r) {
                const int kk = 16 * (r >> 3) + 8 * hh + (r & 7);
                const float z = S[r];
                float v = fmaxf(z, 0.f) + __builtin_amdgcn_logf(1.0f + __builtin_amdgcn_exp2f(-fabsf(z)));
                if (diag && kk >= l31) v = 0.f;
                sp[r] = v;
                if (r < 8) R0 += v; else R1 += v;
            }
            const float R0p = __shfl_xor(R0, 32), R1p = __shfl_xor(R1, 32);
            float suf_hi = carry - (hh == 0 ? R1p : 0.f);
            float suf_lo = carry - R1 - R1p - (hh == 0 ? R0p : 0.f);
            float w[16];
#pragma unroll
            for (int r = 15; r >= 8; --r) { w[r] = __builtin_amdgcn_exp2f(S[r] - sp[r] + suf_hi); suf_hi -= sp[r]; }
#pragma unroll
            for (int r = 7; r >= 0; --r) { w[r] = __builtin_amdgcn_exp2f(S[r] - sp[r] + suf_lo); suf_lo -= sp[r]; }
            if (diag) {
#pragma unroll
                for (int r = 0; r < 16; ++r) { const int kk = 16 * (r >> 3) + 8 * hh + (r & 7); if (kk >= l31) w[r] = 0.f; }
            }
            carry -= (R0 + R1 + R0p + R1p);
            bf16x8 wb[2];
            __builtin_amdgcn_sched_barrier(0);
#pragma unroll
            for (int s = 0; s < 2; ++s) { u32x4 pk; pk.x = cvt_pk_bf16(w[8 * s + 0], w[8 * s + 1]); pk.y = cvt_pk_bf16(w[8 * s + 2], w[8 * s + 3]); pk.z = cvt_pk_bf16(w[8 * s + 4], w[8 * s + 5]); pk.w = cvt_pk_bf16(w[8 * s + 6], w[8 * s + 7]);
                wb[s] = __builtin_bit_cast(bf16x8, pk); }
#pragma unroll
            for (int m = 0; m < 4; ++m)
#pragma unroll
                for (int s = 0; s < 2; ++s) { const bf16x8 vtf = *(const bf16x8*)(wl + 8192 + (32 * m + l31) * 64 + (((2 * s + hh) ^ (((32 * m + l31) >> 2) & 3)) * 16)); O[m] = MFMA32(vtf, wb[s], O[m]); }
            if (!__any(carry >= -150.1f)) break;
        }
        float ss = 0.f;
#pragma unroll
        for (int m = 0; m < 4; ++m)
#pragma unroll
            for (int r = 0; r < 16; ++r) ss += O[m][r] * O[m][r];
        ss += __shfl_xor(ss, 32);
        const float rstd = rsqrtf(ss * (1.0f / HD) + EPS);
        const float* mg = c.in[13] + (size_t)l * DM + DLRU + DCONV + h * HD + 4 * hh;
        bf16_t* yp = c.YMIX() + (size_t)(b * SEQ + q0 + l31) * DM + DLRU + DCONV + h * HD + 8 * hh;
#pragma unroll
        for (int m = 0; m < 4; ++m)
#pragma unroll
            for (int gp = 0; gp < 2; ++gp) { u32x2 o[2];
#pragma unroll
                for (int gg_ = 0; gg_ < 2; ++gg_) { const int g = 2 * gp + gg_; const f32x4 gg = *(const f32x4*)(mg + 32 * m + 8 * g);
                    o[gg_].x = cvt_pk_bf16(O[m][4 * g] * rstd * gg[0], O[m][4 * g + 1] * rstd * gg[1]); o[gg_].y = cvt_pk_bf16(O[m][4 * g + 2] * rstd * gg[2], O[m][4 * g + 3] * rstd * gg[3]); }
                const auto sx = __builtin_amdgcn_permlane32_swap(o[0].x, o[1].x, false, false); const auto sy = __builtin_amdgcn_permlane32_swap(o[0].y, o[1].y, false, false);
                *(u32x4*)(yp + 32 * m + 16 * gp) = (u32x4){sx[0], sy[0], sx[1], sy[1]};
            }
    }
}

#define XB_TMO      128
#define XB_XCNT(j)  (256  + 64 * (j))
#define XB_XSUB(j)  (1280 + 64 * (j))
#define XB_XGEN(j)  (2304 + 64 * (j))
#define XB_TOP      3328
#define XB_TOPGEN   3392
#define XCD_BAR_WORDS 3456
#define XB_SPIN_CAP (1u << 18)
__device__ __forceinline__ unsigned xb_ld(unsigned* p)              { return __hip_atomic_load(p, __ATOMIC_RELAXED, __HIP_MEMORY_SCOPE_AGENT); }
__device__ __forceinline__ unsigned xb_add(unsigned* p, unsigned v) { return __hip_atomic_fetch_add(p, v, __ATOMIC_RELAXED, __HIP_MEMORY_SCOPE_AGENT); }
__device__ __forceinline__ unsigned xb_xcc_id() { return (unsigned)__builtin_amdgcn_s_getreg((3 << 11) | 20) & 0xFu; }
#define XB_SPIN(cond, bar) do { unsigned _sp = 0; while (cond) { __builtin_amdgcn_s_sleep(1); \
    if ((++_sp & 255u) == 0u) { if (xb_ld(&(bar)[XB_TMO])) break; if (_sp > XB_SPIN_CAP) { atomicAdd(&(bar)[XB_TMO], 1u); break; } } } } while (0)
struct XcdBarrier { unsigned* bar; unsigned x; volatile LAS unsigned* st; };
__device__ __forceinline__ XcdBarrier xcd_barrier_post(unsigned* bar, volatile LAS unsigned* st) {
    XcdBarrier b; b.bar = bar; b.x = xb_xcc_id(); b.st = st;
    if (threadIdx.x == 0) (void)xb_add(&bar[XB_XCNT(b.x)], 1u);
    return b;
}
__device__ __forceinline__ void xcd_barrier_complete(unsigned* bar, unsigned x, unsigned& nloc, unsigned& nx) {
    const unsigned G = gridDim.x * gridDim.y * gridDim.z;
    unsigned sum, cnt, mine, sp = 0u;
    for (;;) {
        sum = 0u; cnt = 0u; mine = 0u;
#pragma unroll
        for (unsigned j = 0; j < 16; ++j) { const unsigned c = xb_ld(&bar[XB_XCNT(j)]); sum += c; cnt += (c > 0u) ? 1u : 0u; mine = (j == x) ? c : mine; }
        if (sum == G) break;
        __builtin_amdgcn_s_sleep(1);
        if ((++sp & 255u) == 0u) { if (xb_ld(&bar[XB_TMO])) break; if (sp > XB_SPIN_CAP) { atomicAdd(&bar[XB_TMO], 1u); break; } }
    }
    nloc = mine > 0u ? mine : 1u; nx = cnt > 0u ? cnt : 1u;
}
__device__ __forceinline__ void xcd_barrier(const XcdBarrier& b) {
    asm volatile("s_waitcnt vmcnt(0)" ::: "memory");
    __syncthreads();
    if (threadIdx.x == 0) {
        unsigned* bar = b.bar;
        __builtin_amdgcn_s_waitcnt(0);
        unsigned nloc = b.st[0], nx = b.st[1];
        if (nloc == 0u) { xcd_barrier_complete(bar, b.x, nloc, nx); b.st[0] = nloc; b.st[1] = nx; }
        const unsigned old = xb_add(&bar[XB_XSUB(b.x)], 1u);
        const unsigned gen = old / nloc;
        if (old + 1u == (gen + 1u) * nloc) {
            __builtin_amdgcn_fence(__ATOMIC_RELEASE, "agent");
            asm volatile("s_waitcnt vmcnt(0)" ::: "memory");
            const unsigned og = xb_add(&bar[XB_TOP], 1u);
            const unsigned tg = og / nx;
            if (og + 1u == (tg + 1u) * nx) xb_add(&bar[XB_TOPGEN], 1u);
            else XB_SPIN(xb_ld(&bar[XB_TOPGEN]) == tg, bar);
            __builtin_amdgcn_fence(__ATOMIC_ACQUIRE, "agent");
            xb_add(&bar[XB_XGEN(b.x)], 1u);
            asm volatile("s_waitcnt vmcnt(0)" ::: "memory");
        } else {
            XB_SPIN(xb_ld(&bar[XB_XGEN(b.x)]) == gen, bar);
            __builtin_amdgcn_fence(__ATOMIC_ACQUIRE, "agent");
            asm volatile("s_waitcnt vmcnt(0)" ::: "memory");
        }
    }
    __syncthreads();
}

constexpr int NPH_LAYER = 7, NPH = 1 + DEPTH * NPH_LAYER;
constexpr int LDS_TAB = g8::STAGE_BYTES, LDS_BARW = g8::STAGE_BYTES + 2048, LDS_KX = g8::STAGE_BYTES + 4096, LDS_BYTES = g8::STAGE_BYTES + 4096 + 8192;
__global__ void __launch_bounds__(512, 2) mega(Params p) {
    extern __shared__ __attribute__((aligned(16))) unsigned char lds_raw[];
    float* lds = (float*)lds_raw;
    LAS unsigned char* ldsl = (LAS unsigned char*)lds_raw;
    MoeTab* mt = (MoeTab*)(lds_raw + LDS_TAB);
    Ctx c0; c0.in.p = p.in; c0.in.z = 0; c0.out = p.out; c0.ws = p.ws;
    const int lo = p.ph_lo, hi = p.ph_hi;
    if (threadIdx.x == 0) *(uint4*)(lds_raw + LDS_BARW) = make_uint4(0u, 0u, 0u, 0u);
    __syncthreads();
    XcdBarrier bar = xcd_barrier_post(c0.ctl(), (volatile LAS unsigned*)(ldsl + LDS_BARW));
#ifndef PH_MASK
#define PH_MASK 0x1ff
#endif
#define PHT(k) ((k) == 0 ? 0 : 1 + ((k) - 1) % NPH_LAYER)
#define IN(k) (((PH_MASK >> PHT(k)) & 1) && lo <= (k) && (k) < hi)
#define SEAM(k) do { if (IN(k) && IN((k) + 1)) xcd_barrier(bar); } while (0)
#ifndef PROBE_RSH
#define PROBE_RSH 0
#endif
#ifndef PROBE_DUP
#define PROBE_DUP 0x0
#endif
#define REP(k) for (int rep_ = 0; rep_ < (((PROBE_DUP >> PHT(k)) & 1) ? 2 : 1); ++rep_)
    REP(0) if (IN(0)) { if (rep_) xcd_barrier(bar); const Ctx c = octx(c0); phase_convert(c, lds); phase_norm_in(c, 0); }
    SEAM(0);
#define LAYER_BODY(l) { \
        const int pb = 1 + l * NPH_LAYER; \
        REP(pb + 0) if (IN(pb + 0)) { if (rep_) xcd_barrier(bar); const Ctx c = octx(c0); const bool split_ = (gridDim.x == 256); \
            constexpr bool f8_ = f8in(l); constexpr int ku_ = f8_ ? DM / 2 : DM, ld_ = pb_in(l) / 2;        \
            { g8::DenseOrder S; S.init(T, DIN, gridDim.x, obid(), c.WIN(l), ld_); if (split_) S.lim = 1280; g8::MEpiProjT<f8_> E{c.PROJ(), c.VT(), (LAS float*)(ldsl + LDS_KX), c.in[11] + l * HD, c.in[12] + l * HD}; g8::gemm_mfma(ldsl, c.HB(), ld_, ld_, ku_, S, E); } \
            if (split_) { const int cb_ = obid(), kq_ = cb_ & 3; int k4_ = ku_ / 4; asm volatile("" : "+s"(k4_)); g8::SplitKOrder S{cb_, (const char*)(c.WIN(l) + (size_t)(20 * 256) * ld_ + kq_ * (ku_ / 4))}; g8::MEpiPartT<f8_> E{c.PT(), (LAS float*)(ldsl + LDS_KX)}; g8::gemm_mfma(ldsl, c.HB() + kq_ * (ku_ / 4), ld_, ld_, k4_, S, E); } } \
        SEAM(pb + 0); \
        REP(pb + 1) if (IN(pb + 1)) { if (rep_) xcd_barrier(bar); const Ctx c = octx(c0); if (gridDim.x == 256) phase_vreduce(c); phase_convb(c, l); if (PROBE_SUB == 4) phase_convb(c, l); phase_lruA(c, l, lds_raw); if (PROBE_SUB == 3) phase_lruA(c, l, lds_raw); } \
        SEAM(pb + 1); \
        REP(pb + 2) if (IN(pb + 2)) { if (rep_) xcd_barrier(bar); const Ctx c = octx(c0); phase_lruB(c, l, lds_raw); if (PROBE_SUB == 2) phase_lruB(c, l, lds_raw); phase_attn(c, l, lds_raw); if (PROBE_SUB == 1) phase_attn(c, l, lds_raw); } \
        SEAM(pb + 2); \
        REP(pb + 3) if (IN(pb + 3)) { if (rep_) xcd_barrier(bar); const Ctx c = octx(c0); g8::DenseOrder S; S.init(T, DM, gridDim.x, obid(), c.WOUT(l), DM); if (PROBE_RSH == 3 && l == 0) S.rsh = 1; g8::MEpiOut<l == 0> E{c.in[0], c.XB(), c.X1(), c.X1F8()}; g8::gemm_mfma(ldsl, c.YMIX(), DM, DM, DM, S, E);       } \
        SEAM(pb + 3); \
        REP(pb + 4) if (IN(pb + 4)) { if (rep_) xcd_barrier(bar); const Ctx c = octx(c0); phase_router_mfma(c, l, lds); } \
        SEAM(pb + 4); \
        REP(pb + 5) if (IN(pb + 5)) { if (rep_) xcd_barrier(bar); const Ctx c = octx(c0); build_moe_tab(c, l, mt); \
            const int G_ = (int)gridDim.x, cb_ = obid(), n1_ = __builtin_amdgcn_readfirstlane(mt->tstart[NEXP]) * 4, R_ = n1_ % G_, n1e_ = n1_ - R_, rtA_ = n1e_ >> 2; \
            { g8::MoeOrder<true, 4, DM / 2, (size_t)1024 * DM, (size_t)256 * DM> S{mt, c.LIST(), G_, cb_, (const char*)c.WGU(l)}; g8::MEpiGU E{c.HID8(), c.LISTR(), mt, c.RTC(l), n1e_}; g8::gemm_mfma(ldsl, (const bf16_t*)c.X1F8(), DM / 2, DM / 2, DM / 2, S, E); }       \
            g8::moe_wait_dep(c.RTC(l), cb_, G_, R_, rtA_); \
            { g8::MoeOrder2 S{mt, G_, cb_, R_, rtA_, (const char*)c.WD(l)}; if (PROBE_RSH == 6) S.rsh = 1; g8::MEpiDown8 E{c.YPAD8()}; int k2_ = DEXP / 2; asm volatile("" : "+s"(k2_)); g8::gemm_mfma(ldsl, (const bf16_t*)c.HID8(), DEXP / 2, DEXP / 2, k2_, S, E); } }       \
        SEAM(pb + 5); \
        REP(pb + 6) if (IN(pb + 6)) { if (rep_) xcd_barrier(bar); const Ctx c = octx(c0); build_moe_tab(c, l, mt); if (PROBE_SUB == 6) { phase_combine<true>(c, l, mt); xcd_barrier(bar); } phase_combine<false>(c, l, mt); } \
        SEAM(pb + 6); \
    }
    LAYER_BODY(0)
    LAYER_BODY(1)
#undef LAYER_BODY
#undef IN
#undef SEAM
}

#ifndef N_LAUNCH_SPLIT
#define N_LAUNCH_SPLIT 0
#endif
extern "C" void kernel_launch(void* const* d_in, const int* in_sizes, int n_in, void* d_out, int out_size, void* d_ws, size_t ws_size, hipStream_t stream) {
    static int grid = 0;
    if (grid == 0) {
        if (n_in != 23 || out_size != T * DM || ws_size < WS_END) { fprintf(stderr, "kernel_launch: unexpected problem (n_in %d out %d ws %zu need %zu)\n", n_in, out_size, ws_size, (size_t)WS_END); grid = -1; return; }
        int dev = 0, cus = 0, per_cu = 0;
        if (hipGetDevice(&dev) != hipSuccess || hipDeviceGetAttribute(&cus, hipDeviceAttributeMultiprocessorCount, dev) != hipSuccess) { fprintf(stderr, "kernel_launch: device query failed\n"); grid = -1; return; }
        if (hipFuncSetAttribute((const void*)mega, hipFuncAttributeMaxDynamicSharedMemorySize, LDS_BYTES) != hipSuccess) { fprintf(stderr, "kernel_launch: hipFuncSetAttribute failed\n"); grid = -1; return; }
        if (hipOccupancyMaxActiveBlocksPerMultiprocessor(&per_cu, (const void*)mega, 512, LDS_BYTES) != hipSuccess || per_cu < 1) { fprintf(stderr, "kernel_launch: occupancy query says %d blocks per CU\n", per_cu); }
        (void)hipGetLastError();
        grid = cus;
    }
    if (grid < 0) return;
    (void)hipMemsetAsync((char*)d_ws + OFF_CTL, 0, SZ_CTL, stream);
    Params p{};
    for (int i = 0; i < 23; ++i) p.in[i] = (const float*)d_in[i];
    p.out = (float*)d_out; p.ws = (unsigned char*)d_ws;
    if (N_LAUNCH_SPLIT) { for (int ph = 0; ph < NPH; ++ph) { p.ph_lo = ph; p.ph_hi = ph + 1; hipLaunchKernelGGL(mega, dim3(grid), dim3(512), LDS_BYTES, stream, p); } }
    else { p.ph_lo = 0; p.ph_hi = NPH; hipLaunchKernelGGL(mega, dim3(grid), dim3(512), LDS_BYTES, stream, p); }
}
```

```cpp
#include <hip/hip_runtime.h>
#include <stdint.h>
#include <stdio.h>

typedef unsigned short bf16_t;
typedef float f32x4 __attribute__((ext_vector_type(4)));
typedef unsigned u32x4 __attribute__((ext_vector_type(4)));
typedef unsigned u32x2 __attribute__((ext_vector_type(2)));
typedef short bf16x8 __attribute__((ext_vector_type(8)));

constexpr int T = 16384, DM = 2048, DIN = 5376, DPROJ = 4608, SEQ = 4096, NB = 4, DEPTH = 2;
constexpr int DLRU = 768, DCONV = 512, DSB = 768, HD = 128, NHL = 6, NHS = 6;
constexpr int NEXP = 32, DEXP = 512, MAXTILES = 160, PADROWS = MAXTILES * 256;
constexpr float EPS = 1e-6f;
constexpr float YSCALE_G = 8.0f;
constexpr float SX8 = 8.0f, SW1 = 64.0f, SH8 = 8.0f, SW2 = 32.0f;
#ifndef F8_INPROJ_MASK
#define F8_INPROJ_MASK 2
#endif
constexpr bool f8in(int l) { return ((F8_INPROJ_MASK >> l) & 1) != 0; }
constexpr float SHB = 16.0f, SWI = 64.0f;
#ifndef PITCH_PAD
#define PITCH_PAD 128
#endif
constexpr int pb_in(int l) { return (f8in(l) ? DM : DM * 2) + PITCH_PAD; }
constexpr int VTS = SEQ + 64;
constexpr int C_XA = 0, C_GA = 768, C_BG = 1536, C_CG = 2048, C_XB = 2560, C_Q = 3072, C_K = 3840, C_V = 4608;

constexpr size_t AL(size_t x) { return (x + 255) & ~(size_t)255; }
constexpr size_t SZ_WIN = (size_t)DIN * (DM * 2 + 256), SZ_WOUT = (size_t)DM * DM * 2, SZ_WGU = (size_t)NEXP * 1024 * DM * 2, SZ_WD = (size_t)NEXP * DM * DEXP * 2;
constexpr size_t SZ_WA = (size_t)NHL * HD * HD * 2, SZ_WR = (size_t)48 * DM * 4;
constexpr size_t OFF_CTL = 0, SZ_CTL = 131072;
constexpr size_t OFF_WIN = OFF_CTL + SZ_CTL;
constexpr size_t OFF_WOUT = OFF_WIN + DEPTH * SZ_WIN;
constexpr size_t OFF_WGU = OFF_WOUT + DEPTH * SZ_WOUT;
constexpr size_t OFF_WD = OFF_WGU + DEPTH * SZ_WGU;
constexpr size_t OFF_WA = OFF_WD + DEPTH * SZ_WD;
constexpr size_t OFF_WX = OFF_WA + DEPTH * SZ_WA;
constexpr size_t OFF_WR = OFF_WX + DEPTH * SZ_WA;
constexpr size_t OFF_HB = OFF_WR + DEPTH * SZ_WR;
constexpr size_t OFF_PROJ = OFF_HB + (size_t)T * (DM * 2 + 256);
constexpr size_t OFF_VT = OFF_PROJ + (size_t)T * DPROJ * 2;
constexpr size_t OFF_YPAD = OFF_PROJ;
constexpr size_t OFF_YMIX = OFF_VT + (size_t)NB * NHS * HD * VTS * 2;
constexpr size_t OFF_X = OFF_YMIX + (size_t)T * DM * 2;
constexpr size_t OFF_HID = OFF_X + (size_t)T * DM * 4;
constexpr size_t OFF_AGG = OFF_HID + (size_t)PADROWS * DEXP * 2;
constexpr size_t OFF_ROUTE = OFF_AGG + (size_t)256 * DLRU * 8;
constexpr size_t OFF_LIST = OFF_ROUTE + (size_t)T * 8 * 4;
constexpr size_t OFF_LISTR = OFF_LIST + (size_t)NEXP * T * 4;
constexpr size_t OFF_DB = OFF_LISTR + (size_t)NEXP * T * 4;
constexpr size_t WS_END = OFF_DB + (size_t)T * DM * 2;
static_assert((size_t)PADROWS * DM * 2 <= (size_t)T * DPROJ * 2 + (size_t)NB * NHS * HD * VTS * 2, "YPAD alias");
constexpr int CW_RT = 16384;
constexpr int CW_CNT = 8192;

typedef __bf16 bf16v2_t __attribute__((ext_vector_type(2)));
typedef float f32v2_t __attribute__((ext_vector_type(2)));
__device__ __forceinline__ unsigned cvt_pk_bf16(float lo, float hi) { const f32v2_t f = {lo, hi}; const bf16v2_t b = __builtin_convertvector(f, bf16v2_t); return __builtin_bit_cast(unsigned, b); }
__device__ __forceinline__ bf16_t f2bf(float f) { return (bf16_t)(cvt_pk_bf16(f, 0.f) & 0xffffu); }
__device__ __forceinline__ float bf2f(bf16_t b) { return __uint_as_float(((unsigned)b) << 16); }
__device__ __forceinline__ float bflo(unsigned w) { return __uint_as_float(w << 16); }
__device__ __forceinline__ float bfhi(unsigned w) { return __uint_as_float(w & 0xffff0000u); }
__device__ __forceinline__ float sat8(float v) { return __builtin_amdgcn_fmed3f(v, -448.0f, 448.0f); }
__device__ __forceinline__ float wave_sum(float v) {
#pragma unroll
    for (int o = 32; o >= 1; o >>= 1) v += __shfl_xor(v, o);
    return v;
}
__device__ __forceinline__ float fast_exp(float x) { return __builtin_amdgcn_exp2f(x * 1.4426950408889634f); }
__device__ __forceinline__ float sigmoidf_(float x) { return __builtin_amdgcn_rcpf(1.0f + fast_exp(-x)); }
__device__ __forceinline__ float one_minus_exp(float x) { const float s = -x * (1.0f + x * (0.5f + x * 0.16666667f)); const float d = 1.0f - fast_exp(x); return x > -0.02f ? s : d; }
__device__ __forceinline__ float softplusf_(float x) { return fmaxf(x, 0.f) + log1pf(__expf(-fabsf(x))); }
__device__ __forceinline__ float gelu_tanh(float x) { const float u2 = 1.5957691216057308f * (x + 0.044715f * x * x * x); return x * sigmoidf_(u2); }

__device__ __forceinline__ int otid() { int t = (int)threadIdx.x; asm volatile("" : "+v"(t)); return t; }
__device__ __forceinline__ int obid() { int b = (int)blockIdx.x; asm volatile("" : "+s"(b)); return b; }
#ifndef PROBE_SUB
#define PROBE_SUB 0
#endif
struct Params { const float* in[23]; float* out; unsigned char* ws; int ph_lo, ph_hi; };

struct InProxy { const float* const* p; int z; __device__ __forceinline__ const float* operator[](int k) const { return p[k + z]; } };
struct Ctx {
    InProxy in; float* out; unsigned char* ws;
    __device__ __forceinline__ unsigned* ctl() const { return (unsigned*)(ws + OFF_CTL); }
    __device__ __forceinline__ bf16_t* WIN(int l) const { return (bf16_t*)(ws + OFF_WIN + l * SZ_WIN); }
    __device__ __forceinline__ bf16_t* WOUT(int l) const { return (bf16_t*)(ws + OFF_WOUT + l * SZ_WOUT); }
    __device__ __forceinline__ bf16_t* WGU(int l) const { return (bf16_t*)(ws + OFF_WGU + l * SZ_WGU); }
    __device__ __forceinline__ bf16_t* WD(int l) const { return (bf16_t*)(ws + OFF_WD + l * SZ_WD); }
    __device__ __forceinline__ bf16_t* WA(int l) const { return (bf16_t*)(ws + OFF_WA + l * SZ_WA); }
    __device__ __forceinline__ bf16_t* WX(int l) const { return (bf16_t*)(ws + OFF_WX + l * SZ_WA); }
    __device__ __forceinline__ float* WR(int l) const { return (float*)(ws + OFF_WR + l * SZ_WR); }
    __device__ __forceinline__ unsigned* RTC(int l) const { return ctl() + CW_RT + l * 8192; }
    __device__ __forceinline__ unsigned* CNT(int l) const { return ctl() + CW_CNT + l * 2048; }
#define WSP(name, type, off) __device__ __forceinline__ type* name() const { return (type*)(ws + (off)); }
    WSP(HB, bf16_t, OFF_HB) WSP(PROJ, bf16_t, OFF_PROJ) WSP(VT, bf16_t, OFF_VT) WSP(YPAD, bf16_t, OFF_YPAD) WSP(YPAD8, unsigned char, OFF_YPAD) WSP(YMIX, bf16_t, OFF_YMIX) WSP(HID, bf16_t, OFF_HID)
    WSP(X, float, OFF_X) WSP(XB, bf16_t, OFF_X) WSP(AGG, float, OFF_AGG) WSP(ROUTE, unsigned, OFF_ROUTE) WSP(LIST, int, OFF_LIST) WSP(LISTR, float, OFF_LISTR) WSP(PT, bf16_t, OFF_X + (size_t)T * DM * 2) WSP(X1, bf16_t, OFF_X + (size_t)T * DM * 2) WSP(X1F8, unsigned char, OFF_HB) WSP(HID8, unsigned char, OFF_HID) WSP(DB, bf16_t, OFF_DB) WSP(HL, bf16_t, OFF_DB) WSP(PL, bf16_t, OFF_DB + (size_t)T * DLRU * 2)
#undef WSP
};

__device__ __forceinline__ Ctx octx(const Ctx& c) { int z = 0; asm volatile("" : "+s"(z)); Ctx r; r.in.p = c.in.p; r.in.z = z; r.out = c.out + z; r.ws = c.ws + z; return r; }

__device__ __forceinline__ void cvt_tile_out(const float* tile, int st, int r0, bf16_t* dst, int ld_dst, int drow0, bool f8) {
    const int rr = (st & 7) * 8;
    if (f8) {
#pragma unroll
        for (int p = 0; p < 2; ++p) {
            const int c = (st >> 3) + 32 * p; int w0 = 0, w1 = 0;
            w0 = __builtin_amdgcn_cvt_pk_fp8_f32(tile[(rr + 0) * 65 + c], tile[(rr + 1) * 65 + c], w0, false); w0 = __builtin_amdgcn_cvt_pk_fp8_f32(tile[(rr + 2) * 65 + c], tile[(rr + 3) * 65 + c], w0, true);
            w1 = __builtin_amdgcn_cvt_pk_fp8_f32(tile[(rr + 4) * 65 + c], tile[(rr + 5) * 65 + c], w1, false); w1 = __builtin_amdgcn_cvt_pk_fp8_f32(tile[(rr + 6) * 65 + c], tile[(rr + 7) * 65 + c], w1, true);
            *(u32x2*)((unsigned char*)dst + (size_t)(drow0 + c) * ld_dst + r0 + rr) = (u32x2){(unsigned)w0, (unsigned)w1};
        }
        return;
    }
#pragma unroll
    for (int p = 0; p < 2; ++p) {
        const int c = (st >> 3) + 32 * p;
        u32x4 w;
        w.x = cvt_pk_bf16(tile[(rr + 0) * 65 + c], tile[(rr + 1) * 65 + c]); w.y = cvt_pk_bf16(tile[(rr + 2) * 65 + c], tile[(rr + 3) * 65 + c]);
        w.z = cvt_pk_bf16(tile[(rr + 4) * 65 + c], tile[(rr + 5) * 65 + c]); w.w = cvt_pk_bf16(tile[(rr + 6) * 65 + c], tile[(rr + 7) * 65 + c]);
        *(u32x4*)(dst + (size_t)(drow0 + c) * ld_dst + r0 + rr) = w;
    }
}
constexpr int CV_WIN = 32 * 84, CV_WOUT = 32 * 32, CV_EXP = 32 * 8  , CV_G = NEXP * CV_EXP, CV_LRU = NHL * 4;
constexpr int CV_PER_LAYER = CV_WIN + CV_WOUT + 3 * CV_G + 2 * CV_LRU;
struct CvtTile { const float* src; bf16_t* dst; const float* gk; int ld_src, ld_dst, r0, c0, drow0; float sc; };
__device__ __forceinline__ void cvt_decode(const Ctx& c, int id, CvtTile& t) {
    const int l = id / CV_PER_LAYER; int j = id % CV_PER_LAYER; t.gk = nullptr; t.sc = 1.0f;
    if (j < CV_WIN) { t.src = c.in[2] + (size_t)l * DM * DIN; t.ld_src = DIN; { const int g = j >> 3, kp = g / 21, nq = g % 21; t.r0 = (2 * kp + ((j >> 2) & 1)) * 64; t.c0 = (4 * nq + (j & 3)) * 64; } t.dst = c.WIN(l); t.ld_dst = f8in(l) ? pb_in(l) : pb_in(l) / 2; t.drow0 = t.c0; if (f8in(l)) t.sc = -SWI; }
    else if ((j -= CV_WIN) < CV_WOUT) { t.src = c.in[14] + (size_t)l * DM * DM; t.ld_src = DM; { const int g = j >> 3, kp = g / 8, nq = g % 8; t.r0 = (2 * kp + ((j >> 2) & 1)) * 64; t.c0 = (4 * nq + (j & 3)) * 64; } t.dst = c.WOUT(l); t.ld_dst = DM; t.drow0 = t.c0; }
    else if ((j -= CV_WOUT) < 2 * CV_G) {
        const int isup = j / CV_G; j %= CV_G; const int e = j / CV_EXP; j %= CV_EXP;
        t.src = c.in[isup ? 21 : 20] + ((size_t)l * NEXP + e) * DM * DEXP; t.ld_src = DEXP; { const int g = j >> 3, kp = g / 2, nq = g % 2; t.r0 = (2 * kp + ((j >> 2) & 1)) * 64; t.c0 = (4 * nq + (j & 3)) * 64; }
        t.dst = (bf16_t*)((unsigned char*)c.WGU(l) + (size_t)e * 1024 * DM); t.ld_dst = DM; t.drow0 = 256 * (t.c0 / 128) + 128 * isup + (t.c0 % 128); t.gk = c.in[15] + (size_t)l * DM; t.sc = -SW1;
    } else if ((j -= 2 * CV_G) < CV_G) {
        const int e = j / CV_EXP; j %= CV_EXP;
        t.src = c.in[22] + ((size_t)l * NEXP + e) * DEXP * DM; t.ld_src = DM; { const int g = j >> 3, kp = g / 8, nq = g % 8; t.r0 = (2 * kp + ((j >> 2) & 1)) * 64; t.c0 = (4 * nq + (j & 3)) * 64; }
        t.dst = (bf16_t*)((unsigned char*)c.WD(l) + (size_t)e * DM * DEXP); t.ld_dst = DEXP; t.drow0 = t.c0; t.sc = -SW2;
    } else { j -= CV_G; const int isx = j / CV_LRU; j %= CV_LRU; const int h = j / 4; j %= 4;
        t.src = c.in[isx ? 7 : 5] + ((size_t)l * NHL + h) * HD * HD; t.ld_src = HD; t.r0 = (j / 2) * 64; t.c0 = (j % 2) * 64;
        t.dst = (isx ? c.WX(l) : c.WA(l)) + (size_t)h * HD * HD; t.ld_dst = HD; t.drow0 = t.c0; }
}
constexpr int CVT_NT = 4;
__device__ __forceinline__ void phase_convert(const Ctx& c, float* lds) {
    const int tid = otid(), sb = tid >> 8, st = tid & 255;
    float* tile0 = lds + sb * (CVT_NT * 64 * 65);
    const int total = DEPTH * CV_PER_LAYER;
    const int nsub = gridDim.x * 2 * CVT_NT;
    const int idb = (obid() * 2 + sb) * CVT_NT;
    CvtTile tA[CVT_NT]; f32x4 vA[CVT_NT][4];
#define CVT_LOAD(T_, V_, base_) do { _Pragma("unroll") for (int k = 0; k < CVT_NT; ++k) { const int id_ = (base_) + idb + k; cvt_decode(c, id_ < total ? id_ : 0, T_[k]); \
        _Pragma("unroll") for (int i = 0; i < 4; ++i) V_[k][i] = __builtin_nontemporal_load((const f32x4*)(T_[k].src + (size_t)(T_[k].r0 + (st >> 4) + 16 * i) * T_[k].ld_src + T_[k].c0 + (st & 15) * 4)); } } while (0)
#define CVT_FLUSH(T_, V_, base_) do { _Pragma("unroll") for (int k = 0; k < CVT_NT; ++k) _Pragma("unroll") for (int i = 0; i < 4; ++i) { \
            float* p = tile0 + k * (64 * 65) + ((st >> 4) + 16 * i) * 65 + (st & 15) * 4; const float gs_ = (T_[k].gk ? T_[k].gk[T_[k].r0 + (st >> 4) + 16 * i] : 1.0f) * fabsf(T_[k].sc); \
            p[0] = V_[k][i][0] * gs_; p[1] = V_[k][i][1] * gs_; p[2] = V_[k][i][2] * gs_; p[3] = V_[k][i][3] * gs_; } \
        __syncthreads(); \
        _Pragma("unroll") for (int k = 0; k < CVT_NT; ++k) if ((base_) + idb + k < total) cvt_tile_out(tile0 + k * (64 * 65), st, T_[k].r0, T_[k].dst, T_[k].ld_dst, T_[k].drow0, T_[k].sc < 0.f); \
        __syncthreads(); } while (0)
    for (int base = 0; base < total; base += nsub) { CVT_LOAD(tA, vA, base); CVT_FLUSH(tA, vA, base); }
#undef CVT_LOAD
#undef CVT_FLUSH
    for (int i = obid() * blockDim.x + tid; i < DEPTH * 48 * DM; i += gridDim.x * blockDim.x) {
        const int l = i / (48 * DM), n = (i / DM) % 48, k = i % DM;
        float v = 0.f;
        if (n < 4) v = c.in[16][((size_t)l * DM + k) * 4 + n]; else if (n < 36) v = c.in[18][((size_t)l * DM + k) * 32 + (n - 4)];
        const float wg = v * c.in[15][(size_t)l * DM + k]; const bf16_t hi = f2bf(wg);
        bf16_t* wr = (bf16_t*)c.WR(l); wr[(size_t)n * DM + k] = hi; wr[(size_t)(48 + n) * DM + k] = f2bf(wg - bf2f(hi));
    }
}

__device__ __forceinline__ void norm_store_row(const f32x4 (&v)[8], const float* g, bf16_t* dst, int lane) {
    float s = 0.f;
#pragma unroll
    for (int j = 0; j < 8; ++j) s += v[j][0] * v[j][0] + v[j][1] * v[j][1] + v[j][2] * v[j][2] + v[j][3] * v[j][3];
    s = wave_sum(s);
    const float rstd = rsqrtf(s * (1.0f / DM) + EPS);
#pragma unroll
    for (int j = 0; j < 8; ++j) {
        const f32x4 gg = *(const f32x4*)(g + j * 256 + lane * 4);
        u32x2 w; w.x = cvt_pk_bf16(v[j][0] * rstd * gg[0], v[j][1] * rstd * gg[1]); w.y = cvt_pk_bf16(v[j][2] * rstd * gg[2], v[j][3] * rstd * gg[3]);
        *(u32x2*)(dst + j * 256 + lane * 4) = w;
    }
}
__device__ __forceinline__ void norm_store_row8(const f32x4 (&v)[8], const float* g, unsigned char* dst, int lane) {
    float s = 0.f;
#pragma unroll
    for (int j = 0; j < 8; ++j) s += v[j][0] * v[j][0] + v[j][1] * v[j][1] + v[j][2] * v[j][2] + v[j][3] * v[j][3];
    s = wave_sum(s);
    const float rstd = rsqrtf(s * (1.0f / DM) + EPS) * SHB;
#pragma unroll
    for (int j = 0; j < 8; ++j) {
        const f32x4 gg = *(const f32x4*)(g + j * 256 + lane * 4);
        int w = 0; w = __builtin_amdgcn_cvt_pk_fp8_f32(sat8(v[j][0] * rstd * gg[0]), sat8(v[j][1] * rstd * gg[1]), w, false); w = __builtin_amdgcn_cvt_pk_fp8_f32(sat8(v[j][2] * rstd * gg[2]), sat8(v[j][3] * rstd * gg[3]), w, true);
        *(int*)(dst + j * 256 + lane * 4) = w;
    }
}
__device__ __forceinline__ void phase_norm_in(const Ctx& c, int l) {
    const int tid = otid(), lane = tid & 63, wv = tid >> 6, stride = gridDim.x * 8;
    for (int r = obid() * 8 + wv; r < T; r += 4 * stride) {
        f32x4 v[4][8];
#pragma unroll
        for (int k = 0; k < 4; ++k) { const int rr = (r + k * stride < T) ? r + k * stride : r;
#pragma unroll
            for (int j = 0; j < 8; ++j) v[k][j] = *(const f32x4*)(c.in[0] + (size_t)rr * DM + j * 256 + lane * 4); }
#pragma unroll
        for (int k = 0; k < 4; ++k) if (k == 0 || r + k * stride < T) norm_store_row(v[k], c.in[1] + (size_t)l * DM, (bf16_t*)((unsigned char*)c.HB() + (size_t)(r + k * stride) * pb_in(0)), lane);
    }
}

struct MoeTab { int cnt[NEXP]; int tstart[NEXP + 1]; int texp[MAXTILES]; };
__device__ __forceinline__ void build_moe_tab(const Ctx& c, int l, MoeTab* mt) {
    __syncthreads();
    const int tid = otid();
    if (tid < 64) {
        const int n = tid < NEXP ? (int)__hip_atomic_load(c.CNT(l) + tid * 64, __ATOMIC_RELAXED, __HIP_MEMORY_SCOPE_AGENT) : 0;
        const int nt = (n + 255) >> 8;
        int incl = nt;
#pragma unroll
        for (int o = 1; o < 32; o <<= 1) { const int v = __shfl_up(incl, o); if (tid >= o) incl += v; }
        const int excl = incl - nt;
        if (tid < NEXP) { mt->cnt[tid] = n; mt->tstart[tid] = excl; for (int i = 0; i < nt; ++i) if (excl + i < MAXTILES) mt->texp[excl + i] = tid; }
        if (tid == NEXP - 1) mt->tstart[NEXP] = incl < MAXTILES ? incl : MAXTILES;
    }
    __syncthreads();
}

template <bool DRY> __device__ __forceinline__ void phase_combine(const Ctx& c, int l, const MoeTab* mt) {
    const int tid = otid(), lane = tid & 63, wv = tid >> 6, stride = gridDim.x * 8;
    bf16_t* XB = c.XB(); const bf16_t* X1 = c.X1(); const unsigned char* YPAD = c.YPAD8(); const unsigned* ROUTE = c.ROUTE();
    for (int r = obid() * 8 + wv; r < T; r += 2 * stride) {
        f32x4 v[2][8]; unsigned ya[2][8], yb[2][8]; u32x2 yd[2][8]; float g0[2], g1[2]; int rr[2];
#pragma unroll
        for (int k = 0; k < 2; ++k) {
            rr[k] = (r + k * stride < T) ? r + k * stride : r;
            const u32x4 ra = *(const u32x4*)(ROUTE + (size_t)rr[k] * 8); const u32x2 rb = *(const u32x2*)(ROUTE + (size_t)rr[k] * 8 + 4);
            const int e0 = ra.x, p0 = ra.y, e1 = ra.w, p1 = rb.x; g0[k] = __uint_as_float(ra.z) * (1.0f / YSCALE_G); g1[k] = __uint_as_float(rb.y) * (1.0f / YSCALE_G);
            const unsigned char* y0 = YPAD + ((size_t)mt->tstart[e0] * 256 + p0) * DM + lane * 4; const unsigned char* y1 = YPAD + ((size_t)mt->tstart[e1] * 256 + p1) * DM + lane * 4;
            const bf16_t* dp = X1 + (size_t)rr[k] * DM + lane * 4;
#pragma unroll
            for (int j = 0; j < 8; ++j) { v[k][j] = (f32x4){0.f, 0.f, 0.f, 0.f};
                ya[k][j] = *(const unsigned*)(y0 + j * 256); yb[k][j] = *(const unsigned*)(y1 + j * 256); yd[k][j] = *(const u32x2*)(dp + j * 256); }
        }
        __builtin_amdgcn_sched_barrier(0);
#pragma unroll
        for (int k = 0; k < 2; ++k) {
            if (k == 0 || r + stride < T) {
#pragma unroll
                for (int j = 0; j < 8; ++j) {
                    typedef float f32x2_t __attribute__((ext_vector_type(2)));
                    const f32x2_t a01 = __builtin_amdgcn_cvt_pk_f32_fp8((int)ya[k][j], false), a23 = __builtin_amdgcn_cvt_pk_f32_fp8((int)ya[k][j], true);
                    const f32x2_t b01 = __builtin_amdgcn_cvt_pk_f32_fp8((int)yb[k][j], false), b23 = __builtin_amdgcn_cvt_pk_f32_fp8((int)yb[k][j], true);
                    v[k][j][0] += bflo(yd[k][j].x) + g0[k] * a01.x + g1[k] * b01.x; v[k][j][1] += bfhi(yd[k][j].x) + g0[k] * a01.y + g1[k] * b01.y;
                    v[k][j][2] += bflo(yd[k][j].y) + g0[k] * a23.x + g1[k] * b23.x; v[k][j][3] += bfhi(yd[k][j].y) + g0[k] * a23.y + g1[k] * b23.y;
                }
                if (l == DEPTH - 1) {
                    if (!DRY) {
#pragma unroll
                    for (int j = 0; j < 8; ++j) *(f32x4*)(c.out + (size_t)rr[k] * DM + j * 256 + lane * 4) = v[k][j]; }
                    else norm_store_row(v[k], c.in[1], c.HB() + (size_t)rr[k] * DM, lane);
                } else {
                    if (!DRY) {
#pragma unroll
                    for (int j = 0; j < 8; ++j) { u32x2 xw; xw.x = cvt_pk_bf16(v[k][j][0], v[k][j][1]); xw.y = cvt_pk_bf16(v[k][j][2], v[k][j][3]); *(u32x2*)(XB + (size_t)rr[k] * DM + j * 256 + lane * 4) = xw; } }
                    if (f8in(l + 1)) norm_store_row8(v[k], c.in[1] + (size_t)(l + 1) * DM, (unsigned char*)c.HB() + (size_t)rr[k] * pb_in(l + 1), lane);
                    else norm_store_row(v[k], c.in[1] + (size_t)(l + 1) * DM, (bf16_t*)((unsigned char*)c.HB() + (size_t)rr[k] * pb_in(l + 1)), lane);
                }
            }
        }
    }
}

__device__ __forceinline__ void phase_router_mfma(const Ctx& c, int l, float* lds) {
    float* LG = lds; float* SS = lds + 26624; float* RS = lds + 27136; int* LC = (int*)(lds + 27200); int* LB = (int*)(lds + 27232);
    const int tid = otid(), lane = tid & 63, wv = tid >> 6, rt = wv & 3, kh = wv >> 2, q = lane >> 4, l15 = lane & 15;
    const float* WR = c.WR(l);
    for (int tile = obid(); tile < T / 64; tile += gridDim.x) {
        const int r0 = tile * 64;
        f32x4 acc[4][3];
#pragma unroll
        for (int g = 0; g < 4; ++g)
#pragma unroll
            for (int ct = 0; ct < 3; ++ct) acc[g][ct] = (f32x4){0.f, 0.f, 0.f, 0.f};
        const bf16_t* xp = c.X1() + (size_t)(r0 + l15) * DM + wv * 256 + 8 * q;
        const bf16_t* wh = (const bf16_t*)WR + (size_t)l15 * DM + wv * 256 + 8 * q; const bf16_t* wl = wh + (size_t)48 * DM;
        float ssq[4] = {0.f, 0.f, 0.f, 0.f};
        bf16x8 xa[2][4], bh[2][3], bl[2][3];
#pragma unroll
        for (int st = 0; st < 2; ++st)
#pragma unroll
            for (int g = 0; g < 4; ++g) xa[st][g] = *(const bf16x8*)(xp + (size_t)(16 * g) * DM + 32 * st);
#pragma unroll
        for (int ct = 0; ct < 3; ++ct) { bh[0][ct] = *(const bf16x8*)(wh + (size_t)(16 * ct) * DM); bl[0][ct] = *(const bf16x8*)(wl + (size_t)(16 * ct) * DM); }
#define RT_STEP(st_, cur_, nxt_, ldb_, ldx_) do { \
            if (ldb_) { _Pragma("unroll") for (int ct = 0; ct < 3; ++ct) { bh[nxt_][ct] = *(const bf16x8*)(wh + (size_t)(16 * ct) * DM + 32 * ((st_) + 1)); bl[nxt_][ct] = *(const bf16x8*)(wl + (size_t)(16 * ct) * DM + 32 * ((st_) + 1)); } } \
            __builtin_amdgcn_sched_barrier(0); \
            _Pragma("unroll") for (int g = 0; g < 4; ++g) { \
                const bf16x8 xv = xa[cur_][g]; \
                _Pragma("unroll") for (int j = 0; j < 8; ++j) { const float xf = __uint_as_float(((unsigned)(unsigned short)xv[j]) << 16); ssq[g] += xf * xf; } \
                _Pragma("unroll") for (int ct = 0; ct < 3; ++ct) { acc[g][ct] = __builtin_amdgcn_mfma_f32_16x16x32_bf16(xv, bh[cur_][ct], acc[g][ct], 0, 0, 0); acc[g][ct] = __builtin_amdgcn_mfma_f32_16x16x32_bf16(xv, bl[cur_][ct], acc[g][ct], 0, 0, 0); } \
                if (ldx_) xa[cur_][g] = *(const bf16x8*)(xp + (size_t)(16 * g) * DM + 32 * ((st_) + 2)); } \
            __builtin_amdgcn_sched_barrier(0); } while (0)
#pragma unroll 1
        for (int sp = 0; sp < 4; ++sp) {
            RT_STEP(2 * sp, 0, 1, true, sp < 3);
            RT_STEP(2 * sp + 1, 1, 0, sp < 3, sp < 3);
        }
#undef RT_STEP
#pragma unroll
        for (int g = 0; g < 4; ++g) { float v = ssq[g]; v += __shfl_xor(v, 16); v += __shfl_xor(v, 32); if (q == 0) SS[wv * 64 + 16 * g + l15] = v; }
#pragma unroll
        for (int g = 0; g < 4; ++g)
#pragma unroll
            for (int ct = 0; ct < 3; ++ct)
#pragma unroll
                for (int i = 0; i < 4; ++i) LG[(wv * 64 + 16 * g + 4 * q + i) * 52 + 16 * ct + l15] = acc[g][ct][i];
        if (tid < NEXP) LC[tid] = 0;
        __syncthreads();
        int e0 = 0, e1 = 0, k0_ = 0, k1_ = 0; float rstd_ = 0.f, g0_ = 0.f, g1_ = 0.f;
        if (tid < 64) {
            float sst_ = 0.f;
#pragma unroll
            for (int w = 0; w < 8; ++w) sst_ += SS[w * 64 + tid];
            const float rstd = rsqrtf(sst_ * (1.0f / DM) + EPS);
            RS[tid] = rstd;
            float gl[4], el[8];
#pragma unroll
            for (int i = 0; i < 4; ++i) { float a_ = 0.f;
#pragma unroll
                for (int w = 0; w < 8; ++w) a_ += LG[(w * 64 + tid) * 52 + i];
                gl[i] = a_ * rstd + c.in[17][l * 4 + i]; }
            int gi = 0; float gm = gl[0];
#pragma unroll
            for (int i = 1; i < 4; ++i) if (gl[i] > gm) { gm = gl[i]; gi = i; }
            float gs = 0.f;
#pragma unroll
            for (int i = 0; i < 4; ++i) gs += __expf(gl[i] - gm);
            const float pg = 1.0f / gs;
#pragma unroll
            for (int i = 0; i < 8; ++i) { const int n = 4 + gi * 8 + i; float a_ = 0.f;
#pragma unroll
                for (int w = 0; w < 8; ++w) a_ += LG[(w * 64 + tid) * 52 + n];
                el[i] = a_ * rstd + c.in[19][l * 32 + gi * 8 + i]; }
            int i0 = 0; float m0 = el[0];
#pragma unroll
            for (int i = 1; i < 8; ++i) if (el[i] > m0) { m0 = el[i]; i0 = i; }
            int i1 = -1; float m1 = -3.0e38f;
#pragma unroll
            for (int i = 0; i < 8; ++i) if (i != i0 && el[i] > m1) { m1 = el[i]; i1 = i; }
            const float ex1 = __expf(m1 - m0), den = 1.0f + ex1;
            const float g0 = pg / den, g1 = pg * ex1 / den;
            e0 = gi * 8 + i0; e1 = gi * 8 + i1; rstd_ = rstd; g0_ = g0; g1_ = g1;
            k0_ = (int)__hip_atomic_fetch_add(&LC[e0], 1, __ATOMIC_RELAXED, __HIP_MEMORY_SCOPE_WORKGROUP);
            k1_ = (int)__hip_atomic_fetch_add(&LC[e1], 1, __ATOMIC_RELAXED, __HIP_MEMORY_SCOPE_WORKGROUP);
        }
        __syncthreads();
        if (tid < NEXP) { const int n = LC[tid]; LB[tid] = n > 0 ? (int)__hip_atomic_fetch_add(c.CNT(l) + tid * 64, (unsigned)n, __ATOMIC_RELAXED, __HIP_MEMORY_SCOPE_AGENT) : 0; }
        __syncthreads();
        if (tid < 64) {
            const int r = r0 + tid, p0 = LB[e0] + k0_, p1 = LB[e1] + k1_;
            c.LIST()[(size_t)e0 * T + p0] = r; c.LIST()[(size_t)e1 * T + p1] = r;
            c.LISTR()[(size_t)e0 * T + p0] = rstd_; c.LISTR()[(size_t)e1 * T + p1] = rstd_;
            unsigned* ro = c.ROUTE() + (size_t)r * 8;
            *(u32x4*)ro = (u32x4){(unsigned)e0, (unsigned)p0, __float_as_uint(g0_), (unsigned)e1};
            *(u32x2*)(ro + 4) = (u32x2){(unsigned)p1, __float_as_uint(g1_)};
        }
        __syncthreads();
    }
}

#define LAS __attribute__((address_space(3)))
typedef int i32x4_t __attribute__((ext_vector_type(4)));
typedef int i32x8_t __attribute__((ext_vector_type(8)));
__device__ __forceinline__ i32x8_t cat8(const bf16x8 a, const bf16x8 b) { const i32x4_t x = __builtin_bit_cast(i32x4_t, a), y = __builtin_bit_cast(i32x4_t, b); return __builtin_shufflevector(x, y, 0, 1, 2, 3, 4, 5, 6, 7); }
__device__ __forceinline__ void mfma_f8(f32x4& acc, const i32x8_t& a, const i32x8_t& b) { asm volatile("v_mfma_f32_16x16x128_f8f6f4 %0, %1, %2, %0" : "+v"(acc) : "v"(a), "v"(b)); }
__device__ __forceinline__ bf16x8 half8(const i32x8_t& v, int k) { const i32x4_t h = k ? __builtin_shufflevector(v, v, 4, 5, 6, 7) : __builtin_shufflevector(v, v, 0, 1, 2, 3); return __builtin_bit_cast(bf16x8, h); }
namespace g8 {
constexpr int BM = 256, BK = 64, HALF = 128, HTB = HALF * BK * 2, STAGE_BYTES = 8 * HTB, NXCD = 8, WGM = 8;
__device__ __forceinline__ int lds_byte(int r, int c) { const int st = (r >> 4) * 2 + (c >> 5), rr = r & 15, cc = c & 31, ob = rr * 64 + cc * 2; return st * 1024 + (ob ^ (((ob >> 9) & 1) << 5)); }
__device__ __forceinline__ void stage_rc(int b, int& R, int& C) { const int st = b / 1024, sb = b % 1024, swz = sb ^ (((sb >> 9) & 1) << 5); R = (st >> 1) * 16 + swz / 64; C = (st & 1) * 32 + (swz % 64) / 2; }
__device__ __forceinline__ int perm32(int rho) { const int n = rho >> 4, i = rho & 15; return 8 * (i >> 2) + 4 * n + (i & 3); }
struct Unit { int pm, pn; const char* B; };
typedef f32x4 Acc[2][2][4][2];

struct DenseOrder {
    static constexpr bool GATHER = false;
    int nM, nN, nwg, G, c; const char* Bt; size_t tstrideB; int rsh = 0, lim = 0x7fffffff;
    __device__ __forceinline__ void init(int M, int N, int G_, int c_, const bf16_t* Bt_, int ldb) { nM = M / BM; nN = N / BM; nwg = nM * nN; G = G_; c = c_; Bt = (const char*)Bt_; tstrideB = (size_t)BM * ldb * 2; }
    __device__ __forceinline__ bool next(int i, Unit& u) const {
        const long L = (long)(i >> rsh) * G + c; if (L >= nwg || L >= lim) return false;
        int wgid = (int)L; { const int q = nwg / NXCD, r = nwg % NXCD, xcd = wgid % NXCD, off = wgid / NXCD; wgid = (xcd < r ? xcd * (q + 1) : r * (q + 1) + (xcd - r) * q) + off; }
        const int nig = WGM * nN, gid = wgid / nig, fm = gid * WGM, gsz = (nM - fm) < WGM ? (nM - fm) : WGM;
        u.pm = fm + ((wgid % nig) % gsz); u.pn = (wgid % nig) / gsz; u.B = Bt + (size_t)u.pn * tstrideB; return true;
    }
    __device__ __forceinline__ unsigned arow_off(int) const { return 0u; }
};
struct SplitKOrder {
    static constexpr bool GATHER = false;
    int c; const char* Bt;
    __device__ __forceinline__ bool next(int i, Unit& u) const { if (i > 0) return false; u.pm = c >> 2; u.pn = c & 3; u.B = Bt; return true; }
    __device__ __forceinline__ unsigned arow_off(int) const { return 0u; }
};
template <bool GATHER_, int NCT, int LDA, size_t ESTRIDE, size_t TSTRIDE> struct MoeOrder {
    static constexpr bool GATHER = GATHER_;
    const MoeTab* mt; const int* LIST; int G, c; const char* W; int rsh = 0;
    __device__ __forceinline__ bool next(int i, Unit& u) const {
        const int L = (i >> rsh) * G + c; const int total = __builtin_amdgcn_readfirstlane(mt->tstart[NEXP]) * NCT; if (L >= total) return false;
        const int rt = L / NCT, ct = L % NCT; u.pm = rt; u.pn = ct; const int e = __builtin_amdgcn_readfirstlane(mt->texp[rt]); u.B = W + (size_t)e * ESTRIDE + (size_t)ct * TSTRIDE; return true;
    }
    __device__ __forceinline__ unsigned arow_off(int r) const {
        const int e = mt->texp[r >> 8]; const int pos = r - mt->tstart[e] * 256; const int tok = pos < mt->cnt[e] ? LIST[(size_t)e * T + pos] : 0; return (unsigned)tok * (unsigned)(LDA * 2);
    }
};

struct MoeOrder2 {
    static constexpr bool GATHER = false;
    const MoeTab* mt; int G, c, R, rtA; const char* W; int rsh = 0;
    __device__ __forceinline__ bool next(int i0, Unit& u) const {
        const int i = i0 >> rsh; int u2;
        if (c < R) { if (i >= 2) return false; u2 = rtA * 8 + 2 * c + i; }
        else { u2 = (c - R) + i * (G - R); if (u2 >= rtA * 8) return false; }
        const int rt = u2 >> 3, ct = u2 & 7; u.pm = rt; u.pn = ct; const int e = __builtin_amdgcn_readfirstlane(mt->texp[rt]);
        u.B = W + (size_t)e * ((size_t)DM * DEXP) + (size_t)ct * ((size_t)256 * DEXP); return true;
    }
    __device__ __forceinline__ unsigned arow_off(int) const { return 0u; }
};
__device__ __forceinline__ void moe_wait_dep(unsigned* rtc, int c, int G, int R, int rtA) {
    const int tid = otid();
    if (tid < 64) {
        int rt = -1;
        if (c < R) { if (tid < 2) rt = rtA + ((2 * c + tid) >> 3); } else if (tid < 32) { const int u2 = (c - R) + tid * (G - R); if (u2 < rtA * 8) rt = u2 >> 3; }
        unsigned spins = 0;
        for (;;) {
            const bool ok = rt < 0 || __hip_atomic_load(rtc + (rt < 0 ? 0 : rt) * 32, __ATOMIC_RELAXED, __HIP_MEMORY_SCOPE_AGENT) >= 32u;
            if (__all(ok)) break;
            __builtin_amdgcn_s_sleep(2); if (++spins > (1u << 22)) break;
        }
        __builtin_amdgcn_fence(__ATOMIC_ACQUIRE, "agent");
        asm volatile("s_waitcnt vmcnt(0)" ::: "memory");
    }
    __syncthreads();
}

template <class Epi, class Sched>
__device__ __forceinline__ void gemm_mfma(LAS unsigned char* lds, const bf16_t* A, int lda, int ldb, int K, const Sched& S, const Epi& E) {
    constexpr bool GATHER = Sched::GATHER;
    const int tid = otid(), wid = __builtin_amdgcn_readfirstlane(tid >> 6), lane = tid & 63, wr = wid >> 2, wc = wid & 3, fr = lane & 15, fq = lane >> 4;
    const int nt = K / BK;
    int Rst[2], Cst[2]; unsigned voffB[2], voA[2][2], voAn[2][2];
#pragma unroll
    for (int i = 0; i < 2; ++i) { stage_rc(tid * 16 + i * 8192, Rst[i], Cst[i]); const int Rb = Epi::PERM ? ((Rst[i] & ~31) + perm32(Rst[i] & 31)) : Rst[i];
        voffB[i] = (unsigned)(Rb * ldb + Cst[i]) * 2u;
#pragma unroll
        for (int h = 0; h < 2; ++h) { voA[h][i] = (unsigned)((h * HALF + Rst[i]) * lda + Cst[i]) * 2u; voAn[h][i] = voA[h][i]; } }
    const size_t kstep = (size_t)(BK * 2), hstepB = (size_t)HALF * ldb * 2, tstepA = (size_t)BM * lda * 2;
    const unsigned ldsw = (unsigned)wid * 1024u;
    const int aoff = lds_byte(wr * 64 + fr, fq * 8), boff = lds_byte(wc * 32 + fr, fq * 8);
#define G8_SA(b, h) (((b) * 2 + (h)) * HTB)
#define G8_SB(b, h) ((4 + (b) * 2 + (h)) * HTB)
#define G8_OPQ(x) ({ unsigned _o = (x); asm volatile("" : "+v"(_o)); _o; })
#define G8_STAGE_B(bufoff, gbase) do { _Pragma("unroll") for (int _i = 0; _i < 2; ++_i) \
        __builtin_amdgcn_global_load_lds((const unsigned*)((const char*)(gbase) + G8_OPQ(voffB[_i])), (LAS unsigned*)(lds + (bufoff) + ldsw + _i * 8192), 16, 0, 0); } while (0)
#define G8_STAGE_A(bufoff, gbase, o0, o1) do { \
        __builtin_amdgcn_global_load_lds((const unsigned*)((const char*)(gbase) + G8_OPQ(o0)), (LAS unsigned*)(lds + (bufoff) + ldsw), 16, 0, 0); \
        __builtin_amdgcn_global_load_lds((const unsigned*)((const char*)(gbase) + G8_OPQ(o1)), (LAS unsigned*)(lds + (bufoff) + ldsw + 8192), 16, 0, 0); } while (0)
#define G8_LDA(dst, b, h) do { _Pragma("unroll") for (int m = 0; m < 4; ++m) dst[m] = cat8(*(const LAS bf16x8*)(lds + G8_SA(b, h) + aoff + m * 2048), *(const LAS bf16x8*)(lds + G8_SA(b, h) + aoff + m * 2048 + 1024)); } while (0)
#define G8_LDB(dst, b, h) do { _Pragma("unroll") for (int n = 0; n < 2; ++n) dst[n] = cat8(*(const LAS bf16x8*)(lds + G8_SB(b, h) + boff + n * 2048), *(const LAS bf16x8*)(lds + G8_SB(b, h) + boff + n * 2048 + 1024)); } while (0)
#define G8_MMA(ai, bj, At, Bt) do { __builtin_amdgcn_s_setprio(1); \
        if constexpr (Epi::F8) { _Pragma("unroll") for (int m = 0; m < 4; ++m) _Pragma("unroll") for (int n = 0; n < 2; ++n) \
            mfma_f8(acc[ai][bj][m][n], Bt[n], At[m]); } \
        else { _Pragma("unroll") for (int m = 0; m < 4; ++m) _Pragma("unroll") for (int n = 0; n < 2; ++n) _Pragma("unroll") for (int k = 0; k < 2; ++k) \
            acc[ai][bj][m][n] = __builtin_amdgcn_mfma_f32_16x16x32_bf16(half8(Bt[n], k), half8(At[m], k), acc[ai][bj][m][n], 0, 0, 0); } \
        __builtin_amdgcn_s_setprio(0); } while (0)
#define G8_WAIT_V(n) asm volatile("s_waitcnt vmcnt(" #n ")" ::: "memory")
#define G8_WAIT_L(n) asm volatile("s_waitcnt lgkmcnt(" #n ")" ::: "memory")
#define G8_BAR __builtin_amdgcn_s_barrier()
#define G8_SCHED __builtin_amdgcn_sched_barrier(0)
    Unit cur, nxt; int ui = 0, prev_pm = -1;
    if (!S.next(0, cur)) return;
    Acc acc;
#pragma unroll
    for (int a = 0; a < 2; ++a)
#pragma unroll
        for (int b = 0; b < 2; ++b)
#pragma unroll
            for (int m = 0; m < 4; ++m)
#pragma unroll
                for (int n = 0; n < 2; ++n) acc[a][b][m][n] = (f32x4){0.f, 0.f, 0.f, 0.f};
    i32x8_t At[4], B0[2], B1[2];
    const char* cA; const char* cB = cur.B;
    if (GATHER) { cA = (const char*)A;
#pragma unroll
        for (int h = 0; h < 2; ++h)
#pragma unroll
            for (int i = 0; i < 2; ++i) voA[h][i] = S.arow_off(cur.pm * BM + h * HALF + Rst[i]) + (unsigned)Cst[i] * 2u;
    } else cA = (const char*)A + (size_t)cur.pm * tstepA;
    G8_STAGE_B(G8_SB(0, 0), cB); G8_STAGE_A(G8_SA(0, 0), cA, voA[0][0], voA[0][1]); G8_STAGE_B(G8_SB(0, 1), cB + hstepB); G8_STAGE_A(G8_SA(0, 1), cA, voA[1][0], voA[1][1]);
    if (wr == 1) G8_BAR;
    G8_WAIT_V(4); G8_BAR;
    G8_STAGE_B(G8_SB(1, 0), cB + kstep); G8_STAGE_A(G8_SA(1, 0), cA + kstep, voA[0][0], voA[0][1]); G8_STAGE_B(G8_SB(1, 1), cB + hstepB + kstep);
    G8_WAIT_V(6); G8_BAR;
    for (;;) {
        const bool has_next = S.next(ui + 1, nxt);
        const char* nA; const char* nB = has_next ? nxt.B : cB;
        if (GATHER) { nA = cA;
            if (has_next) {
#pragma unroll
                for (int h = 0; h < 2; ++h)
#pragma unroll
                    for (int i = 0; i < 2; ++i) voAn[h][i] = S.arow_off(nxt.pm * BM + h * HALF + Rst[i]) + (unsigned)Cst[i] * 2u;
            } else {
#pragma unroll
                for (int h = 0; h < 2; ++h)
#pragma unroll
                    for (int i = 0; i < 2; ++i) voAn[h][i] = voA[h][i];
            }
        } else nA = has_next ? (const char*)A + (size_t)nxt.pm * tstepA : cA;
        for (int t = 0; t < nt; t += 2) {
            const bool last = (t == nt - 2);
            const char* a1 = cA + (size_t)(t + 1) * kstep;
            const char* a2 = last ? nA : cA + (size_t)(t + 2) * kstep; const char* b2 = last ? nB : cB + (size_t)(t + 2) * kstep;
            const char* a3 = a2 + kstep; const char* b3 = b2 + kstep;
            unsigned o00 = voA[0][0], o01 = voA[0][1], o10 = voA[1][0], o11 = voA[1][1];
            if (GATHER) { if (last) { o00 = voAn[0][0]; o01 = voAn[0][1]; o10 = voAn[1][0]; o11 = voAn[1][1]; } }
            G8_LDB(B0, 0, 0); G8_SCHED; G8_LDA(At, 0, 0); G8_STAGE_A(G8_SA(1, 1), a1, voA[1][0], voA[1][1]);
            G8_WAIT_L(8); G8_BAR; G8_WAIT_L(0); G8_MMA(0, 0, At, B0); G8_BAR; G8_SCHED;
            G8_LDB(B1, 0, 1); G8_STAGE_B(G8_SB(0, 0), b2);
            G8_BAR; G8_WAIT_L(0); G8_MMA(0, 1, At, B1); G8_BAR;
            G8_LDA(At, 0, 1); G8_STAGE_A(G8_SA(0, 0), a2, o00, o01);
            G8_BAR; G8_WAIT_L(0); G8_MMA(1, 0, At, B0); G8_BAR; G8_SCHED;
            G8_STAGE_B(G8_SB(0, 1), b2 + hstepB);
            G8_WAIT_V(6);
            if constexpr (Epi::PUBLISH) { if (prev_pm >= 0) { E.publish(prev_pm); prev_pm = -1; } }
            G8_BAR; G8_MMA(1, 1, At, B1); G8_BAR;
            G8_LDB(B0, 1, 0); G8_SCHED; G8_LDA(At, 1, 0); G8_STAGE_A(G8_SA(0, 1), a2, o10, o11);
            G8_WAIT_L(8); G8_BAR; G8_WAIT_L(0); G8_MMA(0, 0, At, B0); G8_BAR; G8_SCHED;
            G8_LDB(B1, 1, 1); G8_STAGE_B(G8_SB(1, 0), b3);
            G8_BAR; G8_WAIT_L(0); G8_MMA(0, 1, At, B1); G8_BAR;
            G8_LDA(At, 1, 1); G8_STAGE_A(G8_SA(1, 0), a3, o00, o01);
            G8_BAR; G8_WAIT_L(0); G8_MMA(1, 0, At, B0); G8_BAR; G8_SCHED;
            G8_STAGE_B(G8_SB(1, 1), b3 + hstepB);
            G8_WAIT_V(6); G8_BAR; G8_MMA(1, 1, At, B1); G8_BAR;
        }
        if constexpr (Epi::F8) {
#define G8_TIE(a, b, txt) asm volatile(txt : "+v"(acc[a][b][0][0]), "+v"(acc[a][b][0][1]), "+v"(acc[a][b][1][0]), "+v"(acc[a][b][1][1]), "+v"(acc[a][b][2][0]), "+v"(acc[a][b][2][1]), "+v"(acc[a][b][3][0]), "+v"(acc[a][b][3][1]))
            G8_TIE(0, 0, ""); G8_TIE(0, 1, ""); G8_TIE(1, 0, "s_nop 7"); G8_TIE(1, 1, "s_nop 15\n\ts_nop 7");
#undef G8_TIE
        }
        if constexpr (Epi::ASCALE != 1.0f) {
#pragma unroll
            for (int a = 0; a < 2; ++a)
#pragma unroll
                for (int b = 0; b < 2; ++b)
#pragma unroll
                    for (int m = 0; m < 4; ++m)
#pragma unroll
                        for (int n = 0; n < 2; ++n) acc[a][b][m][n] *= Epi::ASCALE;
        }
        E(acc, cur, wr, wc, fr, fq);
        if constexpr (Epi::PUBLISH) prev_pm = cur.pm;
        if (!has_next) break;
#pragma unroll
        for (int a = 0; a < 2; ++a)
#pragma unroll
            for (int b = 0; b < 2; ++b)
#pragma unroll
                for (int m = 0; m < 4; ++m)
#pragma unroll
                    for (int n = 0; n < 2; ++n) acc[a][b][m][n] = (f32x4){0.f, 0.f, 0.f, 0.f};
        cur = nxt; cA = nA; cB = nB; ++ui;
        if (GATHER) {
#pragma unroll
            for (int h = 0; h < 2; ++h)
#pragma unroll
                for (int i = 0; i < 2; ++i) voA[h][i] = voAn[h][i];
        }
    }
    G8_WAIT_V(0);
    if constexpr (Epi::PUBLISH) { if (prev_pm >= 0) { E.publish(prev_pm); prev_pm = -1; } }
    if (wr == 0) G8_BAR;
    G8_BAR;
#undef G8_SA
#undef G8_SB
#undef G8_STAGE_A
#undef G8_STAGE_B
#undef G8_OPQ
#undef G8_LDA
#undef G8_LDB
#undef G8_MMA
#undef G8_WAIT_V
#undef G8_WAIT_L
#undef G8_BAR
#undef G8_SCHED
}

__device__ __forceinline__ u32x4 pack8(const f32x4& a, const f32x4& b) { u32x4 w; w.x = cvt_pk_bf16(a[0], a[1]); w.y = cvt_pk_bf16(a[2], a[3]); w.z = cvt_pk_bf16(b[0], b[1]); w.w = cvt_pk_bf16(b[2], b[3]); return w; }
__device__ __forceinline__ u32x4 subtile_T(LAS bf16_t* Tw, const f32x4& a, const f32x4& b, int fr, int fq, int lane) {
#pragma unroll
    for (int j = 0; j < 4; ++j) { Tw[(8 * fq + j) * 16 + fr] = f2bf(a[j]); Tw[(8 * fq + 4 + j) * 16 + fr] = f2bf(b[j]); }
    asm volatile("" ::: "memory");
    const u32x4 r = *(const LAS u32x4*)(Tw + (lane >> 1) * 16 + (lane & 1) * 8);
    asm volatile("" ::: "memory");
    return r;
}
template <bool F8_> struct MEpiProjT { static constexpr bool PERM = true, PUBLISH = false, F8 = F8_; static constexpr float ASCALE = F8_ ? 1.0f / (SHB * SWI) : 1.0f; bf16_t* PROJ; bf16_t* VT; LAS float* KX; const float* gq; const float* gk;
    __device__ __forceinline__ void operator()(const Acc& acc, const Unit& u, int wr, int wc, int fr, int fq) const {
        const int row0 = u.pm * BM + wr * 64 + fr;
        if (u.pn >= C_K / 256 && u.pn < DPROJ / 256) {
#pragma unroll
            for (int ai = 0; ai < 2; ++ai)
#pragma unroll
                for (int m = 0; m < 4; ++m)
#pragma unroll
                    for (int bj = 0; bj < 2; ++bj) {
                        const f32x4 a = acc[ai][bj][m][0], b = acc[ai][bj][m][1];
                        float ss = a[0] * a[0] + a[1] * a[1] + a[2] * a[2] + a[3] * a[3] + b[0] * b[0] + b[1] * b[1] + b[2] * b[2] + b[3] * b[3];
                        ss += __shfl_xor(ss, 16); ss += __shfl_xor(ss, 32);
                        if (fq == 0) KX[((ai * HALF + wr * 64 + m * 16 + fr) * 2 + bj) * 4 + wc] = ss;
                    }
            asm volatile("s_waitcnt lgkmcnt(0)" ::: "memory"); __builtin_amdgcn_s_barrier(); asm volatile("" ::: "memory");
            const int col0 = u.pn * BM + wc * 32 + 8 * fq;
            f32x4 g0[2], g1[2];
#pragma unroll
            for (int bj = 0; bj < 2; ++bj) { const int d0 = wc * 32 + 8 * fq; g0[bj] = *(const f32x4*)(gq + d0) * *(const f32x4*)(gk + d0); g1[bj] = *(const f32x4*)(gq + d0 + 4) * *(const f32x4*)(gk + d0 + 4); }
#pragma unroll
            for (int ai = 0; ai < 2; ++ai)
#pragma unroll
                for (int m = 0; m < 4; ++m) { bf16_t* rowp = PROJ + (size_t)(row0 + ai * HALF + m * 16) * DPROJ + col0;
#pragma unroll
                    for (int bj = 0; bj < 2; ++bj) { const f32x4 p4 = *(const LAS f32x4*)(KX + ((ai * HALF + wr * 64 + m * 16 + fr) * 2 + bj) * 4);
                        const float rs = rsqrtf(((p4[0] + p4[1]) + (p4[2] + p4[3])) * (1.0f / HD) + EPS);
                        *(u32x4*)(rowp + bj * HALF) = pack8(acc[ai][bj][m][0] * g0[bj] * rs, acc[ai][bj][m][1] * g1[bj] * rs); } }
            return;
        }
        if (u.pn < DPROJ / 256) {
            const int col0 = u.pn * BM + wc * 32 + 8 * fq;
#pragma unroll
            for (int ai = 0; ai < 2; ++ai)
#pragma unroll
                for (int m = 0; m < 4; ++m) { bf16_t* rowp = PROJ + (size_t)(row0 + ai * HALF + m * 16) * DPROJ + col0;
#pragma unroll
                    for (int bj = 0; bj < 2; ++bj) *(u32x4*)(rowp + bj * HALF) = pack8(acc[ai][bj][m][0], acc[ai][bj][m][1]); }
        } else {
            const int lane = fq * 16 + fr, cl = lane >> 1, hf = lane & 1; LAS bf16_t* Tw = (LAS bf16_t*)KX + (wr * 4 + wc) * 512;
            const int cc0 = (u.pn - DPROJ / 256) * BM + wc * 32 + cl;
#pragma unroll
            for (int ai = 0; ai < 2; ++ai)
#pragma unroll
                for (int m = 0; m < 4; ++m) { const int rowb = u.pm * BM + wr * 64 + ai * HALF + m * 16, b = rowb >> 12, s = (rowb & (SEQ - 1)) + hf * 8;
#pragma unroll
                    for (int bj = 0; bj < 2; ++bj) { const int cc = cc0 + bj * HALF;
                        const u32x4 w = subtile_T(Tw, acc[ai][bj][m][0], acc[ai][bj][m][1], fr, fq, lane);
                        *(u32x4*)(VT + ((size_t)(b * NHS + (cc >> 7)) * HD + (cc & 127)) * VTS + s) = w; } }
        }
    } };
template <bool F8_> struct MEpiPartT { static constexpr bool PERM = true, PUBLISH = false, F8 = F8_; static constexpr float ASCALE = F8_ ? 1.0f / (SHB * SWI) : 1.0f; bf16_t* PT; LAS float* KX;
    __device__ __forceinline__ void operator()(const Acc& acc, const Unit& u, int wr, int wc, int fr, int fq) const {
        const int lane = fq * 16 + fr, cl = lane >> 1, hf = lane & 1; LAS bf16_t* Tw = (LAS bf16_t*)KX + (wr * 4 + wc) * 512;
        bf16_t* base0 = PT + (size_t)(u.pm * 4 + u.pn) * 65536 + (size_t)(wc * 32 + cl) * 256 + wr * 64 + hf * 8;
#pragma unroll
        for (int ai = 0; ai < 2; ++ai)
#pragma unroll
            for (int m = 0; m < 4; ++m)
#pragma unroll
                for (int bj = 0; bj < 2; ++bj) {
                    const u32x4 w = subtile_T(Tw, acc[ai][bj][m][0], acc[ai][bj][m][1], fr, fq, lane);
                    *(u32x4*)(base0 + (size_t)(bj * HALF) * 256 + ai * HALF + m * 16) = w; }
    } };
__device__ __forceinline__ u32x4 pair16(unsigned a0, unsigned a1, unsigned b0, unsigned b1) {
    const auto s0 = __builtin_amdgcn_permlane16_swap(a0, b0, false, false); const auto s1 = __builtin_amdgcn_permlane16_swap(a1, b1, false, false);
    return (u32x4){s0[0], s1[0], s0[1], s1[1]};
}
__device__ __forceinline__ f32x4 silu_mul(const f32x4& g, const f32x4& u) { f32x4 r;
#pragma unroll
    for (int j = 0; j < 4; ++j) r[j] = g[j] * sigmoidf_(g[j]) * u[j];
    return r; }
struct MEpiGU { static constexpr bool PERM = true, PUBLISH = true, F8 = true; static constexpr float ASCALE = 1.0f; unsigned char* HID; const float* LISTR; const MoeTab* mt; unsigned* rtc; int n1early;
    __device__ __forceinline__ void operator()(const Acc& acc, const Unit& u, int wr, int wc, int fr, int fq) const {
        const int row0 = u.pm * BM + wr * 64 + fr, col0 = u.pn * HALF + wc * 32 + 8 * fq;
        const int e = __builtin_amdgcn_readfirstlane(mt->texp[u.pm]), cnt = __builtin_amdgcn_readfirstlane(mt->cnt[e]), pb = __builtin_amdgcn_readfirstlane(mt->tstart[e]) * 256;
        const float* lr = LISTR + (size_t)e * T;
        const __amdgpu_buffer_rsrc_t rsrc = __builtin_amdgcn_make_buffer_rsrc(HID, 0, (int)((size_t)PADROWS * DEXP), 0x00020000);
#pragma unroll
        for (int ai = 0; ai < 2; ++ai)
#pragma unroll
            for (int mp = 0; mp < 2; ++mp) { int w[2][2];
#pragma unroll
                for (int mm = 0; mm < 2; ++mm) { const int m = 2 * mp + mm;
                    const int row = row0 + ai * HALF + m * 16, pos = row - pb;
                    const float rs = pos < cnt ? lr[pos] * (1.0f / (SX8 * SW1)) : 0.f;
                    const f32x4 h0 = silu_mul(acc[ai][0][m][0] * rs, acc[ai][1][m][0] * rs) * SH8, h1 = silu_mul(acc[ai][0][m][1] * rs, acc[ai][1][m][1] * rs) * SH8;
                    int w0 = 0, w1 = 0;
                    w0 = __builtin_amdgcn_cvt_pk_fp8_f32(__builtin_amdgcn_fmed3f(h0[0], -448.f, 448.f), __builtin_amdgcn_fmed3f(h0[1], -448.f, 448.f), w0, false); w0 = __builtin_amdgcn_cvt_pk_fp8_f32(__builtin_amdgcn_fmed3f(h0[2], -448.f, 448.f), __builtin_amdgcn_fmed3f(h0[3], -448.f, 448.f), w0, true);
                    w1 = __builtin_amdgcn_cvt_pk_fp8_f32(__builtin_amdgcn_fmed3f(h1[0], -448.f, 448.f), __builtin_amdgcn_fmed3f(h1[1], -448.f, 448.f), w1, false); w1 = __builtin_amdgcn_cvt_pk_fp8_f32(__builtin_amdgcn_fmed3f(h1[2], -448.f, 448.f), __builtin_amdgcn_fmed3f(h1[3], -448.f, 448.f), w1, true);
                    w[mm][0] = w0; w[mm][1] = w1; }
                __builtin_amdgcn_raw_buffer_store_b128(pair16((unsigned)w[0][0], (unsigned)w[0][1], (unsigned)w[1][0], (unsigned)w[1][1]), rsrc, (row0 + ai * HALF + mp * 32 + 16 * (fq & 1)) * DEXP + (u.pn * HALF + wc * 32 + 16 * (fq >> 1)), 0, 16);
            }
    }
    __device__ __forceinline__ void publish(int pm) const {
        if ((otid() & 63) == 0) __hip_atomic_fetch_add(rtc + pm * 32, 1u, __ATOMIC_RELAXED, __HIP_MEMORY_SCOPE_AGENT);
    } };
struct MEpiDown { static constexpr bool PERM = true, PUBLISH = false, F8 = false; static constexpr float ASCALE = 1.0f; bf16_t* YPAD;
    __device__ __forceinline__ void operator()(const Acc& acc, const Unit& u, int wr, int wc, int fr, int fq) const {
        const int row0 = u.pm * BM + wr * 64 + fr, col0 = u.pn * BM + wc * 32 + 8 * fq;
#pragma unroll
        for (int ai = 0; ai < 2; ++ai)
#pragma unroll
            for (int m = 0; m < 4; ++m) { bf16_t* rowp = YPAD + (size_t)(row0 + ai * HALF + m * 16) * DM + col0;
#pragma unroll
                for (int bj = 0; bj < 2; ++bj) *(u32x4*)(rowp + bj * HALF) = pack8(acc[ai][bj][m][0], acc[ai][bj][m][1]); }
    } };
template <bool XF32> struct MEpiOut { static constexpr bool STAMP = false, PERM = true, PUBLISH = false, F8 = false; static constexpr float ASCALE = 1.0f; const float* Xf; const bf16_t* Xb; bf16_t* X1; unsigned char* X18;
    __device__ __forceinline__ void operator()(const Acc& acc, const Unit& u, int wr, int wc, int fr, int fq) const {
        const int row0 = u.pm * BM + wr * 64 + fr, col0 = u.pn * BM + wc * 32 + 8 * fq;
        const int row8 = u.pm * BM + wr * 64 + fr + 16 * (fq & 1), col8 = u.pn * BM + wc * 32 + 16 * (fq >> 1);
#pragma unroll
        for (int ai = 0; ai < 2; ++ai) {
            f32x4 xa[4][2][2]; u32x4 xh[4][2];
#pragma unroll
            for (int m = 0; m < 4; ++m)
#pragma unroll
                for (int bj = 0; bj < 2; ++bj) { const size_t o = (size_t)(row0 + ai * HALF + m * 16) * DM + col0 + bj * HALF;
                    if (XF32) { xa[m][bj][0] = *(const f32x4*)(Xf + o); xa[m][bj][1] = *(const f32x4*)(Xf + o + 4); } else xh[m][bj] = *(const u32x4*)(Xb + o); }
            __builtin_amdgcn_sched_barrier(0);
#pragma unroll
            for (int mp = 0; mp < 2; ++mp)
#pragma unroll
                for (int bj = 0; bj < 2; ++bj) { int w8[2][2];
#pragma unroll
                    for (int mm = 0; mm < 2; ++mm) { const int m = 2 * mp + mm; const size_t o = (size_t)(row0 + ai * HALF + m * 16) * DM + col0 + bj * HALF;
                        f32x4 a = acc[ai][bj][m][0], b = acc[ai][bj][m][1];
                        if (XF32) { a += xa[m][bj][0]; b += xa[m][bj][1]; }
                        else { const u32x4 w = xh[m][bj]; a[0] += bflo(w.x); a[1] += bfhi(w.x); a[2] += bflo(w.y); a[3] += bfhi(w.y); b[0] += bflo(w.z); b[1] += bfhi(w.z); b[2] += bflo(w.w); b[3] += bfhi(w.w); }
                        *(u32x4*)(X1 + o) = pack8(a, b);
                        int w0 = 0, w1 = 0;
                        w0 = __builtin_amdgcn_cvt_pk_fp8_f32(sat8(a[0] * SX8), sat8(a[1] * SX8), w0, false); w0 = __builtin_amdgcn_cvt_pk_fp8_f32(sat8(a[2] * SX8), sat8(a[3] * SX8), w0, true);
                        w1 = __builtin_amdgcn_cvt_pk_fp8_f32(sat8(b[0] * SX8), sat8(b[1] * SX8), w1, false); w1 = __builtin_amdgcn_cvt_pk_fp8_f32(sat8(b[2] * SX8), sat8(b[3] * SX8), w1, true);
                        w8[mm][0] = w0; w8[mm][1] = w1; }
                    *(u32x4*)(X18 + (size_t)(row8 + ai * HALF + mp * 32) * DM + col8 + bj * HALF) = pair16((unsigned)w8[0][0], (unsigned)w8[0][1], (unsigned)w8[1][0], (unsigned)w8[1][1]); }
        }
    } };
constexpr float YSCALE = YSCALE_G;
struct MEpiDown8 { static constexpr bool PERM = true, PUBLISH = false, F8 = true; static constexpr float ASCALE = 1.0f; unsigned char* Y8;
    __device__ __forceinline__ void operator()(const Acc& acc, const Unit& u, int wr, int wc, int fr, int fq) const {
        const int row0 = u.pm * BM + wr * 64 + fr + 16 * (fq & 1), col0 = u.pn * BM + wc * 32 + 16 * (fq >> 1);
#pragma unroll
        for (int ai = 0; ai < 2; ++ai)
#pragma unroll
            for (int mp = 0; mp < 2; ++mp)
#pragma unroll
                for (int bj = 0; bj < 2; ++bj) { int w[2][2];
#pragma unroll
                    for (int mm = 0; mm < 2; ++mm) { const int m = 2 * mp + mm; const f32x4 a = acc[ai][bj][m][0] * (YSCALE / (SH8 * SW2)), b = acc[ai][bj][m][1] * (YSCALE / (SH8 * SW2)); int w0 = 0, w1 = 0;
                        w0 = __builtin_amdgcn_cvt_pk_fp8_f32(sat8(a[0]), sat8(a[1]), w0, false); w0 = __builtin_amdgcn_cvt_pk_fp8_f32(sat8(a[2]), sat8(a[3]), w0, true);
                        w1 = __builtin_amdgcn_cvt_pk_fp8_f32(sat8(b[0]), sat8(b[1]), w1, false); w1 = __builtin_amdgcn_cvt_pk_fp8_f32(sat8(b[2]), sat8(b[3]), w1, true); w[mm][0] = w0; w[mm][1] = w1; }
                    *(u32x4*)(Y8 + (size_t)(row0 + ai * HALF + mp * 32) * DM + col0 + bj * HALF) = pair16((unsigned)w[0][0], (unsigned)w[0][1], (unsigned)w[1][0], (unsigned)w[1][1]); }
    } };
}

__device__ __forceinline__ void phase_convb(const Ctx& c, int l) {
    const int gt = obid() * 512 + otid(), ng = gridDim.x * 512, sub = gt & 15;
    const float* cw = c.in[10] + (size_t)l * 3 * DCONV; const bf16_t* PROJ = c.PROJ();
#pragma unroll 2
    for (int item = gt >> 4; item < T * 4; item += ng >> 4) {
        const int t = item >> 2, hh = item & 3, ch = hh * HD + sub * 8, s = t & (SEQ - 1);
        u32x4 cg[3], xb[3];
#pragma unroll
        for (int tap = 0; tap < 3; ++tap) { const int ds = (s + tap - 2 >= 0) ? tap - 2 : 0; const bf16_t* row = PROJ + (size_t)(t + ds) * DPROJ; cg[tap] = *(const u32x4*)(row + C_CG + ch); xb[tap] = *(const u32x4*)(row + C_XB + ch); }
        const u32x4 bg = *(const u32x4*)(PROJ + (size_t)t * DPROJ + C_BG + ch);
        float acc[8] = {0, 0, 0, 0, 0, 0, 0, 0};
#pragma unroll
        for (int tap = 0; tap < 3; ++tap) {
            if (s + tap - 2 >= 0) {
                const f32x4 w0 = *(const f32x4*)(cw + tap * DCONV + ch), w1 = *(const f32x4*)(cw + tap * DCONV + ch + 4);
                acc[0] += w0[0] * bflo(cg[tap].x) * bflo(xb[tap].x); acc[1] += w0[1] * bfhi(cg[tap].x) * bfhi(xb[tap].x); acc[2] += w0[2] * bflo(cg[tap].y) * bflo(xb[tap].y); acc[3] += w0[3] * bfhi(cg[tap].y) * bfhi(xb[tap].y);
                acc[4] += w1[0] * bflo(cg[tap].z) * bflo(xb[tap].z); acc[5] += w1[1] * bfhi(cg[tap].z) * bfhi(xb[tap].z); acc[6] += w1[2] * bflo(cg[tap].w) * bflo(xb[tap].w); acc[7] += w1[3] * bfhi(cg[tap].w) * bfhi(xb[tap].w);
            }
        }
        acc[0] *= bflo(bg.x); acc[1] *= bfhi(bg.x); acc[2] *= bflo(bg.y); acc[3] *= bfhi(bg.y); acc[4] *= bflo(bg.z); acc[5] *= bfhi(bg.z); acc[6] *= bflo(bg.w); acc[7] *= bfhi(bg.w);
        float ss = 0.f;
#pragma unroll
        for (int i = 0; i < 8; ++i) ss += acc[i] * acc[i];
        ss += __shfl_xor(ss, 1); ss += __shfl_xor(ss, 2); ss += __shfl_xor(ss, 4); ss += __shfl_xor(ss, 8);
        const float rstd = rsqrtf(ss * (1.0f / HD) + EPS);
        const float* mg = c.in[13] + (size_t)l * DM + DLRU + ch;
        const f32x4 m0 = *(const f32x4*)mg, m1 = *(const f32x4*)(mg + 4);
        u32x4 o; o.x = cvt_pk_bf16(acc[0] * rstd * m0[0], acc[1] * rstd * m0[1]); o.y = cvt_pk_bf16(acc[2] * rstd * m0[2], acc[3] * rstd * m0[3]);
        o.z = cvt_pk_bf16(acc[4] * rstd * m1[0], acc[5] * rstd * m1[1]); o.w = cvt_pk_bf16(acc[6] * rstd * m1[2], acc[7] * rstd * m1[3]);
        *(u32x4*)(c.YMIX() + (size_t)t * DM + DLRU + ch) = o;
    }
}
typedef float f32x16 __attribute__((ext_vector_type(16)));
#define MFMA32(a, b, c) __builtin_amdgcn_mfma_f32_32x32x16_bf16((a), (b), (c), 0, 0, 0)
constexpr int XCS = 776;
__device__ __forceinline__ void phase_lruA(const Ctx& c, int l, unsigned char* ldsb) {
    constexpr bool PASS2 = false;
    bf16_t* XC = (bf16_t*)ldsb; bf16_t* PR = (bf16_t*)(ldsb + 99328); bf16_t* HL = c.HL(); bf16_t* PL = c.PL();
    const int tid = otid(), lane = tid & 63, wv = tid >> 6, hh = lane >> 5, l31 = lane & 31;
    const float* cw = c.in[3] + (size_t)l * 4 * DLRU; const float* cb = c.in[4] + (size_t)l * DLRU;
    const bf16_t* PROJ = c.PROJ(); float* AGG = c.AGG();
    typedef float f32x2_t __attribute__((ext_vector_type(2)));
    for (int tile = obid(); tile < T / 64; tile += gridDim.x) {
        const int t0 = tile * 64, s0 = t0 & (SEQ - 1), tb = tile & 63;
        if (tid < 480) {
            const int cg = tid % 48, tslot = tid / 48, ch = cg * 16;
            float w[4][16], bias[16];
#pragma unroll
            for (int i = 0; i < 16; i += 4) { *(f32x4*)&bias[i] = *(const f32x4*)(cb + ch + i);
#pragma unroll
                for (int tap = 0; tap < 4; ++tap) *(f32x4*)&w[tap][i] = *(const f32x4*)(cw + tap * DLRU + ch + i); }
#pragma unroll
            for (int it = 0; it < 7; ++it) {
                const int tokr = tslot + 10 * it, tok = tokr < 64 ? tokr : 63;
                u32x4 x0[4], x1[4]; float msk[4];
#pragma unroll
                for (int tap = 0; tap < 4; ++tap) {
                    const int ds = tap - 3; const bool ok = (s0 + tok + ds >= 0); msk[tap] = ok ? 1.0f : 0.0f;
                    const bf16_t* row = PROJ + (size_t)(t0 + tok + (ok ? ds : 0)) * DPROJ + C_XA + ch;
                    x0[tap] = *(const u32x4*)row; x1[tap] = *(const u32x4*)(row + 8);
                }
                float a[16];
#pragma unroll
                for (int i = 0; i < 16; ++i) a[i] = bias[i];
#pragma unroll
                for (int tap = 0; tap < 4; ++tap) {
                    const float m = msk[tap];
                    a[0] += m * w[tap][0] * bflo(x0[tap].x); a[1] += m * w[tap][1] * bfhi(x0[tap].x); a[2] += m * w[tap][2] * bflo(x0[tap].y); a[3] += m * w[tap][3] * bfhi(x0[tap].y);
                    a[4] += m * w[tap][4] * bflo(x0[tap].z); a[5] += m * w[tap][5] * bfhi(x0[tap].z); a[6] += m * w[tap][6] * bflo(x0[tap].w); a[7] += m * w[tap][7] * bfhi(x0[tap].w);
                    a[8] += m * w[tap][8] * bflo(x1[tap].x); a[9] += m * w[tap][9] * bfhi(x1[tap].x); a[10] += m * w[tap][10] * bflo(x1[tap].y); a[11] += m * w[tap][11] * bfhi(x1[tap].y);
                    a[12] += m * w[tap][12] * bflo(x1[tap].z); a[13] += m * w[tap][13] * bfhi(x1[tap].z); a[14] += m * w[tap][14] * bflo(x1[tap].w); a[15] += m * w[tap][15] * bfhi(x1[tap].w);
                }
                u32x4 o0, o1; o0.x = cvt_pk_bf16(a[0], a[1]); o0.y = cvt_pk_bf16(a[2], a[3]); o0.z = cvt_pk_bf16(a[4], a[5]); o0.w = cvt_pk_bf16(a[6], a[7]);
                o1.x = cvt_pk_bf16(a[8], a[9]); o1.y = cvt_pk_bf16(a[10], a[11]); o1.z = cvt_pk_bf16(a[12], a[13]); o1.w = cvt_pk_bf16(a[14], a[15]);
                if (tokr < 64) { *(u32x4*)(XC + tok * XCS + ch) = o0; *(u32x4*)(XC + tok * XCS + ch + 8) = o1; }
            }
        }
        __syncthreads();
#pragma unroll 1
        for (int i = 0; i < 3; ++i) {
            const int hd = 2 * i + (wv >> 2), ntw = wv & 3, chl = 32 * ntw + l31, ch = hd * HD + chl;
            const bf16_t* wa = c.WA(l) + ((size_t)hd * HD + chl) * HD + 8 * hh; const bf16_t* wx = c.WX(l) + ((size_t)hd * HD + chl) * HD + 8 * hh;
            const float ba = c.in[6][l * DLRU + ch], bx = c.in[8][l * DLRU + ch], c8 = -8.0f * softplusf_(-c.in[9][l * DLRU + ch]);
            float sst = 0.f, Pt = 1.f;
            float hreg[2][16], preg[2][16];
            bf16x8 bRf[8], bIf[8];
#pragma unroll
            for (int s = 0; s < 8; ++s) { bRf[s] = *(const bf16x8*)(wa + 16 * s); bIf[s] = *(const bf16x8*)(wx + 16 * s); }
            __builtin_amdgcn_sched_barrier(0);
#pragma unroll
            for (int half = 0; half < 2; ++half) {
                float av[16], uv[16];
                {
                    f32x16 accR, accI;
#pragma unroll
                    for (int r = 0; r < 16; ++r) { accR[r] = 0.f; accI[r] = 0.f; }
#pragma unroll
                    for (int s = 0; s < 8; ++s) {
                        const bf16x8 a = *(const bf16x8*)(XC + (32 * half + l31) * XCS + hd * HD + 16 * s + 8 * hh);
                        accR = MFMA32(a, bRf[s], accR); accI = MFMA32(a, bIf[s], accI);
                    }
#pragma unroll
                    for (int r = 0; r < 16; ++r) {
                        const int tok = 32 * half + (r & 3) + 8 * (r >> 2) + 4 * hh;
                        const float xc = bf2f(XC[tok * XCS + ch]);
                        const float rg = sigmoidf_(accR[r] + ba), ig = sigmoidf_(accI[r] + bx);
                        const float la = c8 * rg;
                        av[r] = fast_exp(la); uv[r] = __builtin_amdgcn_sqrtf((1.0f - av[r]) * (1.0f + av[r])) * (ig * xc);
                    }
                }
                float Pp[4], Hp[4];
#pragma unroll
                for (int g = 0; g < 4; ++g) { float P = 1.f, H = 0.f;
#pragma unroll
                    for (int r = 4 * g; r < 4 * g + 4; ++r) { H = av[r] * H + uv[r]; P *= av[r]; }
                    Pp[g] = __shfl_xor(P, 32); Hp[g] = __shfl_xor(H, 32); }
#pragma unroll
                for (int g = 0; g < 4; ++g) {
                    if (hh == 0) {
#pragma unroll
                        for (int r = 4 * g; r < 4 * g + 4; ++r) { sst = av[r] * sst + uv[r]; Pt *= av[r]; hreg[half][r] = sst; preg[half][r] = Pt; }
                        sst = Pp[g] * sst + Hp[g]; Pt *= Pp[g];
                    } else {
                        sst = Pp[g] * sst + Hp[g]; Pt *= Pp[g];
#pragma unroll
                        for (int r = 4 * g; r < 4 * g + 4; ++r) { sst = av[r] * sst + uv[r]; Pt *= av[r]; hreg[half][r] = sst; preg[half][r] = Pt; }
                    }
                }
            }
            if (hh == 0) { f32x2_t o; o.x = Pt; o.y = sst; ((f32x2_t*)AGG)[(size_t)tile * DLRU + ch] = o; }
            __syncthreads();
#pragma unroll
            for (int half = 0; half < 2; ++half)
#pragma unroll
                for (int r = 0; r < 16; ++r) { const int tok = 32 * half + (r & 3) + 8 * (r >> 2) + 4 * hh;
                    XC[tok * XCS + ch] = f2bf(hreg[half][r]); PR[tok * 264 + (wv >> 2) * HD + chl] = f2bf(preg[half][r]); }
            __syncthreads();
#pragma unroll
            for (int k = 0; k < 4; ++k) {
                const int item = tid + 512 * k, tok = item >> 5, g = item & 31, hs = g >> 4, sub = g & 15, cc = (2 * i + hs) * HD + sub * 8;
                *(u32x4*)(HL + (size_t)(t0 + tok) * DLRU + cc) = *(const u32x4*)(XC + tok * XCS + cc);
                *(u32x4*)(PL + (size_t)(t0 + tok) * DLRU + cc) = *(const u32x4*)(PR + tok * 264 + hs * HD + sub * 8);
            }
        }
        __syncthreads();
    }
}

__device__ __forceinline__ void phase_lruB(const Ctx& c, int l, unsigned char* ldsb) {
    float* HIN = (float*)ldsb;
    const int tid = otid();
    const bf16_t* PROJ = c.PROJ(); const float* AGG = c.AGG(); const bf16_t* HL = c.HL(); const bf16_t* PL = c.PL();
    typedef float f32x2_t __attribute__((ext_vector_type(2)));
    for (int tile = obid(); tile < T / 64; tile += gridDim.x) {
        const int t0 = tile * 64, tb = tile & 63;
        {
            const f32x2_t* ag = (const f32x2_t*)AGG + (size_t)(tile - tb) * DLRU;
            const int chb = 512 + (tid & 255);
            float ha = 0.f, hb = 0.f;
#pragma unroll 8
            for (int k = 0; k < tb; ++k) { const f32x2_t pa = ag[(size_t)k * DLRU + tid], pb_ = ag[(size_t)k * DLRU + chb]; ha = pa.x * ha + pa.y; hb = pb_.x * hb + pb_.y; }
            HIN[tid] = ha; if (tid < 256) HIN[chb] = hb;
        }
        __syncthreads();
        const int wv_ = tid >> 6, wit0 = wv_ < 4 ? 8 * wv_ : 32 + 16 * (wv_ - 4), wcnt = wv_ < 4 ? 8 : 16;
#define LB_ADDR(it_, tok_, cc_) const int item_##it_ = (wit0 + (it_)) * 64 + (tid & 63), tok_ = item_##it_ / 96, rem_##it_ = item_##it_ % 96, cc_ = (rem_##it_ >> 4) * HD + (rem_##it_ & 15) * 8
#define LB_LOAD(H_, P_, G_, tok_, cc_) do { H_ = *(const u32x4*)(HL + (size_t)(t0 + tok_) * DLRU + cc_); P_ = *(const u32x4*)(PL + (size_t)(t0 + tok_) * DLRU + cc_); G_ = *(const u32x4*)(PROJ + (size_t)(t0 + tok_) * DPROJ + C_GA + cc_); } while (0)
#define LB_BODY(hv, pv, ga, tok, cc) do { \
            const f32x4 i0 = *(const f32x4*)(HIN + cc), i1 = *(const f32x4*)(HIN + cc + 4); \
            float y[8] = {(bflo(hv.x) + bflo(pv.x) * i0[0]) * gelu_tanh(bflo(ga.x)), (bfhi(hv.x) + bfhi(pv.x) * i0[1]) * gelu_tanh(bfhi(ga.x)), \
                          (bflo(hv.y) + bflo(pv.y) * i0[2]) * gelu_tanh(bflo(ga.y)), (bfhi(hv.y) + bfhi(pv.y) * i0[3]) * gelu_tanh(bfhi(ga.y)), \
                          (bflo(hv.z) + bflo(pv.z) * i1[0]) * gelu_tanh(bflo(ga.z)), (bfhi(hv.z) + bfhi(pv.z) * i1[1]) * gelu_tanh(bfhi(ga.z)), \
                          (bflo(hv.w) + bflo(pv.w) * i1[2]) * gelu_tanh(bflo(ga.w)), (bfhi(hv.w) + bfhi(pv.w) * i1[3]) * gelu_tanh(bfhi(ga.w))}; \
            float ss = 0.f; \
            _Pragma("unroll") for (int k = 0; k < 8; ++k) ss += y[k] * y[k]; \
            ss += __shfl_xor(ss, 1); ss += __shfl_xor(ss, 2); ss += __shfl_xor(ss, 4); ss += __shfl_xor(ss, 8); \
            const float rstd = rsqrtf(ss * (1.0f / HD) + EPS); \
            const float* mg = c.in[13] + (size_t)l * DM + cc; \
            const f32x4 m0 = *(const f32x4*)mg, m1 = *(const f32x4*)(mg + 4); \
            u32x4 o; o.x = cvt_pk_bf16(y[0] * rstd * m0[0], y[1] * rstd * m0[1]); o.y = cvt_pk_bf16(y[2] * rstd * m0[2], y[3] * rstd * m0[3]); \
            o.z = cvt_pk_bf16(y[4] * rstd * m1[0], y[5] * rstd * m1[1]); o.w = cvt_pk_bf16(y[6] * rstd * m1[2], y[7] * rstd * m1[3]); \
            *(u32x4*)(c.YMIX() + (size_t)(t0 + tok) * DM + cc) = o; } while (0)
        {
            u32x4 hA, pA, gA, hB, pB, gB;
            { LB_ADDR(0, tk_, cc_); LB_LOAD(hA, pA, gA, tk_, cc_); }
#pragma unroll 1
            for (int it = 0; it < wcnt; it += 2) {
                LB_ADDR(it, tkA, ccA); const int itb = it + 1; LB_ADDR(itb, tkB, ccB);
                LB_LOAD(hB, pB, gB, tkB, ccB); __builtin_amdgcn_sched_barrier(0);
                LB_BODY(hA, pA, gA, tkA, ccA);
                if (it + 2 < wcnt) { const int itc = it + 2; LB_ADDR(itc, tkC, ccC); LB_LOAD(hA, pA, gA, tkC, ccC); } __builtin_amdgcn_sched_barrier(0);
                LB_BODY(hB, pB, gB, tkB, ccB);
            }
        }
#undef LB_ADDR
#undef LB_LOAD
#undef LB_BODY
        __syncthreads();
    }
}

__device__ __forceinline__ void phase_vreduce(const Ctx& c) {
    const bf16_t* PT = c.PT(); bf16_t* VT = c.VT();
    for (int item = obid() * 512 + otid(); item < 64 * 256 * 32; item += gridDim.x * 512) {
        const int ro = item & 31, col = (item >> 5) & 255, u = item >> 13;
        const bf16_t* p = PT + (size_t)(u * 4) * 65536 + col * 256 + ro * 8;
        float a[8] = {0, 0, 0, 0, 0, 0, 0, 0};
#pragma unroll
        for (int kq = 0; kq < 4; ++kq) { const u32x4 w = *(const u32x4*)(p + (size_t)kq * 65536);
            a[0] += bflo(w.x); a[1] += bfhi(w.x); a[2] += bflo(w.y); a[3] += bfhi(w.y); a[4] += bflo(w.z); a[5] += bfhi(w.z); a[6] += bflo(w.w); a[7] += bfhi(w.w); }
        const int b = u >> 4, s0 = (u & 15) * 256 + ro * 8, h = 4 + (col >> 7), d = col & 127;
        u32x4 o; o.x = cvt_pk_bf16(a[0], a[1]); o.y = cvt_pk_bf16(a[2], a[3]); o.z = cvt_pk_bf16(a[4], a[5]); o.w = cvt_pk_bf16(a[6], a[7]);
        *(u32x4*)(VT + ((size_t)(b * NHS + h) * HD + d) * VTS + s0) = o;
    }
}

__device__ __forceinline__ void phase_attn(const Ctx& c, int l, unsigned char* ldsb) {
    const int lane = otid() & 63, wv = otid() >> 6, hh = lane >> 5, l31 = lane & 31;
    const bf16_t* PROJ = c.PROJ(); const bf16_t* VT = c.VT();
    const int prow = (l31 & ~12) | ((l31 & 4) << 1) | ((l31 & 8) >> 1);
    unsigned char* wl = ldsb + wv * 16384;
    const int kwbase = (lane >> 4) * 256 + (((lane & 15) ^ (lane >> 4)) * 16);
    const int vwoff = (lane >> 2) * 64 + (((lane & 3) ^ (lane >> 4)) * 16);
    const int kroff = prow * 256;
    const int nwt = NB * NHS * (SEQ / 32);
    const int nper = (nwt + (int)gridDim.x - 1) / (int)gridDim.x, wt0 = obid() * nper, wt1 = (wt0 + nper < nwt) ? wt0 + nper : nwt;
    for (int wt = wt0 + wv; wt < wt1; wt += 8) {
        const int qt = wt % (SEQ / 32), bh = wt / (SEQ / 32), b = bh / NHS, h = bh % NHS, q0 = qt * 32;
        const bf16_t* qp = PROJ + (size_t)(b * SEQ + q0 + l31) * DPROJ + C_Q + h * HD + 8 * hh;
        bf16x8 bq[8];
#pragma unroll
        for (int s = 0; s < 8; ++s) bq[s] = *(const bf16x8*)(qp + 16 * s);
        {
            float qs = 0.f;
#pragma unroll
            for (int s = 0; s < 8; ++s) { const u32x4 w = __builtin_bit_cast(u32x4, bq[s]);
                qs += bflo(w.x) * bflo(w.x) + bfhi(w.x) * bfhi(w.x) + bflo(w.y) * bflo(w.y) + bfhi(w.y) * bfhi(w.y) + bflo(w.z) * bflo(w.z) + bfhi(w.z) * bfhi(w.z) + bflo(w.w) * bflo(w.w) + bfhi(w.w) * bfhi(w.w); }
            qs += __shfl_xor(qs, 32);
            const float sc = rsqrtf(qs * (1.0f / HD) + EPS) * (1.4426950408889634f * 0.08838834764831845f);
#pragma unroll
            for (int s = 0; s < 8; ++s) { const u32x4 w = __builtin_bit_cast(u32x4, bq[s]); u32x4 o;
                o.x = cvt_pk_bf16(bflo(w.x) * sc, bfhi(w.x) * sc); o.y = cvt_pk_bf16(bflo(w.y) * sc, bfhi(w.y) * sc); o.z = cvt_pk_bf16(bflo(w.z) * sc, bfhi(w.z) * sc); o.w = cvt_pk_bf16(bflo(w.w) * sc, bfhi(w.w) * sc);
                bq[s] = __builtin_bit_cast(bf16x8, o); }
        }
        f32x16 O[4];
#pragma unroll
        for (int m = 0; m < 4; ++m)
#pragma unroll
            for (int r = 0; r < 16; ++r) O[m][r] = 0.f;
        float carry = 0.f;
        const bf16_t* kgl = PROJ + (size_t)(b * SEQ + (lane >> 4)) * DPROJ + C_K + h * HD + (lane & 15) * 8;
        const bf16_t* vgl = VT + ((size_t)bh * HD + (lane >> 2)) * VTS + (lane & 3) * 8;
        u32x4 stK[8], stV[8];
#define ATT_LOAD(kk0) do { _Pragma("unroll") for (int j = 0; j < 8; ++j) { \
            stK[j] = *(const u32x4*)(kgl + (size_t)((kk0) + 4 * j) * DPROJ); stV[j] = *(const u32x4*)(vgl + (size_t)(16 * j) * VTS + (kk0)); } } while (0)
        ATT_LOAD(q0);
        for (int k0 = q0; k0 >= 0; k0 -= 32) {
#pragma unroll
            for (int j = 0; j < 8; ++j) { *(u32x4*)(wl + j * 1024 + (kwbase ^ (64 * (j & 3)))) = stK[j]; *(u32x4*)(wl + 8192 + vwoff + j * 1024) = stV[j]; }
            const int kn = k0 >= 32 ? k0 - 32 : k0;
            ATT_LOAD(kn);
            __builtin_amdgcn_sched_barrier(0);
            f32x16 S;
#pragma unroll
            for (int r = 0; r < 16; ++r) S[r] = 0.f;
#pragma unroll
            for (int s = 0; s < 8; ++s) { const bf16x8 ak = *(const bf16x8*)(wl + kroff + (((2 * s + hh) ^ (prow & 15)) * 16)); S = MFMA32(ak, bq[s], S); }
            const bool diag = (k0 == q0);
            float sp[16];
            float R0 = 0.f, R1 = 0.f;
#pragma unroll
            for (int r = 0; r < 16; ++r) {
                const int kk = 16 * (r >> 3) + 8 * hh + (r & 7);
                const float z = S[r];
                float v = fmaxf(z, 0.f) + __builtin_amdgcn_logf(1.0f + __builtin_amdgcn_exp2f(-fabsf(z)));
                if (diag && kk >= l31) v = 0.f;
                sp[r] = v;
                if (r < 8) R0 += v; else R1 += v;
            }
            const float R0p = __shfl_xor(R0, 32), R1p = __shfl_xor(R1, 32);
            float suf_hi = carry - (hh == 0 ? R1p : 0.f);
            float suf_lo = carry - R1 - R1p - (hh == 0 ? R0p : 0.f);
            float w[16];
#pragma unroll
            for (int r = 15; r >= 8; --r) { w[r] = __builtin_amdgcn_exp2f(S[r] - sp[r] + suf_hi); suf_hi -= sp[r]; }
#pragma unroll
            for (int r = 7; r >= 0; --r) { w[r] = __builtin_amdgcn_exp2f(S[r] - sp[r] + suf_lo); suf_lo -= sp[r]; }
            if (diag) {
#pragma unroll
                for (int r = 0; r < 16; ++r) { const int kk = 16 * (r >> 3) + 8 * hh + (r & 7); if (kk >= l31) w[r] = 0.f; }
            }
            carry -= (R0 + R1 + R0p + R1p);
            bf16x8 wb[2];
            __builtin_amdgcn_sched_barrier(0);
#pragma unroll
            for (int s = 0; s < 2; ++s) { u32x4 pk; pk.x = cvt_pk_bf16(w[8 * s + 0], w[8 * s + 1]); pk.y = cvt_pk_bf16(w[8 * s + 2], w[8 * s + 3]); pk.z = cvt_pk_bf16(w[8 * s + 4], w[8 * s + 5]); pk.w = cvt_pk_bf16(w[8 * s + 6], w[8 * s + 7]);
                wb[s] = __builtin_bit_cast(bf16x8, pk); }
#pragma unroll
            for (int m = 0; m < 4; ++m)
#pragma unroll
                for (int s = 0; s < 2; ++s) { const bf16x8 vtf = *(const bf16x8*)(wl + 8192 + (32 * m + l31) * 64 + (((2 * s + hh) ^ (((32 * m + l31) >> 2) & 3)) * 16)); O[m] = MFMA32(vtf, wb[s], O[m]); }
            if (!__any(carry >= -150.1f)) break;
        }
        float ss = 0.f;
#pragma unroll
        for (int m = 0; m < 4; ++m)
#pragma unroll
            for (int r = 0; r < 16; ++r) ss += O[m][r] * O[m][r];
        ss += __shfl_xor(ss, 32);
        const float rstd = rsqrtf(ss * (1.0f / HD) + EPS);
        const float* mg = c.in[13] + (size_t)l * DM + DLRU + DCONV + h * HD + 4 * hh;
        bf16_t* yp = c.YMIX() + (size_t)(b * SEQ + q0 + l31) * DM + DLRU + DCONV + h * HD + 8 * hh;
#pragma unroll
        for (int m = 0; m < 4; ++m)
#pragma unroll
            for (int gp = 0; gp < 2; ++gp) { u32x2 o[2];
#pragma unroll
                for (int gg_ = 0; gg_ < 2; ++gg_) { const int g = 2 * gp + gg_; const f32x4 gg = *(const f32x4*)(mg + 32 * m + 8 * g);
                    o[gg_].x = cvt_pk_bf16(O[m][4 * g] * rstd * gg[0], O[m][4 * g + 1] * rstd * gg[1]); o[gg_].y = cvt_pk_bf16(O[m][4 * g + 2] * rstd * gg[2], O[m][4 * g + 3] * rstd * gg[3]); }
                const auto sx = __builtin_amdgcn_permlane32_swap(o[0].x, o[1].x, false, false); const auto sy = __builtin_amdgcn_permlane32_swap(o[0].y, o[1].y, false, false);
                *(u32x4*)(yp + 32 * m + 16 * gp) = (u32x4){sx[0], sy[0], sx[1], sy[1]};
            }
    }
}

#define XB_TMO      128
#define XB_XCNT(j)  (256  + 64 * (j))
#define XB_XSUB(j)  (1280 + 64 * (j))
#define XB_XGEN(j)  (2304 + 64 * (j))
#define XB_TOP      3328
#define XB_TOPGEN   3392
#define XCD_BAR_WORDS 3456
#define XB_SPIN_CAP (1u << 18)
__device__ __forceinline__ unsigned xb_ld(unsigned* p)              { return __hip_atomic_load(p, __ATOMIC_RELAXED, __HIP_MEMORY_SCOPE_AGENT); }
__device__ __forceinline__ unsigned xb_add(unsigned* p, unsigned v) { return __hip_atomic_fetch_add(p, v, __ATOMIC_RELAXED, __HIP_MEMORY_SCOPE_AGENT); }
__device__ __forceinline__ unsigned xb_xcc_id() { return (unsigned)__builtin_amdgcn_s_getreg((3 << 11) | 20) & 0xFu; }
#define XB_SPIN(cond, bar) do { unsigned _sp = 0; while (cond) { __builtin_amdgcn_s_sleep(1); \
    if ((++_sp & 255u) == 0u) { if (xb_ld(&(bar)[XB_TMO])) break; if (_sp > XB_SPIN_CAP) { atomicAdd(&(bar)[XB_TMO], 1u); break; } } } } while (0)
struct XcdBarrier { unsigned* bar; unsigned x; volatile LAS unsigned* st; };
__device__ __forceinline__ XcdBarrier xcd_barrier_post(unsigned* bar, volatile LAS unsigned* st) {
    XcdBarrier b; b.bar = bar; b.x = xb_xcc_id(); b.st = st;
    if (threadIdx.x == 0) (void)xb_add(&bar[XB_XCNT(b.x)], 1u);
    return b;
}
__device__ __forceinline__ void xcd_barrier_complete(unsigned* bar, unsigned x, unsigned& nloc, unsigned& nx) {
    const unsigned G = gridDim.x * gridDim.y * gridDim.z;
    unsigned sum, cnt, mine, sp = 0u;
    for (;;) {
        sum = 0u; cnt = 0u; mine = 0u;
#pragma unroll
        for (unsigned j = 0; j < 16; ++j) { const unsigned c = xb_ld(&bar[XB_XCNT(j)]); sum += c; cnt += (c > 0u) ? 1u : 0u; mine = (j == x) ? c : mine; }
        if (sum == G) break;
        __builtin_amdgcn_s_sleep(1);
        if ((++sp & 255u) == 0u) { if (xb_ld(&bar[XB_TMO])) break; if (sp > XB_SPIN_CAP) { atomicAdd(&bar[XB_TMO], 1u); break; } }
    }
    nloc = mine > 0u ? mine : 1u; nx = cnt > 0u ? cnt : 1u;
}
__device__ __forceinline__ void xcd_barrier(const XcdBarrier& b) {
    asm volatile("s_waitcnt vmcnt(0)" ::: "memory");
    __syncthreads();
    if (threadIdx.x == 0) {
        unsigned* bar = b.bar;
        __builtin_amdgcn_s_waitcnt(0);
        unsigned nloc = b.st[0], nx = b.st[1];
        if (nloc == 0u) { xcd_barrier_complete(bar, b.x, nloc, nx); b.st[0] = nloc; b.st[1] = nx; }
        const unsigned old = xb_add(&bar[XB_XSUB(b.x)], 1u);
        const unsigned gen = old / nloc;
        if (old + 1u == (gen + 1u) * nloc) {
            __builtin_amdgcn_fence(__ATOMIC_RELEASE, "agent");
            asm volatile("s_waitcnt vmcnt(0)" ::: "memory");
            const unsigned og = xb_add(&bar[XB_TOP], 1u);
            const unsigned tg = og / nx;
            if (og + 1u == (tg + 1u) * nx) xb_add(&bar[XB_TOPGEN], 1u);
            else XB_SPIN(xb_ld(&bar[XB_TOPGEN]) == tg, bar);
            __builtin_amdgcn_fence(__ATOMIC_ACQUIRE, "agent");
            xb_add(&bar[XB_XGEN(b.x)], 1u);
            asm volatile("s_waitcnt vmcnt(0)" ::: "memory");
        } else {
            XB_SPIN(xb_ld(&bar[XB_XGEN(b.x)]) == gen, bar);
            __builtin_amdgcn_fence(__ATOMIC_ACQUIRE, "agent");
            asm volatile("s_waitcnt vmcnt(0)" ::: "memory");
        }
    }
    __syncthreads();
}

constexpr int NPH_LAYER = 7, NPH = 1 + DEPTH * NPH_LAYER;
constexpr int LDS_TAB = g8::STAGE_BYTES, LDS_BARW = g8::STAGE_BYTES + 2048, LDS_KX = g8::STAGE_BYTES + 4096, LDS_BYTES = g8::STAGE_BYTES + 4096 + 8192;
__global__ void __launch_bounds__(512, 2) mega(Params p) {
    extern __shared__ __attribute__((aligned(16))) unsigned char lds_raw[];
    float* lds = (float*)lds_raw;
    LAS unsigned char* ldsl = (LAS unsigned char*)lds_raw;
    MoeTab* mt = (MoeTab*)(lds_raw + LDS_TAB);
    Ctx c0; c0.in.p = p.in; c0.in.z = 0; c0.out = p.out; c0.ws = p.ws;
    const int lo = p.ph_lo, hi = p.ph_hi;
    if (threadIdx.x == 0) *(uint4*)(lds_raw + LDS_BARW) = make_uint4(0u, 0u, 0u, 0u);
    __syncthreads();
    XcdBarrier bar = xcd_barrier_post(c0.ctl(), (volatile LAS unsigned*)(ldsl + LDS_BARW));
#ifndef PH_MASK
#define PH_MASK 0x1ff
#endif
#define PHT(k) ((k) == 0 ? 0 : 1 + ((k) - 1) % NPH_LAYER)
#define IN(k) (((PH_MASK >> PHT(k)) & 1) && lo <= (k) && (k) < hi)
#define SEAM(k) do { if (IN(k) && IN((k) + 1)) xcd_barrier(bar); } while (0)
#ifndef PROBE_RSH
#define PROBE_RSH 0
#endif
#ifndef PROBE_DUP
#define PROBE_DUP 0x0
#endif
#define REP(k) for (int rep_ = 0; rep_ < (((PROBE_DUP >> PHT(k)) & 1) ? 2 : 1); ++rep_)
    REP(0) if (IN(0)) { if (rep_) xcd_barrier(bar); const Ctx c = octx(c0); phase_convert(c, lds); phase_norm_in(c, 0); }
    SEAM(0);
#define LAYER_BODY(l) { \
        const int pb = 1 + l * NPH_LAYER; \
        REP(pb + 0) if (IN(pb + 0)) { if (rep_) xcd_barrier(bar); const Ctx c = octx(c0); const bool split_ = (gridDim.x == 256); \
            constexpr bool f8_ = f8in(l); constexpr int ku_ = f8_ ? DM / 2 : DM, ld_ = pb_in(l) / 2;        \
            { g8::DenseOrder S; S.init(T, DIN, gridDim.x, obid(), c.WIN(l), ld_); if (split_) S.lim = 1280; g8::MEpiProjT<f8_> E{c.PROJ(), c.VT(), (LAS float*)(ldsl + LDS_KX), c.in[11] + l * HD, c.in[12] + l * HD}; g8::gemm_mfma(ldsl, c.HB(), ld_, ld_, ku_, S, E); } \
            if (split_) { const int cb_ = obid(), kq_ = cb_ & 3; int k4_ = ku_ / 4; asm volatile("" : "+s"(k4_)); g8::SplitKOrder S{cb_, (const char*)(c.WIN(l) + (size_t)(20 * 256) * ld_ + kq_ * (ku_ / 4))}; g8::MEpiPartT<f8_> E{c.PT(), (LAS float*)(ldsl + LDS_KX)}; g8::gemm_mfma(ldsl, c.HB() + kq_ * (ku_ / 4), ld_, ld_, k4_, S, E); } } \
        SEAM(pb + 0); \
        REP(pb + 1) if (IN(pb + 1)) { if (rep_) xcd_barrier(bar); const Ctx c = octx(c0); if (gridDim.x == 256) phase_vreduce(c); phase_convb(c, l); if (PROBE_SUB == 4) phase_convb(c, l); phase_lruA(c, l, lds_raw); if (PROBE_SUB == 3) phase_lruA(c, l, lds_raw); } \
        SEAM(pb + 1); \
        REP(pb + 2) if (IN(pb + 2)) { if (rep_) xcd_barrier(bar); const Ctx c = octx(c0); phase_lruB(c, l, lds_raw); if (PROBE_SUB == 2) phase_lruB(c, l, lds_raw); phase_attn(c, l, lds_raw); if (PROBE_SUB == 1) phase_attn(c, l, lds_raw); } \
        SEAM(pb + 2); \
        REP(pb + 3) if (IN(pb + 3)) { if (rep_) xcd_barrier(bar); const Ctx c = octx(c0); g8::DenseOrder S; S.init(T, DM, gridDim.x, obid(), c.WOUT(l), DM); if (PROBE_RSH == 3 && l == 0) S.rsh = 1; g8::MEpiOut<l == 0> E{c.in[0], c.XB(), c.X1(), c.X1F8()}; g8::gemm_mfma(ldsl, c.YMIX(), DM, DM, DM, S, E);       } \
        SEAM(pb + 3); \
        REP(pb + 4) if (IN(pb + 4)) { if (rep_) xcd_barrier(bar); const Ctx c = octx(c0); phase_router_mfma(c, l, lds); } \
        SEAM(pb + 4); \
        REP(pb + 5) if (IN(pb + 5)) { if (rep_) xcd_barrier(bar); const Ctx c = octx(c0); build_moe_tab(c, l, mt); \
            const int G_ = (int)gridDim.x, cb_ = obid(), n1_ = __builtin_amdgcn_readfirstlane(mt->tstart[NEXP]) * 4, R_ = n1_ % G_, n1e_ = n1_ - R_, rtA_ = n1e_ >> 2; \
            { g8::MoeOrder<true, 4, DM / 2, (size_t)1024 * DM, (size_t)256 * DM> S{mt, c.LIST(), G_, cb_, (const char*)c.WGU(l)}; g8::MEpiGU E{c.HID8(), c.LISTR(), mt, c.RTC(l), n1e_}; g8::gemm_mfma(ldsl, (const bf16_t*)c.X1F8(), DM / 2, DM / 2, DM / 2, S, E); }       \
            g8::moe_wait_dep(c.RTC(l), cb_, G_, R_, rtA_); \
            { g8::MoeOrder2 S{mt, G_, cb_, R_, rtA_, (const char*)c.WD(l)}; if (PROBE_RSH == 6) S.rsh = 1; g8::MEpiDown8 E{c.YPAD8()}; int k2_ = DEXP / 2; asm volatile("" : "+s"(k2_)); g8::gemm_mfma(ldsl, (const bf16_t*)c.HID8(), DEXP / 2, DEXP / 2, k2_, S, E); } }       \
        SEAM(pb + 5); \
        REP(pb + 6) if (IN(pb + 6)) { if (rep_) xcd_barrier(bar); const Ctx c = octx(c0); build_moe_tab(c, l, mt); if (PROBE_SUB == 6) { phase_combine<true>(c, l, mt); xcd_barrier(bar); } phase_combine<false>(c, l, mt); } \
        SEAM(pb + 6); \
    }
    LAYER_BODY(0)
    LAYER_BODY(1)
#undef LAYER_BODY
#undef IN
#undef SEAM
}

#ifndef N_LAUNCH_SPLIT
#define N_LAUNCH_SPLIT 0
#endif
extern "C" void kernel_launch(void* const* d_in, const int* in_sizes, int n_in, void* d_out, int out_size, void* d_ws, size_t ws_size, hipStream_t stream) {
    static int grid = 0;
    if (grid == 0) {
        if (n_in != 23 || out_size != T * DM || ws_size < WS_END) { fprintf(stderr, "kernel_launch: unexpected problem (n_in %d out %d ws %zu need %zu)\n", n_in, out_size, ws_size, (size_t)WS_END); grid = -1; return; }
        int dev = 0, cus = 0, per_cu = 0;
        if (hipGetDevice(&dev) != hipSuccess || hipDeviceGetAttribute(&cus, hipDeviceAttributeMultiprocessorCount, dev) != hipSuccess) { fprintf(stderr, "kernel_launch: device query failed\n"); grid = -1; return; }
        if (hipFuncSetAttribute((const void*)mega, hipFuncAttributeMaxDynamicSharedMemorySize, LDS_BYTES) != hipSuccess) { fprintf(stderr, "kernel_launch: hipFuncSetAttribute failed\n"); grid = -1; return; }
        if (hipOccupancyMaxActiveBlocksPerMultiprocessor(&per_cu, (const void*)mega, 512, LDS_BYTES) != hipSuccess || per_cu < 1) { fprintf(stderr, "kernel_launch: occupancy query says %d blocks per CU\n", per_cu); }
        (void)hipGetLastError();
        grid = cus;
    }
    if (grid < 0) return;
    (void)hipMemsetAsync((char*)d_ws + OFF_CTL, 0, SZ_CTL, stream);
    Params p{};
    for (int i = 0; i < 23; ++i) p.in[i] = (const float*)d_in[i];
    p.out = (float*)d_out; p.ws = (unsigned char*)d_ws;
    if (N_LAUNCH_SPLIT) { for (int ph = 0; ph < NPH; ++ph) { p.ph_lo = ph; p.ph_hi = ph + 1; hipLaunchKernelGGL(mega, dim3(grid), dim3(512), LDS_BYTES, stream, p); } }
    else { p.ph_lo = 0; p.ph_hi = NPH; hipLaunchKernelGGL(mega, dim3(grid), dim3(512), LDS_BYTES, stream, p); }
}
```

```cpp
#include <hip/hip_runtime.h>
#include <stdint.h>
#include <stdio.h>

typedef unsigned short bf16_t;
typedef float f32x4 __attribute__((ext_vector_type(4)));
typedef unsigned u32x4 __attribute__((ext_vector_type(4)));
typedef unsigned u32x2 __attribute__((ext_vector_type(2)));
typedef short bf16x8 __attribute__((ext_vector_type(8)));

constexpr int T = 16384, DM = 2048, DIN = 5376, DPROJ = 4608, SEQ = 4096, NB = 4, DEPTH = 2;
constexpr int DLRU = 768, DCONV = 512, DSB = 768, HD = 128, NHL = 6, NHS = 6;
constexpr int NEXP = 32, DEXP = 512, MAXTILES = 160, PADROWS = MAXTILES * 256;
constexpr float EPS = 1e-6f;
constexpr float YSCALE_G = 8.0f;
constexpr float SX8 = 8.0f, SW1 = 64.0f, SH8 = 8.0f, SW2 = 32.0f;
#ifndef F8_INPROJ_MASK
#define F8_INPROJ_MASK 2
#endif
constexpr bool f8in(int l) { return ((F8_INPROJ_MASK >> l) & 1) != 0; }
constexpr float SHB = 16.0f, SWI = 64.0f;
#ifndef PITCH_PAD
#define PITCH_PAD 128
#endif
constexpr int pb_in(int l) { return (f8in(l) ? DM : DM * 2) + PITCH_PAD; }
constexpr int VTS = SEQ + 64;
constexpr int C_XA = 0, C_GA = 768, C_BG = 1536, C_CG = 2048, C_XB = 2560, C_Q = 3072, C_K = 3840, C_V = 4608;

constexpr size_t AL(size_t x) { return (x + 255) & ~(size_t)255; }
constexpr size_t SZ_WIN = (size_t)DIN * (DM * 2 + 256), SZ_WOUT = (size_t)DM * DM * 2, SZ_WGU = (size_t)NEXP * 1024 * DM * 2, SZ_WD = (size_t)NEXP * DM * DEXP * 2;
constexpr size_t SZ_WA = (size_t)NHL * HD * HD * 2, SZ_WR = (size_t)48 * DM * 4;
constexpr size_t OFF_CTL = 0, SZ_CTL = 131072;
constexpr size_t OFF_WIN = OFF_CTL + SZ_CTL;
constexpr size_t OFF_WOUT = OFF_WIN + DEPTH * SZ_WIN;
constexpr size_t OFF_WGU = OFF_WOUT + DEPTH * SZ_WOUT;
constexpr size_t OFF_WD = OFF_WGU + DEPTH * SZ_WGU;
constexpr size_t OFF_WA = OFF_WD + DEPTH * SZ_WD;
constexpr size_t OFF_WX = OFF_WA + DEPTH * SZ_WA;
constexpr size_t OFF_WR = OFF_WX + DEPTH * SZ_WA;
constexpr size_t OFF_HB = OFF_WR + DEPTH * SZ_WR;
constexpr size_t OFF_PROJ = OFF_HB + (size_t)T * (DM * 2 + 256);
constexpr size_t OFF_VT = OFF_PROJ + (size_t)T * DPROJ * 2;
constexpr size_t OFF_YPAD = OFF_PROJ;
constexpr size_t OFF_YMIX = OFF_VT + (size_t)NB * NHS * HD * VTS * 2;
constexpr size_t OFF_X = OFF_YMIX + (size_t)T * DM * 2;
constexpr size_t OFF_HID = OFF_X + (size_t)T * DM * 4;
constexpr size_t OFF_AGG = OFF_HID + (size_t)PADROWS * DEXP * 2;
constexpr size_t OFF_ROUTE = OFF_AGG + (size_t)256 * DLRU * 8;
constexpr size_t OFF_LIST = OFF_ROUTE + (size_t)T * 8 * 4;
constexpr size_t OFF_LISTR = OFF_LIST + (size_t)NEXP * T * 4;
constexpr size_t OFF_DB = OFF_LISTR + (size_t)NEXP * T * 4;
constexpr size_t WS_END = OFF_DB + (size_t)T * DM * 2;
static_assert((size_t)PADROWS * DM * 2 <= (size_t)T * DPROJ * 2 + (size_t)NB * NHS * HD * VTS * 2, "YPAD alias");
constexpr int CW_RT = 16384;
constexpr int CW_CNT = 8192;

typedef __bf16 bf16v2_t __attribute__((ext_vector_type(2)));
typedef float f32v2_t __attribute__((ext_vector_type(2)));
__device__ __forceinline__ unsigned cvt_pk_bf16(float lo, float hi) { const f32v2_t f = {lo, hi}; const bf16v2_t b = __builtin_convertvector(f, bf16v2_t); return __builtin_bit_cast(unsigned, b); }
__device__ __forceinline__ bf16_t f2bf(float f) { return (bf16_t)(cvt_pk_bf16(f, 0.f) & 0xffffu); }
__device__ __forceinline__ float bf2f(bf16_t b) { return __uint_as_float(((unsigned)b) << 16); }
__device__ __forceinline__ float bflo(unsigned w) { return __uint_as_float(w << 16); }
__device__ __forceinline__ float bfhi(unsigned w) { return __uint_as_float(w & 0xffff0000u); }
__device__ __forceinline__ float sat8(float v) { return __builtin_amdgcn_fmed3f(v, -448.0f, 448.0f); }
__device__ __forceinline__ float wave_sum(float v) {
#pragma unroll
    for (int o = 32; o >= 1; o >>= 1) v += __shfl_xor(v, o);
    return v;
}
__device__ __forceinline__ float fast_exp(float x) { return __builtin_amdgcn_exp2f(x * 1.4426950408889634f); }
__device__ __forceinline__ float sigmoidf_(float x) { return __builtin_amdgcn_rcpf(1.0f + fast_exp(-x)); }
__device__ __forceinline__ float one_minus_exp(float x) { const float s = -x * (1.0f + x * (0.5f + x * 0.16666667f)); const float d = 1.0f - fast_exp(x); return x > -0.02f ? s : d; }
__device__ __forceinline__ float softplusf_(float x) { return fmaxf(x, 0.f) + log1pf(__expf(-fabsf(x))); }
__device__ __forceinline__ float gelu_tanh(float x) { const float u2 = 1.5957691216057308f * (x + 0.044715f * x * x * x); return x * sigmoidf_(u2); }

__device__ __forceinline__ int otid() { int t = (int)threadIdx.x; asm volatile("" : "+v"(t)); return t; }
__device__ __forceinline__ int obid() { int b = (int)blockIdx.x; asm volatile("" : "+s"(b)); return b; }
#ifndef PROBE_SUB
#define PROBE_SUB 0
#endif
struct Params { const float* in[23]; float* out; unsigned char* ws; int ph_lo, ph_hi; };

struct InProxy { const float* const* p; int z; __device__ __forceinline__ const float* operator[](int k) const { return p[k + z]; } };
struct Ctx {
    InProxy in; float* out; unsigned char* ws;
    __device__ __forceinline__ unsigned* ctl() const { return (unsigned*)(ws + OFF_CTL); }
    __device__ __forceinline__ bf16_t* WIN(int l) const { return (bf16_t*)(ws + OFF_WIN + l * SZ_WIN); }
    __device__ __forceinline__ bf16_t* WOUT(int l) const { return (bf16_t*)(ws + OFF_WOUT + l * SZ_WOUT); }
    __device__ __forceinline__ bf16_t* WGU(int l) const { return (bf16_t*)(ws + OFF_WGU + l * SZ_WGU); }
    __device__ __forceinline__ bf16_t* WD(int l) const { return (bf16_t*)(ws + OFF_WD + l * SZ_WD); }
    __device__ __forceinline__ bf16_t* WA(int l) const { return (bf16_t*)(ws + OFF_WA + l * SZ_WA); }
    __device__ __forceinline__ bf16_t* WX(int l) const { return (bf16_t*)(ws + OFF_WX + l * SZ_WA); }
    __device__ __forceinline__ float* WR(int l) const { return (float*)(ws + OFF_WR + l * SZ_WR); }
    __device__ __forceinline__ unsigned* RTC(int l) const { return ctl() + CW_RT + l * 8192; }
    __device__ __forceinline__ unsigned* CNT(int l) const { return ctl() + CW_CNT + l * 2048; }
#define WSP(name, type, off) __device__ __forceinline__ type* name() const { return (type*)(ws + (off)); }
    WSP(HB, bf16_t, OFF_HB) WSP(PROJ, bf16_t, OFF_PROJ) WSP(VT, bf16_t, OFF_VT) WSP(YPAD, bf16_t, OFF_YPAD) WSP(YPAD8, unsigned char, OFF_YPAD) WSP(YMIX, bf16_t, OFF_YMIX) WSP(HID, bf16_t, OFF_HID)
    WSP(X, float, OFF_X) WSP(XB, bf16_t, OFF_X) WSP(AGG, float, OFF_AGG) WSP(ROUTE, unsigned, OFF_ROUTE) WSP(LIST, int, OFF_LIST) WSP(LISTR, float, OFF_LISTR) WSP(PT, bf16_t, OFF_X + (size_t)T * DM * 2) WSP(X1, bf16_t, OFF_X + (size_t)T * DM * 2) WSP(X1F8, unsigned char, OFF_HB) WSP(HID8, unsigned char, OFF_HID) WSP(DB, bf16_t, OFF_DB) WSP(HL, bf16_t, OFF_DB) WSP(PL, bf16_t, OFF_DB + (size_t)T * DLRU * 2)
#undef WSP
};

__device__ __forceinline__ Ctx octx(const Ctx& c) { int z = 0; asm volatile("" : "+s"(z)); Ctx r; r.in.p = c.in.p; r.in.z = z; r.out = c.out + z; r.ws = c.ws + z; return r; }

__device__ __forceinline__ void cvt_tile_out(const float* tile, int st, int r0, bf16_t* dst, int ld_dst, int drow0, bool f8) {
    const int rr = (st & 7) * 8;
    if (f8) {
#pragma unroll
        for (int p = 0; p < 2; ++p) {
            const int c = (st >> 3) + 32 * p; int w0 = 0, w1 = 0;
            w0 = __builtin_amdgcn_cvt_pk_fp8_f32(tile[(rr + 0) * 65 + c], tile[(rr + 1) * 65 + c], w0, false); w0 = __builtin_amdgcn_cvt_pk_fp8_f32(tile[(rr + 2) * 65 + c], tile[(rr + 3) * 65 + c], w0, true);
            w1 = __builtin_amdgcn_cvt_pk_fp8_f32(tile[(rr + 4) * 65 + c], tile[(rr + 5) * 65 + c], w1, false); w1 = __builtin_amdgcn_cvt_pk_fp8_f32(tile[(rr + 6) * 65 + c], tile[(rr + 7) * 65 + c], w1, true);
            *(u32x2*)((unsigned char*)dst + (size_t)(drow0 + c) * ld_dst + r0 + rr) = (u32x2){(unsigned)w0, (unsigned)w1};
        }
        return;
    }
#pragma unroll
    for (int p = 0; p < 2; ++p) {
        const int c = (st >> 3) + 32 * p;
        u32x4 w;
        w.x = cvt_pk_bf16(tile[(rr + 0) * 65 + c], tile[(rr + 1) * 65 + c]); w.y = cvt_pk_bf16(tile[(rr + 2) * 65 + c], tile[(rr + 3) * 65 + c]);
        w.z = cvt_pk_bf16(tile[(rr + 4) * 65 + c], tile[(rr + 5) * 65 + c]); w.w = cvt_pk_bf16(tile[(rr + 6) * 65 + c], tile[(rr + 7) * 65 + c]);
        *(u32x4*)(dst + (size_t)(drow0 + c) * ld_dst + r0 + rr) = w;
    }
}
constexpr int CV_WIN = 32 * 84, CV_WOUT = 32 * 32, CV_EXP = 32 * 8  , CV_G = NEXP * CV_EXP, CV_LRU = NHL * 4;
constexpr int CV_PER_LAYER = CV_WIN + CV_WOUT + 3 * CV_G + 2 * CV_LRU;
struct CvtTile { const float* src; bf16_t* dst; const float* gk; int ld_src, ld_dst, r0, c0, drow0; float sc; };
__device__ __forceinline__ void cvt_decode(const Ctx& c, int id, CvtTile& t) {
    const int l = id / CV_PER_LAYER; int j = id % CV_PER_LAYER; t.gk = nullptr; t.sc = 1.0f;
    if (j < CV_WIN) { t.src = c.in[2] + (size_t)l * DM * DIN; t.ld_src = DIN; { const int g = j >> 3, kp = g / 21, nq = g % 21; t.r0 = (2 * kp + ((j >> 2) & 1)) * 64; t.c0 = (4 * nq + (j & 3)) * 64; } t.dst = c.WIN(l); t.ld_dst = f8in(l) ? pb_in(l) : pb_in(l) / 2; t.drow0 = t.c0; if (f8in(l)) t.sc = -SWI; }
    else if ((j -= CV_WIN) < CV_WOUT) { t.src = c.in[14] + (size_t)l * DM * DM; t.ld_src = DM; { const int g = j >> 3, kp = g / 8, nq = g % 8; t.r0 = (2 * kp + ((j >> 2) & 1)) * 64; t.c0 = (4 * nq + (j & 3)) * 64; } t.dst = c.WOUT(l); t.ld_dst = DM; t.drow0 = t.c0; }
    else if ((j -= CV_WOUT) < 2 * CV_G) {
        const int isup = j / CV_G; j %= CV_G; const int e = j / CV_EXP; j %= CV_EXP;
        t.src = c.in[isup ? 21 : 20] + ((size_t)l * NEXP + e) * DM * DEXP; t.ld_src = DEXP; { const int g = j >> 3, kp = g / 2, nq = g % 2; t.r0 = (2 * kp + ((j >> 2) & 1)) * 64; t.c0 = (4 * nq + (j & 3)) * 64; }
        t.dst = (bf16_t*)((unsigned char*)c.WGU(l) + (size_t)e * 1024 * DM); t.ld_dst = DM; t.drow0 = 256 * (t.c0 / 128) + 128 * isup + (t.c0 % 128); t.gk = c.in[15] + (size_t)l * DM; t.sc = -SW1;
    } else if ((j -= 2 * CV_G) < CV_G) {
        const int e = j / CV_EXP; j %= CV_EXP;
        t.src = c.in[22] + ((size_t)l * NEXP + e) * DEXP * DM; t.ld_src = DM; { const int g = j >> 3, kp = g / 8, nq = g % 8; t.r0 = (2 * kp + ((j >> 2) & 1)) * 64; t.c0 = (4 * nq + (j & 3)) * 64; }
        t.dst = (bf16_t*)((unsigned char*)c.WD(l) + (size_t)e * DM * DEXP); t.ld_dst = DEXP; t.drow0 = t.c0; t.sc = -SW2;
    } else { j -= CV_G; const int isx = j / CV_LRU; j %= CV_LRU; const int h = j / 4; j %= 4;
        t.src = c.in[isx ? 7 : 5] + ((size_t)l * NHL + h) * HD * HD; t.ld_src = HD; t.r0 = (j / 2) * 64; t.c0 = (j % 2) * 64;
        t.dst = (isx ? c.WX(l) : c.WA(l)) + (size_t)h * HD * HD; t.ld_dst = HD; t.drow0 = t.c0; }
}
constexpr int CVT_NT = 4;
__device__ __forceinline__ void phase_convert(const Ctx& c, float* lds) {
    const int tid = otid(), sb = __builtin_amdgcn_readfirstlane(tid >> 8), st = tid & 255;
    float* tile0 = lds + sb * (CVT_NT * 64 * 65);
    const int total = DEPTH * CV_PER_LAYER;
    const int nsub = gridDim.x * 2 * CVT_NT;
    const int idb = (obid() * 2 + sb) * CVT_NT;
    CvtTile tA[CVT_NT], tB[CVT_NT]; f32x4 vA[CVT_NT][4], vB[CVT_NT][4]; float gA[CVT_NT][4], gB[CVT_NT][4];
#define CVT_LOAD(T_, V_, G_, base_) do { _Pragma("unroll") for (int k = 0; k < CVT_NT; ++k) { const int id_ = (base_) + idb + k; cvt_decode(c, id_ < total ? id_ : 0, T_[k]); \
        _Pragma("unroll") for (int i = 0; i < 4; ++i) { V_[k][i] = __builtin_nontemporal_load((const f32x4*)(T_[k].src + (size_t)(T_[k].r0 + (st >> 4) + 16 * i) * T_[k].ld_src + T_[k].c0 + (st & 15) * 4)); \
            G_[k][i] = T_[k].gk ? T_[k].gk[T_[k].r0 + (st >> 4) + 16 * i] : 1.0f; } } } while (0)
#define CVT_FLUSH(T_, V_, G_, base_) do { _Pragma("unroll") for (int k = 0; k < CVT_NT; ++k) _Pragma("unroll") for (int i = 0; i < 4; ++i) { \
            float* p = tile0 + k * (64 * 65) + ((st >> 4) + 16 * i) * 65 + (st & 15) * 4; const float gs_ = G_[k][i] * fabsf(T_[k].sc); \
            p[0] = V_[k][i][0] * gs_; p[1] = V_[k][i][1] * gs_; p[2] = V_[k][i][2] * gs_; p[3] = V_[k][i][3] * gs_; } \
        __syncthreads(); \
        _Pragma("unroll") for (int k = 0; k < CVT_NT; ++k) if ((base_) + idb + k < total) cvt_tile_out(tile0 + k * (64 * 65), st, T_[k].r0, T_[k].dst, T_[k].ld_dst, T_[k].drow0, T_[k].sc < 0.f); \
        __syncthreads(); } while (0)
    CVT_LOAD(tA, vA, gA, 0);
    for (int base = 0; base < total; base += 2 * nsub) {
        CVT_LOAD(tB, vB, gB, base + nsub); __builtin_amdgcn_sched_barrier(0);
        CVT_FLUSH(tA, vA, gA, base);
        CVT_LOAD(tA, vA, gA, base + 2 * nsub); __builtin_amdgcn_sched_barrier(0);
        CVT_FLUSH(tB, vB, gB, base + nsub);
    }
#undef CVT_LOAD
#undef CVT_FLUSH
    for (int i = obid() * blockDim.x + tid; i < DEPTH * 48 * DM; i += gridDim.x * blockDim.x) {
        const int l = i / (48 * DM), n = (i / DM) % 48, k = i % DM;
        float v = 0.f;
        if (n < 4) v = c.in[16][((size_t)l * DM + k) * 4 + n]; else if (n < 36) v = c.in[18][((size_t)l * DM + k) * 32 + (n - 4)];
        const float wg = v * c.in[15][(size_t)l * DM + k]; const bf16_t hi = f2bf(wg);
        bf16_t* wr = (bf16_t*)c.WR(l); wr[(size_t)n * DM + k] = hi; wr[(size_t)(48 + n) * DM + k] = f2bf(wg - bf2f(hi));
    }
}

__device__ __forceinline__ void norm_store_row(const f32x4 (&v)[8], const float* g, bf16_t* dst, int lane) {
    float s = 0.f;
#pragma unroll
    for (int j = 0; j < 8; ++j) s += v[j][0] * v[j][0] + v[j][1] * v[j][1] + v[j][2] * v[j][2] + v[j][3] * v[j][3];
    s = wave_sum(s);
    const float rstd = rsqrtf(s * (1.0f / DM) + EPS);
#pragma unroll
    for (int j = 0; j < 8; ++j) {
        const f32x4 gg = *(const f32x4*)(g + j * 256 + lane * 4);
        u32x2 w; w.x = cvt_pk_bf16(v[j][0] * rstd * gg[0], v[j][1] * rstd * gg[1]); w.y = cvt_pk_bf16(v[j][2] * rstd * gg[2], v[j][3] * rstd * gg[3]);
        *(u32x2*)(dst + j * 256 + lane * 4) = w;
    }
}
__device__ __forceinline__ void norm_store_row8(const f32x4 (&v)[8], const float* g, unsigned char* dst, int lane) {
    float s = 0.f;
#pragma unroll
    for (int j = 0; j < 8; ++j) s += v[j][0] * v[j][0] + v[j][1] * v[j][1] + v[j][2] * v[j][2] + v[j][3] * v[j][3];
    s = wave_sum(s);
    const float rstd = rsqrtf(s * (1.0f / DM) + EPS) * SHB;
#pragma unroll
    for (int j = 0; j < 8; ++j) {
        const f32x4 gg = *(const f32x4*)(g + j * 256 + lane * 4);
        int w = 0; w = __builtin_amdgcn_cvt_pk_fp8_f32(sat8(v[j][0] * rstd * gg[0]), sat8(v[j][1] * rstd * gg[1]), w, false); w = __builtin_amdgcn_cvt_pk_fp8_f32(sat8(v[j][2] * rstd * gg[2]), sat8(v[j][3] * rstd * gg[3]), w, true);
        *(int*)(dst + j * 256 + lane * 4) = w;
    }
}
__device__ __forceinline__ void phase_norm_in(const Ctx& c, int l) {
    const int tid = otid(), lane = tid & 63, wv = tid >> 6, stride = gridDim.x * 8;
    for (int r = obid() * 8 + wv; r < T; r += 4 * stride) {
        f32x4 v[4][8];
#pragma unroll
        for (int k = 0; k < 4; ++k) { const int rr = (r + k * stride < T) ? r + k * stride : r;
#pragma unroll
            for (int j = 0; j < 8; ++j) v[k][j] = *(const f32x4*)(c.in[0] + (size_t)rr * DM + j * 256 + lane * 4); }
#pragma unroll
        for (int k = 0; k < 4; ++k) if (k == 0 || r + k * stride < T) norm_store_row(v[k], c.in[1] + (size_t)l * DM, (bf16_t*)((unsigned char*)c.HB() + (size_t)(r + k * stride) * pb_in(0)), lane);
    }
}

struct MoeTab { int cnt[NEXP]; int tstart[NEXP + 1]; int texp[MAXTILES]; };
__device__ __forceinline__ void build_moe_tab(const Ctx& c, int l, MoeTab* mt) {
    __syncthreads();
    const int tid = otid();
    if (tid < 64) {
        const int n = tid < NEXP ? (int)__hip_atomic_load(c.CNT(l) + tid * 64, __ATOMIC_RELAXED, __HIP_MEMORY_SCOPE_AGENT) : 0;
        const int nt = (n + 255) >> 8;
        int incl = nt;
#pragma unroll
        for (int o = 1; o < 32; o <<= 1) { const int v = __shfl_up(incl, o); if (tid >= o) incl += v; }
        const int excl = incl - nt;
        if (tid < NEXP) { mt->cnt[tid] = n; mt->tstart[tid] = excl; for (int i = 0; i < nt; ++i) if (excl + i < MAXTILES) mt->texp[excl + i] = tid; }
        if (tid == NEXP - 1) mt->tstart[NEXP] = incl < MAXTILES ? incl : MAXTILES;
    }
    __syncthreads();
}

template <bool DRY> __device__ __forceinline__ void phase_combine(const Ctx& c, int l, const MoeTab* mt) {
    const int tid = otid(), lane = tid & 63, wv = tid >> 6, stride = gridDim.x * 8;
    bf16_t* XB = c.XB(); const bf16_t* X1 = c.X1(); const unsigned char* YPAD = c.YPAD8(); const unsigned* ROUTE = c.ROUTE();
    for (int r = obid() * 8 + wv; r < T; r += 2 * stride) {
        f32x4 v[2][8]; unsigned ya[2][8], yb[2][8]; u32x2 yd[2][8]; float g0[2], g1[2]; int rr[2];
#pragma unroll
        for (int k = 0; k < 2; ++k) {
            rr[k] = (r + k * stride < T) ? r + k * stride : r;
            const u32x4 ra = *(const u32x4*)(ROUTE + (size_t)rr[k] * 8); const u32x2 rb = *(const u32x2*)(ROUTE + (size_t)rr[k] * 8 + 4);
            const int e0 = ra.x, p0 = ra.y, e1 = ra.w, p1 = rb.x; g0[k] = __uint_as_float(ra.z) * (1.0f / YSCALE_G); g1[k] = __uint_as_float(rb.y) * (1.0f / YSCALE_G);
            const unsigned char* y0 = YPAD + ((size_t)mt->tstart[e0] * 256 + p0) * DM + lane * 4; const unsigned char* y1 = YPAD + ((size_t)mt->tstart[e1] * 256 + p1) * DM + lane * 4;
            const bf16_t* dp = X1 + (size_t)rr[k] * DM + lane * 4;
#pragma unroll
            for (int j = 0; j < 8; ++j) { v[k][j] = (f32x4){0.f, 0.f, 0.f, 0.f};
                ya[k][j] = *(const unsigned*)(y0 + j * 256); yb[k][j] = *(const unsigned*)(y1 + j * 256); yd[k][j] = *(const u32x2*)(dp + j * 256); }
        }
        __builtin_amdgcn_sched_barrier(0);
#pragma unroll
        for (int k = 0; k < 2; ++k) {
            if (k == 0 || r + stride < T) {
#pragma unroll
                for (int j = 0; j < 8; ++j) {
                    typedef float f32x2_t __attribute__((ext_vector_type(2)));
                    const f32x2_t a01 = __builtin_amdgcn_cvt_pk_f32_fp8((int)ya[k][j], false), a23 = __builtin_amdgcn_cvt_pk_f32_fp8((int)ya[k][j], true);
                    const f32x2_t b01 = __builtin_amdgcn_cvt_pk_f32_fp8((int)yb[k][j], false), b23 = __builtin_amdgcn_cvt_pk_f32_fp8((int)yb[k][j], true);
                    v[k][j][0] += bflo(yd[k][j].x) + g0[k] * a01.x + g1[k] * b01.x; v[k][j][1] += bfhi(yd[k][j].x) + g0[k] * a01.y + g1[k] * b01.y;
                    v[k][j][2] += bflo(yd[k][j].y) + g0[k] * a23.x + g1[k] * b23.x; v[k][j][3] += bfhi(yd[k][j].y) + g0[k] * a23.y + g1[k] * b23.y;
                }
                if (l == DEPTH - 1) {
                    if (!DRY) {
#pragma unroll
                    for (int j = 0; j < 8; ++j) *(f32x4*)(c.out + (size_t)rr[k] * DM + j * 256 + lane * 4) = v[k][j]; }
                    else norm_store_row(v[k], c.in[1], c.HB() + (size_t)rr[k] * DM, lane);
                } else {
                    if (!DRY) {
#pragma unroll
                    for (int j = 0; j < 8; ++j) { u32x2 xw; xw.x = cvt_pk_bf16(v[k][j][0], v[k][j][1]); xw.y = cvt_pk_bf16(v[k][j][2], v[k][j][3]); *(u32x2*)(XB + (size_t)rr[k] * DM + j * 256 + lane * 4) = xw; } }
                    if (f8in(l + 1)) norm_store_row8(v[k], c.in[1] + (size_t)(l + 1) * DM, (unsigned char*)c.HB() + (size_t)rr[k] * pb_in(l + 1), lane);
                    else norm_store_row(v[k], c.in[1] + (size_t)(l + 1) * DM, (bf16_t*)((unsigned char*)c.HB() + (size_t)rr[k] * pb_in(l + 1)), lane);
                }
            }
        }
    }
}

__device__ __forceinline__ void phase_router_mfma(const Ctx& c, int l, float* lds) {
    float* LG = lds; float* SS = lds + 26624; float* RS = lds + 27136; int* LC = (int*)(lds + 27200); int* LB = (int*)(lds + 27232);
    const int tid = otid(), lane = tid & 63, wv = tid >> 6, rt = wv & 3, kh = wv >> 2, q = lane >> 4, l15 = lane & 15;
    const float* WR = c.WR(l);
    for (int tile = obid(); tile < T / 64; tile += gridDim.x) {
        const int r0 = tile * 64;
        f32x4 acc[4][3];
#pragma unroll
        for (int g = 0; g < 4; ++g)
#pragma unroll
            for (int ct = 0; ct < 3; ++ct) acc[g][ct] = (f32x4){0.f, 0.f, 0.f, 0.f};
        const bf16_t* xp = c.X1() + (size_t)(r0 + l15) * DM + wv * 256 + 8 * q;
        const bf16_t* wh = (const bf16_t*)WR + (size_t)l15 * DM + wv * 256 + 8 * q; const bf16_t* wl = wh + (size_t)48 * DM;
        float ssq[4] = {0.f, 0.f, 0.f, 0.f};
        bf16x8 xa[2][4], bh[2][3], bl[2][3];
#pragma unroll
        for (int st = 0; st < 2; ++st)
#pragma unroll
            for (int g = 0; g < 4; ++g) xa[st][g] = *(const bf16x8*)(xp + (size_t)(16 * g) * DM + 32 * st);
#pragma unroll
        for (int ct = 0; ct < 3; ++ct) { bh[0][ct] = *(const bf16x8*)(wh + (size_t)(16 * ct) * DM); bl[0][ct] = *(const bf16x8*)(wl + (size_t)(16 * ct) * DM); }
#define RT_STEP(st_, cur_, nxt_, ldb_, ldx_) do { \
            if (ldb_) { _Pragma("unroll") for (int ct = 0; ct < 3; ++ct) { bh[nxt_][ct] = *(const bf16x8*)(wh + (size_t)(16 * ct) * DM + 32 * ((st_) + 1)); bl[nxt_][ct] = *(const bf16x8*)(wl + (size_t)(16 * ct) * DM + 32 * ((st_) + 1)); } } \
            __builtin_amdgcn_sched_barrier(0); \
            _Pragma("unroll") for (int g = 0; g < 4; ++g) { \
                const bf16x8 xv = xa[cur_][g]; \
                _Pragma("unroll") for (int j = 0; j < 8; ++j) { const float xf = __uint_as_float(((unsigned)(unsigned short)xv[j]) << 16); ssq[g] += xf * xf; } \
                _Pragma("unroll") for (int ct = 0; ct < 3; ++ct) { acc[g][ct] = __builtin_amdgcn_mfma_f32_16x16x32_bf16(xv, bh[cur_][ct], acc[g][ct], 0, 0, 0); acc[g][ct] = __builtin_amdgcn_mfma_f32_16x16x32_bf16(xv, bl[cur_][ct], acc[g][ct], 0, 0, 0); } \
                if (ldx_) xa[cur_][g] = *(const bf16x8*)(xp + (size_t)(16 * g) * DM + 32 * ((st_) + 2)); } \
            __builtin_amdgcn_sched_barrier(0); } while (0)
#pragma unroll 1
        for (int sp = 0; sp < 4; ++sp) {
            RT_STEP(2 * sp, 0, 1, true, sp < 3);
            RT_STEP(2 * sp + 1, 1, 0, sp < 3, sp < 3);
        }
#undef RT_STEP
#pragma unroll
        for (int g = 0; g < 4; ++g) { float v = ssq[g]; v += __shfl_xor(v, 16); v += __shfl_xor(v, 32); if (q == 0) SS[wv * 64 + 16 * g + l15] = v; }
#pragma unroll
        for (int g = 0; g < 4; ++g)
#pragma unroll
            for (int ct = 0; ct < 3; ++ct)
#pragma unroll
                for (int i = 0; i < 4; ++i) LG[(wv * 64 + 16 * g + 4 * q + i) * 52 + 16 * ct + l15] = acc[g][ct][i];
        if (tid < NEXP) LC[tid] = 0;
        __syncthreads();
        int e0 = 0, e1 = 0, k0_ = 0, k1_ = 0; float rstd_ = 0.f, g0_ = 0.f, g1_ = 0.f;
        if (tid < 64) {
            float sst_ = 0.f;
#pragma unroll
            for (int w = 0; w < 8; ++w) sst_ += SS[w * 64 + tid];
            const float rstd = rsqrtf(sst_ * (1.0f / DM) + EPS);
            RS[tid] = rstd;
            float gl[4], el[8];
#pragma unroll
            for (int i = 0; i < 4; ++i) { float a_ = 0.f;
#pragma unroll
                for (int w = 0; w < 8; ++w) a_ += LG[(w * 64 + tid) * 52 + i];
                gl[i] = a_ * rstd + c.in[17][l * 4 + i]; }
            int gi = 0; float gm = gl[0];
#pragma unroll
            for (int i = 1; i < 4; ++i) if (gl[i] > gm) { gm = gl[i]; gi = i; }
            float gs = 0.f;
#pragma unroll
            for (int i = 0; i < 4; ++i) gs += __expf(gl[i] - gm);
            const float pg = 1.0f / gs;
#pragma unroll
            for (int i = 0; i < 8; ++i) { const int n = 4 + gi * 8 + i; float a_ = 0.f;
#pragma unroll
                for (int w = 0; w < 8; ++w) a_ += LG[(w * 64 + tid) * 52 + n];
                el[i] = a_ * rstd + c.in[19][l * 32 + gi * 8 + i]; }
            int i0 = 0; float m0 = el[0];
#pragma unroll
            for (int i = 1; i < 8; ++i) if (el[i] > m0) { m0 = el[i]; i0 = i; }
            int i1 = -1; float m1 = -3.0e38f;
#pragma unroll
            for (int i = 0; i < 8; ++i) if (i != i0 && el[i] > m1) { m1 = el[i]; i1 = i; }
            const float ex1 = __expf(m1 - m0), den = 1.0f + ex1;
            const float g0 = pg / den, g1 = pg * ex1 / den;
            e0 = gi * 8 + i0; e1 = gi * 8 + i1; rstd_ = rstd; g0_ = g0; g1_ = g1;
            k0_ = (int)__hip_atomic_fetch_add(&LC[e0], 1, __ATOMIC_RELAXED, __HIP_MEMORY_SCOPE_WORKGROUP);
            k1_ = (int)__hip_atomic_fetch_add(&LC[e1], 1, __ATOMIC_RELAXED, __HIP_MEMORY_SCOPE_WORKGROUP);
        }
        __syncthreads();
        if (tid < NEXP) { const int n = LC[tid]; LB[tid] = n > 0 ? (int)__hip_atomic_fetch_add(c.CNT(l) + tid * 64, (unsigned)n, __ATOMIC_RELAXED, __HIP_MEMORY_SCOPE_AGENT) : 0; }
        __syncthreads();
        if (tid < 64) {
            const int r = r0 + tid, p0 = LB[e0] + k0_, p1 = LB[e1] + k1_;
            c.LIST()[(size_t)e0 * T + p0] = r; c.LIST()[(size_t)e1 * T + p1] = r;
            c.LISTR()[(size_t)e0 * T + p0] = rstd_; c.LISTR()[(size_t)e1 * T + p1] = rstd_;
            unsigned* ro = c.ROUTE() + (size_t)r * 8;
            *(u32x4*)ro = (u32x4){(unsigned)e0, (unsigned)p0, __float_as_uint(g0_), (unsigned)e1};
            *(u32x2*)(ro + 4) = (u32x2){(unsigned)p1, __float_as_uint(g1_)};
        }
        __syncthreads();
    }
}

#define LAS __attribute__((address_space(3)))
typedef int i32x4_t __attribute__((ext_vector_type(4)));
typedef int i32x8_t __attribute__((ext_vector_type(8)));
__device__ __forceinline__ i32x8_t cat8(const bf16x8 a, const bf16x8 b) { const i32x4_t x = __builtin_bit_cast(i32x4_t, a), y = __builtin_bit_cast(i32x4_t, b); return __builtin_shufflevector(x, y, 0, 1, 2, 3, 4, 5, 6, 7); }
__device__ __forceinline__ void mfma_f8(f32x4& acc, const i32x8_t& a, const i32x8_t& b) { asm volatile("v_mfma_f32_16x16x128_f8f6f4 %0, %1, %2, %0" : "+v"(acc) : "v"(a), "v"(b)); }
__device__ __forceinline__ bf16x8 half8(const i32x8_t& v, int k) { const i32x4_t h = k ? __builtin_shufflevector(v, v, 4, 5, 6, 7) : __builtin_shufflevector(v, v, 0, 1, 2, 3); return __builtin_bit_cast(bf16x8, h); }
namespace g8 {
constexpr int BM = 256, BK = 64, HALF = 128, HTB = HALF * BK * 2, STAGE_BYTES = 8 * HTB, NXCD = 8, WGM = 8;
__device__ __forceinline__ int lds_byte(int r, int c) { const int st = (r >> 4) * 2 + (c >> 5), rr = r & 15, cc = c & 31, ob = rr * 64 + cc * 2; return st * 1024 + (ob ^ (((ob >> 9) & 1) << 5)); }
__device__ __forceinline__ void stage_rc(int b, int& R, int& C) { const int st = b / 1024, sb = b % 1024, swz = sb ^ (((sb >> 9) & 1) << 5); R = (st >> 1) * 16 + swz / 64; C = (st & 1) * 32 + (swz % 64) / 2; }
__device__ __forceinline__ int perm32(int rho) { const int n = rho >> 4, i = rho & 15; return 8 * (i >> 2) + 4 * n + (i & 3); }
struct Unit { int pm, pn; const char* B; };
typedef f32x4 Acc[2][2][4][2];

struct DenseOrder {
    static constexpr bool GATHER = false;
    int nM, nN, nwg, G, c; const char* Bt; size_t tstrideB; int rsh = 0, lim = 0x7fffffff;
    __device__ __forceinline__ void init(int M, int N, int G_, int c_, const bf16_t* Bt_, int ldb) { nM = M / BM; nN = N / BM; nwg = nM * nN; G = G_; c = c_; Bt = (const char*)Bt_; tstrideB = (size_t)BM * ldb * 2; }
    __device__ __forceinline__ bool next(int i, Unit& u) const {
        const long L = (long)(i >> rsh) * G + c; if (L >= nwg || L >= lim) return false;
        int wgid = (int)L; { const int q = nwg / NXCD, r = nwg % NXCD, xcd = wgid % NXCD, off = wgid / NXCD; wgid = (xcd < r ? xcd * (q + 1) : r * (q + 1) + (xcd - r) * q) + off; }
        const int nig = WGM * nN, gid = wgid / nig, fm = gid * WGM, gsz = (nM - fm) < WGM ? (nM - fm) : WGM;
        u.pm = fm + ((wgid % nig) % gsz); u.pn = (wgid % nig) / gsz; u.B = Bt + (size_t)u.pn * tstrideB; return true;
    }
    __device__ __forceinline__ unsigned arow_off(int) const { return 0u; }
};
struct SplitKOrder {
    static constexpr bool GATHER = false;
    int c; const char* Bt;
    __device__ __forceinline__ bool next(int i, Unit& u) const { if (i > 0) return false; u.pm = c >> 2; u.pn = c & 3; u.B = Bt; return true; }
    __device__ __forceinline__ unsigned arow_off(int) const { return 0u; }
};
template <bool GATHER_, int NCT, int LDA, size_t ESTRIDE, size_t TSTRIDE> struct MoeOrder {
    static constexpr bool GATHER = GATHER_;
    const MoeTab* mt; const int* LIST; int G, c; const char* W; int rsh = 0;
    __device__ __forceinline__ bool next(int i, Unit& u) const {
        const int L = (i >> rsh) * G + c; const int total = __builtin_amdgcn_readfirstlane(mt->tstart[NEXP]) * NCT; if (L >= total) return false;
        const int rt = L / NCT, ct = L % NCT; u.pm = rt; u.pn = ct; const int e = __builtin_amdgcn_readfirstlane(mt->texp[rt]); u.B = W + (size_t)e * ESTRIDE + (size_t)ct * TSTRIDE; return true;
    }
    __device__ __forceinline__ unsigned arow_off(int r) const {
        const int e = mt->texp[r >> 8]; const int pos = r - mt->tstart[e] * 256; const int tok = pos < mt->cnt[e] ? LIST[(size_t)e * T + pos] : 0; return (unsigned)tok * (unsigned)(LDA * 2);
    }
};

struct MoeOrder2 {
    static constexpr bool GATHER = false;
    const MoeTab* mt; int G, c, R, rtA; const char* W; int rsh = 0;
    __device__ __forceinline__ bool next(int i0, Unit& u) const {
        const int i = i0 >> rsh; int u2;
        if (c < R) { if (i >= 2) return false; u2 = rtA * 8 + 2 * c + i; }
        else { u2 = (c - R) + i * (G - R); if (u2 >= rtA * 8) return false; }
        const int rt = u2 >> 3, ct = u2 & 7; u.pm = rt; u.pn = ct; const int e = __builtin_amdgcn_readfirstlane(mt->texp[rt]);
        u.B = W + (size_t)e * ((size_t)DM * DEXP) + (size_t)ct * ((size_t)256 * DEXP); return true;
    }
    __device__ __forceinline__ unsigned arow_off(int) const { return 0u; }
};
__device__ __forceinline__ void moe_wait_dep(unsigned* rtc, int c, int G, int R, int rtA) {
    const int tid = otid();
    if (tid < 64) {
        int rt = -1;
        if (c < R) { if (tid < 2) rt = rtA + ((2 * c + tid) >> 3); } else if (tid < 32) { const int u2 = (c - R) + tid * (G - R); if (u2 < rtA * 8) rt = u2 >> 3; }
        unsigned spins = 0;
        for (;;) {
            const bool ok = rt < 0 || __hip_atomic_load(rtc + (rt < 0 ? 0 : rt) * 32, __ATOMIC_RELAXED, __HIP_MEMORY_SCOPE_AGENT) >= 32u;
            if (__all(ok)) break;
            __builtin_amdgcn_s_sleep(2); if (++spins > (1u << 22)) break;
        }
        __builtin_amdgcn_fence(__ATOMIC_ACQUIRE, "agent");
        asm volatile("s_waitcnt vmcnt(0)" ::: "memory");
    }
    __syncthreads();
}

template <class Epi, class Sched>
__device__ __forceinline__ void gemm_mfma(LAS unsigned char* lds, const bf16_t* A, int lda, int ldb, int K, const Sched& S, const Epi& E) {
    constexpr bool GATHER = Sched::GATHER;
    const int tid = otid(), wid = __builtin_amdgcn_readfirstlane(tid >> 6), lane = tid & 63, wr = wid >> 2, wc = wid & 3, fr = lane & 15, fq = lane >> 4;
    const int nt = K / BK;
    int Rst[2], Cst[2]; unsigned voffB[2], voA[2][2], voAn[2][2];
#pragma unroll
    for (int i = 0; i < 2; ++i) { stage_rc(tid * 16 + i * 8192, Rst[i], Cst[i]); const int Rb = Epi::PERM ? ((Rst[i] & ~31) + perm32(Rst[i] & 31)) : Rst[i];
        voffB[i] = (unsigned)(Rb * ldb + Cst[i]) * 2u;
#pragma unroll
        for (int h = 0; h < 2; ++h) { voA[h][i] = (unsigned)((h * HALF + Rst[i]) * lda + Cst[i]) * 2u; voAn[h][i] = voA[h][i]; } }
    const size_t kstep = (size_t)(BK * 2), hstepB = (size_t)HALF * ldb * 2, tstepA = (size_t)BM * lda * 2;
    const unsigned ldsw = (unsigned)wid * 1024u;
    const int aoff = lds_byte(wr * 64 + fr, fq * 8), boff = lds_byte(wc * 32 + fr, fq * 8);
#define G8_SA(b, h) (((b) * 2 + (h)) * HTB)
#define G8_SB(b, h) ((4 + (b) * 2 + (h)) * HTB)
#define G8_OPQ(x) ({ unsigned _o = (x); asm volatile("" : "+v"(_o)); _o; })
#define G8_STAGE_B(bufoff, gbase) do { _Pragma("unroll") for (int _i = 0; _i < 2; ++_i) \
        __builtin_amdgcn_global_load_lds((const unsigned*)((const char*)(gbase) + G8_OPQ(voffB[_i])), (LAS unsigned*)(lds + (bufoff) + ldsw + _i * 8192), 16, 0, 0); } while (0)
#define G8_STAGE_A(bufoff, gbase, o0, o1) do { \
        __builtin_amdgcn_global_load_lds((const unsigned*)((const char*)(gbase) + G8_OPQ(o0)), (LAS unsigned*)(lds + (bufoff) + ldsw), 16, 0, 0); \
        __builtin_amdgcn_global_load_lds((const unsigned*)((const char*)(gbase) + G8_OPQ(o1)), (LAS unsigned*)(lds + (bufoff) + ldsw + 8192), 16, 0, 0); } while (0)
#define G8_LDA(dst, b, h) do { _Pragma("unroll") for (int m = 0; m < 4; ++m) dst[m] = cat8(*(const LAS bf16x8*)(lds + G8_SA(b, h) + aoff + m * 2048), *(const LAS bf16x8*)(lds + G8_SA(b, h) + aoff + m * 2048 + 1024)); } while (0)
#define G8_LDB(dst, b, h) do { _Pragma("unroll") for (int n = 0; n < 2; ++n) dst[n] = cat8(*(const LAS bf16x8*)(lds + G8_SB(b, h) + boff + n * 2048), *(const LAS bf16x8*)(lds + G8_SB(b, h) + boff + n * 2048 + 1024)); } while (0)
#define G8_MMA(ai, bj, At, Bt) do { __builtin_amdgcn_s_setprio(1); \
        if constexpr (Epi::F8) { _Pragma("unroll") for (int m = 0; m < 4; ++m) _Pragma("unroll") for (int n = 0; n < 2; ++n) \
            mfma_f8(acc[ai][bj][m][n], Bt[n], At[m]); } \
        else { _Pragma("unroll") for (int m = 0; m < 4; ++m) _Pragma("unroll") for (int n = 0; n < 2; ++n) _Pragma("unroll") for (int k = 0; k < 2; ++k) \
            acc[ai][bj][m][n] = __builtin_amdgcn_mfma_f32_16x16x32_bf16(half8(Bt[n], k), half8(At[m], k), acc[ai][bj][m][n], 0, 0, 0); } \
        __builtin_amdgcn_s_setprio(0); } while (0)
#define G8_WAIT_V(n) asm volatile("s_waitcnt vmcnt(" #n ")" ::: "memory")
#define G8_WAIT_L(n) asm volatile("s_waitcnt lgkmcnt(" #n ")" ::: "memory")
#define G8_BAR __builtin_amdgcn_s_barrier()
#define G8_SCHED __builtin_amdgcn_sched_barrier(0)
    Unit cur, nxt; int ui = 0, prev_pm = -1;
    if (!S.next(0, cur)) return;
    Acc acc;
#pragma unroll
    for (int a = 0; a < 2; ++a)
#pragma unroll
        for (int b = 0; b < 2; ++b)
#pragma unroll
            for (int m = 0; m < 4; ++m)
#pragma unroll
                for (int n = 0; n < 2; ++n) acc[a][b][m][n] = (f32x4){0.f, 0.f, 0.f, 0.f};
    i32x8_t At[4], B0[2], B1[2];
    const char* cA; const char* cB = cur.B;
    if (GATHER) { cA = (const char*)A;
#pragma unroll
        for (int h = 0; h < 2; ++h)
#pragma unroll
            for (int i = 0; i < 2; ++i) voA[h][i] = S.arow_off(cur.pm * BM + h * HALF + Rst[i]) + (unsigned)Cst[i] * 2u;
    } else cA = (const char*)A + (size_t)cur.pm * tstepA;
    G8_STAGE_B(G8_SB(0, 0), cB); G8_STAGE_A(G8_SA(0, 0), cA, voA[0][0], voA[0][1]); G8_STAGE_B(G8_SB(0, 1), cB + hstepB); G8_STAGE_A(G8_SA(0, 1), cA, voA[1][0], voA[1][1]);
    if (wr == 1) G8_BAR;
    G8_WAIT_V(4); G8_BAR;
    G8_STAGE_B(G8_SB(1, 0), cB + kstep); G8_STAGE_A(G8_SA(1, 0), cA + kstep, voA[0][0], voA[0][1]); G8_STAGE_B(G8_SB(1, 1), cB + hstepB + kstep);
    G8_WAIT_V(6); G8_BAR;
    for (;;) {
        const bool has_next = S.next(ui + 1, nxt);
        const char* nA; const char* nB = has_next ? nxt.B : cB;
        if (GATHER) { nA = cA;
            if (has_next) {
#pragma unroll
                for (int h = 0; h < 2; ++h)
#pragma unroll
                    for (int i = 0; i < 2; ++i) voAn[h][i] = S.arow_off(nxt.pm * BM + h * HALF + Rst[i]) + (unsigned)Cst[i] * 2u;
            } else {
#pragma unroll
                for (int h = 0; h < 2; ++h)
#pragma unroll
                    for (int i = 0; i < 2; ++i) voAn[h][i] = voA[h][i];
            }
        } else nA = has_next ? (const char*)A + (size_t)nxt.pm * tstepA : cA;
        for (int t = 0; t < nt; t += 2) {
            const bool last = (t == nt - 2);
            const char* a1 = cA + (size_t)(t + 1) * kstep;
            const char* a2 = last ? nA : cA + (size_t)(t + 2) * kstep; const char* b2 = last ? nB : cB + (size_t)(t + 2) * kstep;
            const char* a3 = a2 + kstep; const char* b3 = b2 + kstep;
            unsigned o00 = voA[0][0], o01 = voA[0][1], o10 = voA[1][0], o11 = voA[1][1];
            if (GATHER) { if (last) { o00 = voAn[0][0]; o01 = voAn[0][1]; o10 = voAn[1][0]; o11 = voAn[1][1]; } }
            G8_LDB(B0, 0, 0); G8_SCHED; G8_LDA(At, 0, 0); G8_STAGE_A(G8_SA(1, 1), a1, voA[1][0], voA[1][1]);
            G8_WAIT_L(8); G8_BAR; G8_WAIT_L(0); G8_MMA(0, 0, At, B0); G8_BAR; G8_SCHED;
            G8_LDB(B1, 0, 1); G8_STAGE_B(G8_SB(0, 0), b2);
            G8_BAR; G8_WAIT_L(0); G8_MMA(0, 1, At, B1); G8_BAR;
            G8_LDA(At, 0, 1); G8_STAGE_A(G8_SA(0, 0), a2, o00, o01);
            G8_BAR; G8_WAIT_L(0); G8_MMA(1, 0, At, B0); G8_BAR; G8_SCHED;
            G8_STAGE_B(G8_SB(0, 1), b2 + hstepB);
            G8_WAIT_V(6);
            if constexpr (Epi::PUBLISH) { if (prev_pm >= 0) { E.publish(prev_pm); prev_pm = -1; } }
            G8_BAR; G8_MMA(1, 1, At, B1); G8_BAR;
            G8_LDB(B0, 1, 0); G8_SCHED; G8_LDA(At, 1, 0); G8_STAGE_A(G8_SA(0, 1), a2, o10, o11);
            G8_WAIT_L(8); G8_BAR; G8_WAIT_L(0); G8_MMA(0, 0, At, B0); G8_BAR; G8_SCHED;
            G8_LDB(B1, 1, 1); G8_STAGE_B(G8_SB(1, 0), b3);
            G8_BAR; G8_WAIT_L(0); G8_MMA(0, 1, At, B1); G8_BAR;
            G8_LDA(At, 1, 1); G8_STAGE_A(G8_SA(1, 0), a3, o00, o01);
            G8_BAR; G8_WAIT_L(0); G8_MMA(1, 0, At, B0); G8_BAR; G8_SCHED;
            G8_STAGE_B(G8_SB(1, 1), b3 + hstepB);
            G8_WAIT_V(6); G8_BAR; G8_MMA(1, 1, At, B1); G8_BAR;
        }
        if constexpr (Epi::F8) {
#define G8_TIE(a, b, txt) asm volatile(txt : "+v"(acc[a][b][0][0]), "+v"(acc[a][b][0][1]), "+v"(acc[a][b][1][0]), "+v"(acc[a][b][1][1]), "+v"(acc[a][b][2][0]), "+v"(acc[a][b][2][1]), "+v"(acc[a][b][3][0]), "+v"(acc[a][b][3][1]))
            G8_TIE(0, 0, ""); G8_TIE(0, 1, ""); G8_TIE(1, 0, "s_nop 7"); G8_TIE(1, 1, "s_nop 15\n\ts_nop 7");
#undef G8_TIE
        }
        if constexpr (Epi::ASCALE != 1.0f) {
#pragma unroll
            for (int a = 0; a < 2; ++a)
#pragma unroll
                for (int b = 0; b < 2; ++b)
#pragma unroll
                    for (int m = 0; m < 4; ++m)
#pragma unroll
                        for (int n = 0; n < 2; ++n) acc[a][b][m][n] *= Epi::ASCALE;
        }
        E(acc, cur, wr, wc, fr, fq);
        if constexpr (Epi::PUBLISH) prev_pm = cur.pm;
        if (!has_next) break;
#pragma unroll
        for (int a = 0; a < 2; ++a)
#pragma unroll
            for (int b = 0; b < 2; ++b)
#pragma unroll
                for (int m = 0; m < 4; ++m)
#pragma unroll
                    for (int n = 0; n < 2; ++n) acc[a][b][m][n] = (f32x4){0.f, 0.f, 0.f, 0.f};
        cur = nxt; cA = nA; cB = nB; ++ui;
        if (GATHER) {
#pragma unroll
            for (int h = 0; h < 2; ++h)
#pragma unroll
                for (int i = 0; i < 2; ++i) voA[h][i] = voAn[h][i];
        }
    }
    G8_WAIT_V(0);
    if constexpr (Epi::PUBLISH) { if (prev_pm >= 0) { E.publish(prev_pm); prev_pm = -1; } }
    if (wr == 0) G8_BAR;
    G8_BAR;
#undef G8_SA
#undef G8_SB
#undef G8_STAGE_A
#undef G8_STAGE_B
#undef G8_OPQ
#undef G8_LDA
#undef G8_LDB
#undef G8_MMA
#undef G8_WAIT_V
#undef G8_WAIT_L
#undef G8_BAR
#undef G8_SCHED
}

__device__ __forceinline__ u32x4 pack8(const f32x4& a, const f32x4& b) { u32x4 w; w.x = cvt_pk_bf16(a[0], a[1]); w.y = cvt_pk_bf16(a[2], a[3]); w.z = cvt_pk_bf16(b[0], b[1]); w.w = cvt_pk_bf16(b[2], b[3]); return w; }
__device__ __forceinline__ u32x4 subtile_T(LAS bf16_t* Tw, const f32x4& a, const f32x4& b, int fr, int fq, int lane) {
#pragma unroll
    for (int j = 0; j < 4; ++j) { Tw[(8 * fq + j) * 16 + fr] = f2bf(a[j]); Tw[(8 * fq + 4 + j) * 16 + fr] = f2bf(b[j]); }
    asm volatile("" ::: "memory");
    const u32x4 r = *(const LAS u32x4*)(Tw + (lane >> 1) * 16 + (lane & 1) * 8);
    asm volatile("" ::: "memory");
    return r;
}
template <bool F8_> struct MEpiProjT { static constexpr bool PERM = true, PUBLISH = false, F8 = F8_; static constexpr float ASCALE = F8_ ? 1.0f / (SHB * SWI) : 1.0f; bf16_t* PROJ; bf16_t* VT; LAS float* KX; const float* gq; const float* gk;
    __device__ __forceinline__ void operator()(const Acc& acc, const Unit& u, int wr, int wc, int fr, int fq) const {
        const int row0 = u.pm * BM + wr * 64 + fr;
        if (u.pn >= C_K / 256 && u.pn < DPROJ / 256) {
#pragma unroll
            for (int ai = 0; ai < 2; ++ai)
#pragma unroll
                for (int m = 0; m < 4; ++m)
#pragma unroll
                    for (int bj = 0; bj < 2; ++bj) {
                        const f32x4 a = acc[ai][bj][m][0], b = acc[ai][bj][m][1];
                        float ss = a[0] * a[0] + a[1] * a[1] + a[2] * a[2] + a[3] * a[3] + b[0] * b[0] + b[1] * b[1] + b[2] * b[2] + b[3] * b[3];
                        ss += __shfl_xor(ss, 16); ss += __shfl_xor(ss, 32);
                        if (fq == 0) KX[((ai * HALF + wr * 64 + m * 16 + fr) * 2 + bj) * 4 + wc] = ss;
                    }
            asm volatile("s_waitcnt lgkmcnt(0)" ::: "memory"); __builtin_amdgcn_s_barrier(); asm volatile("" ::: "memory");
            const int col0 = u.pn * BM + wc * 32 + 8 * fq;
            f32x4 g0[2], g1[2];
#pragma unroll
            for (int bj = 0; bj < 2; ++bj) { const int d0 = wc * 32 + 8 * fq; g0[bj] = *(const f32x4*)(gq + d0) * *(const f32x4*)(gk + d0); g1[bj] = *(const f32x4*)(gq + d0 + 4) * *(const f32x4*)(gk + d0 + 4); }
#pragma unroll
            for (int ai = 0; ai < 2; ++ai)
#pragma unroll
                for (int m = 0; m < 4; ++m) { bf16_t* rowp = PROJ + (size_t)(row0 + ai * HALF + m * 16) * DPROJ + col0;
#pragma unroll
                    for (int bj = 0; bj < 2; ++bj) { const f32x4 p4 = *(const LAS f32x4*)(KX + ((ai * HALF + wr * 64 + m * 16 + fr) * 2 + bj) * 4);
                        const float rs = rsqrtf(((p4[0] + p4[1]) + (p4[2] + p4[3])) * (1.0f / HD) + EPS);
                        *(u32x4*)(rowp + bj * HALF) = pack8(acc[ai][bj][m][0] * g0[bj] * rs, acc[ai][bj][m][1] * g1[bj] * rs); } }
            return;
        }
        if (u.pn < DPROJ / 256) {
            const int col0 = u.pn * BM + wc * 32 + 8 * fq;
#pragma unroll
            for (int ai = 0; ai < 2; ++ai)
#pragma unroll
                for (int m = 0; m < 4; ++m) { bf16_t* rowp = PROJ + (size_t)(row0 + ai * HALF + m * 16) * DPROJ + col0;
#pragma unroll
                    for (int bj = 0; bj < 2; ++bj) *(u32x4*)(rowp + bj * HALF) = pack8(acc[ai][bj][m][0], acc[ai][bj][m][1]); }
        } else {
            const int lane = fq * 16 + fr, cl = lane >> 1, hf = lane & 1; LAS bf16_t* Tw = (LAS bf16_t*)KX + (wr * 4 + wc) * 512;
            const int cc0 = (u.pn - DPROJ / 256) * BM + wc * 32 + cl;
#pragma unroll
            for (int ai = 0; ai < 2; ++ai)
#pragma unroll
                for (int m = 0; m < 4; ++m) { const int rowb = u.pm * BM + wr * 64 + ai * HALF + m * 16, b = rowb >> 12, s = (rowb & (SEQ - 1)) + hf * 8;
#pragma unroll
                    for (int bj = 0; bj < 2; ++bj) { const int cc = cc0 + bj * HALF;
                        const u32x4 w = subtile_T(Tw, acc[ai][bj][m][0], acc[ai][bj][m][1], fr, fq, lane);
                        *(u32x4*)(VT + ((size_t)(b * NHS + (cc >> 7)) * HD + (cc & 127)) * VTS + s) = w; } }
        }
    } };
template <bool F8_> struct MEpiPartT { static constexpr bool PERM = true, PUBLISH = false, F8 = F8_; static constexpr float ASCALE = F8_ ? 1.0f / (SHB * SWI) : 1.0f; bf16_t* PT; LAS float* KX;
    __device__ __forceinline__ void operator()(const Acc& acc, const Unit& u, int wr, int wc, int fr, int fq) const {
        const int lane = fq * 16 + fr, cl = lane >> 1, hf = lane & 1; LAS bf16_t* Tw = (LAS bf16_t*)KX + (wr * 4 + wc) * 512;
        bf16_t* base0 = PT + (size_t)(u.pm * 4 + u.pn) * 65536 + (size_t)(wc * 32 + cl) * 256 + wr * 64 + hf * 8;
#pragma unroll
        for (int ai = 0; ai < 2; ++ai)
#pragma unroll
            for (int m = 0; m < 4; ++m)
#pragma unroll
                for (int bj = 0; bj < 2; ++bj) {
                    const u32x4 w = subtile_T(Tw, acc[ai][bj][m][0], acc[ai][bj][m][1], fr, fq, lane);
                    *(u32x4*)(base0 + (size_t)(bj * HALF) * 256 + ai * HALF + m * 16) = w; }
    } };
__device__ __forceinline__ u32x4 pair16(unsigned a0, unsigned a1, unsigned b0, unsigned b1) {
    const auto s0 = __builtin_amdgcn_permlane16_swap(a0, b0, false, false); const auto s1 = __builtin_amdgcn_permlane16_swap(a1, b1, false, false);
    return (u32x4){s0[0], s1[0], s0[1], s1[1]};
}
__device__ __forceinline__ f32x4 silu_mul(const f32x4& g, const f32x4& u) { f32x4 r;
#pragma unroll
    for (int j = 0; j < 4; ++j) r[j] = g[j] * sigmoidf_(g[j]) * u[j];
    return r; }
struct MEpiGU { static constexpr bool PERM = true, PUBLISH = true, F8 = true; static constexpr float ASCALE = 1.0f; unsigned char* HID; const float* LISTR; const MoeTab* mt; unsigned* rtc; int n1early;
    __device__ __forceinline__ void operator()(const Acc& acc, const Unit& u, int wr, int wc, int fr, int fq) const {
        const int row0 = u.pm * BM + wr * 64 + fr, col0 = u.pn * HALF + wc * 32 + 8 * fq;
        const int e = __builtin_amdgcn_readfirstlane(mt->texp[u.pm]), cnt = __builtin_amdgcn_readfirstlane(mt->cnt[e]), pb = __builtin_amdgcn_readfirstlane(mt->tstart[e]) * 256;
        const float* lr = LISTR + (size_t)e * T;
        const __amdgpu_buffer_rsrc_t rsrc = __builtin_amdgcn_make_buffer_rsrc(HID, 0, (int)((size_t)PADROWS * DEXP), 0x00020000);
#pragma unroll
        for (int ai = 0; ai < 2; ++ai)
#pragma unroll
            for (int mp = 0; mp < 2; ++mp) { int w[2][2];
#pragma unroll
                for (int mm = 0; mm < 2; ++mm) { const int m = 2 * mp + mm;
                    const int row = row0 + ai * HALF + m * 16, pos = row - pb;
                    const float rs = pos < cnt ? lr[pos] * (1.0f / (SX8 * SW1)) : 0.f;
                    const f32x4 h0 = silu_mul(acc[ai][0][m][0] * rs, acc[ai][1][m][0] * rs) * SH8, h1 = silu_mul(acc[ai][0][m][1] * rs, acc[ai][1][m][1] * rs) * SH8;
                    int w0 = 0, w1 = 0;
                    w0 = __builtin_amdgcn_cvt_pk_fp8_f32(__builtin_amdgcn_fmed3f(h0[0], -448.f, 448.f), __builtin_amdgcn_fmed3f(h0[1], -448.f, 448.f), w0, false); w0 = __builtin_amdgcn_cvt_pk_fp8_f32(__builtin_amdgcn_fmed3f(h0[2], -448.f, 448.f), __builtin_amdgcn_fmed3f(h0[3], -448.f, 448.f), w0, true);
                    w1 = __builtin_amdgcn_cvt_pk_fp8_f32(__builtin_amdgcn_fmed3f(h1[0], -448.f, 448.f), __builtin_amdgcn_fmed3f(h1[1], -448.f, 448.f), w1, false); w1 = __builtin_amdgcn_cvt_pk_fp8_f32(__builtin_amdgcn_fmed3f(h1[2], -448.f, 448.f), __builtin_amdgcn_fmed3f(h1[3], -448.f, 448.f), w1, true);
                    w[mm][0] = w0; w[mm][1] = w1; }
                __builtin_amdgcn_raw_buffer_store_b128(pair16((unsigned)w[0][0], (unsigned)w[0][1], (unsigned)w[1][0], (unsigned)w[1][1]), rsrc, (row0 + ai * HALF + mp * 32 + 16 * (fq & 1)) * DEXP + (u.pn * HALF + wc * 32 + 16 * (fq >> 1)), 0, 16);
            }
    }
    __device__ __forceinline__ void publish(int pm) const {
        if ((otid() & 63) == 0) __hip_atomic_fetch_add(rtc + pm * 32, 1u, __ATOMIC_RELAXED, __HIP_MEMORY_SCOPE_AGENT);
    } };
struct MEpiDown { static constexpr bool PERM = true, PUBLISH = false, F8 = false; static constexpr float ASCALE = 1.0f; bf16_t* YPAD;
    __device__ __forceinline__ void operator()(const Acc& acc, const Unit& u, int wr, int wc, int fr, int fq) const {
        const int row0 = u.pm * BM + wr * 64 + fr, col0 = u.pn * BM + wc * 32 + 8 * fq;
#pragma unroll
        for (int ai = 0; ai < 2; ++ai)
#pragma unroll
            for (int m = 0; m < 4; ++m) { bf16_t* rowp = YPAD + (size_t)(row0 + ai * HALF + m * 16) * DM + col0;
#pragma unroll
                for (int bj = 0; bj < 2; ++bj) *(u32x4*)(rowp + bj * HALF) = pack8(acc[ai][bj][m][0], acc[ai][bj][m][1]); }
    } };
template <bool XF32> struct MEpiOut { static constexpr bool STAMP = false, PERM = true, PUBLISH = false, F8 = false; static constexpr float ASCALE = 1.0f; const float* Xf; const bf16_t* Xb; bf16_t* X1; unsigned char* X18;
    __device__ __forceinline__ void operator()(const Acc& acc, const Unit& u, int wr, int wc, int fr, int fq) const {
        const int row0 = u.pm * BM + wr * 64 + fr, col0 = u.pn * BM + wc * 32 + 8 * fq;
        const int row8 = u.pm * BM + wr * 64 + fr + 16 * (fq & 1), col8 = u.pn * BM + wc * 32 + 16 * (fq >> 1);
#pragma unroll
        for (int ai = 0; ai < 2; ++ai) {
            f32x4 xa[4][2][2]; u32x4 xh[4][2];
#pragma unroll
            for (int m = 0; m < 4; ++m)
#pragma unroll
                for (int bj = 0; bj < 2; ++bj) { const size_t o = (size_t)(row0 + ai * HALF + m * 16) * DM + col0 + bj * HALF;
                    if (XF32) { xa[m][bj][0] = *(const f32x4*)(Xf + o); xa[m][bj][1] = *(const f32x4*)(Xf + o + 4); } else xh[m][bj] = *(const u32x4*)(Xb + o); }
            __builtin_amdgcn_sched_barrier(0);
#pragma unroll
            for (int mp = 0; mp < 2; ++mp)
#pragma unroll
                for (int bj = 0; bj < 2; ++bj) { int w8[2][2];
#pragma unroll
                    for (int mm = 0; mm < 2; ++mm) { const int m = 2 * mp + mm; const size_t o = (size_t)(row0 + ai * HALF + m * 16) * DM + col0 + bj * HALF;
                        f32x4 a = acc[ai][bj][m][0], b = acc[ai][bj][m][1];
                        if (XF32) { a += xa[m][bj][0]; b += xa[m][bj][1]; }
                        else { const u32x4 w = xh[m][bj]; a[0] += bflo(w.x); a[1] += bfhi(w.x); a[2] += bflo(w.y); a[3] += bfhi(w.y); b[0] += bflo(w.z); b[1] += bfhi(w.z); b[2] += bflo(w.w); b[3] += bfhi(w.w); }
                        *(u32x4*)(X1 + o) = pack8(a, b);
                        int w0 = 0, w1 = 0;
                        w0 = __builtin_amdgcn_cvt_pk_fp8_f32(sat8(a[0] * SX8), sat8(a[1] * SX8), w0, false); w0 = __builtin_amdgcn_cvt_pk_fp8_f32(sat8(a[2] * SX8), sat8(a[3] * SX8), w0, true);
                        w1 = __builtin_amdgcn_cvt_pk_fp8_f32(sat8(b[0] * SX8), sat8(b[1] * SX8), w1, false); w1 = __builtin_amdgcn_cvt_pk_fp8_f32(sat8(b[2] * SX8), sat8(b[3] * SX8), w1, true);
                        w8[mm][0] = w0; w8[mm][1] = w1; }
                    *(u32x4*)(X18 + (size_t)(row8 + ai * HALF + mp * 32) * DM + col8 + bj * HALF) = pair16((unsigned)w8[0][0], (unsigned)w8[0][1], (unsigned)w8[1][0], (unsigned)w8[1][1]); }
        }
    } };
constexpr float YSCALE = YSCALE_G;
struct MEpiDown8 { static constexpr bool PERM = true, PUBLISH = false, F8 = true; static constexpr float ASCALE = 1.0f; unsigned char* Y8;
    __device__ __forceinline__ void operator()(const Acc& acc, const Unit& u, int wr, int wc, int fr, int fq) const {
        const int row0 = u.pm * BM + wr * 64 + fr + 16 * (fq & 1), col0 = u.pn * BM + wc * 32 + 16 * (fq >> 1);
#pragma unroll
        for (int ai = 0; ai < 2; ++ai)
#pragma unroll
            for (int mp = 0; mp < 2; ++mp)
#pragma unroll
                for (int bj = 0; bj < 2; ++bj) { int w[2][2];
#pragma unroll
                    for (int mm = 0; mm < 2; ++mm) { const int m = 2 * mp + mm; const f32x4 a = acc[ai][bj][m][0] * (YSCALE / (SH8 * SW2)), b = acc[ai][bj][m][1] * (YSCALE / (SH8 * SW2)); int w0 = 0, w1 = 0;
                        w0 = __builtin_amdgcn_cvt_pk_fp8_f32(sat8(a[0]), sat8(a[1]), w0, false); w0 = __builtin_amdgcn_cvt_pk_fp8_f32(sat8(a[2]), sat8(a[3]), w0, true);
                        w1 = __builtin_amdgcn_cvt_pk_fp8_f32(sat8(b[0]), sat8(b[1]), w1, false); w1 = __builtin_amdgcn_cvt_pk_fp8_f32(sat8(b[2]), sat8(b[3]), w1, true); w[mm][0] = w0; w[mm][1] = w1; }
                    *(u32x4*)(Y8 + (size_t)(row0 + ai * HALF + mp * 32) * DM + col0 + bj * HALF) = pair16((unsigned)w[0][0], (unsigned)w[0][1], (unsigned)w[1][0], (unsigned)w[1][1]); }
    } };
}

__device__ __forceinline__ void phase_convb(const Ctx& c, int l) {
    const int gt = obid() * 512 + otid(), ng = gridDim.x * 512, sub = gt & 15;
    const float* cw = c.in[10] + (size_t)l * 3 * DCONV; const bf16_t* PROJ = c.PROJ();
#pragma unroll 2
    for (int item = gt >> 4; item < T * 4; item += ng >> 4) {
        const int t = item >> 2, hh = item & 3, ch = hh * HD + sub * 8, s = t & (SEQ - 1);
        u32x4 cg[3], xb[3];
#pragma unroll
        for (int tap = 0; tap < 3; ++tap) { const int ds = (s + tap - 2 >= 0) ? tap - 2 : 0; const bf16_t* row = PROJ + (size_t)(t + ds) * DPROJ; cg[tap] = *(const u32x4*)(row + C_CG + ch); xb[tap] = *(const u32x4*)(row + C_XB + ch); }
        const u32x4 bg = *(const u32x4*)(PROJ + (size_t)t * DPROJ + C_BG + ch);
        float acc[8] = {0, 0, 0, 0, 0, 0, 0, 0};
#pragma unroll
        for (int tap = 0; tap < 3; ++tap) {
            if (s + tap - 2 >= 0) {
                const f32x4 w0 = *(const f32x4*)(cw + tap * DCONV + ch), w1 = *(const f32x4*)(cw + tap * DCONV + ch + 4);
                acc[0] += w0[0] * bflo(cg[tap].x) * bflo(xb[tap].x); acc[1] += w0[1] * bfhi(cg[tap].x) * bfhi(xb[tap].x); acc[2] += w0[2] * bflo(cg[tap].y) * bflo(xb[tap].y); acc[3] += w0[3] * bfhi(cg[tap].y) * bfhi(xb[tap].y);
                acc[4] += w1[0] * bflo(cg[tap].z) * bflo(xb[tap].z); acc[5] += w1[1] * bfhi(cg[tap].z) * bfhi(xb[tap].z); acc[6] += w1[2] * bflo(cg[tap].w) * bflo(xb[tap].w); acc[7] += w1[3] * bfhi(cg[tap].w) * bfhi(xb[tap].w);
            }
        }
        acc[0] *= bflo(bg.x); acc[1] *= bfhi(bg.x); acc[2] *= bflo(bg.y); acc[3] *= bfhi(bg.y); acc[4] *= bflo(bg.z); acc[5] *= bfhi(bg.z); acc[6] *= bflo(bg.w); acc[7] *= bfhi(bg.w);
        float ss = 0.f;
#pragma unroll
        for (int i = 0; i < 8; ++i) ss += acc[i] * acc[i];
        ss += __shfl_xor(ss, 1); ss += __shfl_xor(ss, 2); ss += __shfl_xor(ss, 4); ss += __shfl_xor(ss, 8);
        const float rstd = rsqrtf(ss * (1.0f / HD) + EPS);
        const float* mg = c.in[13] + (size_t)l * DM + DLRU + ch;
        const f32x4 m0 = *(const f32x4*)mg, m1 = *(const f32x4*)(mg + 4);
        u32x4 o; o.x = cvt_pk_bf16(acc[0] * rstd * m0[0], acc[1] * rstd * m0[1]); o.y = cvt_pk_bf16(acc[2] * rstd * m0[2], acc[3] * rstd * m0[3]);
        o.z = cvt_pk_bf16(acc[4] * rstd * m1[0], acc[5] * rstd * m1[1]); o.w = cvt_pk_bf16(acc[6] * rstd * m1[2], acc[7] * rstd * m1[3]);
        *(u32x4*)(c.YMIX() + (size_t)t * DM + DLRU + ch) = o;
    }
}
typedef float f32x16 __attribute__((ext_vector_type(16)));
#define MFMA32(a, b, c) __builtin_amdgcn_mfma_f32_32x32x16_bf16((a), (b), (c), 0, 0, 0)
constexpr int XCS = 776;
__device__ __forceinline__ void phase_lruA(const Ctx& c, int l, unsigned char* ldsb) {
    constexpr bool PASS2 = false;
    bf16_t* XC = (bf16_t*)ldsb; bf16_t* PR = (bf16_t*)(ldsb + 99328); bf16_t* HL = c.HL(); bf16_t* PL = c.PL();
    const int tid = otid(), lane = tid & 63, wv = tid >> 6, hh = lane >> 5, l31 = lane & 31;
    const float* cw = c.in[3] + (size_t)l * 4 * DLRU; const float* cb = c.in[4] + (size_t)l * DLRU;
    const bf16_t* PROJ = c.PROJ(); float* AGG = c.AGG();
    typedef float f32x2_t __attribute__((ext_vector_type(2)));
    for (int tile = obid(); tile < T / 64; tile += gridDim.x) {
        const int t0 = tile * 64, s0 = t0 & (SEQ - 1), tb = tile & 63;
        if (tid < 480) {
            const int cg = tid % 48, tslot = tid / 48, ch = cg * 16;
            float w[4][16], bias[16];
#pragma unroll
            for (int i = 0; i < 16; i += 4) { *(f32x4*)&bias[i] = *(const f32x4*)(cb + ch + i);
#pragma unroll
                for (int tap = 0; tap < 4; ++tap) *(f32x4*)&w[tap][i] = *(const f32x4*)(cw + tap * DLRU + ch + i); }
#pragma unroll
            for (int it = 0; it < 7; ++it) {
                const int tokr = tslot + 10 * it, tok = tokr < 64 ? tokr : 63;
                u32x4 x0[4], x1[4]; float msk[4];
#pragma unroll
                for (int tap = 0; tap < 4; ++tap) {
                    const int ds = tap - 3; const bool ok = (s0 + tok + ds >= 0); msk[tap] = ok ? 1.0f : 0.0f;
                    const bf16_t* row = PROJ + (size_t)(t0 + tok + (ok ? ds : 0)) * DPROJ + C_XA + ch;
                    x0[tap] = *(const u32x4*)row; x1[tap] = *(const u32x4*)(row + 8);
                }
                float a[16];
#pragma unroll
                for (int i = 0; i < 16; ++i) a[i] = bias[i];
#pragma unroll
                for (int tap = 0; tap < 4; ++tap) {
                    const float m = msk[tap];
                    a[0] += m * w[tap][0] * bflo(x0[tap].x); a[1] += m * w[tap][1] * bfhi(x0[tap].x); a[2] += m * w[tap][2] * bflo(x0[tap].y); a[3] += m * w[tap][3] * bfhi(x0[tap].y);
                    a[4] += m * w[tap][4] * bflo(x0[tap].z); a[5] += m * w[tap][5] * bfhi(x0[tap].z); a[6] += m * w[tap][6] * bflo(x0[tap].w); a[7] += m * w[tap][7] * bfhi(x0[tap].w);
                    a[8] += m * w[tap][8] * bflo(x1[tap].x); a[9] += m * w[tap][9] * bfhi(x1[tap].x); a[10] += m * w[tap][10] * bflo(x1[tap].y); a[11] += m * w[tap][11] * bfhi(x1[tap].y);
                    a[12] += m * w[tap][12] * bflo(x1[tap].z); a[13] += m * w[tap][13] * bfhi(x1[tap].z); a[14] += m * w[tap][14] * bflo(x1[tap].w); a[15] += m * w[tap][15] * bfhi(x1[tap].w);
                }
                u32x4 o0, o1; o0.x = cvt_pk_bf16(a[0], a[1]); o0.y = cvt_pk_bf16(a[2], a[3]); o0.z = cvt_pk_bf16(a[4], a[5]); o0.w = cvt_pk_bf16(a[6], a[7]);
                o1.x = cvt_pk_bf16(a[8], a[9]); o1.y = cvt_pk_bf16(a[10], a[11]); o1.z = cvt_pk_bf16(a[12], a[13]); o1.w = cvt_pk_bf16(a[14], a[15]);
                if (tokr < 64) { *(u32x4*)(XC + tok * XCS + ch) = o0; *(u32x4*)(XC + tok * XCS + ch + 8) = o1; }
            }
        }
        __syncthreads();
#pragma unroll 1
        for (int i = 0; i < 3; ++i) {
            const int hd = 2 * i + (wv >> 2), ntw = wv & 3, chl = 32 * ntw + l31, ch = hd * HD + chl;
            const bf16_t* wa = c.WA(l) + ((size_t)hd * HD + chl) * HD + 8 * hh; const bf16_t* wx = c.WX(l) + ((size_t)hd * HD + chl) * HD + 8 * hh;
            const float ba = c.in[6][l * DLRU + ch], bx = c.in[8][l * DLRU + ch], c8 = -8.0f * softplusf_(-c.in[9][l * DLRU + ch]);
            float sst = 0.f, Pt = 1.f;
            float hreg[2][16], preg[2][16];
            bf16x8 bRf[8], bIf[8];
#pragma unroll
            for (int s = 0; s < 8; ++s) { bRf[s] = *(const bf16x8*)(wa + 16 * s); bIf[s] = *(const bf16x8*)(wx + 16 * s); }
            __builtin_amdgcn_sched_barrier(0);
#pragma unroll
            for (int half = 0; half < 2; ++half) {
                float av[16], uv[16];
                {
                    f32x16 accR, accI;
#pragma unroll
                    for (int r = 0; r < 16; ++r) { accR[r] = 0.f; accI[r] = 0.f; }
#pragma unroll
                    for (int s = 0; s < 8; ++s) {
                        const bf16x8 a = *(const bf16x8*)(XC + (32 * half + l31) * XCS + hd * HD + 16 * s + 8 * hh);
                        accR = MFMA32(a, bRf[s], accR); accI = MFMA32(a, bIf[s], accI);
                    }
#pragma unroll
                    for (int r = 0; r < 16; ++r) {
                        const int tok = 32 * half + (r & 3) + 8 * (r >> 2) + 4 * hh;
                        const float xc = bf2f(XC[tok * XCS + ch]);
                        const float rg = sigmoidf_(accR[r] + ba), ig = sigmoidf_(accI[r] + bx);
                        const float la = c8 * rg;
                        av[r] = fast_exp(la); uv[r] = __builtin_amdgcn_sqrtf((1.0f - av[r]) * (1.0f + av[r])) * (ig * xc);
                    }
                }
                float Pp[4], Hp[4];
#pragma unroll
                for (int g = 0; g < 4; ++g) { float P = 1.f, H = 0.f;
#pragma unroll
                    for (int r = 4 * g; r < 4 * g + 4; ++r) { H = av[r] * H + uv[r]; P *= av[r]; }
                    Pp[g] = __shfl_xor(P, 32); Hp[g] = __shfl_xor(H, 32); }
#pragma unroll
                for (int g = 0; g < 4; ++g) {
                    if (hh == 0) {
#pragma unroll
                        for (int r = 4 * g; r < 4 * g + 4; ++r) { sst = av[r] * sst + uv[r]; Pt *= av[r]; hreg[half][r] = sst; preg[half][r] = Pt; }
                        sst = Pp[g] * sst + Hp[g]; Pt *= Pp[g];
                    } else {
                        sst = Pp[g] * sst + Hp[g]; Pt *= Pp[g];
#pragma unroll
                        for (int r = 4 * g; r < 4 * g + 4; ++r) { sst = av[r] * sst + uv[r]; Pt *= av[r]; hreg[half][r] = sst; preg[half][r] = Pt; }
                    }
                }
            }
            if (hh == 0) { f32x2_t o; o.x = Pt; o.y = sst; ((f32x2_t*)AGG)[(size_t)tile * DLRU + ch] = o; }
            __syncthreads();
#pragma unroll
            for (int half = 0; half < 2; ++half)
#pragma unroll
                for (int r = 0; r < 16; ++r) { const int tok = 32 * half + (r & 3) + 8 * (r >> 2) + 4 * hh;
                    XC[tok * XCS + ch] = f2bf(hreg[half][r]); PR[tok * 264 + (wv >> 2) * HD + chl] = f2bf(preg[half][r]); }
            __syncthreads();
#pragma unroll
            for (int k = 0; k < 4; ++k) {
                const int item = tid + 512 * k, tok = item >> 5, g = item & 31, hs = g >> 4, sub = g & 15, cc = (2 * i + hs) * HD + sub * 8;
                *(u32x4*)(HL + (size_t)(t0 + tok) * DLRU + cc) = *(const u32x4*)(XC + tok * XCS + cc);
                *(u32x4*)(PL + (size_t)(t0 + tok) * DLRU + cc) = *(const u32x4*)(PR + tok * 264 + hs * HD + sub * 8);
            }
        }
        __syncthreads();
    }
}

__device__ __forceinline__ void phase_lruB(const Ctx& c, int l, unsigned char* ldsb) {
    float* HIN = (float*)ldsb;
    const int tid = otid();
    const bf16_t* PROJ = c.PROJ(); const float* AGG = c.AGG(); const bf16_t* HL = c.HL(); const bf16_t* PL = c.PL();
    typedef float f32x2_t __attribute__((ext_vector_type(2)));
    for (int tile = obid(); tile < T / 64; tile += gridDim.x) {
        const int t0 = tile * 64, tb = tile & 63;
        {
            const f32x2_t* ag = (const f32x2_t*)AGG + (size_t)(tile - tb) * DLRU;
            const int chb = 512 + (tid & 255);
            float ha = 0.f, hb = 0.f;
#pragma unroll 8
            for (int k = 0; k < tb; ++k) { const f32x2_t pa = ag[(size_t)k * DLRU + tid], pb_ = ag[(size_t)k * DLRU + chb]; ha = pa.x * ha + pa.y; hb = pb_.x * hb + pb_.y; }
            HIN[tid] = ha; if (tid < 256) HIN[chb] = hb;
        }
        __syncthreads();
        const int wv_ = tid >> 6, wit0 = wv_ < 4 ? 8 * wv_ : 32 + 16 * (wv_ - 4), wcnt = wv_ < 4 ? 8 : 16;
#define LB_ADDR(it_, tok_, cc_) const int item_##it_ = (wit0 + (it_)) * 64 + (tid & 63), tok_ = item_##it_ / 96, rem_##it_ = item_##it_ % 96, cc_ = (rem_##it_ >> 4) * HD + (rem_##it_ & 15) * 8
#define LB_LOAD(H_, P_, G_, tok_, cc_) do { H_ = *(const u32x4*)(HL + (size_t)(t0 + tok_) * DLRU + cc_); P_ = *(const u32x4*)(PL + (size_t)(t0 + tok_) * DLRU + cc_); G_ = *(const u32x4*)(PROJ + (size_t)(t0 + tok_) * DPROJ + C_GA + cc_); } while (0)
#define LB_BODY(hv, pv, ga, tok, cc) do { \
            const f32x4 i0 = *(const f32x4*)(HIN + cc), i1 = *(const f32x4*)(HIN + cc + 4); \
            float y[8] = {(bflo(hv.x) + bflo(pv.x) * i0[0]) * gelu_tanh(bflo(ga.x)), (bfhi(hv.x) + bfhi(pv.x) * i0[1]) * gelu_tanh(bfhi(ga.x)), \
                          (bflo(hv.y) + bflo(pv.y) * i0[2]) * gelu_tanh(bflo(ga.y)), (bfhi(hv.y) + bfhi(pv.y) * i0[3]) * gelu_tanh(bfhi(ga.y)), \
                          (bflo(hv.z) + bflo(pv.z) * i1[0]) * gelu_tanh(bflo(ga.z)), (bfhi(hv.z) + bfhi(pv.z) * i1[1]) * gelu_tanh(bfhi(ga.z)), \
                          (bflo(hv.w) + bflo(pv.w) * i1[2]) * gelu_tanh(bflo(ga.w)), (bfhi(hv.w) + bfhi(pv.w) * i1[3]) * gelu_tanh(bfhi(ga.w))}; \
            float ss = 0.f; \
            _Pragma("unroll") for (int k = 0; k < 8; ++k) ss += y[k] * y[k]; \
            ss += __shfl_xor(ss, 1); ss += __shfl_xor(ss, 2); ss += __shfl_xor(ss, 4); ss += __shfl_xor(ss, 8); \
            const float rstd = rsqrtf(ss * (1.0f / HD) + EPS); \
            const float* mg = c.in[13] + (size_t)l * DM + cc; \
            const f32x4 m0 = *(const f32x4*)mg, m1 = *(const f32x4*)(mg + 4); \
            u32x4 o; o.x = cvt_pk_bf16(y[0] * rstd * m0[0], y[1] * rstd * m0[1]); o.y = cvt_pk_bf16(y[2] * rstd * m0[2], y[3] * rstd * m0[3]); \
            o.z = cvt_pk_bf16(y[4] * rstd * m1[0], y[5] * rstd * m1[1]); o.w = cvt_pk_bf16(y[6] * rstd * m1[2], y[7] * rstd * m1[3]); \
            *(u32x4*)(c.YMIX() + (size_t)(t0 + tok) * DM + cc) = o; } while (0)
        {
            u32x4 hA, pA, gA, hB, pB, gB;
            { LB_ADDR(0, tk_, cc_); LB_LOAD(hA, pA, gA, tk_, cc_); }
#pragma unroll 1
            for (int it = 0; it < wcnt; it += 2) {
                LB_ADDR(it, tkA, ccA); const int itb = it + 1; LB_ADDR(itb, tkB, ccB);
                LB_LOAD(hB, pB, gB, tkB, ccB); __builtin_amdgcn_sched_barrier(0);
                LB_BODY(hA, pA, gA, tkA, ccA);
                if (it + 2 < wcnt) { const int itc = it + 2; LB_ADDR(itc, tkC, ccC); LB_LOAD(hA, pA, gA, tkC, ccC); } __builtin_amdgcn_sched_barrier(0);
                LB_BODY(hB, pB, gB, tkB, ccB);
            }
        }
#undef LB_ADDR
#undef LB_LOAD
#undef LB_BODY
        __syncthreads();
    }
}

__device__ __forceinline__ void phase_vreduce(const Ctx& c) {
    const bf16_t* PT = c.PT(); bf16_t* VT = c.VT();
    for (int item = obid() * 512 + otid(); item < 64 * 256 * 32; item += gridDim.x * 512) {
        const int ro = item & 31, col = (item >> 5) & 255, u = item >> 13;
        const bf16_t* p = PT + (size_t)(u * 4) * 65536 + col * 256 + ro * 8;
        float a[8] = {0, 0, 0, 0, 0, 0, 0, 0};
#pragma unroll
        for (int kq = 0; kq < 4; ++kq) { const u32x4 w = *(const u32x4*)(p + (size_t)kq * 65536);
            a[0] += bflo(w.x); a[1] += bfhi(w.x); a[2] += bflo(w.y); a[3] += bfhi(w.y); a[4] += bflo(w.z); a[5] += bfhi(w.z); a[6] += bflo(w.w); a[7] += bfhi(w.w); }
        const int b = u >> 4, s0 = (u & 15) * 256 + ro * 8, h = 4 + (col >> 7), d = col & 127;
        u32x4 o; o.x = cvt_pk_bf16(a[0], a[1]); o.y = cvt_pk_bf16(a[2], a[3]); o.z = cvt_pk_bf16(a[4], a[5]); o.w = cvt_pk_bf16(a[6], a[7]);
        *(u32x4*)(VT + ((size_t)(b * NHS + h) * HD + d) * VTS + s0) = o;
    }
}

__device__ __forceinline__ void phase_attn(const Ctx& c, int l, unsigned char* ldsb) {
    const int lane = otid() & 63, wv = otid() >> 6, hh = lane >> 5, l31 = lane & 31;
    const bf16_t* PROJ = c.PROJ(); const bf16_t* VT = c.VT();
    const int prow = (l31 & ~12) | ((l31 & 4) << 1) | ((l31 & 8) >> 1);
    unsigned char* wl = ldsb + wv * 16384;
    const int kwbase = (lane >> 4) * 256 + (((lane & 15) ^ (lane >> 4)) * 16);
    const int vwoff = (lane >> 2) * 64 + (((lane & 3) ^ (lane >> 4)) * 16);
    const int kroff = prow * 256;
    const int nwt = NB * NHS * (SEQ / 32);
    const int nper = (nwt + (int)gridDim.x - 1) / (int)gridDim.x, wt0 = obid() * nper, wt1 = (wt0 + nper < nwt) ? wt0 + nper : nwt;
    for (int wt = wt0 + wv; wt < wt1; wt += 8) {
        const int qt = wt % (SEQ / 32), bh = wt / (SEQ / 32), b = bh / NHS, h = bh % NHS, q0 = qt * 32;
        const bf16_t* qp = PROJ + (size_t)(b * SEQ + q0 + l31) * DPROJ + C_Q + h * HD + 8 * hh;
        bf16x8 bq[8];
#pragma unroll
        for (int s = 0; s < 8; ++s) bq[s] = *(const bf16x8*)(qp + 16 * s);
        {
            float qs = 0.f;
#pragma unroll
            for (int s = 0; s < 8; ++s) { const u32x4 w = __builtin_bit_cast(u32x4, bq[s]);
                qs += bflo(w.x) * bflo(w.x) + bfhi(w.x) * bfhi(w.x) + bflo(w.y) * bflo(w.y) + bfhi(w.y) * bfhi(w.y) + bflo(w.z) * bflo(w.z) + bfhi(w.z) * bfhi(w.z) + bflo(w.w) * bflo(w.w) + bfhi(w.w) * bfhi(w.w); }
            qs += __shfl_xor(qs, 32);
            const float sc = rsqrtf(qs * (1.0f / HD) + EPS) * (1.4426950408889634f * 0.08838834764831845f);
#pragma unroll
            for (int s = 0; s < 8; ++s) { const u32x4 w = __builtin_bit_cast(u32x4, bq[s]); u32x4 o;
                o.x = cvt_pk_bf16(bflo(w.x) * sc, bfhi(w.x) * sc); o.y = cvt_pk_bf16(bflo(w.y) * sc, bfhi(w.y) * sc); o.z = cvt_pk_bf16(bflo(w.z) * sc, bfhi(w.z) * sc); o.w = cvt_pk_bf16(bflo(w.w) * sc, bfhi(w.w) * sc);
                bq[s] = __builtin_bit_cast(bf16x8, o); }
        }
        f32x16 O[4];
#pragma unroll
        for (int m = 0; m < 4; ++m)
#pragma unroll
            for (int r = 0; r < 16; ++r) O[m][r] = 0.f;
        float carry = 0.f;
        const bf16_t* kgl = PROJ + (size_t)(b * SEQ + (lane >> 4)) * DPROJ + C_K + h * HD + (lane & 15) * 8;
        const bf16_t* vgl = VT + ((size_t)bh * HD + (lane >> 2)) * VTS + (lane & 3) * 8;
        u32x4 stK[8], stV[8];
#define ATT_LOAD(kk0) do { _Pragma("unroll") for (int j = 0; j < 8; ++j) { \
            stK[j] = *(const u32x4*)(kgl + (size_t)((kk0) + 4 * j) * DPROJ); stV[j] = *(const u32x4*)(vgl + (size_t)(16 * j) * VTS + (kk0)); } } while (0)
        ATT_LOAD(q0);
        for (int k0 = q0; k0 >= 0; k0 -= 32) {
#pragma unroll
            for (int j = 0; j < 8; ++j) { *(u32x4*)(wl + j * 1024 + (kwbase ^ (64 * (j & 3)))) = stK[j]; *(u32x4*)(wl + 8192 + vwoff + j * 1024) = stV[j]; }
            const int kn = k0 >= 32 ? k0 - 32 : k0;
            ATT_LOAD(kn);
            __builtin_amdgcn_sched_barrier(0);
            f32x16 S;
#pragma unroll
            for (int r = 0; r < 16; ++r) S[r] = 0.f;
#pragma unroll
            for (int s = 0; s < 8; ++s) { const bf16x8 ak = *(const bf16x8*)(wl + kroff + (((2 * s + hh) ^ (prow & 15)) * 16)); S = MFMA32(ak, bq[s], S); }
            const bool diag = (k0 == q0);
            float sp[16];
            float R0 = 0.f, R1 = 0.f;
#pragma unroll
            for (int r = 0; r < 16; ++r) {
                const int kk = 16 * (r >> 3) + 8 * hh + (r & 7);
                const float z = S[r];
                float v = fmaxf(z, 0.f) + __builtin_amdgcn_logf(1.0f + __builtin_amdgcn_exp2f(-fabsf(z)));
                if (diag && kk >= l31) v = 0.f;
                sp[r] = v;
                if (r < 8) R0 += v; else R1 += v;
            }
            const float R0p = __shfl_xor(R0, 32), R1p = __shfl_xor(R1, 32);
            float suf_hi = carry - (hh == 0 ? R1p : 0.f);
            float suf_lo = carry - R1 - R1p - (hh == 0 ? R0p : 0.f);
            float w[16];
#pragma unroll
            for (int r = 15; r >= 8; --r) { w[r] = __builtin_amdgcn_exp2f(S[r] - sp[r] + suf_hi); suf_hi -= sp[r]; }
#pragma unroll
            for (int r = 7; r >= 0; --r) { w[r] = __builtin_amdgcn_exp2f(S[r] - sp[r] + suf_lo); suf_lo -= sp[r]; }
            if (diag) {
#pragma unroll
                for (int r = 0; r < 16; ++r) { const int kk = 16 * (r >> 3) + 8 * hh + (r & 7); if (kk >= l31) w[r] = 0.f; }
            }
            carry -= (R0 + R1 + R0p + R1p);
            bf16x8 wb[2];
            __builtin_amdgcn_sched_barrier(0);
#pragma unroll
            for (int s = 0; s < 2; ++s) { u32x4 pk; pk.x = cvt_pk_bf16(w[8 * s + 0], w[8 * s + 1]); pk.y = cvt_pk_bf16(w[8 * s + 2], w[8 * s + 3]); pk.z = cvt_pk_bf16(w[8 * s + 4], w[8 * s + 5]); pk.w = cvt_pk_bf16(w[8 * s + 6], w[8 * s + 7]);
                wb[s] = __builtin_bit_cast(bf16x8, pk); }
#pragma unroll
            for (int m = 0; m < 4; ++m)
#pragma unroll
                for (int s = 0; s < 2; ++s) { const bf16x8 vtf = *(const bf16x8*)(wl + 8192 + (32 * m + l31) * 64 + (((2 * s + hh) ^ (((32 * m + l31) >> 2) & 3)) * 16)); O[m] = MFMA32(vtf, wb[s], O[m]); }
            if (!__any(carry >= -150.1f)) break;
        }
        float ss = 0.f;
#pragma unroll
        for (int m = 0; m < 4; ++m)
#pragma unroll
            for (int r = 0; r < 16; ++r) ss += O[m][r] * O[m][r];
        ss += __shfl_xor(ss, 32);
        const float rstd = rsqrtf(ss * (1.0f / HD) + EPS);
        const float* mg = c.in[13] + (size_t)l * DM + DLRU + DCONV + h * HD + 4 * hh;
        bf16_t* yp = c.YMIX() + (size_t)(b * SEQ + q0 + l31) * DM + DLRU + DCONV + h * HD + 8 * hh;
#pragma unroll
        for (int m = 0; m < 4; ++m)
#pragma unroll
            for (int gp = 0; gp < 2; ++gp) { u32x2 o[2];
#pragma unroll
                for (int gg_ = 0; gg_ < 2; ++gg_) { const int g = 2 * gp + gg_; const f32x4 gg = *(const f32x4*)(mg + 32 * m + 8 * g);
                    o[gg_].x = cvt_pk_bf16(O[m][4 * g] * rstd * gg[0], O[m][4 * g + 1] * rstd * gg[1]); o[gg_].y = cvt_pk_bf16(O[m][4 * g + 2] * rstd * gg[2], O[m][4 * g + 3] * rstd * gg[3]); }
                const auto sx = __builtin_amdgcn_permlane32_swap(o[0].x, o[1].x, false, false); const auto sy = __builtin_amdgcn_permlane32_swap(o[0].y, o[1].y, false, false);
                *(u32x4*)(yp + 32 * m + 16 * gp) = (u32x4){sx[0], sy[0], sx[1], sy[1]};
            }
    }
}

#define XB_TMO      128
#define XB_XCNT(j)  (256  + 64 * (j))
#define XB_XSUB(j)  (1280 + 64 * (j))
#define XB_XGEN(j)  (2304 + 64 * (j))
#define XB_TOP      3328
#define XB_TOPGEN   3392
#define XCD_BAR_WORDS 3456
#define XB_SPIN_CAP (1u << 18)
__device__ __forceinline__ unsigned xb_ld(unsigned* p)              { return __hip_atomic_load(p, __ATOMIC_RELAXED, __HIP_MEMORY_SCOPE_AGENT); }
__device__ __forceinline__ unsigned xb_add(unsigned* p, unsigned v) { return __hip_atomic_fetch_add(p, v, __ATOMIC_RELAXED, __HIP_MEMORY_SCOPE_AGENT); }
__device__ __forceinline__ unsigned xb_xcc_id() { return (unsigned)__builtin_amdgcn_s_getreg((3 << 11) | 20) & 0xFu; }
#define XB_SPIN(cond, bar) do { unsigned _sp = 0; while (cond) { __builtin_amdgcn_s_sleep(1); \
    if ((++_sp & 255u) == 0u) { if (xb_ld(&(bar)[XB_TMO])) break; if (_sp > XB_SPIN_CAP) { atomicAdd(&(bar)[XB_TMO], 1u); break; } } } } while (0)
struct XcdBarrier { unsigned* bar; unsigned x; volatile LAS unsigned* st; };
__device__ __forceinline__ XcdBarrier xcd_barrier_post(unsigned* bar, volatile LAS unsigned* st) {
    XcdBarrier b; b.bar = bar; b.x = xb_xcc_id(); b.st = st;
    if (threadIdx.x == 0) (void)xb_add(&bar[XB_XCNT(b.x)], 1u);
    return b;
}
__device__ __forceinline__ void xcd_barrier_complete(unsigned* bar, unsigned x, unsigned& nloc, unsigned& nx) {
    const unsigned G = gridDim.x * gridDim.y * gridDim.z;
    unsigned sum, cnt, mine, sp = 0u;
    for (;;) {
        sum = 0u; cnt = 0u; mine = 0u;
#pragma unroll
        for (unsigned j = 0; j < 16; ++j) { const unsigned c = xb_ld(&bar[XB_XCNT(j)]); sum += c; cnt += (c > 0u) ? 1u : 0u; mine = (j == x) ? c : mine; }
        if (sum == G) break;
        __builtin_amdgcn_s_sleep(1);
        if ((++sp & 255u) == 0u) { if (xb_ld(&bar[XB_TMO])) break; if (sp > XB_SPIN_CAP) { atomicAdd(&bar[XB_TMO], 1u); break; } }
    }
    nloc = mine > 0u ? mine : 1u; nx = cnt > 0u ? cnt : 1u;
}
__device__ __forceinline__ void xcd_barrier(const XcdBarrier& b) {
    asm volatile("s_waitcnt vmcnt(0)" ::: "memory");
    __syncthreads();
    if (threadIdx.x == 0) {
        unsigned* bar = b.bar;
        __builtin_amdgcn_s_waitcnt(0);
        unsigned nloc = b.st[0], nx = b.st[1];
        if (nloc == 0u) { xcd_barrier_complete(bar, b.x, nloc, nx); b.st[0] = nloc; b.st[1] = nx; }
        const unsigned old = xb_add(&bar[XB_XSUB(b.x)], 1u);
        const unsigned gen = old / nloc;
        if (old + 1u == (gen + 1u) * nloc) {
            __builtin_amdgcn_fence(__ATOMIC_RELEASE, "agent");
            asm volatile("s_waitcnt vmcnt(0)" ::: "memory");
            const unsigned og = xb_add(&bar[XB_TOP], 1u);
            const unsigned tg = og / nx;
            if (og + 1u == (tg + 1u) * nx) xb_add(&bar[XB_TOPGEN], 1u);
            else XB_SPIN(xb_ld(&bar[XB_TOPGEN]) == tg, bar);
            __builtin_amdgcn_fence(__ATOMIC_ACQUIRE, "agent");
            xb_add(&bar[XB_XGEN(b.x)], 1u);
            asm volatile("s_waitcnt vmcnt(0)" ::: "memory");
        } else {
            XB_SPIN(xb_ld(&bar[XB_XGEN(b.x)]) == gen, bar);
            __builtin_amdgcn_fence(__ATOMIC_ACQUIRE, "agent");
            asm volatile("s_waitcnt vmcnt(0)" ::: "memory");
        }
    }
    __syncthreads();
}

constexpr int NPH_LAYER = 7, NPH = 1 + DEPTH * NPH_LAYER;
constexpr int LDS_TAB = g8::STAGE_BYTES, LDS_BARW = g8::STAGE_BYTES + 2048, LDS_KX = g8::STAGE_BYTES + 4096, LDS_BYTES = g8::STAGE_BYTES + 4096 + 8192;
__global__ void __launch_bounds__(512, 2) mega(Params p) {
    extern __shared__ __attribute__((aligned(16))) unsigned char lds_raw[];
    float* lds = (float*)lds_raw;
    LAS unsigned char* ldsl = (LAS unsigned char*)lds_raw;
    MoeTab* mt = (MoeTab*)(lds_raw + LDS_TAB);
    Ctx c0; c0.in.p = p.in; c0.in.z = 0; c0.out = p.out; c0.ws = p.ws;
    const int lo = p.ph_lo, hi = p.ph_hi;
    if (threadIdx.x == 0) *(uint4*)(lds_raw + LDS_BARW) = make_uint4(0u, 0u, 0u, 0u);
    __syncthreads();
    XcdBarrier bar = xcd_barrier_post(c0.ctl(), (volatile LAS unsigned*)(ldsl + LDS_BARW));
#ifndef PH_MASK
#define PH_MASK 0x1ff
#endif
#define PHT(k) ((k) == 0 ? 0 : 1 + ((k) - 1) % NPH_LAYER)
#define IN(k) (((PH_MASK >> PHT(k)) & 1) && lo <= (k) && (k) < hi)
#define SEAM(k) do { if (IN(k) && IN((k) + 1)) xcd_barrier(bar); } while (0)
#ifndef PROBE_RSH
#define PROBE_RSH 0
#endif
#ifndef PROBE_DUP
#define PROBE_DUP 0x0
#endif
#define REP(k) for (int rep_ = 0; rep_ < (((PROBE_DUP >> PHT(k)) & 1) ? 2 : 1); ++rep_)
    REP(0) if (IN(0)) { if (rep_) xcd_barrier(bar); const Ctx c = octx(c0); phase_convert(c, lds); phase_norm_in(c, 0); }
    SEAM(0);
#define LAYER_BODY(l) { \
        const int pb = 1 + l * NPH_LAYER; \
        REP(pb + 0) if (IN(pb + 0)) { if (rep_) xcd_barrier(bar); const Ctx c = octx(c0); const bool split_ = (gridDim.x == 256); \
            constexpr bool f8_ = f8in(l); constexpr int ku_ = f8_ ? DM / 2 : DM, ld_ = pb_in(l) / 2;        \
            { g8::DenseOrder S; S.init(T, DIN, gridDim.x, obid(), c.WIN(l), ld_); if (split_) S.lim = 1280; g8::MEpiProjT<f8_> E{c.PROJ(), c.VT(), (LAS float*)(ldsl + LDS_KX), c.in[11] + l * HD, c.in[12] + l * HD}; g8::gemm_mfma(ldsl, c.HB(), ld_, ld_, ku_, S, E); } \
            if (split_) { const int cb_ = obid(), kq_ = cb_ & 3; int k4_ = ku_ / 4; asm volatile("" : "+s"(k4_)); g8::SplitKOrder S{cb_, (const char*)(c.WIN(l) + (size_t)(20 * 256) * ld_ + kq_ * (ku_ / 4))}; g8::MEpiPartT<f8_> E{c.PT(), (LAS float*)(ldsl + LDS_KX)}; g8::gemm_mfma(ldsl, c.HB() + kq_ * (ku_ / 4), ld_, ld_, k4_, S, E); } } \
        SEAM(pb + 0); \
        REP(pb + 1) if (IN(pb + 1)) { if (rep_) xcd_barrier(bar); const Ctx c = octx(c0); if (gridDim.x == 256) phase_vreduce(c); phase_convb(c, l); if (PROBE_SUB == 4) phase_convb(c, l); phase_lruA(c, l, lds_raw); if (PROBE_SUB == 3) phase_lruA(c, l, lds_raw); } \
        SEAM(pb + 1); \
        REP(pb + 2) if (IN(pb + 2)) { if (rep_) xcd_barrier(bar); const Ctx c = octx(c0); phase_lruB(c, l, lds_raw); if (PROBE_SUB == 2) phase_lruB(c, l, lds_raw); phase_attn(c, l, lds_raw); if (PROBE_SUB == 1) phase_attn(c, l, lds_raw); } \
        SEAM(pb + 2); \
        REP(pb + 3) if (IN(pb + 3)) { if (rep_) xcd_barrier(bar); const Ctx c = octx(c0); g8::DenseOrder S; S.init(T, DM, gridDim.x, obid(), c.WOUT(l), DM); if (PROBE_RSH == 3 && l == 0) S.rsh = 1; g8::MEpiOut<l == 0> E{c.in[0], c.XB(), c.X1(), c.X1F8()}; g8::gemm_mfma(ldsl, c.YMIX(), DM, DM, DM, S, E);       } \
        SEAM(pb + 3); \
        REP(pb + 4) if (IN(pb + 4)) { if (rep_) xcd_barrier(bar); const Ctx c = octx(c0); phase_router_mfma(c, l, lds); } \
        SEAM(pb + 4); \
        REP(pb + 5) if (IN(pb + 5)) { if (rep_) xcd_barrier(bar); const Ctx c = octx(c0); build_moe_tab(c, l, mt); \
            const int G_ = (int)gridDim.x, cb_ = obid(), n1_ = __builtin_amdgcn_readfirstlane(mt->tstart[NEXP]) * 4, R_ = n1_ % G_, n1e_ = n1_ - R_, rtA_ = n1e_ >> 2; \
            { g8::MoeOrder<true, 4, DM / 2, (size_t)1024 * DM, (size_t)256 * DM> S{mt, c.LIST(), G_, cb_, (const char*)c.WGU(l)}; g8::MEpiGU E{c.HID8(), c.LISTR(), mt, c.RTC(l), n1e_}; g8::gemm_mfma(ldsl, (const bf16_t*)c.X1F8(), DM / 2, DM / 2, DM / 2, S, E); }       \
            g8::moe_wait_dep(c.RTC(l), cb_, G_, R_, rtA_); \
            { g8::MoeOrder2 S{mt, G_, cb_, R_, rtA_, (const char*)c.WD(l)}; if (PROBE_RSH == 6) S.rsh = 1; g8::MEpiDown8 E{c.YPAD8()}; int k2_ = DEXP / 2; asm volatile("" : "+s"(k2_)); g8::gemm_mfma(ldsl, (const bf16_t*)c.HID8(), DEXP / 2, DEXP / 2, k2_, S, E); } }       \
        SEAM(pb + 5); \
        REP(pb + 6) if (IN(pb + 6)) { if (rep_) xcd_barrier(bar); const Ctx c = octx(c0); build_moe_tab(c, l, mt); if (PROBE_SUB == 6) { phase_combine<true>(c, l, mt); xcd_barrier(bar); } phase_combine<false>(c, l, mt); } \
        SEAM(pb + 6); \
    }
    LAYER_BODY(0)
    LAYER_BODY(1)
#undef LAYER_BODY
#undef IN
#undef SEAM
}

#ifndef N_LAUNCH_SPLIT
#define N_LAUNCH_SPLIT 0
#endif
extern "C" void kernel_launch(void* const* d_in, const int* in_sizes, int n_in, void* d_out, int out_size, void* d_ws, size_t ws_size, hipStream_t stream) {
    static int grid = 0;
    if (grid == 0) {
        if (n_in != 23 || out_size != T * DM || ws_size < WS_END) { fprintf(stderr, "kernel_launch: unexpected problem (n_in %d out %d ws %zu need %zu)\n", n_in, out_size, ws_size, (size_t)WS_END); grid = -1; return; }
        int dev = 0, cus = 0, per_cu = 0;
        if (hipGetDevice(&dev) != hipSuccess || hipDeviceGetAttribute(&cus, hipDeviceAttributeMultiprocessorCount, dev) != hipSuccess) { fprintf(stderr, "kernel_launch: device query failed\n"); grid = -1; return; }
        if (hipFuncSetAttribute((const void*)mega, hipFuncAttributeMaxDynamicSharedMemorySize, LDS_BYTES) != hipSuccess) { fprintf(stderr, "kernel_launch: hipFuncSetAttribute failed\n"); grid = -1; return; }
        if (hipOccupancyMaxActiveBlocksPerMultiprocessor(&per_cu, (const void*)mega, 512, LDS_BYTES) != hipSuccess || per_cu < 1) { fprintf(stderr, "kernel_launch: occupancy query says %d blocks per CU\n", per_cu); }
        (void)hipGetLastError();
        grid = cus;
    }
    if (grid < 0) return;
    (void)hipMemsetAsync((char*)d_ws + OFF_CTL, 0, SZ_CTL, stream);
    Params p{};
    for (int i = 0; i < 23; ++i) p.in[i] = (const float*)d_in[i];
    p.out = (float*)d_out; p.ws = (unsigned char*)d_ws;
    if (N_LAUNCH_SPLIT) { for (int ph = 0; ph < NPH; ++ph) { p.ph_lo = ph; p.ph_hi = ph + 1; hipLaunchKernelGGL(mega, dim3(grid), dim3(512), LDS_BYTES, stream, p); } }
    else { p.ph_lo = 0; p.ph_hi = NPH; hipLaunchKernelGGL(mega, dim3(grid), dim3(512), LDS_BYTES, stream, p); }
}
```

```cpp
#include <hip/hip_runtime.h>
#include <stdint.h>
#include <stdio.h>

typedef unsigned short bf16_t;
typedef float f32x4 __attribute__((ext_vector_type(4)));
typedef unsigned u32x4 __attribute__((ext_vector_type(4)));
typedef unsigned u32x2 __attribute__((ext_vector_type(2)));
typedef short bf16x8 __attribute__((ext_vector_type(8)));

constexpr int T = 16384, DM = 2048, DIN = 5376, DPROJ = 4608, SEQ = 4096, NB = 4, DEPTH = 2;
constexpr int DLRU = 768, DCONV = 512, DSB = 768, HD = 128, NHL = 6, NHS = 6;
constexpr int NEXP = 32, DEXP = 512, MAXTILES = 160, PADROWS = MAXTILES * 256;
constexpr float EPS = 1e-6f;
constexpr float YSCALE_G = 8.0f;
constexpr float SX8 = 8.0f, SW1 = 64.0f, SH8 = 8.0f, SW2 = 32.0f;
#ifndef F8_INPROJ_MASK
#define F8_INPROJ_MASK 3
#endif
constexpr bool f8in(int l) { return ((F8_INPROJ_MASK >> l) & 1) != 0; }
constexpr float SHB = 16.0f, SWI = 64.0f;
#ifndef F8_OUTPROJ_MASK
#define F8_OUTPROJ_MASK 2
#endif
constexpr bool f8out(int l) { return ((F8_OUTPROJ_MASK >> l) & 1) != 0; }
constexpr float SY8 = 16.0f, SWO = 64.0f;
#ifndef PITCH_PAD
#define PITCH_PAD 128
#endif
constexpr int pb_in(int l) { return (f8in(l) ? DM : DM * 2) + PITCH_PAD; }
constexpr int VTS = SEQ + 64;
constexpr int C_XA = 0, C_GA = 768, C_BG = 1536, C_CG = 2048, C_XB = 2560, C_Q = 3072, C_K = 3840, C_V = 4608;

constexpr size_t AL(size_t x) { return (x + 255) & ~(size_t)255; }
constexpr size_t SZ_WIN = (size_t)DIN * (DM * 2 + 256), SZ_WOUT = (size_t)DM * DM * 2, SZ_WGU = (size_t)NEXP * 1024 * DM * 2, SZ_WD = (size_t)NEXP * DM * DEXP * 2;
constexpr size_t SZ_WA = (size_t)NHL * HD * HD * 2, SZ_WR = (size_t)48 * DM * 4;
constexpr size_t OFF_CTL = 0, SZ_CTL = 262144;
constexpr size_t OFF_WIN = OFF_CTL + SZ_CTL;
constexpr size_t OFF_WOUT = OFF_WIN + DEPTH * SZ_WIN;
constexpr size_t OFF_WGU = OFF_WOUT + DEPTH * SZ_WOUT;
constexpr size_t OFF_WD = OFF_WGU + DEPTH * SZ_WGU;
constexpr size_t OFF_WA = OFF_WD + DEPTH * SZ_WD;
constexpr size_t OFF_WX = OFF_WA + DEPTH * SZ_WA;
constexpr size_t OFF_WR = OFF_WX + DEPTH * SZ_WA;
constexpr size_t OFF_HB = OFF_WR + DEPTH * SZ_WR;
constexpr size_t OFF_PROJ = OFF_HB + (size_t)T * (DM * 2 + 256);
constexpr size_t OFF_VT = OFF_PROJ + (size_t)T * DPROJ * 2;
constexpr size_t OFF_YPAD = OFF_PROJ;
constexpr size_t OFF_YMIX = OFF_VT + (size_t)NB * NHS * HD * VTS * 2;
constexpr size_t OFF_X = OFF_YMIX + (size_t)T * DM * 2;
constexpr size_t OFF_HID = OFF_X + (size_t)T * DM * 4;
constexpr size_t OFF_AGG = OFF_HID + (size_t)PADROWS * DEXP * 2;
constexpr size_t OFF_ROUTE = OFF_AGG + (size_t)256 * DLRU * 8;
constexpr size_t OFF_LIST = OFF_ROUTE + (size_t)T * 8 * 4;
constexpr size_t OFF_LISTR = OFF_LIST + (size_t)NEXP * T * 4;
constexpr size_t OFF_DB = OFF_LISTR + (size_t)NEXP * T * 4;
constexpr size_t OFF_SA = OFF_DB + (size_t)T * DM * 2;
constexpr size_t WS_END = OFF_SA + (size_t)T * 4;
static_assert((size_t)PADROWS * DM * 2 <= (size_t)T * DPROJ * 2 + (size_t)NB * NHS * HD * VTS * 2, "YPAD alias");
constexpr int CW_RT = 16384;
constexpr int CW_CM = 32768;
constexpr int CW_CNT = 8192;

typedef __bf16 bf16v2_t __attribute__((ext_vector_type(2)));
typedef float f32v2_t __attribute__((ext_vector_type(2)));
__device__ __forceinline__ unsigned cvt_pk_bf16(float lo, float hi) { const f32v2_t f = {lo, hi}; const bf16v2_t b = __builtin_convertvector(f, bf16v2_t); return __builtin_bit_cast(unsigned, b); }
__device__ __forceinline__ bf16_t f2bf(float f) { return (bf16_t)(cvt_pk_bf16(f, 0.f) & 0xffffu); }
__device__ __forceinline__ float bf2f(bf16_t b) { return __uint_as_float(((unsigned)b) << 16); }
__device__ __forceinline__ float bflo(unsigned w) { return __uint_as_float(w << 16); }
__device__ __forceinline__ float bfhi(unsigned w) { return __uint_as_float(w & 0xffff0000u); }
__device__ __forceinline__ unsigned pack_i8(float a, float b, float c_, float d) {
    const int q0 = (int)__builtin_rintf(a), q1 = (int)__builtin_rintf(b), q2 = (int)__builtin_rintf(c_), q3 = (int)__builtin_rintf(d);
    return ((unsigned)q0 & 255u) | (((unsigned)q1 & 255u) << 8) | (((unsigned)q2 & 255u) << 16) | ((unsigned)q3 << 24);
}
__device__ __forceinline__ float sat8(float v) { return __builtin_amdgcn_fmed3f(v, -448.0f, 448.0f); }
__device__ __forceinline__ u32x2 y8pack(float a0, float a1, float a2, float a3, float a4, float a5, float a6, float a7) { int w0 = 0, w1 = 0;
    w0 = __builtin_amdgcn_cvt_pk_fp8_f32(sat8(a0 * SY8), sat8(a1 * SY8), w0, false); w0 = __builtin_amdgcn_cvt_pk_fp8_f32(sat8(a2 * SY8), sat8(a3 * SY8), w0, true);
    w1 = __builtin_amdgcn_cvt_pk_fp8_f32(sat8(a4 * SY8), sat8(a5 * SY8), w1, false); w1 = __builtin_amdgcn_cvt_pk_fp8_f32(sat8(a6 * SY8), sat8(a7 * SY8), w1, true);
    return (u32x2){(unsigned)w0, (unsigned)w1}; }
__device__ __forceinline__ float wave_sum(float v) {
#pragma unroll
    for (int o = 32; o >= 1; o >>= 1) v += __shfl_xor(v, o);
    return v;
}
__device__ __forceinline__ float fast_exp(float x) { return __builtin_amdgcn_exp2f(x * 1.4426950408889634f); }
__device__ __forceinline__ float sigmoidf_(float x) { return __builtin_amdgcn_rcpf(1.0f + fast_exp(-x)); }
__device__ __forceinline__ float one_minus_exp(float x) { const float s = -x * (1.0f + x * (0.5f + x * 0.16666667f)); const float d = 1.0f - fast_exp(x); return x > -0.02f ? s : d; }
__device__ __forceinline__ float softplusf_(float x) { return fmaxf(x, 0.f) + log1pf(__expf(-fabsf(x))); }
__device__ __forceinline__ float gelu_tanh(float x) { const float p = __builtin_fmaf(x * x, -0.044715f * 1.5957691216057308f * 1.4426950408889634f, -1.5957691216057308f * 1.4426950408889634f); return x * __builtin_amdgcn_rcpf(1.0f + __builtin_amdgcn_exp2f(x * p)); }

__device__ __forceinline__ int otid() { int t = (int)threadIdx.x; asm volatile("" : "+v"(t)); return t; }
__device__ __forceinline__ int obid() { int b = (int)blockIdx.x; asm volatile("" : "+s"(b)); return b; }
#ifndef PROBE_SUB
#define PROBE_SUB 0
#endif
struct Params { const float* in[23]; float* out; unsigned char* ws; int ph_lo, ph_hi; };

struct InProxy { const float* const* p; int z; __device__ __forceinline__ const float* operator[](int k) const { return p[k + z]; } };
struct Ctx {
    InProxy in; float* out; unsigned char* ws;
    __device__ __forceinline__ unsigned* ctl() const { return (unsigned*)(ws + OFF_CTL); }
    __device__ __forceinline__ bf16_t* WIN(int l) const { return (bf16_t*)(ws + OFF_WIN + l * SZ_WIN); }
    __device__ __forceinline__ bf16_t* WOUT(int l) const { return (bf16_t*)(ws + OFF_WOUT + l * SZ_WOUT); }
    __device__ __forceinline__ bf16_t* WGU(int l) const { return (bf16_t*)(ws + OFF_WGU + l * SZ_WGU); }
    __device__ __forceinline__ bf16_t* WD(int l) const { return (bf16_t*)(ws + OFF_WD + l * SZ_WD); }
    __device__ __forceinline__ bf16_t* WA(int l) const { return (bf16_t*)(ws + OFF_WA + l * SZ_WA); }
    __device__ __forceinline__ bf16_t* WX(int l) const { return (bf16_t*)(ws + OFF_WX + l * SZ_WA); }
    __device__ __forceinline__ float* WR(int l) const { return (float*)(ws + OFF_WR + l * SZ_WR); }
    __device__ __forceinline__ unsigned* CM(int l) const { return ctl() + CW_CM + l * 8192; }
    __device__ __forceinline__ float* SA() const { return (float*)(ws + OFF_SA); }
    __device__ __forceinline__ unsigned* RTC(int l) const { return ctl() + CW_RT + l * 8192; }
    __device__ __forceinline__ unsigned* CNT(int l) const { return ctl() + CW_CNT + l * 2048; }
#define WSP(name, type, off) __device__ __forceinline__ type* name() const { return (type*)(ws + (off)); }
    WSP(HB, bf16_t, OFF_HB) WSP(PROJ, bf16_t, OFF_PROJ) WSP(VT, bf16_t, OFF_VT) WSP(YPAD, bf16_t, OFF_YPAD) WSP(YPAD8, unsigned char, OFF_YPAD) WSP(YMIX, bf16_t, OFF_YMIX) WSP(HID, bf16_t, OFF_HID)
    WSP(X, float, OFF_X) WSP(XB, bf16_t, OFF_X) WSP(AGG, float, OFF_AGG) WSP(ROUTE, unsigned, OFF_ROUTE) WSP(LIST, int, OFF_LIST) WSP(LISTR, float, OFF_LISTR) WSP(PT, bf16_t, OFF_X + (size_t)T * DM * 2) WSP(X1, bf16_t, OFF_X + (size_t)T * DM * 2) WSP(X1F8, unsigned char, OFF_HB) WSP(HID8, unsigned char, OFF_HID) WSP(DB, bf16_t, OFF_DB) WSP(HL, bf16_t, OFF_DB) WSP(PL, bf16_t, OFF_DB + (size_t)T * DLRU * 2)
#undef WSP
};

__device__ __forceinline__ Ctx octx(const Ctx& c) { int z = 0; asm volatile("" : "+s"(z)); Ctx r; r.in.p = c.in.p; r.in.z = z; r.out = c.out + z; r.ws = c.ws + z; return r; }

__device__ __forceinline__ void cvt_tile_out(const float* tile, int st, int r0, bf16_t* dst, int ld_dst, int drow0, bool f8, const unsigned* cm) {
    const int rr = (st & 7) * 8;
    if (cm) {
#pragma unroll
        for (int p = 0; p < 2; ++p) {
            const int c = (st >> 3) + 32 * p; const float inv = 127.0f / fmaxf(__uint_as_float(cm[drow0 + c]), 1e-30f);
            const unsigned w0 = pack_i8(tile[(rr + 0) * 65 + c] * inv, tile[(rr + 1) * 65 + c] * inv, tile[(rr + 2) * 65 + c] * inv, tile[(rr + 3) * 65 + c] * inv);
            const unsigned w1 = pack_i8(tile[(rr + 4) * 65 + c] * inv, tile[(rr + 5) * 65 + c] * inv, tile[(rr + 6) * 65 + c] * inv, tile[(rr + 7) * 65 + c] * inv);
            *(u32x2*)((unsigned char*)dst + (size_t)(drow0 + c) * ld_dst + r0 + rr) = (u32x2){w0, w1};
        }
        return;
    }
    if (f8) {
#pragma unroll
        for (int p = 0; p < 2; ++p) {
            const int c = (st >> 3) + 32 * p; int w0 = 0, w1 = 0;
            w0 = __builtin_amdgcn_cvt_pk_fp8_f32(tile[(rr + 0) * 65 + c], tile[(rr + 1) * 65 + c], w0, false); w0 = __builtin_amdgcn_cvt_pk_fp8_f32(tile[(rr + 2) * 65 + c], tile[(rr + 3) * 65 + c], w0, true);
            w1 = __builtin_amdgcn_cvt_pk_fp8_f32(tile[(rr + 4) * 65 + c], tile[(rr + 5) * 65 + c], w1, false); w1 = __builtin_amdgcn_cvt_pk_fp8_f32(tile[(rr + 6) * 65 + c], tile[(rr + 7) * 65 + c], w1, true);
            *(u32x2*)((unsigned char*)dst + (size_t)(drow0 + c) * ld_dst + r0 + rr) = (u32x2){(unsigned)w0, (unsigned)w1};
        }
        return;
    }
#pragma unroll
    for (int p = 0; p < 2; ++p) {
        const int c = (st >> 3) + 32 * p;
        u32x4 w;
        w.x = cvt_pk_bf16(tile[(rr + 0) * 65 + c], tile[(rr + 1) * 65 + c]); w.y = cvt_pk_bf16(tile[(rr + 2) * 65 + c], tile[(rr + 3) * 65 + c]);
        w.z = cvt_pk_bf16(tile[(rr + 4) * 65 + c], tile[(rr + 5) * 65 + c]); w.w = cvt_pk_bf16(tile[(rr + 6) * 65 + c], tile[(rr + 7) * 65 + c]);
        *(u32x4*)(dst + (size_t)(drow0 + c) * ld_dst + r0 + rr) = w;
    }
}
constexpr int CV_WIN = 32 * 84, CV_WOUT = 32 * 32, CV_EXP = 32 * 8  , CV_G = NEXP * CV_EXP, CV_LRU = NHL * 4;
constexpr int CV_PER_LAYER = CV_WIN + CV_WOUT + 3 * CV_G + 2 * CV_LRU;
struct CvtTile { const float* src; bf16_t* dst; const float* gk; const unsigned* cm; int ld_src, ld_dst, r0, c0, drow0; float sc; };
__device__ __forceinline__ void cvt_decode(const Ctx& c, int id, CvtTile& t) {
    const int l = id / CV_PER_LAYER; int j = id % CV_PER_LAYER; t.gk = nullptr; t.cm = nullptr; t.sc = 1.0f;
    if (j < CV_WIN) { t.src = c.in[2] + (size_t)l * DM * DIN; t.ld_src = DIN; { const int g = j >> 3, kp = g / 21, nq = g % 21; t.r0 = (2 * kp + ((j >> 2) & 1)) * 64; t.c0 = (4 * nq + (j & 3)) * 64; } t.dst = c.WIN(l); t.ld_dst = f8in(l) ? pb_in(l) : pb_in(l) / 2; t.drow0 = t.c0; if (f8in(l)) { t.sc = -1.0f; t.cm = c.CM(l); } }
    else if ((j -= CV_WIN) < CV_WOUT) { t.src = c.in[14] + (size_t)l * DM * DM; t.ld_src = DM; { const int g = j >> 3, kp = g / 8, nq = g % 8; t.r0 = (2 * kp + ((j >> 2) & 1)) * 64; t.c0 = (4 * nq + (j & 3)) * 64; } t.dst = c.WOUT(l); t.ld_dst = DM; t.drow0 = t.c0; if (f8out(l)) t.sc = -SWO; }
    else if ((j -= CV_WOUT) < 2 * CV_G) {
        const int isup = j / CV_G; j %= CV_G; const int e = j / CV_EXP; j %= CV_EXP;
        t.src = c.in[isup ? 21 : 20] + ((size_t)l * NEXP + e) * DM * DEXP; t.ld_src = DEXP; { const int g = j >> 3, kp = g / 2, nq = g % 2; t.r0 = (2 * kp + ((j >> 2) & 1)) * 64; t.c0 = (4 * nq + (j & 3)) * 64; }
        t.dst = (bf16_t*)((unsigned char*)c.WGU(l) + (size_t)e * 1024 * DM); t.ld_dst = DM; t.drow0 = 256 * (t.c0 / 128) + 128 * isup + (t.c0 % 128); t.gk = c.in[15] + (size_t)l * DM; t.sc = -SW1;
    } else if ((j -= 2 * CV_G) < CV_G) {
        const int e = j / CV_EXP; j %= CV_EXP;
        t.src = c.in[22] + ((size_t)l * NEXP + e) * DEXP * DM; t.ld_src = DM; { const int g = j >> 3, kp = g / 8, nq = g % 8; t.r0 = (2 * kp + ((j >> 2) & 1)) * 64; t.c0 = (4 * nq + (j & 3)) * 64; }
        t.dst = (bf16_t*)((unsigned char*)c.WD(l) + (size_t)e * DM * DEXP); t.ld_dst = DEXP; t.drow0 = t.c0; t.sc = -SW2;
    } else { j -= CV_G; const int isx = j / CV_LRU; j %= CV_LRU; const int h = j / 4; j %= 4;
        t.src = c.in[isx ? 7 : 5] + ((size_t)l * NHL + h) * HD * HD; t.ld_src = HD; t.r0 = (j / 2) * 64; t.c0 = (j % 2) * 64;
        t.dst = (isx ? c.WX(l) : c.WA(l)) + (size_t)h * HD * HD; t.ld_dst = HD; t.drow0 = t.c0; }
}
constexpr int CVT_NT = 4;
__device__ __forceinline__ void phase_colmax(const Ctx& c) {
    constexpr int NQ = DIN / 4, NKB = DM / 64;
    for (int item = obid() * 512 + otid(); item < DEPTH * NKB * NQ; item += gridDim.x * 512) {
        const int l = item / (NKB * NQ), rem = item % (NKB * NQ), kb = rem / NQ, nq = rem % NQ;
        if (!f8in(l)) continue;
        const float* p = c.in[2] + ((size_t)l * DM + kb * 64) * DIN + nq * 4;
        f32x4 m = (f32x4){0.f, 0.f, 0.f, 0.f};
#pragma unroll 16
        for (int r = 0; r < 64; ++r) { const f32x4 w = *(const f32x4*)(p + (size_t)r * DIN); m[0] = fmaxf(m[0], fabsf(w[0])); m[1] = fmaxf(m[1], fabsf(w[1])); m[2] = fmaxf(m[2], fabsf(w[2])); m[3] = fmaxf(m[3], fabsf(w[3])); }
        unsigned* cm = c.CM(l) + nq * 4;
#pragma unroll
        for (int i = 0; i < 4; ++i) atomicMax(cm + i, __float_as_uint(m[i]));
    }
}
__device__ __forceinline__ void phase_convert(const Ctx& c, float* lds) {
    const int tid = otid(), sb = __builtin_amdgcn_readfirstlane(tid >> 8), st = tid & 255;
    float* tile0 = lds + sb * (CVT_NT * 64 * 65);
    const int total = DEPTH * CV_PER_LAYER;
    const int nsub = gridDim.x * 2 * CVT_NT;
    const int idb = (obid() * 2 + sb) * CVT_NT;
    CvtTile tA[CVT_NT], tB[CVT_NT]; f32x4 vA[CVT_NT][4], vB[CVT_NT][4]; float gA[CVT_NT][4], gB[CVT_NT][4];
#define CVT_LOAD(T_, V_, G_, base_) do { _Pragma("unroll") for (int k = 0; k < CVT_NT; ++k) { const int id_ = (base_) + idb + k; cvt_decode(c, id_ < total ? id_ : 0, T_[k]); \
        _Pragma("unroll") for (int i = 0; i < 4; ++i) { V_[k][i] = __builtin_nontemporal_load((const f32x4*)(T_[k].src + (size_t)(T_[k].r0 + (st >> 4) + 16 * i) * T_[k].ld_src + T_[k].c0 + (st & 15) * 4)); \
            G_[k][i] = T_[k].gk ? T_[k].gk[T_[k].r0 + (st >> 4) + 16 * i] : 1.0f; } } } while (0)
#define CVT_FLUSH(T_, V_, G_, base_) do { _Pragma("unroll") for (int k = 0; k < CVT_NT; ++k) _Pragma("unroll") for (int i = 0; i < 4; ++i) { \
            float* p = tile0 + k * (64 * 65) + ((st >> 4) + 16 * i) * 65 + (st & 15) * 4; const float gs_ = G_[k][i] * fabsf(T_[k].sc); \
            p[0] = V_[k][i][0] * gs_; p[1] = V_[k][i][1] * gs_; p[2] = V_[k][i][2] * gs_; p[3] = V_[k][i][3] * gs_; } \
        __syncthreads(); \
        _Pragma("unroll") for (int k = 0; k < CVT_NT; ++k) if ((base_) + idb + k < total) cvt_tile_out(tile0 + k * (64 * 65), st, T_[k].r0, T_[k].dst, T_[k].ld_dst, T_[k].drow0, T_[k].sc < 0.f, T_[k].cm); \
        __syncthreads(); } while (0)
    CVT_LOAD(tA, vA, gA, 0);
    for (int base = 0; base < total; base += 2 * nsub) {
        CVT_LOAD(tB, vB, gB, base + nsub); __builtin_amdgcn_sched_barrier(0);
        CVT_FLUSH(tA, vA, gA, base);
        CVT_LOAD(tA, vA, gA, base + 2 * nsub); __builtin_amdgcn_sched_barrier(0);
        CVT_FLUSH(tB, vB, gB, base + nsub);
    }
#undef CVT_LOAD
#undef CVT_FLUSH
    for (int i = obid() * blockDim.x + tid; i < DEPTH * 48 * DM; i += gridDim.x * blockDim.x) {
        const int l = i / (48 * DM), n = (i / DM) % 48, k = i % DM;
        float v = 0.f;
        if (n < 4) v = c.in[16][((size_t)l * DM + k) * 4 + n]; else if (n < 36) v = c.in[18][((size_t)l * DM + k) * 32 + (n - 4)];
        const float wg = v * c.in[15][(size_t)l * DM + k]; const bf16_t hi = f2bf(wg);
        bf16_t* wr = (bf16_t*)c.WR(l); wr[(size_t)n * DM + k] = hi; wr[(size_t)(48 + n) * DM + k] = f2bf(wg - bf2f(hi));
    }
}

__device__ __forceinline__ void norm_store_row(const f32x4 (&v)[8], const float* g, bf16_t* dst, int lane) {
    float s = 0.f;
#pragma unroll
    for (int j = 0; j < 8; ++j) s += v[j][0] * v[j][0] + v[j][1] * v[j][1] + v[j][2] * v[j][2] + v[j][3] * v[j][3];
    s = wave_sum(s);
    const float rstd = rsqrtf(s * (1.0f / DM) + EPS);
#pragma unroll
    for (int j = 0; j < 8; ++j) {
        const f32x4 gg = *(const f32x4*)(g + j * 256 + lane * 4);
        u32x2 w; w.x = cvt_pk_bf16(v[j][0] * rstd * gg[0], v[j][1] * rstd * gg[1]); w.y = cvt_pk_bf16(v[j][2] * rstd * gg[2], v[j][3] * rstd * gg[3]);
        *(u32x2*)(dst + j * 256 + lane * 4) = w;
    }
}
__device__ __forceinline__ void norm_store_row8(const f32x4 (&v)[8], const f32x4 (&G)[8], unsigned char* dst, int lane, float* sa_row) {
    float s = 0.f;
#pragma unroll
    for (int j = 0; j < 8; ++j) s += v[j][0] * v[j][0] + v[j][1] * v[j][1] + v[j][2] * v[j][2] + v[j][3] * v[j][3];
    s = wave_sum(s);
    const float rstd = rsqrtf(s * (1.0f / DM) + EPS);
    f32x4 h[8]; float am = 0.f;
#pragma unroll
    for (int j = 0; j < 8; ++j) { const f32x4 gg = G[j]; h[j] = v[j] * rstd * gg;
        am = fmaxf(am, fmaxf(fmaxf(fabsf(h[j][0]), fabsf(h[j][1])), fmaxf(fabsf(h[j][2]), fabsf(h[j][3])))); }
#pragma unroll
    for (int o = 32; o >= 1; o >>= 1) am = fmaxf(am, __shfl_xor(am, o));
    am = fmaxf(am, 1e-20f);
    const float inv = 127.0f / am;
#pragma unroll
    for (int j = 0; j < 8; ++j) *(unsigned*)(dst + j * 256 + lane * 4) = pack_i8(h[j][0] * inv, h[j][1] * inv, h[j][2] * inv, h[j][3] * inv);
    if (lane == 0) *sa_row = am * (1.0f / 127.0f);
}
__device__ __forceinline__ void phase_norm_in(const Ctx& c, int l) {
    const int tid = otid(), lane = tid & 63, wv = tid >> 6, stride = gridDim.x * 8;
    f32x4 G[8];
#pragma unroll
    for (int j = 0; j < 8; ++j) G[j] = *(const f32x4*)(c.in[1] + (size_t)l * DM + j * 256 + lane * 4);
    __builtin_amdgcn_sched_barrier(0);
    for (int r = obid() * 8 + wv; r < T; r += 4 * stride) {
        f32x4 v[4][8];
#pragma unroll
        for (int k = 0; k < 4; ++k) { const int rr = (r + k * stride < T) ? r + k * stride : r;
#pragma unroll
            for (int j = 0; j < 8; ++j) v[k][j] = *(const f32x4*)(c.in[0] + (size_t)rr * DM + j * 256 + lane * 4); }
#pragma unroll
        for (int k = 0; k < 4; ++k) if (k == 0 || r + k * stride < T) { if (f8in(0)) norm_store_row8(v[k], G, (unsigned char*)c.HB() + (size_t)(r + k * stride) * pb_in(0), lane, c.SA() + (r + k * stride));
            else norm_store_row(v[k], c.in[1] + (size_t)l * DM, (bf16_t*)((unsigned char*)c.HB() + (size_t)(r + k * stride) * pb_in(0)), lane); }
    }
}

struct MoeTab { int cnt[NEXP]; int tstart[NEXP + 1]; int texp[MAXTILES]; };
__device__ __forceinline__ void build_moe_tab(const Ctx& c, int l, MoeTab* mt) {
    __syncthreads();
    const int tid = otid();
    if (tid < 64) {
        const int n = tid < NEXP ? (int)__hip_atomic_load(c.CNT(l) + tid * 64, __ATOMIC_RELAXED, __HIP_MEMORY_SCOPE_AGENT) : 0;
        const int nt = (n + 255) >> 8;
        int incl = nt;
#pragma unroll
        for (int o = 1; o < 32; o <<= 1) { const int v = __shfl_up(incl, o); if (tid >= o) incl += v; }
        const int excl = incl - nt;
        if (tid < NEXP) { mt->cnt[tid] = n; mt->tstart[tid] = excl; for (int i = 0; i < nt; ++i) if (excl + i < MAXTILES) mt->texp[excl + i] = tid; }
        if (tid == NEXP - 1) mt->tstart[NEXP] = incl < MAXTILES ? incl : MAXTILES;
    }
    __syncthreads();
}

template <bool DRY> __device__ __forceinline__ void phase_combine(const Ctx& c, int l, const MoeTab* mt) {
    const int tid = otid(), lane = tid & 63, wv = tid >> 6, stride = gridDim.x * 8;
    bf16_t* XB = c.XB(); const bf16_t* X1 = c.X1(); const unsigned char* YPAD = c.YPAD8(); const unsigned* ROUTE = c.ROUTE();
    f32x4 G[8];
#pragma unroll
    for (int j = 0; j < 8; ++j) G[j] = *(const f32x4*)(c.in[1] + (size_t)(l + 1 < DEPTH ? l + 1 : 0) * DM + j * 256 + lane * 4);
    __builtin_amdgcn_sched_barrier(0);
    for (int r = obid() * 8 + wv; r < T; r += 2 * stride) {
        f32x4 v[2][8]; unsigned ya[2][8], yb[2][8]; u32x2 yd[2][8]; float g0[2], g1[2]; int rr[2];
#pragma unroll
        for (int k = 0; k < 2; ++k) {
            rr[k] = (r + k * stride < T) ? r + k * stride : r;
            const u32x4 ra = *(const u32x4*)(ROUTE + (size_t)rr[k] * 8); const u32x2 rb = *(const u32x2*)(ROUTE + (size_t)rr[k] * 8 + 4);
            const int e0 = ra.x, p0 = ra.y, e1 = ra.w, p1 = rb.x; g0[k] = __uint_as_float(ra.z) * (1.0f / YSCALE_G); g1[k] = __uint_as_float(rb.y) * (1.0f / YSCALE_G);
            const unsigned char* y0 = YPAD + ((size_t)mt->tstart[e0] * 256 + p0) * DM + lane * 4; const unsigned char* y1 = YPAD + ((size_t)mt->tstart[e1] * 256 + p1) * DM + lane * 4;
            const bf16_t* dp = X1 + (size_t)rr[k] * DM + lane * 4;
#pragma unroll
            for (int j = 0; j < 8; ++j) { v[k][j] = (f32x4){0.f, 0.f, 0.f, 0.f};
                ya[k][j] = *(const unsigned*)(y0 + j * 256); yb[k][j] = *(const unsigned*)(y1 + j * 256); yd[k][j] = *(const u32x2*)(dp + j * 256); }
        }
        __builtin_amdgcn_sched_barrier(0);
#pragma unroll
        for (int k = 0; k < 2; ++k) {
            if (k == 0 || r + stride < T) {
#pragma unroll
                for (int j = 0; j < 8; ++j) {
                    typedef float f32x2_t __attribute__((ext_vector_type(2)));
                    const f32x2_t a01 = __builtin_amdgcn_cvt_pk_f32_fp8((int)ya[k][j], false), a23 = __builtin_amdgcn_cvt_pk_f32_fp8((int)ya[k][j], true);
                    const f32x2_t b01 = __builtin_amdgcn_cvt_pk_f32_fp8((int)yb[k][j], false), b23 = __builtin_amdgcn_cvt_pk_f32_fp8((int)yb[k][j], true);
                    v[k][j][0] += bflo(yd[k][j].x) + g0[k] * a01.x + g1[k] * b01.x; v[k][j][1] += bfhi(yd[k][j].x) + g0[k] * a01.y + g1[k] * b01.y;
                    v[k][j][2] += bflo(yd[k][j].y) + g0[k] * a23.x + g1[k] * b23.x; v[k][j][3] += bfhi(yd[k][j].y) + g0[k] * a23.y + g1[k] * b23.y;
                }
                if (l == DEPTH - 1) {
                    if (!DRY) {
#pragma unroll
                    for (int j = 0; j < 8; ++j) *(f32x4*)(c.out + (size_t)rr[k] * DM + j * 256 + lane * 4) = v[k][j]; }
                    else norm_store_row(v[k], c.in[1], c.HB() + (size_t)rr[k] * DM, lane);
                } else {
                    if (!DRY) {
#pragma unroll
                    for (int j = 0; j < 8; ++j) { u32x2 xw; xw.x = cvt_pk_bf16(v[k][j][0], v[k][j][1]); xw.y = cvt_pk_bf16(v[k][j][2], v[k][j][3]); *(u32x2*)(XB + (size_t)rr[k] * DM + j * 256 + lane * 4) = xw; } }
                    if (f8in(l + 1)) norm_store_row8(v[k], G, (unsigned char*)c.HB() + (size_t)rr[k] * pb_in(l + 1), lane, c.SA() + rr[k]);
                    else norm_store_row(v[k], c.in[1] + (size_t)(l + 1) * DM, (bf16_t*)((unsigned char*)c.HB() + (size_t)rr[k] * pb_in(l + 1)), lane);
                }
            }
        }
    }
}

__device__ __forceinline__ void phase_router_mfma(const Ctx& c, int l, float* lds) {
    float* LG = lds; float* SS = lds + 26624; float* RS = lds + 27136; int* LC = (int*)(lds + 27200); int* LB = (int*)(lds + 27232);
    const int tid = otid(), lane = tid & 63, wv = tid >> 6, rt = wv & 3, kh = wv >> 2, q = lane >> 4, l15 = lane & 15;
    const float* WR = c.WR(l);
    for (int tile = obid(); tile < T / 64; tile += gridDim.x) {
        const int r0 = tile * 64;
        f32x4 acc[4][3];
#pragma unroll
        for (int g = 0; g < 4; ++g)
#pragma unroll
            for (int ct = 0; ct < 3; ++ct) acc[g][ct] = (f32x4){0.f, 0.f, 0.f, 0.f};
        const bf16_t* xp = c.X1() + (size_t)(r0 + l15) * DM + wv * 256 + 8 * q;
        const bf16_t* wh = (const bf16_t*)WR + (size_t)l15 * DM + wv * 256 + 8 * q; const bf16_t* wl = wh + (size_t)48 * DM;
        float ssq[4] = {0.f, 0.f, 0.f, 0.f};
        bf16x8 xa[2][4], bh[2][3], bl[2][3];
#pragma unroll
        for (int st = 0; st < 2; ++st)
#pragma unroll
            for (int g = 0; g < 4; ++g) xa[st][g] = *(const bf16x8*)(xp + (size_t)(16 * g) * DM + 32 * st);
#pragma unroll
        for (int ct = 0; ct < 3; ++ct) { bh[0][ct] = *(const bf16x8*)(wh + (size_t)(16 * ct) * DM); bl[0][ct] = *(const bf16x8*)(wl + (size_t)(16 * ct) * DM); }
#define RT_STEP(st_, cur_, nxt_, ldb_, ldx_) do { \
            if (ldb_) { _Pragma("unroll") for (int ct = 0; ct < 3; ++ct) { bh[nxt_][ct] = *(const bf16x8*)(wh + (size_t)(16 * ct) * DM + 32 * ((st_) + 1)); bl[nxt_][ct] = *(const bf16x8*)(wl + (size_t)(16 * ct) * DM + 32 * ((st_) + 1)); } } \
            __builtin_amdgcn_sched_barrier(0); \
            _Pragma("unroll") for (int g = 0; g < 4; ++g) { \
                const bf16x8 xv = xa[cur_][g]; \
                _Pragma("unroll") for (int j = 0; j < 8; ++j) { const float xf = __uint_as_float(((unsigned)(unsigned short)xv[j]) << 16); ssq[g] += xf * xf; } \
                _Pragma("unroll") for (int ct = 0; ct < 3; ++ct) { acc[g][ct] = __builtin_amdgcn_mfma_f32_16x16x32_bf16(xv, bh[cur_][ct], acc[g][ct], 0, 0, 0); acc[g][ct] = __builtin_amdgcn_mfma_f32_16x16x32_bf16(xv, bl[cur_][ct], acc[g][ct], 0, 0, 0); } \
                if (ldx_) xa[cur_][g] = *(const bf16x8*)(xp + (size_t)(16 * g) * DM + 32 * ((st_) + 2)); } \
            __builtin_amdgcn_sched_barrier(0); } while (0)
#pragma unroll 1
        for (int sp = 0; sp < 4; ++sp) {
            RT_STEP(2 * sp, 0, 1, true, sp < 3);
            RT_STEP(2 * sp + 1, 1, 0, sp < 3, sp < 3);
        }
#undef RT_STEP
#pragma unroll
        for (int g = 0; g < 4; ++g) { float v = ssq[g]; v += __shfl_xor(v, 16); v += __shfl_xor(v, 32); if (q == 0) SS[wv * 64 + 16 * g + l15] = v; }
#pragma unroll
        for (int g = 0; g < 4; ++g)
#pragma unroll
            for (int ct = 0; ct < 3; ++ct)
#pragma unroll
                for (int i = 0; i < 4; ++i) LG[(wv * 64 + 16 * g + 4 * q + i) * 52 + 16 * ct + l15] = acc[g][ct][i];
        if (tid < NEXP) LC[tid] = 0;
        __syncthreads();
        int e0 = 0, e1 = 0, k0_ = 0, k1_ = 0; float rstd_ = 0.f, g0_ = 0.f, g1_ = 0.f;
        if (tid < 64) {
            float sst_ = 0.f;
#pragma unroll
            for (int w = 0; w < 8; ++w) sst_ += SS[w * 64 + tid];
            const float rstd = rsqrtf(sst_ * (1.0f / DM) + EPS);
            RS[tid] = rstd;
            float gl[4], el[8];
#pragma unroll
            for (int i = 0; i < 4; ++i) { float a_ = 0.f;
#pragma unroll
                for (int w = 0; w < 8; ++w) a_ += LG[(w * 64 + tid) * 52 + i];
                gl[i] = a_ * rstd + c.in[17][l * 4 + i]; }
            int gi = 0; float gm = gl[0];
#pragma unroll
            for (int i = 1; i < 4; ++i) if (gl[i] > gm) { gm = gl[i]; gi = i; }
            float gs = 0.f;
#pragma unroll
            for (int i = 0; i < 4; ++i) gs += __expf(gl[i] - gm);
            const float pg = 1.0f / gs;
#pragma unroll
            for (int i = 0; i < 8; ++i) { const int n = 4 + gi * 8 + i; float a_ = 0.f;
#pragma unroll
                for (int w = 0; w < 8; ++w) a_ += LG[(w * 64 + tid) * 52 + n];
                el[i] = a_ * rstd + c.in[19][l * 32 + gi * 8 + i]; }
            int i0 = 0; float m0 = el[0];
#pragma unroll
            for (int i = 1; i < 8; ++i) if (el[i] > m0) { m0 = el[i]; i0 = i; }
            int i1 = -1; float m1 = -3.0e38f;
#pragma unroll
            for (int i = 0; i < 8; ++i) if (i != i0 && el[i] > m1) { m1 = el[i]; i1 = i; }
            const float ex1 = __expf(m1 - m0), den = 1.0f + ex1;
            const float g0 = pg / den, g1 = pg * ex1 / den;
            e0 = gi * 8 + i0; e1 = gi * 8 + i1; rstd_ = rstd; g0_ = g0; g1_ = g1;
            k0_ = (int)__hip_atomic_fetch_add(&LC[e0], 1, __ATOMIC_RELAXED, __HIP_MEMORY_SCOPE_WORKGROUP);
            k1_ = (int)__hip_atomic_fetch_add(&LC[e1], 1, __ATOMIC_RELAXED, __HIP_MEMORY_SCOPE_WORKGROUP);
        }
        __syncthreads();
        if (tid < NEXP) { const int n = LC[tid]; LB[tid] = n > 0 ? (int)__hip_atomic_fetch_add(c.CNT(l) + tid * 64, (unsigned)n, __ATOMIC_RELAXED, __HIP_MEMORY_SCOPE_AGENT) : 0; }
        __syncthreads();
        if (tid < 64) {
            const int r = r0 + tid, p0 = LB[e0] + k0_, p1 = LB[e1] + k1_;
            c.LIST()[(size_t)e0 * T + p0] = r; c.LIST()[(size_t)e1 * T + p1] = r;
            c.LISTR()[(size_t)e0 * T + p0] = rstd_; c.LISTR()[(size_t)e1 * T + p1] = rstd_;
            unsigned* ro = c.ROUTE() + (size_t)r * 8;
            *(u32x4*)ro = (u32x4){(unsigned)e0, (unsigned)p0, __float_as_uint(g0_), (unsigned)e1};
            *(u32x2*)(ro + 4) = (u32x2){(unsigned)p1, __float_as_uint(g1_)};
        }
        __syncthreads();
    }
}

#define LAS __attribute__((address_space(3)))
typedef int i32x4_t __attribute__((ext_vector_type(4)));
typedef int i32x8_t __attribute__((ext_vector_type(8)));
__device__ __forceinline__ i32x8_t cat8(const bf16x8 a, const bf16x8 b) { const i32x4_t x = __builtin_bit_cast(i32x4_t, a), y = __builtin_bit_cast(i32x4_t, b); return __builtin_shufflevector(x, y, 0, 1, 2, 3, 4, 5, 6, 7); }
__device__ __forceinline__ void mfma_f8(f32x4& acc, const i32x8_t& a, const i32x8_t& b) { asm volatile("v_mfma_f32_16x16x128_f8f6f4 %0, %1, %2, %0" : "+v"(acc) : "v"(a), "v"(b)); }
__device__ __forceinline__ bf16x8 half8(const i32x8_t& v, int k) { const i32x4_t h = k ? __builtin_shufflevector(v, v, 4, 5, 6, 7) : __builtin_shufflevector(v, v, 0, 1, 2, 3); return __builtin_bit_cast(bf16x8, h); }
namespace g8 {
constexpr int BM = 256, BK = 64, HALF = 128, HTB = HALF * BK * 2, STAGE_BYTES = 8 * HTB, NXCD = 8, WGM = 8;
__device__ __forceinline__ int lds_byte(int r, int c) { const int st = (r >> 4) * 2 + (c >> 5), rr = r & 15, cc = c & 31, ob = rr * 64 + cc * 2; return st * 1024 + (ob ^ (((ob >> 9) & 1) << 5)); }
__device__ __forceinline__ void stage_rc(int b, int& R, int& C) { const int st = b / 1024, sb = b % 1024, swz = sb ^ (((sb >> 9) & 1) << 5); R = (st >> 1) * 16 + swz / 64; C = (st & 1) * 32 + (swz % 64) / 2; }
__device__ __forceinline__ int perm32(int rho) { const int n = rho >> 4, i = rho & 15; return 8 * (i >> 2) + 4 * n + (i & 3); }
struct Unit { int pm, pn; const char* B; };
typedef f32x4 Acc[2][2][4][2];

struct DenseOrder {
    static constexpr bool GATHER = false;
    int nM, nN, nwg, G, c; const char* Bt; size_t tstrideB; int rsh = 0, lim = 0x7fffffff;
    __device__ __forceinline__ void init(int M, int N, int G_, int c_, const bf16_t* Bt_, int ldb) { nM = M / BM; nN = N / BM; nwg = nM * nN; G = G_; c = c_; Bt = (const char*)Bt_; tstrideB = (size_t)BM * ldb * 2; }
    __device__ __forceinline__ bool next(int i, Unit& u) const {
        const long L = (long)(i >> rsh) * G + c; if (L >= nwg || L >= lim) return false;
        int wgid = (int)L; { const int q = nwg / NXCD, r = nwg % NXCD, xcd = wgid % NXCD, off = wgid / NXCD; wgid = (xcd < r ? xcd * (q + 1) : r * (q + 1) + (xcd - r) * q) + off; }
        const int nig = WGM * nN, gid = wgid / nig, fm = gid * WGM, gsz = (nM - fm) < WGM ? (nM - fm) : WGM;
        u.pm = fm + ((wgid % nig) % gsz); u.pn = (wgid % nig) / gsz; u.B = Bt + (size_t)u.pn * tstrideB; return true;
    }
    __device__ __forceinline__ unsigned arow_off(int) const { return 0u; }
    __device__ __forceinline__ unsigned arow_fin(unsigned t) const { return t; }
};
struct SplitKOrder {
    static constexpr bool GATHER = false;
    int c; const char* Bt;
    __device__ __forceinline__ bool next(int i, Unit& u) const { if (i > 0) return false; u.pm = c >> 2; u.pn = c & 3; u.B = Bt; return true; }
    __device__ __forceinline__ unsigned arow_off(int) const { return 0u; }
    __device__ __forceinline__ unsigned arow_fin(unsigned t) const { return t; }
};
template <bool GATHER_, int NCT, int LDA, size_t ESTRIDE, size_t TSTRIDE> struct MoeOrder {
    static constexpr bool GATHER = GATHER_;
    const MoeTab* mt; const int* LIST; int G, c; const char* W; int rsh = 0;
    __device__ __forceinline__ bool next(int i, Unit& u) const {
        const int L = (i >> rsh) * G + c; const int total = __builtin_amdgcn_readfirstlane(mt->tstart[NEXP]) * NCT; if (L >= total) return false;
        const int rt = L / NCT, ct = L % NCT; u.pm = rt; u.pn = ct; const int e = __builtin_amdgcn_readfirstlane(mt->texp[rt]); u.B = W + (size_t)e * ESTRIDE + (size_t)ct * TSTRIDE; return true;
    }
    __device__ __forceinline__ unsigned arow_off(int r) const {
        const int e = mt->texp[r >> 8]; const int pos = r - mt->tstart[e] * 256; const bool ok = pos < mt->cnt[e]; const int tok = LIST[(size_t)e * T + (ok ? pos : 0)]; return ok ? (unsigned)tok : 0u;
    }
    __device__ __forceinline__ unsigned arow_fin(unsigned t) const { return t * (unsigned)(LDA * 2); }
};

struct MoeOrder2 {
    static constexpr bool GATHER = false;
    const MoeTab* mt; int G, c, R, rtA; const char* W; int rsh = 0;
    __device__ __forceinline__ bool next(int i0, Unit& u) const {
        const int i = i0 >> rsh; int u2;
        if (c < R) { if (i >= 2) return false; u2 = rtA * 8 + 2 * c + i; }
        else { u2 = (c - R) + i * (G - R); if (u2 >= rtA * 8) return false; }
        const int rt = u2 >> 3, ct = u2 & 7; u.pm = rt; u.pn = ct; const int e = __builtin_amdgcn_readfirstlane(mt->texp[rt]);
        u.B = W + (size_t)e * ((size_t)DM * DEXP) + (size_t)ct * ((size_t)256 * DEXP); return true;
    }
    __device__ __forceinline__ unsigned arow_off(int) const { return 0u; }
    __device__ __forceinline__ unsigned arow_fin(unsigned t) const { return t; }
};
__device__ __forceinline__ void moe_wait_dep(unsigned* rtc, int c, int G, int R, int rtA) {
    const int tid = otid();
    if (tid < 64) {
        int rt = -1;
        if (c < R) { if (tid < 2) rt = rtA + ((2 * c + tid) >> 3); } else if (tid < 32) { const int u2 = (c - R) + tid * (G - R); if (u2 < rtA * 8) rt = u2 >> 3; }
        unsigned spins = 0;
        for (;;) {
            const bool ok = rt < 0 || __hip_atomic_load(rtc + (rt < 0 ? 0 : rt) * 32, __ATOMIC_RELAXED, __HIP_MEMORY_SCOPE_AGENT) >= 32u;
            if (__all(ok)) break;
            __builtin_amdgcn_s_sleep(2); if (++spins > (1u << 22)) break;
        }
        __builtin_amdgcn_fence(__ATOMIC_ACQUIRE, "agent");
        asm volatile("s_waitcnt vmcnt(0)" ::: "memory");
    }
    __syncthreads();
}

template <class E, class = void> struct EpiI8 { static constexpr bool v = false; };
template <class E> struct EpiI8<E, decltype((void)E::I8)> { static constexpr bool v = E::I8; };
template <class E> constexpr bool epi_i8() { return EpiI8<E>::v; }
__device__ __forceinline__ i32x4_t half4i(const i32x8_t& v, int k) { return k ? __builtin_shufflevector(v, v, 4, 5, 6, 7) : __builtin_shufflevector(v, v, 0, 1, 2, 3); }
template <class Epi, class Sched>
__device__ __forceinline__ void gemm_mfma(LAS unsigned char* lds, const bf16_t* A, int lda, int ldb, int K, const Sched& S, const Epi& E) {
    constexpr bool GATHER = Sched::GATHER;
    const int tid = otid(), wid = __builtin_amdgcn_readfirstlane(tid >> 6), lane = tid & 63, wr = wid >> 2, wc = wid & 3, fr = lane & 15, fq = lane >> 4;
    const int nt = K / BK;
    int Rst[2], Cst[2]; unsigned voffB[2], voA[2][2], voAn[2][2];
#pragma unroll
    for (int i = 0; i < 2; ++i) { stage_rc(tid * 16 + i * 8192, Rst[i], Cst[i]); const int Rb = Epi::PERM ? ((Rst[i] & ~31) + perm32(Rst[i] & 31)) : Rst[i];
        voffB[i] = (unsigned)(Rb * ldb + Cst[i]) * 2u;
#pragma unroll
        for (int h = 0; h < 2; ++h) { voA[h][i] = (unsigned)((h * HALF + Rst[i]) * lda + Cst[i]) * 2u; voAn[h][i] = voA[h][i]; } }
    const size_t kstep = (size_t)(BK * 2), hstepB = (size_t)HALF * ldb * 2, tstepA = (size_t)BM * lda * 2;
    const unsigned ldsw = (unsigned)wid * 1024u;
    const int aoff = lds_byte(wr * 64 + fr, fq * 8), boff = lds_byte(wc * 32 + fr, fq * 8);
#define G8_SA(b, h) (((b) * 2 + (h)) * HTB)
#define G8_SB(b, h) ((4 + (b) * 2 + (h)) * HTB)
#define G8_OPQ(x) ({ unsigned _o = (x); asm volatile("" : "+v"(_o)); _o; })
#define G8_STAGE_B(bufoff, gbase) do { _Pragma("unroll") for (int _i = 0; _i < 2; ++_i) \
        __builtin_amdgcn_global_load_lds((const unsigned*)((const char*)(gbase) + G8_OPQ(voffB[_i])), (LAS unsigned*)(lds + (bufoff) + ldsw + _i * 8192), 16, 0, 0); } while (0)
#define G8_STAGE_A(bufoff, gbase, o0, o1) do { \
        __builtin_amdgcn_global_load_lds((const unsigned*)((const char*)(gbase) + G8_OPQ(o0)), (LAS unsigned*)(lds + (bufoff) + ldsw), 16, 0, 0); \
        __builtin_amdgcn_global_load_lds((const unsigned*)((const char*)(gbase) + G8_OPQ(o1)), (LAS unsigned*)(lds + (bufoff) + ldsw + 8192), 16, 0, 0); } while (0)
#define G8_LDA(dst, b, h) do { _Pragma("unroll") for (int m = 0; m < 4; ++m) dst[m] = cat8(*(const LAS bf16x8*)(lds + G8_SA(b, h) + aoff + m * 2048), *(const LAS bf16x8*)(lds + G8_SA(b, h) + aoff + m * 2048 + 1024)); } while (0)
#define G8_LDB(dst, b, h) do { _Pragma("unroll") for (int n = 0; n < 2; ++n) dst[n] = cat8(*(const LAS bf16x8*)(lds + G8_SB(b, h) + boff + n * 2048), *(const LAS bf16x8*)(lds + G8_SB(b, h) + boff + n * 2048 + 1024)); } while (0)
#define G8_MMA(ai, bj, At, Bt) do { __builtin_amdgcn_s_setprio(1); \
        if constexpr (epi_i8<Epi>()) { _Pragma("unroll") for (int m = 0; m < 4; ++m) _Pragma("unroll") for (int n = 0; n < 2; ++n) _Pragma("unroll") for (int k = 0; k < 2; ++k) \
            acc[ai][bj][m][n] = __builtin_bit_cast(f32x4, __builtin_amdgcn_mfma_i32_16x16x64_i8(half4i(Bt[n], k), half4i(At[m], k), __builtin_bit_cast(i32x4_t, acc[ai][bj][m][n]), 0, 0, 0)); } \
        else if constexpr (Epi::F8) { _Pragma("unroll") for (int m = 0; m < 4; ++m) _Pragma("unroll") for (int n = 0; n < 2; ++n) \
            mfma_f8(acc[ai][bj][m][n], Bt[n], At[m]); } \
        else { _Pragma("unroll") for (int m = 0; m < 4; ++m) _Pragma("unroll") for (int n = 0; n < 2; ++n) _Pragma("unroll") for (int k = 0; k < 2; ++k) \
            acc[ai][bj][m][n] = __builtin_amdgcn_mfma_f32_16x16x32_bf16(half8(Bt[n], k), half8(At[m], k), acc[ai][bj][m][n], 0, 0, 0); } \
        __builtin_amdgcn_s_setprio(0); } while (0)
#define G8_WAIT_V(n) asm volatile("s_waitcnt vmcnt(" #n ")" ::: "memory")
#define G8_WAIT_L(n) asm volatile("s_waitcnt lgkmcnt(" #n ")" ::: "memory")
#define G8_BAR __builtin_amdgcn_s_barrier()
#define G8_SCHED __builtin_amdgcn_sched_barrier(0)
    Unit cur, nxt; int ui = 0, prev_pm = -1;
    if (!S.next(0, cur)) return;
    Acc acc;
#pragma unroll
    for (int a = 0; a < 2; ++a)
#pragma unroll
        for (int b = 0; b < 2; ++b)
#pragma unroll
            for (int m = 0; m < 4; ++m)
#pragma unroll
                for (int n = 0; n < 2; ++n) acc[a][b][m][n] = (f32x4){0.f, 0.f, 0.f, 0.f};
    i32x8_t At[4], B0[2], B1[2];
    const char* cA; const char* cB = cur.B;
    if (GATHER) { cA = (const char*)A;
#pragma unroll
        for (int h = 0; h < 2; ++h)
#pragma unroll
            for (int i = 0; i < 2; ++i) voA[h][i] = S.arow_off(cur.pm * BM + h * HALF + Rst[i]);
        __builtin_amdgcn_sched_barrier(0);
#pragma unroll
        for (int h = 0; h < 2; ++h)
#pragma unroll
            for (int i = 0; i < 2; ++i) voA[h][i] = S.arow_fin(voA[h][i]) + (unsigned)Cst[i] * 2u;
    } else cA = (const char*)A + (size_t)cur.pm * tstepA;
    G8_STAGE_B(G8_SB(0, 0), cB); G8_STAGE_A(G8_SA(0, 0), cA, voA[0][0], voA[0][1]); G8_STAGE_B(G8_SB(0, 1), cB + hstepB); G8_STAGE_A(G8_SA(0, 1), cA, voA[1][0], voA[1][1]);
    if (wr == 1) G8_BAR;
    G8_WAIT_V(4); G8_BAR;
    G8_STAGE_B(G8_SB(1, 0), cB + kstep); G8_STAGE_A(G8_SA(1, 0), cA + kstep, voA[0][0], voA[0][1]); G8_STAGE_B(G8_SB(1, 1), cB + hstepB + kstep);
    G8_WAIT_V(6); G8_BAR;
    for (;;) {
        const bool has_next = S.next(ui + 1, nxt);
        const char* nA; const char* nB = has_next ? nxt.B : cB;
        if (GATHER) { nA = cA;
            if (has_next) {
#pragma unroll
                for (int h = 0; h < 2; ++h)
#pragma unroll
                    for (int i = 0; i < 2; ++i) voAn[h][i] = S.arow_off(nxt.pm * BM + h * HALF + Rst[i]);
                __builtin_amdgcn_sched_barrier(0);
#pragma unroll
                for (int h = 0; h < 2; ++h)
#pragma unroll
                    for (int i = 0; i < 2; ++i) voAn[h][i] = S.arow_fin(voAn[h][i]) + (unsigned)Cst[i] * 2u;
            } else {
#pragma unroll
                for (int h = 0; h < 2; ++h)
#pragma unroll
                    for (int i = 0; i < 2; ++i) voAn[h][i] = voA[h][i];
            }
        } else nA = has_next ? (const char*)A + (size_t)nxt.pm * tstepA : cA;
        for (int t = 0; t < nt; t += 2) {
            const bool last = (t == nt - 2);
            const char* a1 = cA + (size_t)(t + 1) * kstep;
            const char* a2 = last ? nA : cA + (size_t)(t + 2) * kstep; const char* b2 = last ? nB : cB + (size_t)(t + 2) * kstep;
            const char* a3 = a2 + kstep; const char* b3 = b2 + kstep;
            unsigned o00 = voA[0][0], o01 = voA[0][1], o10 = voA[1][0], o11 = voA[1][1];
            if (GATHER) { if (last) { o00 = voAn[0][0]; o01 = voAn[0][1]; o10 = voAn[1][0]; o11 = voAn[1][1]; } }
            G8_LDB(B0, 0, 0); G8_SCHED; G8_LDA(At, 0, 0); G8_STAGE_A(G8_SA(1, 1), a1, voA[1][0], voA[1][1]);
            G8_WAIT_L(8); G8_BAR; G8_WAIT_L(0); G8_MMA(0, 0, At, B0); G8_BAR; G8_SCHED;
            G8_LDB(B1, 0, 1); G8_STAGE_B(G8_SB(0, 0), b2);
            G8_BAR; G8_WAIT_L(0); G8_MMA(0, 1, At, B1); G8_BAR;
            G8_LDA(At, 0, 1); G8_STAGE_A(G8_SA(0, 0), a2, o00, o01);
            G8_BAR; G8_WAIT_L(0); G8_MMA(1, 0, At, B0); G8_BAR; G8_SCHED;
            G8_STAGE_B(G8_SB(0, 1), b2 + hstepB);
            G8_WAIT_V(6);
            if constexpr (Epi::PUBLISH) { if (prev_pm >= 0) { E.publish(prev_pm); prev_pm = -1; } }
            G8_BAR; G8_MMA(1, 1, At, B1); G8_BAR;
            G8_LDB(B0, 1, 0); G8_SCHED; G8_LDA(At, 1, 0); G8_STAGE_A(G8_SA(0, 1), a2, o10, o11);
            G8_WAIT_L(8); G8_BAR; G8_WAIT_L(0); G8_MMA(0, 0, At, B0); G8_BAR; G8_SCHED;
            G8_LDB(B1, 1, 1); G8_STAGE_B(G8_SB(1, 0), b3);
            G8_BAR; G8_WAIT_L(0); G8_MMA(0, 1, At, B1); G8_BAR;
            G8_LDA(At, 1, 1); G8_STAGE_A(G8_SA(1, 0), a3, o00, o01);
            G8_BAR; G8_WAIT_L(0); G8_MMA(1, 0, At, B0); G8_BAR; G8_SCHED;
            G8_STAGE_B(G8_SB(1, 1), b3 + hstepB);
            G8_WAIT_V(6); G8_BAR; G8_MMA(1, 1, At, B1); G8_BAR;
        }
        if constexpr (Epi::F8) {
#define G8_TIE(a, b, txt) asm volatile(txt : "+v"(acc[a][b][0][0]), "+v"(acc[a][b][0][1]), "+v"(acc[a][b][1][0]), "+v"(acc[a][b][1][1]), "+v"(acc[a][b][2][0]), "+v"(acc[a][b][2][1]), "+v"(acc[a][b][3][0]), "+v"(acc[a][b][3][1]))
            G8_TIE(0, 0, ""); G8_TIE(0, 1, ""); G8_TIE(1, 0, "s_nop 7"); G8_TIE(1, 1, "s_nop 15\n\ts_nop 7");
#undef G8_TIE
        }
        if constexpr (epi_i8<Epi>()) {
            const int rb_ = cur.pm * BM + wr * 64 + fr, cb_ = E.ctile(cur) * BM + wc * 32 + 8 * fq;
            float sa_[2][4]; f32x4 sb_[2][2];
#pragma unroll
            for (int a = 0; a < 2; ++a)
#pragma unroll
                for (int m = 0; m < 4; ++m) sa_[a][m] = E.sa[rb_ + a * HALF + m * 16];
#pragma unroll
            for (int b = 0; b < 2; ++b)
#pragma unroll
                for (int n = 0; n < 2; ++n) { const u32x4 cw = *(const u32x4*)(E.cm + cb_ + b * HALF + 4 * n);
                    sb_[b][n] = (f32x4){__uint_as_float(cw.x), __uint_as_float(cw.y), __uint_as_float(cw.z), __uint_as_float(cw.w)} * (1.0f / 127.0f); }
#pragma unroll
            for (int a = 0; a < 2; ++a)
#pragma unroll
                for (int b = 0; b < 2; ++b)
#pragma unroll
                    for (int m = 0; m < 4; ++m)
#pragma unroll
                        for (int n = 0; n < 2; ++n) { const i32x4_t q = __builtin_bit_cast(i32x4_t, acc[a][b][m][n]);
                            acc[a][b][m][n] = (f32x4){(float)q[0], (float)q[1], (float)q[2], (float)q[3]} * sb_[b][n] * sa_[a][m]; }
        }
        if constexpr (Epi::ASCALE != 1.0f) {
#pragma unroll
            for (int a = 0; a < 2; ++a)
#pragma unroll
                for (int b = 0; b < 2; ++b)
#pragma unroll
                    for (int m = 0; m < 4; ++m)
#pragma unroll
                        for (int n = 0; n < 2; ++n) acc[a][b][m][n] *= Epi::ASCALE;
        }
        E(acc, cur, wr, wc, fr, fq);
        if constexpr (Epi::PUBLISH) prev_pm = cur.pm;
        if (!has_next) break;
#pragma unroll
        for (int a = 0; a < 2; ++a)
#pragma unroll
            for (int b = 0; b < 2; ++b)
#pragma unroll
                for (int m = 0; m < 4; ++m)
#pragma unroll
                    for (int n = 0; n < 2; ++n) acc[a][b][m][n] = (f32x4){0.f, 0.f, 0.f, 0.f};
        cur = nxt; cA = nA; cB = nB; ++ui;
        if (GATHER) {
#pragma unroll
            for (int h = 0; h < 2; ++h)
#pragma unroll
                for (int i = 0; i < 2; ++i) voA[h][i] = voAn[h][i];
        }
    }
    G8_WAIT_V(0);
    if constexpr (Epi::PUBLISH) { if (prev_pm >= 0) { E.publish(prev_pm); prev_pm = -1; } }
    if (wr == 0) G8_BAR;
    G8_BAR;
#undef G8_SA
#undef G8_SB
#undef G8_STAGE_A
#undef G8_STAGE_B
#undef G8_OPQ
#undef G8_LDA
#undef G8_LDB
#undef G8_MMA
#undef G8_WAIT_V
#undef G8_WAIT_L
#undef G8_BAR
#undef G8_SCHED
}

__device__ __forceinline__ u32x4 pack8(const f32x4& a, const f32x4& b) { u32x4 w; w.x = cvt_pk_bf16(a[0], a[1]); w.y = cvt_pk_bf16(a[2], a[3]); w.z = cvt_pk_bf16(b[0], b[1]); w.w = cvt_pk_bf16(b[2], b[3]); return w; }
__device__ __forceinline__ u32x4 subtile_T(LAS bf16_t* Tw, const f32x4& a, const f32x4& b, int fr, int fq, int lane) {
#pragma unroll
    for (int j = 0; j < 4; ++j) { Tw[(8 * fq + j) * 16 + fr] = f2bf(a[j]); Tw[(8 * fq + 4 + j) * 16 + fr] = f2bf(b[j]); }
    asm volatile("" ::: "memory");
    const u32x4 r = *(const LAS u32x4*)(Tw + (lane >> 1) * 16 + (lane & 1) * 8);
    asm volatile("" ::: "memory");
    return r;
}
template <bool F8_> struct MEpiProjT { static constexpr bool PERM = true, PUBLISH = false, F8 = false, I8 = F8_; static constexpr float ASCALE = 1.0f; bf16_t* PROJ; bf16_t* VT; LAS float* KX; const float* gq; const float* gk; const float* sa; const unsigned* cm;
    __device__ __forceinline__ int ctile(const Unit& u) const { return u.pn; }
    __device__ __forceinline__ void operator()(const Acc& acc, const Unit& u, int wr, int wc, int fr, int fq) const {
        const int row0 = u.pm * BM + wr * 64 + fr;
        if (u.pn >= C_K / 256 && u.pn < DPROJ / 256) {
#pragma unroll
            for (int ai = 0; ai < 2; ++ai)
#pragma unroll
                for (int m = 0; m < 4; ++m)
#pragma unroll
                    for (int bj = 0; bj < 2; ++bj) {
                        const f32x4 a = acc[ai][bj][m][0], b = acc[ai][bj][m][1];
                        float ss = a[0] * a[0] + a[1] * a[1] + a[2] * a[2] + a[3] * a[3] + b[0] * b[0] + b[1] * b[1] + b[2] * b[2] + b[3] * b[3];
                        ss += __shfl_xor(ss, 16); ss += __shfl_xor(ss, 32);
                        if (fq == 0) KX[((ai * HALF + wr * 64 + m * 16 + fr) * 2 + bj) * 4 + wc] = ss;
                    }
            asm volatile("s_waitcnt lgkmcnt(0)" ::: "memory"); __builtin_amdgcn_s_barrier(); asm volatile("" ::: "memory");
            const int col0 = u.pn * BM + wc * 32 + 8 * fq;
            f32x4 g0[2], g1[2];
#pragma unroll
            for (int bj = 0; bj < 2; ++bj) { const int d0 = wc * 32 + 8 * fq; g0[bj] = *(const f32x4*)(gq + d0) * *(const f32x4*)(gk + d0); g1[bj] = *(const f32x4*)(gq + d0 + 4) * *(const f32x4*)(gk + d0 + 4); }
#pragma unroll
            for (int ai = 0; ai < 2; ++ai)
#pragma unroll
                for (int m = 0; m < 4; ++m) { bf16_t* rowp = PROJ + (size_t)(row0 + ai * HALF + m * 16) * DPROJ + col0;
#pragma unroll
                    for (int bj = 0; bj < 2; ++bj) { const f32x4 p4 = *(const LAS f32x4*)(KX + ((ai * HALF + wr * 64 + m * 16 + fr) * 2 + bj) * 4);
                        const float rs = rsqrtf(((p4[0] + p4[1]) + (p4[2] + p4[3])) * (1.0f / HD) + EPS);
                        *(u32x4*)(rowp + bj * HALF) = pack8(acc[ai][bj][m][0] * g0[bj] * rs, acc[ai][bj][m][1] * g1[bj] * rs); } }
            return;
        }
        if (u.pn < DPROJ / 256) {
            const int col0 = u.pn * BM + wc * 32 + 8 * fq;
#pragma unroll
            for (int ai = 0; ai < 2; ++ai)
#pragma unroll
                for (int m = 0; m < 4; ++m) { bf16_t* rowp = PROJ + (size_t)(row0 + ai * HALF + m * 16) * DPROJ + col0;
#pragma unroll
                    for (int bj = 0; bj < 2; ++bj) *(u32x4*)(rowp + bj * HALF) = pack8(acc[ai][bj][m][0], acc[ai][bj][m][1]); }
        } else {
            const int lane = fq * 16 + fr, cl = lane >> 1, hf = lane & 1; LAS bf16_t* Tw = (LAS bf16_t*)KX + (wr * 4 + wc) * 512;
            const int cc0 = (u.pn - DPROJ / 256) * BM + wc * 32 + cl;
#pragma unroll
            for (int ai = 0; ai < 2; ++ai)
#pragma unroll
                for (int m = 0; m < 4; ++m) { const int rowb = u.pm * BM + wr * 64 + ai * HALF + m * 16, b = rowb >> 12, s = (rowb & (SEQ - 1)) + hf * 8;
#pragma unroll
                    for (int bj = 0; bj < 2; ++bj) { const int cc = cc0 + bj * HALF;
                        const u32x4 w = subtile_T(Tw, acc[ai][bj][m][0], acc[ai][bj][m][1], fr, fq, lane);
                        *(u32x4*)(VT + ((size_t)(b * NHS + (cc >> 7)) * HD + (cc & 127)) * VTS + s) = w; } }
        }
    } };
template <bool F8_> struct MEpiPartT { static constexpr bool PERM = true, PUBLISH = false, F8 = false, I8 = F8_; static constexpr float ASCALE = 1.0f; bf16_t* PT; LAS float* KX; const float* sa; const unsigned* cm;
    __device__ __forceinline__ int ctile(const Unit&) const { return 20; }
    __device__ __forceinline__ void operator()(const Acc& acc, const Unit& u, int wr, int wc, int fr, int fq) const {
        const int lane = fq * 16 + fr, cl = lane >> 1, hf = lane & 1; LAS bf16_t* Tw = (LAS bf16_t*)KX + (wr * 4 + wc) * 512;
        bf16_t* base0 = PT + (size_t)(u.pm * 4 + u.pn) * 65536 + (size_t)(wc * 32 + cl) * 256 + wr * 64 + hf * 8;
#pragma unroll
        for (int ai = 0; ai < 2; ++ai)
#pragma unroll
            for (int m = 0; m < 4; ++m)
#pragma unroll
                for (int bj = 0; bj < 2; ++bj) {
                    const u32x4 w = subtile_T(Tw, acc[ai][bj][m][0], acc[ai][bj][m][1], fr, fq, lane);
                    *(u32x4*)(base0 + (size_t)(bj * HALF) * 256 + ai * HALF + m * 16) = w; }
    } };
__device__ __forceinline__ u32x4 pair16(unsigned a0, unsigned a1, unsigned b0, unsigned b1) {
    const auto s0 = __builtin_amdgcn_permlane16_swap(a0, b0, false, false); const auto s1 = __builtin_amdgcn_permlane16_swap(a1, b1, false, false);
    return (u32x4){s0[0], s1[0], s0[1], s1[1]};
}
__device__ __forceinline__ f32x4 silu_mul(const f32x4& g, const f32x4& u) { f32x4 r;
#pragma unroll
    for (int j = 0; j < 4; ++j) r[j] = g[j] * sigmoidf_(g[j]) * u[j];
    return r; }
struct MEpiGU { static constexpr bool PERM = true, PUBLISH = true, F8 = true; static constexpr float ASCALE = 1.0f; unsigned char* HID; const float* LISTR; const MoeTab* mt; unsigned* rtc; int n1early;
    __device__ __forceinline__ void operator()(const Acc& acc, const Unit& u, int wr, int wc, int fr, int fq) const {
        const int row0 = u.pm * BM + wr * 64 + fr, col0 = u.pn * HALF + wc * 32 + 8 * fq;
        const int e = __builtin_amdgcn_readfirstlane(mt->texp[u.pm]), cnt = __builtin_amdgcn_readfirstlane(mt->cnt[e]), pb = __builtin_amdgcn_readfirstlane(mt->tstart[e]) * 256;
        const float* lr = LISTR + (size_t)e * T;
        const __amdgpu_buffer_rsrc_t rsrc = __builtin_amdgcn_make_buffer_rsrc(HID, 0, (int)((size_t)PADROWS * DEXP), 0x00020000);
        float rsv[2][4];
#pragma unroll
        for (int ai = 0; ai < 2; ++ai)
#pragma unroll
            for (int m = 0; m < 4; ++m) { const int pos = row0 + ai * HALF + m * 16 - pb; rsv[ai][m] = lr[pos < cnt ? pos : 0]; }
        __builtin_amdgcn_sched_barrier(0);
#pragma unroll
        for (int ai = 0; ai < 2; ++ai)
#pragma unroll
            for (int mp = 0; mp < 2; ++mp) { int w[2][2];
#pragma unroll
                for (int mm = 0; mm < 2; ++mm) { const int m = 2 * mp + mm;
                    const int row = row0 + ai * HALF + m * 16, pos = row - pb;
                    const float rs = pos < cnt ? rsv[ai][m] * (1.0f / (SX8 * SW1)) : 0.f;
                    const f32x4 h0 = silu_mul(acc[ai][0][m][0] * rs, acc[ai][1][m][0] * rs) * SH8, h1 = silu_mul(acc[ai][0][m][1] * rs, acc[ai][1][m][1] * rs) * SH8;
                    int w0 = 0, w1 = 0;
                    w0 = __builtin_amdgcn_cvt_pk_fp8_f32(__builtin_amdgcn_fmed3f(h0[0], -448.f, 448.f), __builtin_amdgcn_fmed3f(h0[1], -448.f, 448.f), w0, false); w0 = __builtin_amdgcn_cvt_pk_fp8_f32(__builtin_amdgcn_fmed3f(h0[2], -448.f, 448.f), __builtin_amdgcn_fmed3f(h0[3], -448.f, 448.f), w0, true);
                    w1 = __builtin_amdgcn_cvt_pk_fp8_f32(__builtin_amdgcn_fmed3f(h1[0], -448.f, 448.f), __builtin_amdgcn_fmed3f(h1[1], -448.f, 448.f), w1, false); w1 = __builtin_amdgcn_cvt_pk_fp8_f32(__builtin_amdgcn_fmed3f(h1[2], -448.f, 448.f), __builtin_amdgcn_fmed3f(h1[3], -448.f, 448.f), w1, true);
                    w[mm][0] = w0; w[mm][1] = w1; }
                __builtin_amdgcn_raw_buffer_store_b128(pair16((unsigned)w[0][0], (unsigned)w[0][1], (unsigned)w[1][0], (unsigned)w[1][1]), rsrc, (row0 + ai * HALF + mp * 32 + 16 * (fq & 1)) * DEXP + (u.pn * HALF + wc * 32 + 16 * (fq >> 1)), 0, 16);
            }
    }
    __device__ __forceinline__ void publish(int pm) const {
        if ((otid() & 63) == 0) __hip_atomic_fetch_add(rtc + pm * 32, 1u, __ATOMIC_RELAXED, __HIP_MEMORY_SCOPE_AGENT);
    } };
struct MEpiDown { static constexpr bool PERM = true, PUBLISH = false, F8 = false; static constexpr float ASCALE = 1.0f; bf16_t* YPAD;
    __device__ __forceinline__ void operator()(const Acc& acc, const Unit& u, int wr, int wc, int fr, int fq) const {
        const int row0 = u.pm * BM + wr * 64 + fr, col0 = u.pn * BM + wc * 32 + 8 * fq;
#pragma unroll
        for (int ai = 0; ai < 2; ++ai)
#pragma unroll
            for (int m = 0; m < 4; ++m) { bf16_t* rowp = YPAD + (size_t)(row0 + ai * HALF + m * 16) * DM + col0;
#pragma unroll
                for (int bj = 0; bj < 2; ++bj) *(u32x4*)(rowp + bj * HALF) = pack8(acc[ai][bj][m][0], acc[ai][bj][m][1]); }
    } };
template <bool XF32, bool F8_> struct MEpiOut { static constexpr bool STAMP = false, PERM = true, PUBLISH = false, F8 = F8_; static constexpr float ASCALE = F8_ ? 1.0f / (SY8 * SWO) : 1.0f; const float* Xf; const bf16_t* Xb; bf16_t* X1; unsigned char* X18;
    __device__ __forceinline__ void operator()(const Acc& acc, const Unit& u, int wr, int wc, int fr, int fq) const {
        const int row0 = u.pm * BM + wr * 64 + fr, col0 = u.pn * BM + wc * 32 + 8 * fq;
        const int row8 = u.pm * BM + wr * 64 + fr + 16 * (fq & 1), col8 = u.pn * BM + wc * 32 + 16 * (fq >> 1);
#pragma unroll
        for (int ai = 0; ai < 2; ++ai) {
            f32x4 xa[4][2][2]; u32x4 xh[4][2];
#pragma unroll
            for (int m = 0; m < 4; ++m)
#pragma unroll
                for (int bj = 0; bj < 2; ++bj) { const size_t o = (size_t)(row0 + ai * HALF + m * 16) * DM + col0 + bj * HALF;
                    if (XF32) { xa[m][bj][0] = *(const f32x4*)(Xf + o); xa[m][bj][1] = *(const f32x4*)(Xf + o + 4); } else xh[m][bj] = *(const u32x4*)(Xb + o); }
            __builtin_amdgcn_sched_barrier(0);
#pragma unroll
            for (int mp = 0; mp < 2; ++mp)
#pragma unroll
                for (int bj = 0; bj < 2; ++bj) { int w8[2][2];
#pragma unroll
                    for (int mm = 0; mm < 2; ++mm) { const int m = 2 * mp + mm; const size_t o = (size_t)(row0 + ai * HALF + m * 16) * DM + col0 + bj * HALF;
                        f32x4 a = acc[ai][bj][m][0], b = acc[ai][bj][m][1];
                        if (XF32) { a += xa[m][bj][0]; b += xa[m][bj][1]; }
                        else { const u32x4 w = xh[m][bj]; a[0] += bflo(w.x); a[1] += bfhi(w.x); a[2] += bflo(w.y); a[3] += bfhi(w.y); b[0] += bflo(w.z); b[1] += bfhi(w.z); b[2] += bflo(w.w); b[3] += bfhi(w.w); }
                        *(u32x4*)(X1 + o) = pack8(a, b);
                        int w0 = 0, w1 = 0;
                        w0 = __builtin_amdgcn_cvt_pk_fp8_f32(sat8(a[0] * SX8), sat8(a[1] * SX8), w0, false); w0 = __builtin_amdgcn_cvt_pk_fp8_f32(sat8(a[2] * SX8), sat8(a[3] * SX8), w0, true);
                        w1 = __builtin_amdgcn_cvt_pk_fp8_f32(sat8(b[0] * SX8), sat8(b[1] * SX8), w1, false); w1 = __builtin_amdgcn_cvt_pk_fp8_f32(sat8(b[2] * SX8), sat8(b[3] * SX8), w1, true);
                        w8[mm][0] = w0; w8[mm][1] = w1; }
                    *(u32x4*)(X18 + (size_t)(row8 + ai * HALF + mp * 32) * DM + col8 + bj * HALF) = pair16((unsigned)w8[0][0], (unsigned)w8[0][1], (unsigned)w8[1][0], (unsigned)w8[1][1]); }
        }
    } };
constexpr float YSCALE = YSCALE_G;
struct MEpiDown8 { static constexpr bool PERM = true, PUBLISH = false, F8 = true; static constexpr float ASCALE = 1.0f; unsigned char* Y8;
    __device__ __forceinline__ void operator()(const Acc& acc, const Unit& u, int wr, int wc, int fr, int fq) const {
        const int row0 = u.pm * BM + wr * 64 + fr + 16 * (fq & 1), col0 = u.pn * BM + wc * 32 + 16 * (fq >> 1);
#pragma unroll
        for (int ai = 0; ai < 2; ++ai)
#pragma unroll
            for (int mp = 0; mp < 2; ++mp)
#pragma unroll
                for (int bj = 0; bj < 2; ++bj) { int w[2][2];
#pragma unroll
                    for (int mm = 0; mm < 2; ++mm) { const int m = 2 * mp + mm; const f32x4 a = acc[ai][bj][m][0] * (YSCALE / (SH8 * SW2)), b = acc[ai][bj][m][1] * (YSCALE / (SH8 * SW2)); int w0 = 0, w1 = 0;
                        w0 = __builtin_amdgcn_cvt_pk_fp8_f32(sat8(a[0]), sat8(a[1]), w0, false); w0 = __builtin_amdgcn_cvt_pk_fp8_f32(sat8(a[2]), sat8(a[3]), w0, true);
                        w1 = __builtin_amdgcn_cvt_pk_fp8_f32(sat8(b[0]), sat8(b[1]), w1, false); w1 = __builtin_amdgcn_cvt_pk_fp8_f32(sat8(b[2]), sat8(b[3]), w1, true); w[mm][0] = w0; w[mm][1] = w1; }
                    *(u32x4*)(Y8 + (size_t)(row0 + ai * HALF + mp * 32) * DM + col0 + bj * HALF) = pair16((unsigned)w[0][0], (unsigned)w[0][1], (unsigned)w[1][0], (unsigned)w[1][1]); }
    } };
}

__device__ __forceinline__ void phase_convb(const Ctx& c, int l) {
    const int gt = obid() * 512 + otid(), ng = gridDim.x * 512, sub = gt & 15;
    const float* cw = c.in[10] + (size_t)l * 3 * DCONV; const bf16_t* PROJ = c.PROJ();
    const int ch0 = ((gt >> 4) & 3) * HD + sub * 8;
    f32x4 wv0[3], wv1[3];
#pragma unroll
    for (int tap = 0; tap < 3; ++tap) { wv0[tap] = *(const f32x4*)(cw + tap * DCONV + ch0); wv1[tap] = *(const f32x4*)(cw + tap * DCONV + ch0 + 4); }
    const f32x4 m0 = *(const f32x4*)(c.in[13] + (size_t)l * DM + DLRU + ch0), m1 = *(const f32x4*)(c.in[13] + (size_t)l * DM + DLRU + ch0 + 4);
    __builtin_amdgcn_sched_barrier(0);
#pragma unroll 2
    for (int item = gt >> 4; item < T * 4; item += ng >> 4) {
        const int t = item >> 2, hh = item & 3, ch = hh * HD + sub * 8, s = t & (SEQ - 1);
        u32x4 cg[3], xb[3];
#pragma unroll
        for (int tap = 0; tap < 3; ++tap) { const int ds = (s + tap - 2 >= 0) ? tap - 2 : 0; const bf16_t* row = PROJ + (size_t)(t + ds) * DPROJ; cg[tap] = *(const u32x4*)(row + C_CG + ch); xb[tap] = *(const u32x4*)(row + C_XB + ch); }
        const u32x4 bg = *(const u32x4*)(PROJ + (size_t)t * DPROJ + C_BG + ch);
        float acc[8] = {0, 0, 0, 0, 0, 0, 0, 0};
#pragma unroll
        for (int tap = 0; tap < 3; ++tap) {
            {   const float mk = (s + tap - 2 >= 0) ? 1.0f : 0.0f;
                const f32x4 w0 = wv0[tap] * mk, w1 = wv1[tap] * mk;
                acc[0] += w0[0] * bflo(cg[tap].x) * bflo(xb[tap].x); acc[1] += w0[1] * bfhi(cg[tap].x) * bfhi(xb[tap].x); acc[2] += w0[2] * bflo(cg[tap].y) * bflo(xb[tap].y); acc[3] += w0[3] * bfhi(cg[tap].y) * bfhi(xb[tap].y);
                acc[4] += w1[0] * bflo(cg[tap].z) * bflo(xb[tap].z); acc[5] += w1[1] * bfhi(cg[tap].z) * bfhi(xb[tap].z); acc[6] += w1[2] * bflo(cg[tap].w) * bflo(xb[tap].w); acc[7] += w1[3] * bfhi(cg[tap].w) * bfhi(xb[tap].w);
            }
        }
        acc[0] *= bflo(bg.x); acc[1] *= bfhi(bg.x); acc[2] *= bflo(bg.y); acc[3] *= bfhi(bg.y); acc[4] *= bflo(bg.z); acc[5] *= bfhi(bg.z); acc[6] *= bflo(bg.w); acc[7] *= bfhi(bg.w);
        float ss = 0.f;
#pragma unroll
        for (int i = 0; i < 8; ++i) ss += acc[i] * acc[i];
        ss += __shfl_xor(ss, 1); ss += __shfl_xor(ss, 2); ss += __shfl_xor(ss, 4); ss += __shfl_xor(ss, 8);
        const float rstd = rsqrtf(ss * (1.0f / HD) + EPS);
        if (f8out(l)) { *(u32x2*)((unsigned char*)c.YMIX() + (size_t)t * DM + DLRU + ch) = y8pack(acc[0] * rstd * m0[0], acc[1] * rstd * m0[1], acc[2] * rstd * m0[2], acc[3] * rstd * m0[3], acc[4] * rstd * m1[0], acc[5] * rstd * m1[1], acc[6] * rstd * m1[2], acc[7] * rstd * m1[3]); }
        else {
        u32x4 o; o.x = cvt_pk_bf16(acc[0] * rstd * m0[0], acc[1] * rstd * m0[1]); o.y = cvt_pk_bf16(acc[2] * rstd * m0[2], acc[3] * rstd * m0[3]);
        o.z = cvt_pk_bf16(acc[4] * rstd * m1[0], acc[5] * rstd * m1[1]); o.w = cvt_pk_bf16(acc[6] * rstd * m1[2], acc[7] * rstd * m1[3]);
        *(u32x4*)(c.YMIX() + (size_t)t * DM + DLRU + ch) = o; }
    }
}
typedef float f32x16 __attribute__((ext_vector_type(16)));
#define MFMA32(a, b, c) __builtin_amdgcn_mfma_f32_32x32x16_bf16((a), (b), (c), 0, 0, 0)
constexpr int XCS = 776;
__device__ __forceinline__ void phase_lruA(const Ctx& c, int l, unsigned char* ldsb) {
    constexpr bool PASS2 = false;
    bf16_t* XC = (bf16_t*)ldsb; bf16_t* PR = (bf16_t*)(ldsb + 99328); bf16_t* HL = c.HL(); bf16_t* PL = c.PL();
    const int tid = otid(), lane = tid & 63, wv = tid >> 6, hh = lane >> 5, l31 = lane & 31;
    const float* cw = c.in[3] + (size_t)l * 4 * DLRU; const float* cb = c.in[4] + (size_t)l * DLRU;
    const bf16_t* PROJ = c.PROJ(); float* AGG = c.AGG();
    typedef float f32x2_t __attribute__((ext_vector_type(2)));
    for (int tile = obid(); tile < T / 64; tile += gridDim.x) {
        const int t0 = tile * 64, s0 = t0 & (SEQ - 1), tb = tile & 63;
        if (tid < 480) {
            const int cg = tid % 48, tslot = tid / 48, ch = cg * 16;
            float w[4][16], bias[16];
#pragma unroll
            for (int i = 0; i < 16; i += 4) { *(f32x4*)&bias[i] = *(const f32x4*)(cb + ch + i);
#pragma unroll
                for (int tap = 0; tap < 4; ++tap) *(f32x4*)&w[tap][i] = *(const f32x4*)(cw + tap * DLRU + ch + i); }
#pragma unroll
            for (int it = 0; it < 7; ++it) {
                const int tokr = tslot + 10 * it, tok = tokr < 64 ? tokr : 63;
                u32x4 x0[4], x1[4]; float msk[4];
#pragma unroll
                for (int tap = 0; tap < 4; ++tap) {
                    const int ds = tap - 3; const bool ok = (s0 + tok + ds >= 0); msk[tap] = ok ? 1.0f : 0.0f;
                    const bf16_t* row = PROJ + (size_t)(t0 + tok + (ok ? ds : 0)) * DPROJ + C_XA + ch;
                    x0[tap] = *(const u32x4*)row; x1[tap] = *(const u32x4*)(row + 8);
                }
                float a[16];
#pragma unroll
                for (int i = 0; i < 16; ++i) a[i] = bias[i];
#pragma unroll
                for (int tap = 0; tap < 4; ++tap) {
                    const float m = msk[tap];
                    a[0] += m * w[tap][0] * bflo(x0[tap].x); a[1] += m * w[tap][1] * bfhi(x0[tap].x); a[2] += m * w[tap][2] * bflo(x0[tap].y); a[3] += m * w[tap][3] * bfhi(x0[tap].y);
                    a[4] += m * w[tap][4] * bflo(x0[tap].z); a[5] += m * w[tap][5] * bfhi(x0[tap].z); a[6] += m * w[tap][6] * bflo(x0[tap].w); a[7] += m * w[tap][7] * bfhi(x0[tap].w);
                    a[8] += m * w[tap][8] * bflo(x1[tap].x); a[9] += m * w[tap][9] * bfhi(x1[tap].x); a[10] += m * w[tap][10] * bflo(x1[tap].y); a[11] += m * w[tap][11] * bfhi(x1[tap].y);
                    a[12] += m * w[tap][12] * bflo(x1[tap].z); a[13] += m * w[tap][13] * bfhi(x1[tap].z); a[14] += m * w[tap][14] * bflo(x1[tap].w); a[15] += m * w[tap][15] * bfhi(x1[tap].w);
                }
                u32x4 o0, o1; o0.x = cvt_pk_bf16(a[0], a[1]); o0.y = cvt_pk_bf16(a[2], a[3]); o0.z = cvt_pk_bf16(a[4], a[5]); o0.w = cvt_pk_bf16(a[6], a[7]);
                o1.x = cvt_pk_bf16(a[8], a[9]); o1.y = cvt_pk_bf16(a[10], a[11]); o1.z = cvt_pk_bf16(a[12], a[13]); o1.w = cvt_pk_bf16(a[14], a[15]);
                if (tokr < 64) { *(u32x4*)(XC + tok * XCS + ch) = o0; *(u32x4*)(XC + tok * XCS + ch + 8) = o1; }
            }
        }
        __syncthreads();
#pragma unroll 1
        for (int i = 0; i < 3; ++i) {
            const int hd = 2 * i + (wv >> 2), ntw = wv & 3, chl = 32 * ntw + l31, ch = hd * HD + chl;
            const bf16_t* wa = c.WA(l) + ((size_t)hd * HD + chl) * HD + 8 * hh; const bf16_t* wx = c.WX(l) + ((size_t)hd * HD + chl) * HD + 8 * hh;
            const float bal = c.in[6][l * DLRU + ch] * -1.4426950408889634f, bxl = c.in[8][l * DLRU + ch] * -1.4426950408889634f, c8l = -8.0f * 1.4426950408889634f * softplusf_(-c.in[9][l * DLRU + ch]);
            float sst = 0.f, Pt = 1.f;
            float hreg[2][16], preg[2][16];
            bf16x8 bRf[8], bIf[8];
#pragma unroll
            for (int s = 0; s < 8; ++s) { bRf[s] = *(const bf16x8*)(wa + 16 * s); bIf[s] = *(const bf16x8*)(wx + 16 * s); }
            __builtin_amdgcn_sched_barrier(0);
#pragma unroll
            for (int half = 0; half < 2; ++half) {
                float av[16], uv[16];
                {
                    f32x16 accR, accI;
#pragma unroll
                    for (int r = 0; r < 16; ++r) { accR[r] = 0.f; accI[r] = 0.f; }
#pragma unroll
                    for (int s = 0; s < 8; ++s) {
                        const bf16x8 a = *(const bf16x8*)(XC + (32 * half + l31) * XCS + hd * HD + 16 * s + 8 * hh);
                        accR = MFMA32(a, bRf[s], accR); accI = MFMA32(a, bIf[s], accI);
                    }
#pragma unroll
                    for (int r = 0; r < 16; ++r) {
                        const int tok = 32 * half + (r & 3) + 8 * (r >> 2) + 4 * hh;
                        const float xc = bf2f(XC[tok * XCS + ch]);
                        const float rg = __builtin_amdgcn_rcpf(1.0f + __builtin_amdgcn_exp2f(__builtin_fmaf(accR[r], -1.4426950408889634f, bal))), ig = __builtin_amdgcn_rcpf(1.0f + __builtin_amdgcn_exp2f(__builtin_fmaf(accI[r], -1.4426950408889634f, bxl)));
                        av[r] = __builtin_amdgcn_exp2f(c8l * rg); uv[r] = __builtin_amdgcn_sqrtf(__builtin_fmaf(-av[r], av[r], 1.0f)) * (ig * xc);
                    }
                }
                float Pp[4], Hp[4];
#pragma unroll
                for (int g = 0; g < 4; ++g) { float P = 1.f, H = 0.f;
#pragma unroll
                    for (int r = 4 * g; r < 4 * g + 4; ++r) { H = av[r] * H + uv[r]; P *= av[r]; }
                    Pp[g] = __shfl_xor(P, 32); Hp[g] = __shfl_xor(H, 32); }
#pragma unroll
                for (int g = 0; g < 4; ++g) {
                    if (hh == 0) {
#pragma unroll
                        for (int r = 4 * g; r < 4 * g + 4; ++r) { sst = av[r] * sst + uv[r]; Pt *= av[r]; hreg[half][r] = sst; preg[half][r] = Pt; }
                        sst = Pp[g] * sst + Hp[g]; Pt *= Pp[g];
                    } else {
                        sst = Pp[g] * sst + Hp[g]; Pt *= Pp[g];
#pragma unroll
                        for (int r = 4 * g; r < 4 * g + 4; ++r) { sst = av[r] * sst + uv[r]; Pt *= av[r]; hreg[half][r] = sst; preg[half][r] = Pt; }
                    }
                }
            }
            if (hh == 0) { f32x2_t o; o.x = Pt; o.y = sst; ((f32x2_t*)AGG)[(size_t)tile * DLRU + ch] = o; }
            __syncthreads();
#pragma unroll
            for (int half = 0; half < 2; ++half)
#pragma unroll
                for (int r = 0; r < 16; ++r) { const int tok = 32 * half + (r & 3) + 8 * (r >> 2) + 4 * hh;
                    XC[tok * XCS + ch] = f2bf(hreg[half][r]); PR[tok * 264 + (wv >> 2) * HD + chl] = f2bf(preg[half][r]); }
            __syncthreads();
#pragma unroll
            for (int k = 0; k < 4; ++k) {
                const int item = tid + 512 * k, tok = item >> 5, g = item & 31, hs = g >> 4, sub = g & 15, cc = (2 * i + hs) * HD + sub * 8;
                *(u32x4*)(HL + (size_t)(t0 + tok) * DLRU + cc) = *(const u32x4*)(XC + tok * XCS + cc);
                *(u32x4*)(PL + (size_t)(t0 + tok) * DLRU + cc) = *(const u32x4*)(PR + tok * 264 + hs * HD + sub * 8);
            }
        }
        __syncthreads();
    }
}

__device__ __forceinline__ void phase_lruB(const Ctx& c, int l, unsigned char* ldsb) {
    float* HIN = (float*)ldsb;
    const int tid = otid();
    const bf16_t* PROJ = c.PROJ(); const float* AGG = c.AGG(); const bf16_t* HL = c.HL(); const bf16_t* PL = c.PL();
    typedef float f32x2_t __attribute__((ext_vector_type(2)));
    for (int tile = obid(); tile < T / 64; tile += gridDim.x) {
        const int t0 = tile * 64, tb = tile & 63;
        {
            const f32x2_t* ag = (const f32x2_t*)AGG + (size_t)(tile - tb) * DLRU;
            const int chb = 512 + (tid & 255);
            float ha = 0.f, hb = 0.f;
#pragma unroll 1
            for (int k0 = 0; k0 < tb; k0 += 16) {
                f32x2_t pa[16], pb_[16];
#pragma unroll
                for (int k = 0; k < 16; ++k) { const int kk = (k0 + k < tb) ? k0 + k : tb - 1; pa[k] = ag[(size_t)kk * DLRU + tid]; pb_[k] = ag[(size_t)kk * DLRU + chb]; }
                __builtin_amdgcn_sched_barrier(0);
#pragma unroll
                for (int k = 0; k < 16; ++k) { const bool ok = (k0 + k < tb); const float ax = ok ? pa[k].x : 1.0f, ay = ok ? pa[k].y : 0.0f, bx_ = ok ? pb_[k].x : 1.0f, by_ = ok ? pb_[k].y : 0.0f;
                    ha = ax * ha + ay; hb = bx_ * hb + by_; }
            }
            HIN[tid] = ha; if (tid < 256) HIN[chb] = hb;
        }
        __syncthreads();
        const int wv_ = tid >> 6, wit0 = wv_ < 4 ? 8 * wv_ : 32 + 16 * (wv_ - 4), wcnt = wv_ < 4 ? 8 : 16;
#define LB_ADDR(it_, tok_, cc_) const int item_##it_ = (wit0 + (it_)) * 64 + (tid & 63), tok_ = item_##it_ / 96, rem_##it_ = item_##it_ % 96, cc_ = (rem_##it_ >> 4) * HD + (rem_##it_ & 15) * 8
#define LB_LOAD(H_, P_, G_, tok_, cc_) do { H_ = *(const u32x4*)(HL + (size_t)(t0 + tok_) * DLRU + cc_); P_ = *(const u32x4*)(PL + (size_t)(t0 + tok_) * DLRU + cc_); G_ = *(const u32x4*)(PROJ + (size_t)(t0 + tok_) * DPROJ + C_GA + cc_); \
            G_##m0 = *(const f32x4*)(c.in[13] + (size_t)l * DM + cc_); G_##m1 = *(const f32x4*)(c.in[13] + (size_t)l * DM + cc_ + 4); } while (0)
#define LB_BODY(hv, pv, ga, tok, cc) do { \
            const f32x4 i0 = *(const f32x4*)(HIN + cc), i1 = *(const f32x4*)(HIN + cc + 4); \
            float y[8] = {(bflo(hv.x) + bflo(pv.x) * i0[0]) * gelu_tanh(bflo(ga.x)), (bfhi(hv.x) + bfhi(pv.x) * i0[1]) * gelu_tanh(bfhi(ga.x)), \
                          (bflo(hv.y) + bflo(pv.y) * i0[2]) * gelu_tanh(bflo(ga.y)), (bfhi(hv.y) + bfhi(pv.y) * i0[3]) * gelu_tanh(bfhi(ga.y)), \
                          (bflo(hv.z) + bflo(pv.z) * i1[0]) * gelu_tanh(bflo(ga.z)), (bfhi(hv.z) + bfhi(pv.z) * i1[1]) * gelu_tanh(bfhi(ga.z)), \
                          (bflo(hv.w) + bflo(pv.w) * i1[2]) * gelu_tanh(bflo(ga.w)), (bfhi(hv.w) + bfhi(pv.w) * i1[3]) * gelu_tanh(bfhi(ga.w))}; \
            float ss = 0.f; \
            _Pragma("unroll") for (int k = 0; k < 8; ++k) ss += y[k] * y[k]; \
            ss += __shfl_xor(ss, 1); ss += __shfl_xor(ss, 2); ss += __shfl_xor(ss, 4); ss += __shfl_xor(ss, 8); \
            const float rstd = rsqrtf(ss * (1.0f / HD) + EPS); \
            const f32x4 m0 = ga##m0, m1 = ga##m1; \
            if (f8out(l)) { *(u32x2*)((unsigned char*)c.YMIX() + (size_t)(t0 + tok) * DM + cc) = y8pack(y[0] * rstd * m0[0], y[1] * rstd * m0[1], y[2] * rstd * m0[2], y[3] * rstd * m0[3], y[4] * rstd * m1[0], y[5] * rstd * m1[1], y[6] * rstd * m1[2], y[7] * rstd * m1[3]); } \
            else { u32x4 o; o.x = cvt_pk_bf16(y[0] * rstd * m0[0], y[1] * rstd * m0[1]); o.y = cvt_pk_bf16(y[2] * rstd * m0[2], y[3] * rstd * m0[3]); \
            o.z = cvt_pk_bf16(y[4] * rstd * m1[0], y[5] * rstd * m1[1]); o.w = cvt_pk_bf16(y[6] * rstd * m1[2], y[7] * rstd * m1[3]); \
            *(u32x4*)(c.YMIX() + (size_t)(t0 + tok) * DM + cc) = o; } } while (0)
        {
            u32x4 hA, pA, gA, hB, pB, gB; f32x4 gAm0, gAm1, gBm0, gBm1;
            { LB_ADDR(0, tk_, cc_); LB_LOAD(hA, pA, gA, tk_, cc_); }
#pragma unroll 1
            for (int it = 0; it < wcnt; it += 2) {
                LB_ADDR(it, tkA, ccA); const int itb = it + 1; LB_ADDR(itb, tkB, ccB);
                LB_LOAD(hB, pB, gB, tkB, ccB); __builtin_amdgcn_sched_barrier(0);
                LB_BODY(hA, pA, gA, tkA, ccA);
                if (it + 2 < wcnt) { const int itc = it + 2; LB_ADDR(itc, tkC, ccC); LB_LOAD(hA, pA, gA, tkC, ccC); } __builtin_amdgcn_sched_barrier(0);
                LB_BODY(hB, pB, gB, tkB, ccB);
            }
        }
#undef LB_ADDR
#undef LB_LOAD
#undef LB_BODY
        __syncthreads();
    }
}

__device__ __forceinline__ void phase_vreduce(const Ctx& c) {
    const bf16_t* PT = c.PT(); bf16_t* VT = c.VT();
    for (int item = obid() * 512 + otid(); item < 64 * 256 * 32; item += gridDim.x * 512) {
        const int ro = item & 31, col = (item >> 5) & 255, u = item >> 13;
        const bf16_t* p = PT + (size_t)(u * 4) * 65536 + col * 256 + ro * 8;
        float a[8] = {0, 0, 0, 0, 0, 0, 0, 0};
#pragma unroll
        for (int kq = 0; kq < 4; ++kq) { const u32x4 w = *(const u32x4*)(p + (size_t)kq * 65536);
            a[0] += bflo(w.x); a[1] += bfhi(w.x); a[2] += bflo(w.y); a[3] += bfhi(w.y); a[4] += bflo(w.z); a[5] += bfhi(w.z); a[6] += bflo(w.w); a[7] += bfhi(w.w); }
        const int b = u >> 4, s0 = (u & 15) * 256 + ro * 8, h = 4 + (col >> 7), d = col & 127;
        u32x4 o; o.x = cvt_pk_bf16(a[0], a[1]); o.y = cvt_pk_bf16(a[2], a[3]); o.z = cvt_pk_bf16(a[4], a[5]); o.w = cvt_pk_bf16(a[6], a[7]);
        *(u32x4*)(VT + ((size_t)(b * NHS + h) * HD + d) * VTS + s0) = o;
    }
}

__device__ __forceinline__ void phase_attn(const Ctx& c, int l, unsigned char* ldsb) {
    const int lane = otid() & 63, wv = otid() >> 6, hh = lane >> 5, l31 = lane & 31;
    const bf16_t* PROJ = c.PROJ(); const bf16_t* VT = c.VT();
    const int prow = (l31 & ~12) | ((l31 & 4) << 1) | ((l31 & 8) >> 1);
    unsigned char* wl = ldsb + wv * 16384;
    const int kwbase = (lane >> 4) * 256 + (((lane & 15) ^ (lane >> 4)) * 16);
    const int vwoff = (lane >> 2) * 64 + (((lane & 3) ^ (lane >> 4)) * 16);
    const int kroff = prow * 256;
    const int nwt = NB * NHS * (SEQ / 32);
    const int nper = (nwt + (int)gridDim.x - 1) / (int)gridDim.x, wt0 = obid() * nper, wt1 = (wt0 + nper < nwt) ? wt0 + nper : nwt;
    for (int wt = wt0 + wv; wt < wt1; wt += 8) {
        const int qt = wt % (SEQ / 32), bh = wt / (SEQ / 32), b = bh / NHS, h = bh % NHS, q0 = qt * 32;
        const bf16_t* qp = PROJ + (size_t)(b * SEQ + q0 + l31) * DPROJ + C_Q + h * HD + 8 * hh;
        bf16x8 bq[8];
#pragma unroll
        for (int s = 0; s < 8; ++s) bq[s] = *(const bf16x8*)(qp + 16 * s);
        {
            float qs = 0.f;
#pragma unroll
            for (int s = 0; s < 8; ++s) { const u32x4 w = __builtin_bit_cast(u32x4, bq[s]);
                qs += bflo(w.x) * bflo(w.x) + bfhi(w.x) * bfhi(w.x) + bflo(w.y) * bflo(w.y) + bfhi(w.y) * bfhi(w.y) + bflo(w.z) * bflo(w.z) + bfhi(w.z) * bfhi(w.z) + bflo(w.w) * bflo(w.w) + bfhi(w.w) * bfhi(w.w); }
            qs += __shfl_xor(qs, 32);
            const float sc = rsqrtf(qs * (1.0f / HD) + EPS) * (1.4426950408889634f * 0.08838834764831845f);
#pragma unroll
            for (int s = 0; s < 8; ++s) { const u32x4 w = __builtin_bit_cast(u32x4, bq[s]); u32x4 o;
                o.x = cvt_pk_bf16(bflo(w.x) * sc, bfhi(w.x) * sc); o.y = cvt_pk_bf16(bflo(w.y) * sc, bfhi(w.y) * sc); o.z = cvt_pk_bf16(bflo(w.z) * sc, bfhi(w.z) * sc); o.w = cvt_pk_bf16(bflo(w.w) * sc, bfhi(w.w) * sc);
                bq[s] = __builtin_bit_cast(bf16x8, o); }
        }
        f32x16 O[4];
#pragma unroll
        for (int m = 0; m < 4; ++m)
#pragma unroll
            for (int r = 0; r < 16; ++r) O[m][r] = 0.f;
        float carry = 0.f;
        const bf16_t* kgl = PROJ + (size_t)(b * SEQ + (lane >> 4)) * DPROJ + C_K + h * HD + (lane & 15) * 8;
        const bf16_t* vgl = VT + ((size_t)bh * HD + (lane >> 2)) * VTS + (lane & 3) * 8;
        u32x4 stK[8], stV[8];
#define ATT_LOAD(kk0) do { _Pragma("unroll") for (int j = 0; j < 8; ++j) { \
            stK[j] = *(const u32x4*)(kgl + (size_t)((kk0) + 4 * j) * DPROJ); stV[j] = *(const u32x4*)(vgl + (size_t)(16 * j) * VTS + (kk0)); } } while (0)
        ATT_LOAD(q0);
        for (int k0 = q0; k0 >= 0; k0 -= 32) {
#pragma unroll
            for (int j = 0; j < 8; ++j) { *(u32x4*)(wl + j * 1024 + (kwbase ^ (64 * (j & 3)))) = stK[j]; *(u32x4*)(wl + 8192 + vwoff + j * 1024) = stV[j]; }
            const int kn = k0 >= 32 ? k0 - 32 : k0;
            ATT_LOAD(kn);
            __builtin_amdgcn_sched_barrier(0);
            f32x16 S;
#pragma unroll
            for (int r = 0; r < 16; ++r) S[r] = 0.f;
            __builtin_amdgcn_s_setprio(1);
#pragma unroll
            for (int s = 0; s < 8; ++s) { const bf16x8 ak = *(const bf16x8*)(wl + kroff + (((2 * s + hh) ^ (prow & 15)) * 16)); S = MFMA32(ak, bq[s], S); }
            __builtin_amdgcn_s_setprio(0);
            const bool diag = (k0 == q0);
            float sp[16];
            float R0 = 0.f, R1 = 0.f;
#pragma unroll
            for (int r = 0; r < 16; ++r) {
                const int kk = 16 * (r >> 3) + 8 * hh + (r & 7);
                const float z = S[r];
                float v = fmaxf(z, 0.f) + __builtin_amdgcn_logf(1.0f + __builtin_amdgcn_exp2f(-fabsf(z)));
                if (diag && kk >= l31) v = 0.f;
                sp[r] = v;
                if (r < 8) R0 += v; else R1 += v;
            }
            const float R0p = __shfl_xor(R0, 32), R1p = __shfl_xor(R1, 32);
            float suf_hi = carry - (hh == 0 ? R1p : 0.f);
            float suf_lo = carry - R1 - R1p - (hh == 0 ? R0p : 0.f);
            float w[16];
#pragma unroll
            for (int r = 15; r >= 8; --r) { w[r] = __builtin_amdgcn_exp2f(S[r] - sp[r] + suf_hi); suf_hi -= sp[r]; }
#pragma unroll
            for (int r = 7; r >= 0; --r) { w[r] = __builtin_amdgcn_exp2f(S[r] - sp[r] + suf_lo); suf_lo -= sp[r]; }
            if (diag) {
#pragma unroll
                for (int r = 0; r < 16; ++r) { const int kk = 16 * (r >> 3) + 8 * hh + (r & 7); if (kk >= l31) w[r] = 0.f; }
            }
            carry -= (R0 + R1 + R0p + R1p);
            bf16x8 wb[2];
            __builtin_amdgcn_sched_barrier(0);
#pragma unroll
            for (int s = 0; s < 2; ++s) { u32x4 pk; pk.x = cvt_pk_bf16(w[8 * s + 0], w[8 * s + 1]); pk.y = cvt_pk_bf16(w[8 * s + 2], w[8 * s + 3]); pk.z = cvt_pk_bf16(w[8 * s + 4], w[8 * s + 5]); pk.w = cvt_pk_bf16(w[8 * s + 6], w[8 * s + 7]);
                wb[s] = __builtin_bit_cast(bf16x8, pk); }
            __builtin_amdgcn_s_setprio(1);
#pragma unroll
            for (int m = 0; m < 4; ++m)
#pragma unroll
                for (int s = 0; s < 2; ++s) { const bf16x8 vtf = *(const bf16x8*)(wl + 8192 + (32 * m + l31) * 64 + (((2 * s + hh) ^ (((32 * m + l31) >> 2) & 3)) * 16)); O[m] = MFMA32(vtf, wb[s], O[m]); }
            __builtin_amdgcn_s_setprio(0);
            if (!__any(carry >= -150.1f)) break;
        }
        float ss = 0.f;
#pragma unroll
        for (int m = 0; m < 4; ++m)
#pragma unroll
            for (int r = 0; r < 16; ++r) ss += O[m][r] * O[m][r];
        ss += __shfl_xor(ss, 32);
        const float rstd = rsqrtf(ss * (1.0f / HD) + EPS);
        const float* mg = c.in[13] + (size_t)l * DM + DLRU + DCONV + h * HD + 4 * hh;
        f32x4 ggv[4][4];
#pragma unroll
        for (int m = 0; m < 4; ++m)
#pragma unroll
            for (int g = 0; g < 4; ++g) ggv[m][g] = *(const f32x4*)(mg + 32 * m + 8 * g);
        __builtin_amdgcn_sched_barrier(0);
        if (f8out(l)) {
            unsigned char* yp8 = (unsigned char*)c.YMIX() + (size_t)(b * SEQ + q0 + l31) * DM + DLRU + DCONV + h * HD + 8 * hh;
#pragma unroll
            for (int m = 0; m < 4; ++m)
#pragma unroll
                for (int gp = 0; gp < 2; ++gp) { unsigned d[2];
#pragma unroll
                    for (int gg_ = 0; gg_ < 2; ++gg_) { const int g = 2 * gp + gg_; const f32x4 gg = ggv[m][g]; int w = 0;
                        w = __builtin_amdgcn_cvt_pk_fp8_f32(sat8(O[m][4 * g] * rstd * gg[0] * SY8), sat8(O[m][4 * g + 1] * rstd * gg[1] * SY8), w, false); w = __builtin_amdgcn_cvt_pk_fp8_f32(sat8(O[m][4 * g + 2] * rstd * gg[2] * SY8), sat8(O[m][4 * g + 3] * rstd * gg[3] * SY8), w, true); d[gg_] = (unsigned)w; }
                    const auto sd = __builtin_amdgcn_permlane32_swap(d[0], d[1], false, false);
                    *(u32x2*)(yp8 + 32 * m + 16 * gp) = (u32x2){sd[0], sd[1]}; }
        } else {
        bf16_t* yp = c.YMIX() + (size_t)(b * SEQ + q0 + l31) * DM + DLRU + DCONV + h * HD + 8 * hh;
#pragma unroll
        for (int m = 0; m < 4; ++m)
#pragma unroll
            for (int gp = 0; gp < 2; ++gp) { u32x2 o[2];
#pragma unroll
                for (int gg_ = 0; gg_ < 2; ++gg_) { const int g = 2 * gp + gg_; const f32x4 gg = ggv[m][g];
                    o[gg_].x = cvt_pk_bf16(O[m][4 * g] * rstd * gg[0], O[m][4 * g + 1] * rstd * gg[1]); o[gg_].y = cvt_pk_bf16(O[m][4 * g + 2] * rstd * gg[2], O[m][4 * g + 3] * rstd * gg[3]); }
                const auto sx = __builtin_amdgcn_permlane32_swap(o[0].x, o[1].x, false, false); const auto sy = __builtin_amdgcn_permlane32_swap(o[0].y, o[1].y, false, false);
                *(u32x4*)(yp + 32 * m + 16 * gp) = (u32x4){sx[0], sy[0], sx[1], sy[1]};
            }
        }
    }
}

#define XB_TMO      128
#define XB_XCNT(j)  (256  + 64 * (j))
#define XB_XSUB(j)  (1280 + 64 * (j))
#define XB_XGEN(j)  (2304 + 64 * (j))
#define XB_TOP      3328
#define XB_TOPGEN   3392
#define XCD_BAR_WORDS 3456
#define XB_SPIN_CAP (1u << 18)
__device__ __forceinline__ unsigned xb_ld(unsigned* p)              { return __hip_atomic_load(p, __ATOMIC_RELAXED, __HIP_MEMORY_SCOPE_AGENT); }
__device__ __forceinline__ unsigned xb_add(unsigned* p, unsigned v) { return __hip_atomic_fetch_add(p, v, __ATOMIC_RELAXED, __HIP_MEMORY_SCOPE_AGENT); }
__device__ __forceinline__ unsigned xb_xcc_id() { return (unsigned)__builtin_amdgcn_s_getreg((3 << 11) | 20) & 0xFu; }
#define XB_SPIN(cond, bar) do { unsigned _sp = 0; while (cond) { __builtin_amdgcn_s_sleep(1); \
    if ((++_sp & 255u) == 0u) { if (xb_ld(&(bar)[XB_TMO])) break; if (_sp > XB_SPIN_CAP) { atomicAdd(&(bar)[XB_TMO], 1u); break; } } } } while (0)
struct XcdBarrier { unsigned* bar; unsigned x; volatile LAS unsigned* st; };
__device__ __forceinline__ XcdBarrier xcd_barrier_post(unsigned* bar, volatile LAS unsigned* st) {
    XcdBarrier b; b.bar = bar; b.x = xb_xcc_id(); b.st = st;
    if (threadIdx.x == 0) (void)xb_add(&bar[XB_XCNT(b.x)], 1u);
    return b;
}
__device__ __forceinline__ void xcd_barrier_complete(unsigned* bar, unsigned x, unsigned& nloc, unsigned& nx) {
    const unsigned G = gridDim.x * gridDim.y * gridDim.z;
    unsigned sum, cnt, mine, sp = 0u;
    for (;;) {
        sum = 0u; cnt = 0u; mine = 0u;
#pragma unroll
        for (unsigned j = 0; j < 16; ++j) { const unsigned c = xb_ld(&bar[XB_XCNT(j)]); sum += c; cnt += (c > 0u) ? 1u : 0u; mine = (j == x) ? c : mine; }
        if (sum == G) break;
        __builtin_amdgcn_s_sleep(1);
        if ((++sp & 255u) == 0u) { if (xb_ld(&bar[XB_TMO])) break; if (sp > XB_SPIN_CAP) { atomicAdd(&bar[XB_TMO], 1u); break; } }
    }
    nloc = mine > 0u ? mine : 1u; nx = cnt > 0u ? cnt : 1u;
}
__device__ __forceinline__ void xcd_barrier(const XcdBarrier& b) {
    asm volatile("s_waitcnt vmcnt(0)" ::: "memory");
    __syncthreads();
    if (threadIdx.x == 0) {
        unsigned* bar = b.bar;
        __builtin_amdgcn_s_waitcnt(0);
        unsigned nloc = b.st[0], nx = b.st[1];
        if (nloc == 0u) { xcd_barrier_complete(bar, b.x, nloc, nx); b.st[0] = nloc; b.st[1] = nx; }
        const unsigned old = xb_add(&bar[XB_XSUB(b.x)], 1u);
        const unsigned gen = old / nloc;
        if (old + 1u == (gen + 1u) * nloc) {
            __builtin_amdgcn_fence(__ATOMIC_RELEASE, "agent");
            asm volatile("s_waitcnt vmcnt(0)" ::: "memory");
            const unsigned og = xb_add(&bar[XB_TOP], 1u);
            const unsigned tg = og / nx;
            if (og + 1u == (tg + 1u) * nx) xb_add(&bar[XB_TOPGEN], 1u);
            else XB_SPIN(xb_ld(&bar[XB_TOPGEN]) == tg, bar);
            __builtin_amdgcn_fence(__ATOMIC_ACQUIRE, "agent");
            xb_add(&bar[XB_XGEN(b.x)], 1u);
            asm volatile("s_waitcnt vmcnt(0)" ::: "memory");
        } else {
            XB_SPIN(xb_ld(&bar[XB_XGEN(b.x)]) == gen, bar);
            __builtin_amdgcn_fence(__ATOMIC_ACQUIRE, "agent");
            asm volatile("s_waitcnt vmcnt(0)" ::: "memory");
        }
    }
    __syncthreads();
}

constexpr int NPH_LAYER = 7, NPH = 1 + DEPTH * NPH_LAYER;
constexpr int LDS_TAB = g8::STAGE_BYTES, LDS_BARW = g8::STAGE_BYTES + 2048, LDS_KX = g8::STAGE_BYTES + 4096, LDS_BYTES = g8::STAGE_BYTES + 4096 + 8192;
__global__ void __launch_bounds__(512, 2) mega(Params p) {
    extern __shared__ __attribute__((aligned(16))) unsigned char lds_raw[];
    float* lds = (float*)lds_raw;
    LAS unsigned char* ldsl = (LAS unsigned char*)lds_raw;
    MoeTab* mt = (MoeTab*)(lds_raw + LDS_TAB);
    Ctx c0; c0.in.p = p.in; c0.in.z = 0; c0.out = p.out; c0.ws = p.ws;
    const int lo = p.ph_lo, hi = p.ph_hi;
    if (threadIdx.x == 0) *(uint4*)(lds_raw + LDS_BARW) = make_uint4(0u, 0u, 0u, 0u);
    __syncthreads();
    XcdBarrier bar = xcd_barrier_post(c0.ctl(), (volatile LAS unsigned*)(ldsl + LDS_BARW));
#ifndef PH_MASK
#define PH_MASK 0x1ff
#endif
#define PHT(k) ((k) == 0 ? 0 : 1 + ((k) - 1) % NPH_LAYER)
#define IN(k) (((PH_MASK >> PHT(k)) & 1) && lo <= (k) && (k) < hi)
#define SEAM(k) do { if (IN(k) && IN((k) + 1)) xcd_barrier(bar); } while (0)
#ifndef PROBE_RSH
#define PROBE_RSH 0
#endif
#ifndef PROBE_DUP
#define PROBE_DUP 0x0
#endif
#define REP(k) for (int rep_ = 0; rep_ < (((PROBE_DUP >> PHT(k)) & 1) ? 2 : 1); ++rep_)
    REP(0) if (IN(0)) { if (rep_) xcd_barrier(bar); const Ctx c = octx(c0); if (F8_INPROJ_MASK != 0) { phase_colmax(c); xcd_barrier(bar); } phase_convert(c, lds); phase_norm_in(c, 0); }
    SEAM(0);
#define LAYER_BODY(l) { \
        const int pb = 1 + l * NPH_LAYER; \
        REP(pb + 0) if (IN(pb + 0)) { if (rep_) xcd_barrier(bar); const Ctx c = octx(c0); const bool split_ = (gridDim.x == 256); \
            constexpr bool f8_ = f8in(l); constexpr int ku_ = f8_ ? DM / 2 : DM, ld_ = pb_in(l) / 2;        \
            { g8::DenseOrder S; S.init(T, DIN, gridDim.x, obid(), c.WIN(l), ld_); if (split_) S.lim = 1280; g8::MEpiProjT<f8_> E{c.PROJ(), c.VT(), (LAS float*)(ldsl + LDS_KX), c.in[11] + l * HD, c.in[12] + l * HD, c.SA(), c.CM(l)}; g8::gemm_mfma(ldsl, c.HB(), ld_, ld_, ku_, S, E); } \
            if (split_) { const int cb_ = obid(), kq_ = cb_ & 3; int k4_ = ku_ / 4; asm volatile("" : "+s"(k4_)); g8::SplitKOrder S{cb_, (const char*)(c.WIN(l) + (size_t)(20 * 256) * ld_ + kq_ * (ku_ / 4))}; g8::MEpiPartT<f8_> E{c.PT(), (LAS float*)(ldsl + LDS_KX), c.SA(), c.CM(l)}; g8::gemm_mfma(ldsl, c.HB() + kq_ * (ku_ / 4), ld_, ld_, k4_, S, E); } } \
        SEAM(pb + 0); \
        REP(pb + 1) if (IN(pb + 1)) { if (rep_) xcd_barrier(bar); const Ctx c = octx(c0); if (gridDim.x == 256) phase_vreduce(c); phase_convb(c, l); if (PROBE_SUB == 4) phase_convb(c, l); phase_lruA(c, l, lds_raw); if (PROBE_SUB == 3) phase_lruA(c, l, lds_raw); } \
        SEAM(pb + 1); \
        REP(pb + 2) if (IN(pb + 2)) { if (rep_) xcd_barrier(bar); const Ctx c = octx(c0); phase_lruB(c, l, lds_raw); if (PROBE_SUB == 2) phase_lruB(c, l, lds_raw); phase_attn(c, l, lds_raw); if (PROBE_SUB == 1) phase_attn(c, l, lds_raw); } \
        SEAM(pb + 2); \
        REP(pb + 3) if (IN(pb + 3)) { if (rep_) xcd_barrier(bar); const Ctx c = octx(c0); constexpr bool f8o_ = f8out(l); constexpr int kuo_ = f8o_ ? DM / 2 : DM; g8::DenseOrder S; S.init(T, DM, gridDim.x, obid(), c.WOUT(l), kuo_); if (PROBE_RSH == 3 && l == 0) S.rsh = 1; g8::MEpiOut<l == 0, f8o_> E{c.in[0], c.XB(), c.X1(), c.X1F8()}; g8::gemm_mfma(ldsl, c.YMIX(), kuo_, kuo_, kuo_, S, E);       } \
        SEAM(pb + 3); \
        REP(pb + 4) if (IN(pb + 4)) { if (rep_) xcd_barrier(bar); const Ctx c = octx(c0); phase_router_mfma(c, l, lds); } \
        SEAM(pb + 4); \
        REP(pb + 5) if (IN(pb + 5)) { if (rep_) xcd_barrier(bar); const Ctx c = octx(c0); build_moe_tab(c, l, mt); \
            const int G_ = (int)gridDim.x, cb_ = obid(), n1_ = __builtin_amdgcn_readfirstlane(mt->tstart[NEXP]) * 4, R_ = n1_ % G_, n1e_ = n1_ - R_, rtA_ = n1e_ >> 2; \
            { g8::MoeOrder<true, 4, DM / 2, (size_t)1024 * DM, (size_t)256 * DM> S{mt, c.LIST(), G_, cb_, (const char*)c.WGU(l)}; g8::MEpiGU E{c.HID8(), c.LISTR(), mt, c.RTC(l), n1e_}; g8::gemm_mfma(ldsl, (const bf16_t*)c.X1F8(), DM / 2, DM / 2, DM / 2, S, E); }       \
            g8::moe_wait_dep(c.RTC(l), cb_, G_, R_, rtA_); \
            { g8::MoeOrder2 S{mt, G_, cb_, R_, rtA_, (const char*)c.WD(l)}; if (PROBE_RSH == 6) S.rsh = 1; g8::MEpiDown8 E{c.YPAD8()}; int k2_ = DEXP / 2; asm volatile("" : "+s"(k2_)); g8::gemm_mfma(ldsl, (const bf16_t*)c.HID8(), DEXP / 2, DEXP / 2, k2_, S, E); } }       \
        SEAM(pb + 5); \
        REP(pb + 6) if (IN(pb + 6)) { if (rep_) xcd_barrier(bar); const Ctx c = octx(c0); build_moe_tab(c, l, mt); if (PROBE_SUB == 6) { phase_combine<true>(c, l, mt); xcd_barrier(bar); } phase_combine<false>(c, l, mt); } \
        SEAM(pb + 6); \
    }
    LAYER_BODY(0)
    LAYER_BODY(1)
#undef LAYER_BODY
#undef IN
#undef SEAM
}

#ifndef N_LAUNCH_SPLIT
#define N_LAUNCH_SPLIT 0
#endif
extern "C" void kernel_launch(void* const* d_in, const int* in_sizes, int n_in, void* d_out, int out_size, void* d_ws, size_t ws_size, hipStream_t stream) {
    static int grid = 0;
    if (grid == 0) {
        if (n_in != 23 || out_size != T * DM || ws_size < WS_END) { fprintf(stderr, "kernel_launch: unexpected problem (n_in %d out %d ws %zu need %zu)\n", n_in, out_size, ws_size, (size_t)WS_END); grid = -1; return; }
        int dev = 0, cus = 0, per_cu = 0;
        if (hipGetDevice(&dev) != hipSuccess || hipDeviceGetAttribute(&cus, hipDeviceAttributeMultiprocessorCount, dev) != hipSuccess) { fprintf(stderr, "kernel_launch: device query failed\n"); grid = -1; return; }
        if (hipFuncSetAttribute((const void*)mega, hipFuncAttributeMaxDynamicSharedMemorySize, LDS_BYTES) != hipSuccess) { fprintf(stderr, "kernel_launch: hipFuncSetAttribute failed\n"); grid = -1; return; }
        if (hipOccupancyMaxActiveBlocksPerMultiprocessor(&per_cu, (const void*)mega, 512, LDS_BYTES) != hipSuccess || per_cu < 1) { fprintf(stderr, "kernel_launch: occupancy query says %d blocks per CU\n", per_cu); }
        (void)hipGetLastError();
        grid = cus;
    }
    if (grid < 0) return;
    (void)hipMemsetAsync((char*)d_ws + OFF_CTL, 0, SZ_CTL, stream);
    Params p{};
    for (int i = 0; i < 23; ++i) p.in[i] = (const float*)d_in[i];
    p.out = (float*)d_out; p.ws = (unsigned char*)d_ws;
    if (N_LAUNCH_SPLIT) { for (int ph = 0; ph < NPH; ++ph) { p.ph_lo = ph; p.ph_hi = ph + 1; hipLaunchKernelGGL(mega, dim3(grid), dim3(512), LDS_BYTES, stream, p); } }
    else { p.ph_lo = 0; p.ph_hi = NPH; hipLaunchKernelGGL(mega, dim3(grid), dim3(512), LDS_BYTES, stream, p); }
}
```
